# Optimizing an MI355X kernel written in HIP

```python
import math
import jax, jax.numpy as jnp
from jax import lax
import numpy as np

D_MODEL = 1024
BATCH = 2
SEQ = 8192
DEPTH = 2

CTX_LEN = 256
GRID_W = 64

HEAD_DIM = 64
ATTN_WIDTH = D_MODEL // 2
N_Q_HEADS = ATTN_WIDTH // HEAD_DIM
N_KV_HEADS = N_Q_HEADS // 4
WINDOW = 128
BLOCK = 128
ROPE_BASE = 10000.0
NEG_INF = -1e30

S5_WIDTH = D_MODEL // 4
S5_GROUP = 16
S5_GROUPS = S5_WIDTH // S5_GROUP
S5_STATE = 64

CONV_WIDTH = D_MODEL - ATTN_WIDTH - S5_WIDTH
CONV_K = 31

MIX_WIDTH = ATTN_WIDTH + S5_WIDTH + CONV_WIDTH
Q_END = ATTN_WIDTH
K_END = Q_END + N_KV_HEADS * HEAD_DIM
V_END = K_END + N_KV_HEADS * HEAD_DIM
U_END = V_END + S5_WIDTH
IN_WIDTH = U_END + 2 * CONV_WIDTH

N_EXPERTS = 16
EXPERT_FF = 2 * D_MODEL
CAPACITY_FACTOR = 2

DEEPNORM_ALPHA = (2.0 * DEPTH) ** 0.25
DEEPNORM_BETA = (8.0 * DEPTH) ** -0.25
LN_EPS = 1e-5

kernel_name = 'hybrid_s5_conformer_swa_ec_dit_block'


def layer_norm(x, g=None, b=None):
    x32 = x.astype(jnp.float32)
    mu = jnp.mean(x32, axis=-1, keepdims=True)
    var = jnp.mean(jnp.square(x32 - mu), axis=-1, keepdims=True)
    y = (x32 - mu) * lax.rsqrt(var + LN_EPS)
    if g is not None:
        y = y * g.astype(jnp.float32) + b.astype(jnp.float32)
    return y.astype(x.dtype)


def modulate(h, shift, scale):
    return h * (1 + scale) + shift


def rope_1d(x, pos):
    f = x.shape[-1] // 2
    inv_freq = ROPE_BASE ** (-jnp.arange(f, dtype=jnp.float32) / f)
    ang = pos.astype(jnp.float32)[:, None] * inv_freq
    cos = jnp.cos(ang)[None, :, None, :]
    sin = jnp.sin(ang)[None, :, None, :]
    x1 = x[..., :f].astype(jnp.float32)
    x2 = x[..., f:].astype(jnp.float32)
    return jnp.concatenate([x1 * cos - x2 * sin, x2 * cos + x1 * sin], axis=-1).astype(x.dtype)


def axial_rope(x, pos_row, pos_col):
    half = x.shape[-1] // 2
    return jnp.concatenate([rope_1d(x[..., :half], pos_row), rope_1d(x[..., half:], pos_col)], axis=-1)


def window_attention(q, k, v, k_ctx, v_ctx, sink):
    bsz, seq, n_q, dh = q.shape
    g = n_q // N_KV_HEADS
    nb = seq // BLOCK
    lc = k_ctx.shape[1]
    qb = q.reshape(bsz, nb, BLOCK, N_KV_HEADS, g, dh)

    def band(t):
        tp = jnp.pad(t, ((0, 0), (BLOCK, BLOCK), (0, 0), (0, 0))).reshape(bsz, nb + 2, BLOCK, N_KV_HEADS, dh)
        return jnp.concatenate([tp[:, :-2], tp[:, 1:-1], tp[:, 2:]], axis=2)

    k_win, v_win = band(k), band(v)
    scale = dh ** -0.5
    s_win = jnp.einsum('bnqhgd,bnkhd->bnhgqk', qb, k_win, preferred_element_type=jnp.float32) * scale
    qi = jnp.arange(BLOCK)
    kj = jnp.arange(3 * BLOCK)
    rel = (kj[None, :] - BLOCK) - qi[:, None]
    kpos = jnp.arange(nb)[:, None] * BLOCK - BLOCK + kj[None, :]
    mask = (jnp.abs(rel) <= WINDOW)[None] & ((kpos >= 0) & (kpos < seq))[:, None, :]
    s_win = jnp.where(mask[None, :, None, None], s_win, NEG_INF)
    s_ctx = jnp.einsum('bnqhgd,bkhd->bnhgqk', qb, k_ctx, preferred_element_type=jnp.float32) * scale
    s_sink = jnp.broadcast_to(sink.reshape(N_KV_HEADS, g, 1, 1).astype(jnp.float32), s_ctx.shape[:-1] + (1,))
    p = jax.nn.softmax(jnp.concatenate([s_win, s_ctx, s_sink], axis=-1), axis=-1)
    p_win = p[..., :3 * BLOCK].astype(v.dtype)
    p_ctx = p[..., 3 * BLOCK:3 * BLOCK + lc].astype(v.dtype)
    o = (jnp.einsum('bnhgqk,bnkhd->bnqhgd', p_win, v_win)
         + jnp.einsum('bnhgqk,bkhd->bnqhgd', p_ctx, v_ctx))
    return o.reshape(bsz, seq, n_q * dh)


def context_attention(q, k, v, sink):
    bsz, lc, n_q, dh = q.shape
    g = n_q // N_KV_HEADS
    qg = q.reshape(bsz, lc, N_KV_HEADS, g, dh)
    s = jnp.einsum('bqhgd,bkhd->bhgqk', qg, k, preferred_element_type=jnp.float32) * dh ** -0.5
    s_sink = jnp.broadcast_to(sink.reshape(N_KV_HEADS, g, 1, 1).astype(jnp.float32), s.shape[:-1] + (1,))
    p = jax.nn.softmax(jnp.concatenate([s, s_sink], axis=-1), axis=-1)[..., :lc].astype(v.dtype)
    return jnp.einsum('bhgqk,bkhd->bqhgd', p, v).reshape(bsz, lc, n_q * dh)


def _ssm_combine(e1, e2):
    a1, b1 = e1
    a2, b2 = e2
    return a1 * a2, a2 * b1 + b2


def s5_discretize(lam_re, lam_im, log_dt, b_re, b_im):
    lam = lax.complex(lam_re.astype(jnp.float32), lam_im.astype(jnp.float32))
    dt = jnp.exp(log_dt.astype(jnp.float32))[:, None]
    lbar = jnp.exp(lam * dt)
    bmat = lax.complex(b_re.astype(jnp.float32), b_im.astype(jnp.float32))
    bbar = ((lbar - 1) / lam)[..., None] * bmat
    return lbar, bbar


def s5_scan(u_c, lbar, bbar, h0, reverse):
    bu = jnp.einsum('blgc,gpc->blgp', u_c, bbar)
    if h0 is not None:
        bu = bu.at[:, -1 if reverse else 0].add(lbar * h0)
    a = jnp.broadcast_to(lbar, bu.shape)
    _, h = lax.associative_scan(_ssm_combine, (a, bu), reverse=reverse, axis=1)
    return h


def s5_mixer(u, lam_re, lam_im, log_dt, b_re, b_im, c_re, c_im, d_skip, h0, with_output):
    bsz, seq, _ = u.shape
    u_g = u.astype(jnp.float32).reshape(bsz, seq, S5_GROUPS, S5_GROUP)
    u_c = u_g.astype(jnp.complex64)
    y = d_skip.astype(jnp.float32).reshape(S5_GROUPS, S5_GROUP) * u_g if with_output else None
    finals = []
    for direction, reverse in enumerate((False, True)):
        lbar, bbar = s5_discretize(lam_re[direction], lam_im[direction], log_dt[direction],
                                   b_re[direction], b_im[direction])
        h = s5_scan(u_c, lbar, bbar, None if h0 is None else h0[direction], reverse)
        finals.append(h[:, 0] if reverse else h[:, -1])
        if with_output:
            cmat = lax.complex(c_re[direction].astype(jnp.float32), c_im[direction].astype(jnp.float32))
            y = y + jnp.real(jnp.einsum('blgp,gcp->blgc', h, cmat))
    if with_output:
        y = y.reshape(bsz, seq, S5_WIDTH).astype(u.dtype)
    return y, (finals[0], finals[1])


def s5_glu(y, w_glu, b_glu):
    z = jax.nn.gelu(y)
    return z * jax.nn.sigmoid(z @ w_glu + b_glu)


def conformer_conv(p, w_dw, b_dw, ln_g, ln_b, w_pw, b_pw):
    a, g = jnp.split(p, 2, axis=-1)
    h = a * jax.nn.sigmoid(g)
    h = lax.conv_general_dilated(h, w_dw, window_strides=(1,), padding=[(CONV_K // 2, CONV_K // 2)],
                                 dimension_numbers=('NWC', 'WIO', 'NWC'),
                                 feature_group_count=CONV_WIDTH) + b_dw
    h = jax.nn.silu(layer_norm(h, ln_g, ln_b))
    return h @ w_pw + b_pw


def expert_choice(h, w_router, w_gate, w_up, w_down):
    bsz, n, d = h.shape
    cap = CAPACITY_FACTOR * n // N_EXPERTS
    aff = jax.nn.softmax(jnp.einsum('bnd,de->ben', h, w_router, preferred_element_type=jnp.float32), axis=1)
    gates, idx = lax.top_k(aff, cap)
    xs = jax.vmap(lambda hb, ib: hb[ib])(h, idx)
    hid = (jax.nn.silu(jnp.einsum('becd,edf->becf', xs, w_gate))
           * jnp.einsum('becd,edf->becf', xs, w_up))
    y = jnp.einsum('becf,efd->becd', hid, w_down) * gates[..., None].astype(h.dtype)
    return jax.vmap(lambda ib, yb: jnp.zeros((n, d), yb.dtype).at[ib.reshape(-1)].add(yb.reshape(-1, d)))(idx, y)


def setup_inputs(seed: int = 0) -> dict:
    key = jax.random.key(seed)
    ks = iter(jax.random.split(key, 48))
    f32 = jnp.float32
    D = D_MODEL

    def nrm(shape, scale):
        return scale * jax.random.normal(next(ks), shape, f32)

    x = nrm((BATCH, SEQ, D), 1.0)
    c = nrm((BATCH, D), 1.0)
    ctx = nrm((BATCH, CTX_LEN, D), 1.0)
    c_ctx = nrm((D,), 1.0)
    w_mod = nrm((DEPTH, D, 6 * D), 0.5 * D ** -0.5)
    b_mod = nrm((DEPTH, 6 * D), 0.02)
    w_in = nrm((DEPTH, D, IN_WIDTH), D ** -0.5)
    w_in = w_in.at[:, :, K_END:V_END].multiply(DEEPNORM_BETA)
    b_in = nrm((DEPTH, IN_WIDTH), 0.02)
    attn_sink = nrm((DEPTH, N_Q_HEADS), 0.5)
    n_idx = jnp.arange(S5_STATE, dtype=f32)
    s5_lam_re = -0.5 + nrm((DEPTH, 2, S5_GROUPS, S5_STATE), 0.01)
    s5_lam_im = math.pi * n_idx + nrm((DEPTH, 2, S5_GROUPS, S5_STATE), 0.01)
    s5_log_dt = jax.random.uniform(next(ks), (DEPTH, 2, S5_GROUPS), f32, math.log(1e-3), math.log(1e-1))
    s5_b_re = nrm((DEPTH, 2, S5_GROUPS, S5_STATE, S5_GROUP), (2 * S5_GROUP) ** -0.5)
    s5_b_im = nrm((DEPTH, 2, S5_GROUPS, S5_STATE, S5_GROUP), (2 * S5_GROUP) ** -0.5)
    s5_c_re = nrm((DEPTH, 2, S5_GROUPS, S5_GROUP, S5_STATE), S5_STATE ** -0.5)
    s5_c_im = nrm((DEPTH, 2, S5_GROUPS, S5_GROUP, S5_STATE), S5_STATE ** -0.5)
    s5_d = nrm((DEPTH, S5_WIDTH), 1.0)
    s5_w_glu = nrm((DEPTH, S5_WIDTH, S5_WIDTH), S5_WIDTH ** -0.5)
    s5_b_glu = nrm((DEPTH, S5_WIDTH), 0.02)
    conv_w_dw = nrm((DEPTH, CONV_K, 1, CONV_WIDTH), CONV_K ** -0.5)
    conv_b_dw = nrm((DEPTH, CONV_WIDTH), 0.02)
    conv_ln_g = 1.0 + nrm((DEPTH, CONV_WIDTH), 0.05)
    conv_ln_b = nrm((DEPTH, CONV_WIDTH), 0.02)
    conv_w_pw = nrm((DEPTH, CONV_WIDTH, CONV_WIDTH), CONV_WIDTH ** -0.5)
    conv_b_pw = nrm((DEPTH, CONV_WIDTH), 0.02)
    w_out = nrm((DEPTH, MIX_WIDTH, D), DEEPNORM_BETA * MIX_WIDTH ** -0.5)
    b_out = nrm((DEPTH, D), 0.02)
    ln1_g = 1.0 + nrm((DEPTH, D), 0.05)
    ln1_b = nrm((DEPTH, D), 0.02)
    w_router = nrm((DEPTH, D, N_EXPERTS), D ** -0.5)
    exp_w_gate = nrm((DEPTH, N_EXPERTS, D, EXPERT_FF), D ** -0.5)
    exp_w_up = nrm((DEPTH, N_EXPERTS, D, EXPERT_FF), D ** -0.5)
    exp_w_down = nrm((DEPTH, N_EXPERTS, EXPERT_FF, D), DEEPNORM_BETA * EXPERT_FF ** -0.5)
    ln2_g = 1.0 + nrm((DEPTH, D), 0.05)
    ln2_b = nrm((DEPTH, D), 0.02)
    return {'x': x, 'c': c, 'ctx': ctx, 'c_ctx': c_ctx, 'w_mod': w_mod, 'b_mod': b_mod,
            'w_in': w_in, 'b_in': b_in, 'attn_sink': attn_sink,
            's5_lam_re': s5_lam_re, 's5_lam_im': s5_lam_im, 's5_log_dt': s5_log_dt,
            's5_b_re': s5_b_re, 's5_b_im': s5_b_im, 's5_c_re': s5_c_re, 's5_c_im': s5_c_im,
            's5_d': s5_d, 's5_w_glu': s5_w_glu, 's5_b_glu': s5_b_glu,
            'conv_w_dw': conv_w_dw, 'conv_b_dw': conv_b_dw, 'conv_ln_g': conv_ln_g, 'conv_ln_b': conv_ln_b,
            'conv_w_pw': conv_w_pw, 'conv_b_pw': conv_b_pw, 'w_out': w_out, 'b_out': b_out,
            'ln1_g': ln1_g, 'ln1_b': ln1_b, 'w_router': w_router, 'exp_w_gate': exp_w_gate,
            'exp_w_up': exp_w_up, 'exp_w_down': exp_w_down, 'ln2_g': ln2_g, 'ln2_b': ln2_b}


def reference(x, c, ctx, c_ctx, w_mod, b_mod, w_in, b_in, attn_sink,
              s5_lam_re, s5_lam_im, s5_log_dt, s5_b_re, s5_b_im, s5_c_re, s5_c_im,
              s5_d, s5_w_glu, s5_b_glu, conv_w_dw, conv_b_dw, conv_ln_g, conv_ln_b,
              conv_w_pw, conv_b_pw, w_out, b_out, ln1_g, ln1_b, w_router, exp_w_gate,
              exp_w_up, exp_w_down, ln2_g, ln2_b):
    bsz, seq, _ = x.shape
    lc = ctx.shape[1]
    ROWS = seq // GRID_W
    pos_row = jnp.repeat(jnp.arange(ROWS, dtype=jnp.int32), GRID_W)
    pos_col = jnp.tile(jnp.arange(GRID_W, dtype=jnp.int32), ROWS)
    alpha = DEEPNORM_ALPHA
    silu_c = jax.nn.silu(c)
    silu_cc = jax.nn.silu(c_ctx)
    xc = ctx
    for l in range(DEPTH):
        last = l == DEPTH - 1
        mod_x = jnp.split((silu_c @ w_mod[l] + b_mod[l])[:, None, :], 6, axis=-1)
        mod_c = jnp.split((silu_cc @ w_mod[l] + b_mod[l])[None, None, :], 6, axis=-1)

        hx = modulate(layer_norm(x), mod_x[0], mod_x[1])
        hc = modulate(layer_norm(xc), mod_c[0], mod_c[1])
        px = hx @ w_in[l] + b_in[l]
        col0, col1 = (Q_END, U_END) if last else (0, IN_WIDTH)
        pc = hc @ w_in[l][:, col0:col1] + b_in[l][col0:col1]

        k_c = pc[..., Q_END - col0:K_END - col0].reshape(bsz, lc, N_KV_HEADS, HEAD_DIM)
        v_c = pc[..., K_END - col0:V_END - col0].reshape(bsz, lc, N_KV_HEADS, HEAD_DIM)
        q = axial_rope(px[..., :Q_END].reshape(bsz, seq, N_Q_HEADS, HEAD_DIM), pos_row, pos_col)
        k = axial_rope(px[..., Q_END:K_END].reshape(bsz, seq, N_KV_HEADS, HEAD_DIM), pos_row, pos_col)
        v = px[..., K_END:V_END].reshape(bsz, seq, N_KV_HEADS, HEAD_DIM)
        attn_x = window_attention(q, k, v, k_c, v_c, attn_sink[l])

        s5_params = (s5_lam_re[l], s5_lam_im[l], s5_log_dt[l], s5_b_re[l], s5_b_im[l],
                     s5_c_re[l], s5_c_im[l], s5_d[l])
        y_c_s5, h_ctx = s5_mixer(pc[..., V_END - col0:U_END - col0], *s5_params, None, not last)
        y_x_s5, _ = s5_mixer(px[..., V_END:U_END], *s5_params, h_ctx, True)
        s5_x = s5_glu(y_x_s5, s5_w_glu[l], s5_b_glu[l])

        conv_params = (conv_w_dw[l], conv_b_dw[l], conv_ln_g[l], conv_ln_b[l], conv_w_pw[l], conv_b_pw[l])
        conv_x = conformer_conv(px[..., U_END:], *conv_params)

        y_mix = jnp.concatenate([attn_x, s5_x, conv_x], axis=-1) @ w_out[l] + b_out[l]
        x_mid = layer_norm(alpha * x + mod_x[2] * y_mix, ln1_g[l], ln1_b[l])

        if not last:
            q_c = pc[..., :Q_END].reshape(bsz, lc, N_Q_HEADS, HEAD_DIM)
            attn_c = context_attention(q_c, k_c, v_c, attn_sink[l])
            s5_c = s5_glu(y_c_s5, s5_w_glu[l], s5_b_glu[l])
            conv_c = conformer_conv(pc[..., U_END:], *conv_params)
            yc_mix = jnp.concatenate([attn_c, s5_c, conv_c], axis=-1) @ w_out[l] + b_out[l]
            xc = layer_norm(alpha * xc + mod_c[2] * yc_mix, ln1_g[l], ln1_b[l])

        h2 = modulate(layer_norm(x_mid), mod_x[3], mod_x[4])
        moe_x = expert_choice(h2, w_router[l], exp_w_gate[l], exp_w_up[l], exp_w_down[l])
        x = layer_norm(alpha * x_mid + mod_x[5] * moe_x, ln2_g[l], ln2_b[l])
        if not last:
            hc2 = modulate(layer_norm(xc), mod_c[3], mod_c[4])
            moe_c = expert_choice(hc2, w_router[l], exp_w_gate[l], exp_w_up[l], exp_w_down[l])
            xc = layer_norm(alpha * xc + mod_c[5] * moe_c, ln2_g[l], ln2_b[l])
    return x
```

```cpp
#include <hip/hip_runtime.h>
#include <hip/hip_cooperative_groups.h>
#include <cstdio>
#include <cstdint>
namespace cg = cooperative_groups;
namespace pg8 {
#define PG8_LAS __attribute__((address_space(3)))
typedef unsigned short bf16_t;
typedef short bf16x8 __attribute__((ext_vector_type(8)));
typedef float f32x4 __attribute__((ext_vector_type(4)));
typedef unsigned u32x4 __attribute__((ext_vector_type(4)));
constexpr int BM = 256, BK = 64, HALF = 128, HTB = HALF * BK * 2  , STAGE_BYTES = 8 * HTB, NXCD = 8, WGM = 8;

__host__ __device__ __forceinline__ int lds_byte(int r, int c) { const int st = (r >> 4) * 2 + (c >> 5), rr = r & 15, cc = c & 31, ob = rr * 64 + cc * 2; return st * 1024 + (ob ^ (((ob >> 9) & 1) << 5)); }
__host__ __device__ __forceinline__ void stage_rc(int b, int& R, int& C) { const int st = b / 1024, sb = b % 1024, swz = sb ^ (((sb >> 9) & 1) << 5); R = (st >> 1) * 16 + swz / 64; C = (st & 1) * 32 + (swz % 64) / 2; }
__host__ __device__ __forceinline__ int perm32(int rho) { const int n = rho >> 4, i = rho & 15; return 8 * (i >> 2) + 4 * n + (i & 3); }

struct Unit { int pm, pn; };
__device__ __forceinline__ int lane_id() { int r; asm volatile("v_mbcnt_lo_u32_b32 %0, -1, 0\n\tv_mbcnt_hi_u32_b32 %0, -1, %0" : "=v"(r)); return r; }
struct Gemm { const bf16_t* A; const bf16_t* Bt; int M, N, K, lda, ldb; int wv = 0; };

struct StaticOrder {
    int nM, nN, nwg, G, c;
    __host__ __device__ __forceinline__ void init(int M, int N, int G_, int c_) { nM = M / BM; nN = N / BM; nwg = nM * nN; G = G_; c = c_; }
    __host__ __device__ __forceinline__ bool next(int i, Unit& u) const {
        const long L = (long)i * G + c; if (L >= nwg) return false;
        int wgid = (int)L; { const int q = nwg / NXCD, r = nwg % NXCD, xcd = wgid % NXCD, off = wgid / NXCD; wgid = (xcd < r ? xcd * (q + 1) : r * (q + 1) + (xcd - r) * q) + off; }
        const int nig = WGM * nN, gid = wgid / nig, fm = gid * WGM, gsz = (nM - fm) < WGM ? (nM - fm) : WGM;
        u.pm = fm + ((wgid % nig) % gsz); u.pn = (wgid % nig) / gsz; return true;
    }
    __device__ __forceinline__ void a_ready(const Unit&) const {}
    __device__ __forceinline__ void done(const Unit&) const {}
    __device__ __forceinline__ int vrows(const Unit&) const { return BM; }
};

__device__ __forceinline__ unsigned cvt_pk_bf16(float lo, float hi) { unsigned r; asm volatile("v_cvt_pk_bf16_f32 %0, %1, %2" : "=v"(r) : "v"(lo), "v"(hi)); return r; }
typedef float f32x2 __attribute__((ext_vector_type(2)));
__device__ __forceinline__ f32x2 gelu_pk(f32x2 v) {
    const f32x2 av = __builtin_elementwise_abs(v), d = av * 0.2316418882f + 1.0f;
    f32x2 t; t.x = __builtin_amdgcn_rcpf(d.x); t.y = __builtin_amdgcn_rcpf(d.y);
    f32x2 q = t * 0.5307027145f + (-0.7265760135f); q = q * t + 0.7107068705f; q = q * t + (-0.142248368f); q = q * t + 0.127414796f; q = q * t;
    const f32x2 s = (v * v) * (-0.72134752044f);
    f32x2 e; e.x = __builtin_amdgcn_exp2f(s.x); e.y = __builtin_amdgcn_exp2f(s.y);
    const f32x2 m = v * (q * e), r = v - m;
    f32x2 o; o.x = v.x < 0.f ? m.x : r.x; o.y = v.y < 0.f ? m.y : r.y; return o;
}

typedef unsigned u32x2e __attribute__((ext_vector_type(2)));
__device__ __forceinline__ float silu_f(float x) { return x * __builtin_amdgcn_rcpf(1.f + __expf(-x)); }
struct EpiBf16P {
    static constexpr bool PERM = true, AFTER_DRAIN = false;
    bf16_t* O; int ldo; int ntpe;
    __device__ __forceinline__ void operator()(const f32x4 (&acc)[2][2][4][2], const Unit& u, int wr, int wc, int fr, int fq) const {
        const int row0 = u.pm * BM + wr * 64 + fr; const int col0 = (u.pn % ntpe) * BM + wc * 32 + 8 * fq;
#pragma unroll
        for (int ai = 0; ai < 2; ++ai)
#pragma unroll
            for (int m = 0; m < 4; ++m) { bf16_t* rowp = O + (size_t)(row0 + ai * HALF + m * 16) * ldo + col0;
#pragma unroll
                for (int bj = 0; bj < 2; ++bj) { const f32x4 v0 = acc[ai][bj][m][0], v1 = acc[ai][bj][m][1];
                    u32x4 w; w.x = cvt_pk_bf16(v0[0], v0[1]); w.y = cvt_pk_bf16(v0[2], v0[3]); w.z = cvt_pk_bf16(v1[0], v1[1]); w.w = cvt_pk_bf16(v1[2], v1[3]);
                    *(u32x4*)(rowp + bj * HALF) = w; } }
    }
};
struct EpiBf16B {
    static constexpr bool PERM = true, AFTER_DRAIN = false;
    bf16_t* O; int ldo; const float* bias;
    __device__ __forceinline__ void operator()(const f32x4 (&acc)[2][2][4][2], const Unit& u, int wr, int wc, int fr, int fq) const {
        const int row0 = u.pm * BM + wr * 64 + fr; const int col0 = u.pn * BM + wc * 32 + 8 * fq;
        f32x4 bv[2][2];
        { unsigned long long bp_ = (unsigned long long)bias; asm volatile("" : "+s"(bp_)); const float* bq = (const float*)bp_ + col0;
#pragma unroll
          for (int bj = 0; bj < 2; ++bj) { bv[bj][0] = *(const f32x4*)(bq + bj * HALF); bv[bj][1] = *(const f32x4*)(bq + bj * HALF + 4); } }
#pragma unroll
        for (int ai = 0; ai < 2; ++ai)
#pragma unroll
            for (int m = 0; m < 4; ++m) { bf16_t* rowp = O + (size_t)(row0 + ai * HALF + m * 16) * ldo + col0;
#pragma unroll
                for (int bj = 0; bj < 2; ++bj) {
                    const f32x4 v0 = acc[ai][bj][m][0] + bv[bj][0], v1 = acc[ai][bj][m][1] + bv[bj][1];
                    u32x4 w; w.x = cvt_pk_bf16(v0[0], v0[1]); w.y = cvt_pk_bf16(v0[2], v0[3]); w.z = cvt_pk_bf16(v1[0], v1[1]); w.w = cvt_pk_bf16(v1[2], v1[3]);
                    *(u32x4*)(rowp + bj * HALF) = w; } }
    }
};
__device__ __forceinline__ float sat_e4m3(float x) { return __builtin_amdgcn_fmed3f(x, -448.f, 448.f); }
__device__ __forceinline__ unsigned pack4_fp8(float a, float b, float c, float d) { int w = __builtin_amdgcn_cvt_pk_fp8_f32(sat_e4m3(a), sat_e4m3(b), 0, false); w = __builtin_amdgcn_cvt_pk_fp8_f32(sat_e4m3(c), sat_e4m3(d), w, true); return (unsigned)w; }
struct EpiSwiGLU8 {
    static constexpr bool PERM = true, AFTER_DRAIN = false;
    unsigned char* O; int ldo; int ntpe; int ctxpm, mstride;
    __device__ __forceinline__ void operator()(const f32x4 (&acc)[2][2][4][2], const Unit& u, int wr, int wc, int fr, int fq) const {
        const int row0 = u.pm * BM + wr * 64 + fr; const int col0 = (u.pn % ntpe) * HALF + wc * 32 + 8 * fq;
        const int vr = (ctxpm >= 0 && (u.pm % mstride) == ctxpm) ? 64 : BM;
#pragma unroll
        for (int ai = 0; ai < 2; ++ai) { if (wr * 64 + ai * HALF >= vr) continue;
#pragma unroll
            for (int m = 0; m < 4; ++m) { unsigned char* rowp = O + (size_t)(row0 + ai * HALF + m * 16) * ldo + col0;
                const f32x4 g0 = acc[ai][0][m][0], g1 = acc[ai][0][m][1], u0 = acc[ai][1][m][0] * 4.f, u1 = acc[ai][1][m][1] * 4.f;
                u32x2e w; w.x = pack4_fp8(silu_f(g0[0]) * u0[0], silu_f(g0[1]) * u0[1], silu_f(g0[2]) * u0[2], silu_f(g0[3]) * u0[3]);
                w.y = pack4_fp8(silu_f(g1[0]) * u1[0], silu_f(g1[1]) * u1[1], silu_f(g1[2]) * u1[2], silu_f(g1[3]) * u1[3]);
                *(u32x2e*)rowp = w; } }
    }
};
struct InProjOrder {
    int base, cnt, G, c;
    __device__ __forceinline__ void init(int base_, int cnt_, int G_, int c_) { base = base_; cnt = cnt_; G = G_; c = c_; }
    __device__ __forceinline__ bool next(int i, Unit& u) const {
        const long L = (long)i * G + c; if (L >= cnt) return false;
        int id = (int)L; { const int q = cnt / NXCD, r = cnt % NXCD, xcd = id % NXCD, off = id / NXCD; id = (xcd < r ? xcd * (q + 1) : r * (q + 1) + (xcd - r) * q) + off; }
        id += base; const bool hi = id >= 198; const int id2 = hi ? id - 198 : id;
        u.pm = id2 / 3; u.pn = (hi ? 0 : 3) + id2 % 3; return true;
    }
    __device__ __forceinline__ void a_ready(const Unit&) const {}
    __device__ __forceinline__ void done(const Unit&) const {}
    __device__ __forceinline__ int vrows(const Unit&) const { return BM; }
};
struct MoeOrder {
    int MT, NT, mstride, nwg, G, c, ctxpm, nx;
    __device__ __forceinline__ void init(int MT_, int NT_, int mstride_, int NE_, int G_, int c_, int ctxpm_ = -1, bool ctxlast = false) { MT = MT_; NT = NT_; mstride = mstride_; nwg = MT_ * NT_ * NE_; G = G_; c = c_; ctxpm = ctxpm_; nx = ctxlast ? (MT_ - 1) * NT_ * NE_ : 0; }
    __device__ __forceinline__ bool next(int i, Unit& u) const {
        const long L = (long)i * G + c; if (L >= nwg) return false;
        int id = (int)L;
        if (nx > 0) {
            if (id >= nx) { const int j = id - nx, e = j / NT; u.pm = e * mstride + (MT - 1); u.pn = e * NT + j % NT; return true; }
            { const int q = nx / NXCD, xcd = id % NXCD, off = id / NXCD; id = xcd * q + off; }
            const int upe = (MT - 1) * NT, e = id / upe, r2 = id % upe;
            u.pm = e * mstride + (r2 % (MT - 1)); u.pn = e * NT + (r2 / (MT - 1)); return true;
        }
        { const int q = nwg / NXCD, r = nwg % NXCD, xcd = id % NXCD, off = id / NXCD; id = (xcd < r ? xcd * (q + 1) : r * (q + 1) + (xcd - r) * q) + off; }
        const int upe = MT * NT, e = id / upe, r2 = id % upe;
        u.pm = e * mstride + (r2 % MT); u.pn = e * NT + (r2 / MT); return true;
    }
    __device__ __forceinline__ void a_ready(const Unit&) const {}
    __device__ __forceinline__ void done(const Unit&) const {}
    __device__ __forceinline__ int vrows(const Unit& u) const { return (ctxpm >= 0 && (u.pm % mstride) == ctxpm) ? 64 : BM; }
};
struct EpiF32G {
    static constexpr bool PERM = false, AFTER_DRAIN = false;
    float* C; int ldc; int ntpe;
    __device__ __forceinline__ void operator()(const f32x4 (&acc)[2][2][4][2], const Unit& u, int wr, int wc, int fr, int fq) const {
        const int row0 = u.pm * BM + wr * 64 + fr, col0 = (u.pn % ntpe) * BM + wc * 32 + 4 * fq;
#pragma unroll
        for (int ai = 0; ai < 2; ++ai)
#pragma unroll
            for (int m = 0; m < 4; ++m) { float* rowp = C + (size_t)(row0 + ai * HALF + m * 16) * ldc + col0;
#pragma unroll
                for (int bj = 0; bj < 2; ++bj)
#pragma unroll
                    for (int n = 0; n < 2; ++n) *(f32x4*)(rowp + bj * HALF + n * 16) = acc[ai][bj][m][n]; }
    }
};
__device__ __forceinline__ float gelu_tanh_e(float x) { const float u = 1.5957691216057308f * (x + 0.044715f * x * x * x); return x * __builtin_amdgcn_rcpf(1.f + __expf(-u)); }
struct EpiS5Y {
    static constexpr bool PERM = true, AFTER_DRAIN = false;
    bf16_t* Z;
    __device__ __forceinline__ void operator()(const f32x4 (&acc)[2][2][4][2], const Unit& u, int wr, int wc, int fr, int fq) const {
        const int g = u.pm / 3, R0 = (u.pm % 3) * BM + wr * 64 + fr, n0 = (u.pn & 1) * BM + wc * 32 + 8 * fq;
#pragma unroll
        for (int ai = 0; ai < 2; ++ai)
#pragma unroll
            for (int m = 0; m < 4; ++m) { const int R = R0 + ai * HALF + m * 16; if (R >= 528) continue;
                const int tok0 = (R < 512) ? ((R >> 8) * 8192 + 32 * (R & 255)) : (16384 + ((R - 512) >> 3) * 256 + 32 * ((R - 512) & 7));
#pragma unroll
                for (int bj = 0; bj < 2; ++bj) { const int n = n0 + bj * HALF, j = n >> 4, c0 = n & 15; const f32x4 v0 = acc[ai][bj][m][0], v1 = acc[ai][bj][m][1];
                    u32x4 w; w.x = cvt_pk_bf16(gelu_tanh_e(v0[0]), gelu_tanh_e(v0[1])); w.y = cvt_pk_bf16(gelu_tanh_e(v0[2]), gelu_tanh_e(v0[3])); w.z = cvt_pk_bf16(gelu_tanh_e(v1[0]), gelu_tanh_e(v1[1])); w.w = cvt_pk_bf16(gelu_tanh_e(v1[2]), gelu_tanh_e(v1[3]));
                    *(u32x4*)(Z + ((size_t)(tok0 + j)) * 256 + 16 * g + c0) = w; } }
    }
};
struct EpiPW {
    static constexpr bool PERM = true, AFTER_DRAIN = false;
    bf16_t* CAT; const bf16_t* Z; const float* bglu; const float* bpw; int mtpe;
    __device__ __forceinline__ void operator()(const f32x4 (&acc)[2][2][4][2], const Unit& u, int wr, int wc, int fr, int fq) const {
        const int grp = u.pn, row0 = (u.pm % mtpe) * BM + wr * 64 + fr, col0 = wc * 32 + 8 * fq; const float* bias = grp ? bpw : bglu;
#pragma unroll
        for (int ai = 0; ai < 2; ++ai)
#pragma unroll
            for (int m = 0; m < 4; ++m) { const size_t row = (size_t)(row0 + ai * HALF + m * 16);
#pragma unroll
                for (int bj = 0; bj < 2; ++bj) { const int col = col0 + bj * HALF;
                    unsigned long long bp_ = (unsigned long long)bias; asm volatile("" : "+s"(bp_)); const float* bq = (const float*)bp_ + col;
                    f32x4 v0 = acc[ai][bj][m][0] + *(const f32x4*)bq, v1 = acc[ai][bj][m][1] + *(const f32x4*)(bq + 4);
                    if (grp == 0) { const u32x4 zz = *(const u32x4*)(Z + row * 256 + col);
                        v0[0] = __builtin_bit_cast(float, zz.x << 16) * __builtin_amdgcn_rcpf(1.f + __expf(-v0[0])); v0[1] = __builtin_bit_cast(float, zz.x & 0xffff0000u) * __builtin_amdgcn_rcpf(1.f + __expf(-v0[1]));
                        v0[2] = __builtin_bit_cast(float, zz.y << 16) * __builtin_amdgcn_rcpf(1.f + __expf(-v0[2])); v0[3] = __builtin_bit_cast(float, zz.y & 0xffff0000u) * __builtin_amdgcn_rcpf(1.f + __expf(-v0[3]));
                        v1[0] = __builtin_bit_cast(float, zz.z << 16) * __builtin_amdgcn_rcpf(1.f + __expf(-v1[0])); v1[1] = __builtin_bit_cast(float, zz.z & 0xffff0000u) * __builtin_amdgcn_rcpf(1.f + __expf(-v1[1]));
                        v1[2] = __builtin_bit_cast(float, zz.w << 16) * __builtin_amdgcn_rcpf(1.f + __expf(-v1[2])); v1[3] = __builtin_bit_cast(float, zz.w & 0xffff0000u) * __builtin_amdgcn_rcpf(1.f + __expf(-v1[3])); }
                    u32x4 w; w.x = cvt_pk_bf16(v0[0], v0[1]); w.y = cvt_pk_bf16(v0[2], v0[3]); w.z = cvt_pk_bf16(v1[0], v1[1]); w.w = cvt_pk_bf16(v1[2], v1[3]);
                    *(u32x4*)(CAT + row * 1024 + 512 + grp * 256 + col) = w; }
                asm volatile("" ::: "memory"); }
    }
};
typedef unsigned u32x2 __attribute__((ext_vector_type(2)));
struct EpiInProj {
    static constexpr bool PERM = true, AFTER_DRAIN = false;
    const float* bias; const float* rope; bf16_t* Q; bf16_t* K; bf16_t* V; bf16_t* UC; bf16_t* HG;
    __device__ __forceinline__ void operator()(const f32x4 (&acc)[2][2][4][2], const Unit& u, int wr, int wc, int fr, int fq) const {
        const int pn = u.pn; const bool isx = u.pm < 64;
        f32x4 bv[2][2];
        { unsigned long long bp_ = (unsigned long long)bias; asm volatile("" : "+s"(bp_)); const float* bq = (const float*)bp_ + pn * BM + wc * 32 + 8 * fq;
#pragma unroll
          for (int bj = 0; bj < 2; ++bj) { bv[bj][0] = *(const f32x4*)(bq + bj * HALF); bv[bj][1] = *(const f32x4*)(bq + bj * HALF + 4); } }
        const bool rot = (pn <= 2) && isx; const int hi = fq >> 1, i0 = 8 * (fq & 1);
#pragma unroll
        for (int ai = 0; ai < 2; ++ai)
#pragma unroll
            for (int m = 0; m < 4; ++m) {
                const int r = u.pm * BM + ai * HALF + wr * 64 + m * 16 + fr;
                f32x4 v[2][2];
#pragma unroll
                for (int bj = 0; bj < 2; ++bj)
#pragma unroll
                    for (int n = 0; n < 2; ++n) v[bj][n] = acc[ai][bj][m][n] + bv[bj][n];
                if (pn <= 2) {
                    f32x4 cs[4];
                    if (rot) { const int t = r & 8191, pos = (wc & 1) ? (t & 63) : (t >> 6); const f32x4* rp = (const f32x4*)(rope + ((size_t)pos * 16 + i0) * 2);
#pragma unroll
                        for (int q = 0; q < 4; ++q) cs[q] = rp[q]; }
                    else {
#pragma unroll
                        for (int q = 0; q < 4; ++q) cs[q] = (f32x4){1.f, 0.f, 1.f, 0.f}; }
#pragma unroll
                    for (int bj = 0; bj < 2; ++bj) {
                        u32x4 w;
                        if (pn == 2 && bj == 1) {
                            w.x = cvt_pk_bf16(v[1][0][0], v[1][0][1]); w.y = cvt_pk_bf16(v[1][0][2], v[1][0][3]); w.z = cvt_pk_bf16(v[1][1][0], v[1][1][1]); w.w = cvt_pk_bf16(v[1][1][2], v[1][1][3]);
                            *(u32x4*)(V + (size_t)r * 128 + wc * 32 + 8 * fq) = w;
                        } else {
                            float o[8];
#pragma unroll
                            for (int n = 0; n < 2; ++n)
#pragma unroll
                                for (int e = 0; e < 4; ++e) { const float mine = v[bj][n][e], other = __shfl_xor(mine, 32); const int q = 2 * n + (e >> 1); const float c = cs[q][2 * (e & 1)], s = cs[q][2 * (e & 1) + 1];
                                    o[4 * n + e] = hi ? (mine * c + other * s) : (mine * c - other * s); }
                            const float qs = (pn == 2) ? 1.f : 0.18033688011112042f;
                            w.x = cvt_pk_bf16(o[0] * qs, o[1] * qs); w.y = cvt_pk_bf16(o[2] * qs, o[3] * qs); w.z = cvt_pk_bf16(o[4] * qs, o[5] * qs); w.w = cvt_pk_bf16(o[6] * qs, o[7] * qs);
                            bf16_t* op = (pn == 2) ? K + (size_t)r * 128 + wc * 32 + 8 * fq : Q + (size_t)r * 512 + pn * BM + bj * HALF + wc * 32 + 8 * fq;
                            *(u32x4*)op = w;
                        } }
                } else if (pn == 3) {
                    int R, j; if (isx) { const int t = r & 8191; R = (r >> 13) * 256 + (t >> 5); j = t & 31; } else { const int rc = r - 16384, t = rc & 255; R = 512 + (rc >> 8) * 8 + (t >> 5); j = t & 31; }
#pragma unroll
                    for (int bj = 0; bj < 2; ++bj) { const int g = 8 * bj + 2 * wc + (fq >> 1); u32x4 w;
                        w.x = cvt_pk_bf16(v[bj][0][0], v[bj][0][1]); w.y = cvt_pk_bf16(v[bj][0][2], v[bj][0][3]); w.z = cvt_pk_bf16(v[bj][1][0], v[bj][1][1]); w.w = cvt_pk_bf16(v[bj][1][2], v[bj][1][3]);
                        *(u32x4*)(UC + ((size_t)(g * 768 + R)) * 768 + j * 16 + 8 * (fq & 1)) = w; }
                } else {
                    u32x4 w; float hgv[8];
#pragma unroll
                    for (int n = 0; n < 2; ++n)
#pragma unroll
                        for (int e = 0; e < 4; ++e) hgv[4 * n + e] = v[0][n][e] * __builtin_amdgcn_rcpf(1.f + __expf(-v[1][n][e]));
                    w.x = cvt_pk_bf16(hgv[0], hgv[1]); w.y = cvt_pk_bf16(hgv[2], hgv[3]); w.z = cvt_pk_bf16(hgv[4], hgv[5]); w.w = cvt_pk_bf16(hgv[6], hgv[7]);
                    *(u32x4*)(HG + (size_t)r * 256 + (pn - 4) * HALF + wc * 32 + 8 * fq) = w;
                }
                asm volatile("" ::: "memory");
            }
    }
};
template <class Epi, class Sched, bool ALIGN_EPI = false, bool SP2 = false>
__device__ __forceinline__ void gemm_phase(PG8_LAS unsigned char* lds, const Gemm g, const Sched& S, const Epi& E) {
    int tid_ = g.wv * 64 + lane_id(); asm volatile("" : "+v"(tid_));
    const int tid = tid_, wid = __builtin_amdgcn_readfirstlane(tid >> 6), lane = tid & 63, wr = wid >> 2, wc = wid & 3, fr = lane & 15, fq = lane >> 4;
    const int K = g.K, nt = K / BK;
    unsigned voffA[2], voffB[2];
#pragma unroll
    for (int i = 0; i < 2; ++i) { int R, C; stage_rc(tid * 16 + i * 8192, R, C); const int Rb = Epi::PERM ? ((R & ~31) + perm32(R & 31)) : R;
        voffA[i] = (unsigned)(R * g.lda + C) * 2u; voffB[i] = (unsigned)(Rb * g.ldb + C) * 2u; }
    const size_t kstep = (size_t)(BK * 2);
    const size_t hstepA = (size_t)HALF * g.lda * 2, hstepB = (size_t)HALF * g.ldb * 2;
    const size_t tstepA = 2 * hstepA, tstepB = 2 * hstepB;
    const unsigned ldsw = (unsigned)wid * 1024u;
    const int aoff = lds_byte(wr * 64 + fr, fq * 8), boff = lds_byte(wc * 32 + fr, fq * 8);
#define PG8_SA(b, h) (((b) * 2 + (h)) * HTB)
#define PG8_SB(b, h) ((4 + (b) * 2 + (h)) * HTB)
#define PG8_STAGE(bufoff, gbase, voff) do { _Pragma("unroll") for (int _i = 0; _i < 2; ++_i) \
        __builtin_amdgcn_global_load_lds((const unsigned*)((const char*)(gbase) + (voff)[_i]), (PG8_LAS unsigned*)(lds + (bufoff) + ldsw + _i * 8192), 16, 0, 0); } while (0)
#define PG8_LDA(dst, b, h) do { _Pragma("unroll") for (int m = 0; m < 4; ++m) _Pragma("unroll") for (int k = 0; k < 2; ++k) dst[m][k] = *(const PG8_LAS bf16x8*)(lds + PG8_SA(b, h) + aoff + m * 2048 + k * 1024); } while (0)
#define PG8_LDB(dst, b, h) do { _Pragma("unroll") for (int n = 0; n < 2; ++n) _Pragma("unroll") for (int k = 0; k < 2; ++k) dst[n][k] = *(const PG8_LAS bf16x8*)(lds + PG8_SB(b, h) + boff + n * 2048 + k * 1024); } while (0)
#define PG8_MMA(ai, bj, At, Bt) do { __builtin_amdgcn_s_setprio(1); _Pragma("unroll") for (int m = 0; m < 4; ++m) _Pragma("unroll") for (int n = 0; n < 2; ++n) _Pragma("unroll") for (int k = 0; k < 2; ++k) \
        acc[ai][bj][m][n] = __builtin_amdgcn_mfma_f32_16x16x32_bf16(Bt[n][k], At[m][k], acc[ai][bj][m][n], 0, 0, 0); __builtin_amdgcn_s_setprio(0); } while (0)
#define PG8_WAIT_V(n) asm volatile("s_waitcnt vmcnt(" #n ")" ::: "memory")
#define PG8_WAIT_L(n) asm volatile("s_waitcnt lgkmcnt(" #n ")" ::: "memory")
#define PG8_BAR __builtin_amdgcn_s_barrier()
#define PG8_SCHED __builtin_amdgcn_sched_barrier(0)
    Unit cur, nxt; int ui = 0;
    if (!S.next(0, cur)) return;
    f32x4 acc[2][2][4][2];
#pragma unroll
    for (int a = 0; a < 2; ++a)
#pragma unroll
        for (int b = 0; b < 2; ++b)
#pragma unroll
            for (int m = 0; m < 4; ++m)
#pragma unroll
                for (int n = 0; n < 2; ++n) acc[a][b][m][n] = (f32x4){0.f, 0.f, 0.f, 0.f};
    bf16x8 At[4][2], B0[2][2], B1[2][2];
    const char* cA = (const char*)g.A + (size_t)cur.pm * tstepA; const char* cB = (const char*)g.Bt + (size_t)cur.pn * tstepB;
    S.a_ready(cur);
    if constexpr (SP2) {
        PG8_STAGE(PG8_SB(0, 0), cB, voffB); PG8_STAGE(PG8_SB(0, 1), cB + hstepB, voffB); PG8_STAGE(PG8_SA(0, 0), cA, voffA); PG8_STAGE(PG8_SA(0, 1), cA + hstepA, voffA);
        if (wr == 1) PG8_BAR;
        PG8_WAIT_V(2); PG8_BAR;
        PG8_STAGE(PG8_SB(1, 0), cB + kstep, voffB); PG8_STAGE(PG8_SA(1, 0), cA + kstep, voffA); PG8_STAGE(PG8_SB(1, 1), cB + hstepB + kstep, voffB);
        PG8_WAIT_V(6); PG8_BAR;
    } else {
        PG8_STAGE(PG8_SB(0, 0), cB, voffB); PG8_STAGE(PG8_SA(0, 0), cA, voffA); PG8_STAGE(PG8_SB(0, 1), cB + hstepB, voffB); PG8_STAGE(PG8_SA(0, 1), cA + hstepA, voffA);
        if (wr == 1) PG8_BAR;
        PG8_WAIT_V(4); PG8_BAR;
        PG8_STAGE(PG8_SB(1, 0), cB + kstep, voffB); PG8_STAGE(PG8_SA(1, 0), cA + kstep, voffA); PG8_STAGE(PG8_SB(1, 1), cB + hstepB + kstep, voffB);
        PG8_WAIT_V(6); PG8_BAR;
    }
    for (;;) {
        const bool has_next = S.next(ui + 1, nxt);
        const char* nA = has_next ? (const char*)g.A + (size_t)nxt.pm * tstepA : cA; const char* nB = has_next ? (const char*)g.Bt + (size_t)nxt.pn * tstepB : cB;
        for (int t = 0; t < nt; t += 2) {
            const bool last = (t == nt - 2);
            const char* a1 = cA + (size_t)(t + 1) * kstep;
            const char* a2 = last ? nA : cA + (size_t)(t + 2) * kstep; const char* b2 = last ? nB : cB + (size_t)(t + 2) * kstep;
            const char* a3 = a2 + kstep; const char* b3 = b2 + kstep;
            if (last && has_next) S.a_ready(nxt);
            if constexpr (SP2) {
            PG8_LDB(B0, 0, 0); PG8_LDB(B1, 0, 1); PG8_SCHED; PG8_LDA(At, 0, 0); PG8_STAGE(PG8_SA(1, 1), a1 + hstepA, voffA);
            PG8_WAIT_V(8); PG8_WAIT_L(0); PG8_BAR; PG8_MMA(0, 0, At, B0); PG8_MMA(0, 1, At, B1); PG8_BAR; PG8_SCHED;
            PG8_LDA(At, 0, 1); PG8_STAGE(PG8_SB(0, 0), b2, voffB); PG8_STAGE(PG8_SB(0, 1), b2 + hstepB, voffB); PG8_STAGE(PG8_SA(0, 0), a2, voffA);
            PG8_WAIT_V(8); PG8_WAIT_L(0); PG8_BAR; PG8_MMA(1, 0, At, B0); PG8_MMA(1, 1, At, B1); PG8_BAR; PG8_SCHED;
            PG8_LDB(B0, 1, 0); PG8_LDB(B1, 1, 1); PG8_SCHED; PG8_LDA(At, 1, 0); PG8_STAGE(PG8_SA(0, 1), a2 + hstepA, voffA);
            PG8_WAIT_V(8); PG8_WAIT_L(0); PG8_BAR; PG8_MMA(0, 0, At, B0); PG8_MMA(0, 1, At, B1); PG8_BAR; PG8_SCHED;
            PG8_LDA(At, 1, 1); PG8_STAGE(PG8_SB(1, 0), b3, voffB); PG8_STAGE(PG8_SB(1, 1), b3 + hstepB, voffB); PG8_STAGE(PG8_SA(1, 0), a3, voffA);
            PG8_WAIT_V(8); PG8_WAIT_L(0); PG8_BAR; PG8_MMA(1, 0, At, B0); PG8_MMA(1, 1, At, B1); PG8_BAR; PG8_SCHED;
            } else {
            PG8_LDB(B0, 0, 0); PG8_SCHED; PG8_LDA(At, 0, 0); PG8_STAGE(PG8_SA(1, 1), a1 + hstepA, voffA);
            PG8_WAIT_L(8); PG8_BAR; PG8_WAIT_L(0); PG8_MMA(0, 0, At, B0); PG8_BAR; PG8_SCHED;
            PG8_LDB(B1, 0, 1); PG8_STAGE(PG8_SB(0, 0), b2, voffB);
            PG8_BAR; PG8_WAIT_L(0); PG8_MMA(0, 1, At, B1); PG8_BAR;
            PG8_LDA(At, 0, 1); PG8_STAGE(PG8_SA(0, 0), a2, voffA);
            PG8_BAR; PG8_WAIT_L(0); PG8_MMA(1, 0, At, B0); PG8_BAR; PG8_SCHED;
            PG8_STAGE(PG8_SB(0, 1), b2 + hstepB, voffB);
            PG8_WAIT_V(6); PG8_BAR; PG8_MMA(1, 1, At, B1); PG8_BAR;
            PG8_LDB(B0, 1, 0); PG8_SCHED; PG8_LDA(At, 1, 0); PG8_STAGE(PG8_SA(0, 1), a2 + hstepA, voffA);
            PG8_WAIT_L(8); PG8_BAR; PG8_WAIT_L(0); PG8_MMA(0, 0, At, B0); PG8_BAR; PG8_SCHED;
            PG8_LDB(B1, 1, 1); PG8_STAGE(PG8_SB(1, 0), b3, voffB);
            PG8_BAR; PG8_WAIT_L(0); PG8_MMA(0, 1, At, B1); PG8_BAR;
            PG8_LDA(At, 1, 1); PG8_STAGE(PG8_SA(1, 0), a3, voffA);
            PG8_BAR; PG8_WAIT_L(0); PG8_MMA(1, 0, At, B0); PG8_BAR; PG8_SCHED;
            PG8_STAGE(PG8_SB(1, 1), b3 + hstepB, voffB);
            PG8_WAIT_V(6); PG8_BAR; PG8_MMA(1, 1, At, B1); PG8_BAR;
            }
        }
        if constexpr (ALIGN_EPI) { if (wr == 0) PG8_BAR; }
        if constexpr (!Epi::AFTER_DRAIN) { E(acc, cur, wr, wc, fr, fq); S.done(cur); }
        if (!has_next) break;
#pragma unroll
        for (int a = 0; a < 2; ++a)
#pragma unroll
            for (int b = 0; b < 2; ++b)
#pragma unroll
                for (int m = 0; m < 4; ++m)
#pragma unroll
                    for (int n = 0; n < 2; ++n) acc[a][b][m][n] = (f32x4){0.f, 0.f, 0.f, 0.f};
        cur = nxt; cA = nA; cB = nB; ++ui;
        if constexpr (ALIGN_EPI) { if (wr == 1) PG8_BAR; }
    }
    PG8_WAIT_V(0);
    if constexpr (!ALIGN_EPI) { if (wr == 0) PG8_BAR; }
    PG8_BAR;
    if constexpr (Epi::AFTER_DRAIN) { E.fused(acc, cur, wr, wc, fr, fq, lds, wid, lane); S.done(cur); }
#undef PG8_SA
#undef PG8_SB
#undef PG8_STAGE
#undef PG8_LDA
#undef PG8_LDB
#undef PG8_MMA
#undef PG8_WAIT_V
#undef PG8_WAIT_L
#undef PG8_BAR
#undef PG8_SCHED
}
typedef int v4i_t __attribute__((ext_vector_type(4)));
typedef int v8i_t __attribute__((ext_vector_type(8)));
#define PG8_CAT(x, y) __builtin_shufflevector(__builtin_bit_cast(v4i_t, x), __builtin_bit_cast(v4i_t, y), 0, 1, 2, 3, 4, 5, 6, 7)
template <class Epi, class Sched, bool ALIGN_EPI = false, bool SP2 = false>
__device__ __forceinline__ void gemm_phase_8(PG8_LAS unsigned char* lds, const Gemm g, const Sched& S, const Epi& E, const int sa, const int sb) {
    int tid_ = g.wv * 64 + lane_id(); asm volatile("" : "+v"(tid_));
    const int tid = tid_, wid = __builtin_amdgcn_readfirstlane(tid >> 6), lane = tid & 63, wr = wid >> 2, wc = wid & 3, fr = lane & 15, fq = lane >> 4;
    const int K = g.K, nt = K / BK;
    unsigned voffA[2], voffB[2];
#pragma unroll
    for (int i = 0; i < 2; ++i) { int R, C; stage_rc(tid * 16 + i * 8192, R, C); const int Rb = Epi::PERM ? ((R & ~31) + perm32(R & 31)) : R;
        voffA[i] = (unsigned)(R * g.lda + C) * 2u; voffB[i] = (unsigned)(Rb * g.ldb + C) * 2u; }
    const size_t kstep = (size_t)(BK * 2);
    const size_t hstepA = (size_t)HALF * g.lda * 2, hstepB = (size_t)HALF * g.ldb * 2;
    const size_t tstepA = 2 * hstepA, tstepB = 2 * hstepB;
    const unsigned ldsw = (unsigned)wid * 1024u;
    const int aoff8[2] = {lds_byte(wr * 64 + fr, 16 * fq), lds_byte(wr * 64 + fr, 16 * fq + 8)}, boff8[2] = {lds_byte(wc * 32 + fr, 16 * fq), lds_byte(wc * 32 + fr, 16 * fq + 8)};
#define PG8_SA(b, h) (((b) * 2 + (h)) * HTB)
#define PG8_SB(b, h) ((4 + (b) * 2 + (h)) * HTB)
#define PG8_STAGE(bufoff, gbase, voff) do { _Pragma("unroll") for (int _i = 0; _i < 2; ++_i) \
        __builtin_amdgcn_global_load_lds((const unsigned*)((const char*)(gbase) + (voff)[_i]), (PG8_LAS unsigned*)(lds + (bufoff) + ldsw + _i * 8192), 16, 0, 0); } while (0)
#define PG8_LDA(dst, b, h) do { _Pragma("unroll") for (int m = 0; m < 4; ++m) { const v4i_t lo_ = *(const PG8_LAS v4i_t*)(lds + PG8_SA(b, h) + aoff8[0] + m * 2048), hi_ = *(const PG8_LAS v4i_t*)(lds + PG8_SA(b, h) + aoff8[1] + m * 2048); dst[m] = __builtin_shufflevector(lo_, hi_, 0, 1, 2, 3, 4, 5, 6, 7); } } while (0)
#define PG8_LDB(dst, b, h) do { _Pragma("unroll") for (int n = 0; n < 2; ++n) { const v4i_t lo_ = *(const PG8_LAS v4i_t*)(lds + PG8_SB(b, h) + boff8[0] + n * 2048), hi_ = *(const PG8_LAS v4i_t*)(lds + PG8_SB(b, h) + boff8[1] + n * 2048); dst[n] = __builtin_shufflevector(lo_, hi_, 0, 1, 2, 3, 4, 5, 6, 7); } } while (0)
#define PG8_MMA(ai, bj, At, Bt) do { if ((ai) ? do1 : do0) { __builtin_amdgcn_s_setprio(1); _Pragma("unroll") for (int m = 0; m < 4; ++m) _Pragma("unroll") for (int n = 0; n < 2; ++n) \
        asm volatile("v_mfma_scale_f32_16x16x128_f8f6f4 %0, %1, %2, %0, %3, %4 op_sel_hi:[0,0,0]" : "+v"(acc[ai][bj][m][n]) : "v"(Bt[n]), "v"(At[m]), "v"(sa), "v"(sb)); __builtin_amdgcn_s_setprio(0); } } while (0)
#define PG8_WAIT_V(n) asm volatile("s_waitcnt vmcnt(" #n ")" ::: "memory")
#define PG8_WAIT_L(n) asm volatile("s_waitcnt lgkmcnt(" #n ")" ::: "memory")
#define PG8_BAR __builtin_amdgcn_s_barrier()
#define PG8_SCHED __builtin_amdgcn_sched_barrier(0)
    Unit cur, nxt; int ui = 0;
    if (!S.next(0, cur)) return;
    bool do0 = wr * 64 < S.vrows(cur), do1 = wr * 64 + HALF < S.vrows(cur);
    f32x4 acc[2][2][4][2];
#pragma unroll
    for (int a = 0; a < 2; ++a)
#pragma unroll
        for (int b = 0; b < 2; ++b)
#pragma unroll
            for (int m = 0; m < 4; ++m)
#pragma unroll
                for (int n = 0; n < 2; ++n) acc[a][b][m][n] = (f32x4){0.f, 0.f, 0.f, 0.f};
    v8i_t At[4], B0[2], B1[2];
    const char* cA = (const char*)g.A + (size_t)cur.pm * tstepA; const char* cB = (const char*)g.Bt + (size_t)cur.pn * tstepB;
    S.a_ready(cur);
    if constexpr (SP2) {
        PG8_STAGE(PG8_SB(0, 0), cB, voffB); PG8_STAGE(PG8_SB(0, 1), cB + hstepB, voffB); PG8_STAGE(PG8_SA(0, 0), cA, voffA); PG8_STAGE(PG8_SA(0, 1), cA + hstepA, voffA);
        if (wr == 1) PG8_BAR;
        PG8_WAIT_V(2); PG8_BAR;
        PG8_STAGE(PG8_SB(1, 0), cB + kstep, voffB); PG8_STAGE(PG8_SA(1, 0), cA + kstep, voffA); PG8_STAGE(PG8_SB(1, 1), cB + hstepB + kstep, voffB);
        PG8_WAIT_V(6); PG8_BAR;
    } else {
        PG8_STAGE(PG8_SB(0, 0), cB, voffB); PG8_STAGE(PG8_SA(0, 0), cA, voffA); PG8_STAGE(PG8_SB(0, 1), cB + hstepB, voffB); PG8_STAGE(PG8_SA(0, 1), cA + hstepA, voffA);
        if (wr == 1) PG8_BAR;
        PG8_WAIT_V(4); PG8_BAR;
        PG8_STAGE(PG8_SB(1, 0), cB + kstep, voffB); PG8_STAGE(PG8_SA(1, 0), cA + kstep, voffA); PG8_STAGE(PG8_SB(1, 1), cB + hstepB + kstep, voffB);
        PG8_WAIT_V(6); PG8_BAR;
    }
    for (;;) {
        const bool has_next = S.next(ui + 1, nxt);
        const char* nA = has_next ? (const char*)g.A + (size_t)nxt.pm * tstepA : cA; const char* nB = has_next ? (const char*)g.Bt + (size_t)nxt.pn * tstepB : cB;
        for (int t = 0; t < nt; t += 2) {
            const bool last = (t == nt - 2);
            const char* a1 = cA + (size_t)(t + 1) * kstep;
            const char* a2 = last ? nA : cA + (size_t)(t + 2) * kstep; const char* b2 = last ? nB : cB + (size_t)(t + 2) * kstep;
            const char* a3 = a2 + kstep; const char* b3 = b2 + kstep;
            if (last && has_next) S.a_ready(nxt);
            if constexpr (SP2) {
            PG8_LDB(B0, 0, 0); PG8_LDB(B1, 0, 1); PG8_SCHED; PG8_LDA(At, 0, 0); PG8_STAGE(PG8_SA(1, 1), a1 + hstepA, voffA);
            PG8_WAIT_V(8); PG8_WAIT_L(0); PG8_BAR; PG8_MMA(0, 0, At, B0); PG8_MMA(0, 1, At, B1); PG8_BAR; PG8_SCHED;
            PG8_LDA(At, 0, 1); PG8_STAGE(PG8_SB(0, 0), b2, voffB); PG8_STAGE(PG8_SB(0, 1), b2 + hstepB, voffB); PG8_STAGE(PG8_SA(0, 0), a2, voffA);
            PG8_WAIT_V(8); PG8_WAIT_L(0); PG8_BAR; PG8_MMA(1, 0, At, B0); PG8_MMA(1, 1, At, B1); PG8_BAR; PG8_SCHED;
            PG8_LDB(B0, 1, 0); PG8_LDB(B1, 1, 1); PG8_SCHED; PG8_LDA(At, 1, 0); PG8_STAGE(PG8_SA(0, 1), a2 + hstepA, voffA);
            PG8_WAIT_V(8); PG8_WAIT_L(0); PG8_BAR; PG8_MMA(0, 0, At, B0); PG8_MMA(0, 1, At, B1); PG8_BAR; PG8_SCHED;
            PG8_LDA(At, 1, 1); PG8_STAGE(PG8_SB(1, 0), b3, voffB); PG8_STAGE(PG8_SB(1, 1), b3 + hstepB, voffB); PG8_STAGE(PG8_SA(1, 0), a3, voffA);
            PG8_WAIT_V(8); PG8_WAIT_L(0); PG8_BAR; PG8_MMA(1, 0, At, B0); PG8_MMA(1, 1, At, B1); PG8_BAR; PG8_SCHED;
            } else {
            PG8_LDB(B0, 0, 0); PG8_SCHED; PG8_LDA(At, 0, 0); PG8_STAGE(PG8_SA(1, 1), a1 + hstepA, voffA);
            PG8_WAIT_L(8); PG8_BAR; PG8_WAIT_L(0); PG8_MMA(0, 0, At, B0); PG8_BAR; PG8_SCHED;
            PG8_LDB(B1, 0, 1); PG8_STAGE(PG8_SB(0, 0), b2, voffB);
            PG8_BAR; PG8_WAIT_L(0); PG8_MMA(0, 1, At, B1); PG8_BAR;
            PG8_LDA(At, 0, 1); PG8_STAGE(PG8_SA(0, 0), a2, voffA);
            PG8_BAR; PG8_WAIT_L(0); PG8_MMA(1, 0, At, B0); PG8_BAR; PG8_SCHED;
            PG8_STAGE(PG8_SB(0, 1), b2 + hstepB, voffB);
            PG8_WAIT_V(6); PG8_BAR; PG8_MMA(1, 1, At, B1); PG8_BAR;
            PG8_LDB(B0, 1, 0); PG8_SCHED; PG8_LDA(At, 1, 0); PG8_STAGE(PG8_SA(0, 1), a2 + hstepA, voffA);
            PG8_WAIT_L(8); PG8_BAR; PG8_WAIT_L(0); PG8_MMA(0, 0, At, B0); PG8_BAR; PG8_SCHED;
            PG8_LDB(B1, 1, 1); PG8_STAGE(PG8_SB(1, 0), b3, voffB);
            PG8_BAR; PG8_WAIT_L(0); PG8_MMA(0, 1, At, B1); PG8_BAR;
            PG8_LDA(At, 1, 1); PG8_STAGE(PG8_SA(1, 0), a3, voffA);
            PG8_BAR; PG8_WAIT_L(0); PG8_MMA(1, 0, At, B0); PG8_BAR; PG8_SCHED;
            PG8_STAGE(PG8_SB(1, 1), b3 + hstepB, voffB);
            PG8_WAIT_V(6); PG8_BAR; PG8_MMA(1, 1, At, B1); PG8_BAR;
            }
        }
        if constexpr (ALIGN_EPI) { if (wr == 0) PG8_BAR; }
        asm volatile("s_nop 15\n\ts_nop 15" ::: "memory"); __builtin_amdgcn_sched_barrier(0);
        if constexpr (!Epi::AFTER_DRAIN) { E(acc, cur, wr, wc, fr, fq); S.done(cur); }
        if (!has_next) break;
#pragma unroll
        for (int a = 0; a < 2; ++a)
#pragma unroll
            for (int b = 0; b < 2; ++b)
#pragma unroll
                for (int m = 0; m < 4; ++m)
#pragma unroll
                    for (int n = 0; n < 2; ++n) acc[a][b][m][n] = (f32x4){0.f, 0.f, 0.f, 0.f};
        cur = nxt; cA = nA; cB = nB; ++ui;
        do0 = wr * 64 < S.vrows(cur); do1 = wr * 64 + HALF < S.vrows(cur);
        if constexpr (ALIGN_EPI) { if (wr == 1) PG8_BAR; }
    }
    PG8_WAIT_V(0);
    if constexpr (!ALIGN_EPI) { if (wr == 0) PG8_BAR; }
    PG8_BAR;
    if constexpr (Epi::AFTER_DRAIN) { E.fused(acc, cur, wr, wc, fr, fq, lds, wid, lane); S.done(cur); }
#undef PG8_SA
#undef PG8_SB
#undef PG8_STAGE
#undef PG8_LDA
#undef PG8_LDB
#undef PG8_MMA
#undef PG8_WAIT_V
#undef PG8_WAIT_L
#undef PG8_BAR
#undef PG8_SCHED
}
template <class Epi, class Sched, bool ALIGN_EPI = false, bool SP2 = false>
__device__ __forceinline__ void gemm_phase_g8(PG8_LAS unsigned char* lds, const Gemm g, const Sched& S, const Epi& E, const int* gidx, const int sa, const int sb) {
    int tid_ = g.wv * 64 + lane_id(); asm volatile("" : "+v"(tid_));
    const int tid = tid_, wid = __builtin_amdgcn_readfirstlane(tid >> 6), lane = tid & 63, wr = wid >> 2, wc = wid & 3, fr = lane & 15, fq = lane >> 4;
    const int K = g.K, nt = K / BK;
    unsigned voffA[2], voffB[2];
#pragma unroll
    for (int i = 0; i < 2; ++i) { int R, C; stage_rc(tid * 16 + i * 8192, R, C); const int Rb = Epi::PERM ? ((R & ~31) + perm32(R & 31)) : R;
        voffA[i] = (unsigned)(R * g.lda + C) * 2u; voffB[i] = (unsigned)(Rb * g.ldb + C) * 2u; }
    int RA[2]; unsigned cAo[2];
#pragma unroll
    for (int i = 0; i < 2; ++i) { int R, C; stage_rc(tid * 16 + i * 8192, R, C); RA[i] = R; cAo[i] = (unsigned)C * 2u; }
    unsigned vcur[2][2], vnxt[2][2], vsel[2][2];
#define PG8_GOFF(pm_, dst) do { _Pragma("unroll") for (int h_ = 0; h_ < 2; ++h_) _Pragma("unroll") for (int i_ = 0; i_ < 2; ++i_) dst[h_][i_] = (unsigned)gidx[(pm_) * BM + h_ * HALF + RA[i_]] * (unsigned)(g.lda * 2) + cAo[i_]; } while (0)
    const size_t kstep = (size_t)(BK * 2);
    const size_t hstepA = (size_t)HALF * g.lda * 2, hstepB = (size_t)HALF * g.ldb * 2;
    const size_t tstepA = 2 * hstepA, tstepB = 2 * hstepB;
    const unsigned ldsw = (unsigned)wid * 1024u;
    const int aoff8[2] = {lds_byte(wr * 64 + fr, 16 * fq), lds_byte(wr * 64 + fr, 16 * fq + 8)}, boff8[2] = {lds_byte(wc * 32 + fr, 16 * fq), lds_byte(wc * 32 + fr, 16 * fq + 8)};
#define PG8_SA(b, h) (((b) * 2 + (h)) * HTB)
#define PG8_SB(b, h) ((4 + (b) * 2 + (h)) * HTB)
#define PG8_STAGE(bufoff, gbase, voff) do { _Pragma("unroll") for (int _i = 0; _i < 2; ++_i) \
        __builtin_amdgcn_global_load_lds((const unsigned*)((const char*)(gbase) + (voff)[_i]), (PG8_LAS unsigned*)(lds + (bufoff) + ldsw + _i * 8192), 16, 0, 0); } while (0)
#define PG8_LDA(dst, b, h) do { _Pragma("unroll") for (int m = 0; m < 4; ++m) { const v4i_t lo_ = *(const PG8_LAS v4i_t*)(lds + PG8_SA(b, h) + aoff8[0] + m * 2048), hi_ = *(const PG8_LAS v4i_t*)(lds + PG8_SA(b, h) + aoff8[1] + m * 2048); dst[m] = __builtin_shufflevector(lo_, hi_, 0, 1, 2, 3, 4, 5, 6, 7); } } while (0)
#define PG8_LDB(dst, b, h) do { _Pragma("unroll") for (int n = 0; n < 2; ++n) { const v4i_t lo_ = *(const PG8_LAS v4i_t*)(lds + PG8_SB(b, h) + boff8[0] + n * 2048), hi_ = *(const PG8_LAS v4i_t*)(lds + PG8_SB(b, h) + boff8[1] + n * 2048); dst[n] = __builtin_shufflevector(lo_, hi_, 0, 1, 2, 3, 4, 5, 6, 7); } } while (0)
#define PG8_MMA(ai, bj, At, Bt) do { if ((ai) ? do1 : do0) { __builtin_amdgcn_s_setprio(1); _Pragma("unroll") for (int m = 0; m < 4; ++m) _Pragma("unroll") for (int n = 0; n < 2; ++n) \
        asm volatile("v_mfma_scale_f32_16x16x128_f8f6f4 %0, %1, %2, %0, %3, %4 op_sel_hi:[0,0,0]" : "+v"(acc[ai][bj][m][n]) : "v"(Bt[n]), "v"(At[m]), "v"(sa), "v"(sb)); __builtin_amdgcn_s_setprio(0); } } while (0)
#define PG8_WAIT_V(n) asm volatile("s_waitcnt vmcnt(" #n ")" ::: "memory")
#define PG8_WAIT_L(n) asm volatile("s_waitcnt lgkmcnt(" #n ")" ::: "memory")
#define PG8_BAR __builtin_amdgcn_s_barrier()
#define PG8_SCHED __builtin_amdgcn_sched_barrier(0)
    Unit cur, nxt; int ui = 0;
    if (!S.next(0, cur)) return;
    bool do0 = wr * 64 < S.vrows(cur), do1 = wr * 64 + HALF < S.vrows(cur);
    f32x4 acc[2][2][4][2];
#pragma unroll
    for (int a = 0; a < 2; ++a)
#pragma unroll
        for (int b = 0; b < 2; ++b)
#pragma unroll
            for (int m = 0; m < 4; ++m)
#pragma unroll
                for (int n = 0; n < 2; ++n) acc[a][b][m][n] = (f32x4){0.f, 0.f, 0.f, 0.f};
    v8i_t At[4], B0[2], B1[2];
    const char* cA = (const char*)g.A; PG8_GOFF(cur.pm, vcur); const char* cB = (const char*)g.Bt + (size_t)cur.pn * tstepB;
    S.a_ready(cur);
    if constexpr (SP2) {
        PG8_STAGE(PG8_SB(0, 0), cB, voffB); PG8_STAGE(PG8_SB(0, 1), cB + hstepB, voffB); PG8_STAGE(PG8_SA(0, 0), cA, vcur[0]); PG8_STAGE(PG8_SA(0, 1), cA, vcur[1]);
        if (wr == 1) PG8_BAR;
        PG8_WAIT_V(2); PG8_BAR;
        PG8_STAGE(PG8_SB(1, 0), cB + kstep, voffB); PG8_STAGE(PG8_SA(1, 0), cA + kstep, vcur[0]); PG8_STAGE(PG8_SB(1, 1), cB + hstepB + kstep, voffB);
        PG8_WAIT_V(6); PG8_BAR;
    } else {
        PG8_STAGE(PG8_SB(0, 0), cB, voffB); PG8_STAGE(PG8_SA(0, 0), cA, vcur[0]); PG8_STAGE(PG8_SB(0, 1), cB + hstepB, voffB); PG8_STAGE(PG8_SA(0, 1), cA, vcur[1]);
        if (wr == 1) PG8_BAR;
        PG8_WAIT_V(4); PG8_BAR;
        PG8_STAGE(PG8_SB(1, 0), cB + kstep, voffB); PG8_STAGE(PG8_SA(1, 0), cA + kstep, vcur[0]); PG8_STAGE(PG8_SB(1, 1), cB + hstepB + kstep, voffB);
        PG8_WAIT_V(6); PG8_BAR;
    }
    for (;;) {
        const bool has_next = S.next(ui + 1, nxt);
        const char* nA = cA; if (has_next) PG8_GOFF(nxt.pm, vnxt); else { _Pragma("unroll") for (int h_ = 0; h_ < 2; ++h_) _Pragma("unroll") for (int i_ = 0; i_ < 2; ++i_) vnxt[h_][i_] = vcur[h_][i_]; } const char* nB = has_next ? (const char*)g.Bt + (size_t)nxt.pn * tstepB : cB;
        for (int t = 0; t < nt; t += 2) {
            const bool last = (t == nt - 2);
            _Pragma("unroll") for (int h_ = 0; h_ < 2; ++h_) _Pragma("unroll") for (int i_ = 0; i_ < 2; ++i_) vsel[h_][i_] = last ? vnxt[h_][i_] : vcur[h_][i_];
            const char* a1 = cA + (size_t)(t + 1) * kstep;
            const char* a2 = last ? nA : cA + (size_t)(t + 2) * kstep; const char* b2 = last ? nB : cB + (size_t)(t + 2) * kstep;
            const char* a3 = a2 + kstep; const char* b3 = b2 + kstep;
            if (last && has_next) S.a_ready(nxt);
            if constexpr (SP2) {
            PG8_LDB(B0, 0, 0); PG8_LDB(B1, 0, 1); PG8_SCHED; PG8_LDA(At, 0, 0); PG8_STAGE(PG8_SA(1, 1), a1, vcur[1]);
            PG8_WAIT_V(8); PG8_WAIT_L(0); PG8_BAR; PG8_MMA(0, 0, At, B0); PG8_MMA(0, 1, At, B1); PG8_BAR; PG8_SCHED;
            PG8_LDA(At, 0, 1); PG8_STAGE(PG8_SB(0, 0), b2, voffB); PG8_STAGE(PG8_SB(0, 1), b2 + hstepB, voffB); PG8_STAGE(PG8_SA(0, 0), a2, vsel[0]);
            PG8_WAIT_V(8); PG8_WAIT_L(0); PG8_BAR; PG8_MMA(1, 0, At, B0); PG8_MMA(1, 1, At, B1); PG8_BAR; PG8_SCHED;
            PG8_LDB(B0, 1, 0); PG8_LDB(B1, 1, 1); PG8_SCHED; PG8_LDA(At, 1, 0); PG8_STAGE(PG8_SA(0, 1), a2, vsel[1]);
            PG8_WAIT_V(8); PG8_WAIT_L(0); PG8_BAR; PG8_MMA(0, 0, At, B0); PG8_MMA(0, 1, At, B1); PG8_BAR; PG8_SCHED;
            PG8_LDA(At, 1, 1); PG8_STAGE(PG8_SB(1, 0), b3, voffB); PG8_STAGE(PG8_SB(1, 1), b3 + hstepB, voffB); PG8_STAGE(PG8_SA(1, 0), a3, vsel[0]);
            PG8_WAIT_V(8); PG8_WAIT_L(0); PG8_BAR; PG8_MMA(1, 0, At, B0); PG8_MMA(1, 1, At, B1); PG8_BAR; PG8_SCHED;
            } else {
            PG8_LDB(B0, 0, 0); PG8_SCHED; PG8_LDA(At, 0, 0); PG8_STAGE(PG8_SA(1, 1), a1, vcur[1]);
            PG8_WAIT_L(8); PG8_BAR; PG8_WAIT_L(0); PG8_MMA(0, 0, At, B0); PG8_BAR; PG8_SCHED;
            PG8_LDB(B1, 0, 1); PG8_STAGE(PG8_SB(0, 0), b2, voffB);
            PG8_BAR; PG8_WAIT_L(0); PG8_MMA(0, 1, At, B1); PG8_BAR;
            PG8_LDA(At, 0, 1); PG8_STAGE(PG8_SA(0, 0), a2, vsel[0]);
            PG8_BAR; PG8_WAIT_L(0); PG8_MMA(1, 0, At, B0); PG8_BAR; PG8_SCHED;
            PG8_STAGE(PG8_SB(0, 1), b2 + hstepB, voffB);
            PG8_WAIT_V(6); PG8_BAR; PG8_MMA(1, 1, At, B1); PG8_BAR;
            PG8_LDB(B0, 1, 0); PG8_SCHED; PG8_LDA(At, 1, 0); PG8_STAGE(PG8_SA(0, 1), a2, vsel[1]);
            PG8_WAIT_L(8); PG8_BAR; PG8_WAIT_L(0); PG8_MMA(0, 0, At, B0); PG8_BAR; PG8_SCHED;
            PG8_LDB(B1, 1, 1); PG8_STAGE(PG8_SB(1, 0), b3, voffB);
            PG8_BAR; PG8_WAIT_L(0); PG8_MMA(0, 1, At, B1); PG8_BAR;
            PG8_LDA(At, 1, 1); PG8_STAGE(PG8_SA(1, 0), a3, vsel[0]);
            PG8_BAR; PG8_WAIT_L(0); PG8_MMA(1, 0, At, B0); PG8_BAR; PG8_SCHED;
            PG8_STAGE(PG8_SB(1, 1), b3 + hstepB, voffB);
            PG8_WAIT_V(6); PG8_BAR; PG8_MMA(1, 1, At, B1); PG8_BAR;
            }
        }
        if constexpr (ALIGN_EPI) { if (wr == 0) PG8_BAR; }
        asm volatile("s_nop 15\n\ts_nop 15" ::: "memory"); __builtin_amdgcn_sched_barrier(0);
        if constexpr (!Epi::AFTER_DRAIN) { E(acc, cur, wr, wc, fr, fq); S.done(cur); }
        if (!has_next) break;
#pragma unroll
        for (int a = 0; a < 2; ++a)
#pragma unroll
            for (int b = 0; b < 2; ++b)
#pragma unroll
                for (int m = 0; m < 4; ++m)
#pragma unroll
                    for (int n = 0; n < 2; ++n) acc[a][b][m][n] = (f32x4){0.f, 0.f, 0.f, 0.f};
        cur = nxt; cA = nA; cB = nB; ++ui; _Pragma("unroll") for (int h_ = 0; h_ < 2; ++h_) _Pragma("unroll") for (int i_ = 0; i_ < 2; ++i_) vcur[h_][i_] = vnxt[h_][i_];
        do0 = wr * 64 < S.vrows(cur); do1 = wr * 64 + HALF < S.vrows(cur);
        if constexpr (ALIGN_EPI) { if (wr == 1) PG8_BAR; }
    }
    PG8_WAIT_V(0);
    if constexpr (!ALIGN_EPI) { if (wr == 0) PG8_BAR; }
    PG8_BAR;
    if constexpr (Epi::AFTER_DRAIN) { E.fused(acc, cur, wr, wc, fr, fq, lds, wid, lane); S.done(cur); }
#undef PG8_GOFF
#undef PG8_SA
#undef PG8_SB
#undef PG8_STAGE
#undef PG8_LDA
#undef PG8_LDB
#undef PG8_MMA
#undef PG8_WAIT_V
#undef PG8_WAIT_L
#undef PG8_BAR
#undef PG8_SCHED
}
#undef PG8_CAT
}
#ifndef PG8_SP2
#define PG8_SP2 true
#endif
#ifndef PG8_ALIGN
#define PG8_ALIGN true
#endif
constexpr int NB = 2, SEQ = 8192, DM = 1024, LCTX = 256, DEPTH = 2;
constexpr int NX = NB * SEQ, NC = NB * LCTX, NR = NX + NC;
constexpr int INW = 1536, NE = 16, FF = 2048, CAPX = 1024, CAPC = 32;
constexpr int SLOTS_E = 2304, NSLOT = NE * SLOTS_E;
constexpr float LN_EPS = 1e-5f, ALPHA = 1.41421356237309515f;
constexpr int NWAVES = 8, NTHREADS = 512;
constexpr int RING_BYTES = 131072, LDS_BYTES = 147456;

constexpr size_t MiB = 1u << 20, KiB = 1u << 10;
constexpr size_t WS_MOD = 1 * MiB;
constexpr size_t WS_ROPE = 1 * MiB + 160 * KiB;
constexpr size_t WS_LBAR = 1 * MiB + 192 * KiB;
constexpr size_t WS_BBAR = 1 * MiB + 256 * KiB;
constexpr size_t WS_BINP = 1 * MiB + 768 * KiB;
constexpr size_t WS_AFF = 2 * MiB;
constexpr size_t WS_AFFC = 3 * MiB;
constexpr size_t WS_IDX = 3 * MiB + 64 * KiB;
constexpr size_t WS_GATE = 3 * MiB + 256 * KiB;
constexpr size_t WS_TOKSLOT = 4 * MiB;
constexpr size_t WS_WIN = 6 * MiB;
constexpr size_t WS_WOUT = 12 * MiB;
constexpr size_t WS_WGU = 16 * MiB;
constexpr size_t WS_WD = 272 * MiB;
constexpr size_t WS_HX = 400 * MiB;
constexpr size_t WS_Q = 433 * MiB;
constexpr size_t WS_K = 450 * MiB;
constexpr size_t WS_V = 455 * MiB;
constexpr size_t WS_U = 460 * MiB;
constexpr size_t WS_HG = 477 * MiB;
constexpr size_t WS_YF = 494 * MiB;
constexpr size_t WS_YB = 511 * MiB;
constexpr size_t WS_CAT = 528 * MiB;
constexpr size_t WS_YMIX = 561 * MiB;
constexpr size_t WS_XS = 528 * MiB;
constexpr size_t WS_XMID = 627 * MiB;
constexpr size_t WS_XCUR = 693 * MiB;
constexpr size_t WS_HID = 759 * MiB;
constexpr size_t WS_PX = 759 * MiB;
constexpr size_t WS_YEXP = 903 * MiB;
constexpr size_t WS_END = 975 * MiB;

#define LAS __attribute__((address_space(3)))
typedef unsigned short bf16;
typedef unsigned v4u __attribute__((ext_vector_type(4)));
typedef unsigned v2u __attribute__((ext_vector_type(2)));
typedef float f32x4 __attribute__((ext_vector_type(4)));
#define LDS_WAIT() asm volatile("s_waitcnt lgkmcnt(0)" ::: "memory")
__device__ __forceinline__ unsigned f2bf(float f) { unsigned u = __builtin_bit_cast(unsigned, f); return (u + 0x7fffu + ((u >> 16) & 1u)) >> 16; }
__device__ __forceinline__ unsigned pk2(float lo, float hi) { return f2bf(lo) | (f2bf(hi) << 16); }
__device__ __forceinline__ float bflo(unsigned w) { return __builtin_bit_cast(float, w << 16); }
__device__ __forceinline__ float bfhi(unsigned w) { return __builtin_bit_cast(float, w & 0xffff0000u); }
__device__ __forceinline__ float bf2f(bf16 b) { return __builtin_bit_cast(float, ((unsigned)b) << 16); }
template <int CTRL> __device__ __forceinline__ float dppf(float x) { return __builtin_bit_cast(float, __builtin_amdgcn_update_dpp(0, __builtin_bit_cast(int, x), CTRL, 0xf, 0xf, true)); }
template <int CTRL> __device__ __forceinline__ int dppi(int x) { return __builtin_amdgcn_update_dpp(0, x, CTRL, 0xf, 0xf, true); }
constexpr int DPP_X1 = 0xB1, DPP_X2 = 0x4E, DPP_HM = 0x141, DPP_RM = 0x140;
__device__ __forceinline__ void swap16(float& a, float& b) { asm("s_nop 1\n\tv_permlane16_swap_b32 %0, %1" : "+v"(a), "+v"(b)); }
__device__ __forceinline__ void swap32(float& a, float& b) { asm("s_nop 1\n\tv_permlane32_swap_b32 %0, %1" : "+v"(a), "+v"(b)); }
__device__ __forceinline__ float xrow_sum(float v) { { float a = v, b = v; swap16(a, b); v = a + b; } { float a = v, b = v; swap32(a, b); v = a + b; } return v; }
__device__ __forceinline__ float row_sum16(float v) { v += dppf<DPP_X1>(v); v += dppf<DPP_X2>(v); v += dppf<DPP_HM>(v); v += dppf<DPP_RM>(v); return v; }
__device__ __forceinline__ float row_max16(float v) { v = fmaxf(v, dppf<DPP_X1>(v)); v = fmaxf(v, dppf<DPP_X2>(v)); v = fmaxf(v, dppf<DPP_HM>(v)); v = fmaxf(v, dppf<DPP_RM>(v)); return v; }
__device__ __forceinline__ float wave_sum(float v) { return xrow_sum(row_sum16(v)); }
__device__ __forceinline__ float wave_max(float v) { v = row_max16(v); { float a = v, b = v; swap16(a, b); v = fmaxf(a, b); } { float a = v, b = v; swap32(a, b); v = fmaxf(a, b); } return v; }
__device__ __forceinline__ int wave_sum_i(int v) {
    v += dppi<DPP_X1>(v); v += dppi<DPP_X2>(v); v += dppi<DPP_HM>(v); v += dppi<DPP_RM>(v);
    float f = __builtin_bit_cast(float, v);
    { float a = f, b = f; swap16(a, b); v = __builtin_bit_cast(int, a) + __builtin_bit_cast(int, b); f = __builtin_bit_cast(float, v); }
    { float a = f, b = f; swap32(a, b); v = __builtin_bit_cast(int, a) + __builtin_bit_cast(int, b); }
    return v;
}
__device__ __forceinline__ float sigmoid_f(float x) { return 1.f / (1.f + __expf(-x)); }
__device__ __forceinline__ float silu_f(float x) { return x / (1.f + __expf(-x)); }
__device__ __forceinline__ float gelu_tanh_f(float x) { const float u = 0.7978845608028654f * (x + 0.044715f * x * x * x); return 0.5f * x * (1.f + tanhf(u)); }

struct Args { const float* in[35]; float* out; unsigned char* ws; int ph_lo, ph_hi, G, pad; };
typedef const __attribute__((address_space(4))) Args* KArgs;
__device__ __forceinline__ KArgs kargs() { unsigned long long p = (unsigned long long)__builtin_amdgcn_kernarg_segment_ptr(); asm volatile("" : "+s"(p)); return (KArgs)p; }

__device__ __forceinline__ unsigned char* launder_ws(unsigned char* p) { unsigned long long v = (unsigned long long)p; asm volatile("" : "+s"(v)); return (unsigned char*)v; }
template <class T> __device__ __forceinline__ T* opq(T* p) { unsigned long long v = (unsigned long long)p; asm volatile("" : "+s"(v)); return (T*)v; }
struct Frame {
    LAS unsigned char* lds;
    int tid, lane, wave, bid, G, gw, NGW;
    unsigned char* ws;
};

__device__ __forceinline__ void s5_build_ops(Frame& F, unsigned char* ws_, KArgs ka, int l, int g, int part);
constexpr size_t WS_WPT_FWD = 5 * MiB + 512 * KiB;
constexpr size_t WS_CTR = 16 * KiB;
__device__ __forceinline__ int maprow(int type, int n0) {
    if (type == 1) return 256 * (n0 >> 7) + (n0 & 127);
    if (type == 2) return 256 * (n0 >> 7) + 128 + (n0 & 127);
    if (type == 3) { if (n0 < 1024) return n0; if (n0 < 1280) { const int ch = n0 - 1024; return 1024 + 256 * (ch >> 7) + (ch & 127); } const int ch = n0 - 1280; return 1024 + 256 * (ch >> 7) + 128 + (ch & 127); }
    return n0;
}
struct TItem { const float* src; unsigned char* dst; int N, rowbytes, f8; float scale; };
__device__ __forceinline__ float sat_e4m3(float x) { return __builtin_amdgcn_fmed3f(x, -448.f, 448.f); }
__device__ __forceinline__ unsigned pack4_fp8(float a, float b, float c, float d) { int w = __builtin_amdgcn_cvt_pk_fp8_f32(sat_e4m3(a), sat_e4m3(b), 0, false); w = __builtin_amdgcn_cvt_pk_fp8_f32(sat_e4m3(c), sat_e4m3(d), w, true); return (unsigned)w; }
__device__ __forceinline__ TItem titem(const float* W, int K, int N, void* WT, int type, int item, int lane, int f8 = 0, float scale = 1.f) {
    const int nblk = N / 32, kb = item / nblk, nb = item % nblk, k0 = 64 * kb, n0 = 32 * nb;
    TItem t; t.src = W + (size_t)(k0 + (lane >> 5)) * N + n0 + (lane & 31); t.N = N; t.f8 = f8; t.scale = scale;
    t.rowbytes = f8 ? K : 2 * K; t.dst = (unsigned char*)WT + (size_t)maprow(type, n0) * t.rowbytes + (f8 ? k0 : 2 * k0); return t;
}
__device__ __forceinline__ void titem_load(const TItem& t, float (&tmp)[32]) {
#pragma unroll
    for (int i = 0; i < 32; ++i) tmp[i] = __builtin_nontemporal_load(t.src + (size_t)(2 * i) * t.N);
}
__device__ __forceinline__ void titem_finish(const TItem& t, const float (&tmp)[32], LAS float* scr, int lane) {
#pragma unroll
    for (int i = 0; i < 32; ++i) scr[(2 * i + (lane >> 5)) * 33 + (lane & 31)] = tmp[i];
    LDS_WAIT(); asm volatile("" ::: "memory");
    const int c = lane & 7;
#pragma unroll
    for (int j = 0; j < 4; ++j) { const int n = (lane >> 3) + 8 * j; const LAS float* s = scr + (8 * c) * 33 + n;
        if (t.f8) { const float sc = t.scale; v2u o; o.x = pack4_fp8(s[0 * 33] * sc, s[1 * 33] * sc, s[2 * 33] * sc, s[3 * 33] * sc); o.y = pack4_fp8(s[4 * 33] * sc, s[5 * 33] * sc, s[6 * 33] * sc, s[7 * 33] * sc);
            *(v2u*)(t.dst + (size_t)n * t.rowbytes + 8 * c) = o; }
        else { v4u o; o.x = pk2(s[0 * 33], s[1 * 33]); o.y = pk2(s[2 * 33], s[3 * 33]); o.z = pk2(s[4 * 33], s[5 * 33]); o.w = pk2(s[6 * 33], s[7 * 33]);
            *(v4u*)(t.dst + (size_t)n * t.rowbytes + 16 * c) = o; } }
    LDS_WAIT(); asm volatile("" ::: "memory");
}
__device__ __forceinline__ void ph_prologue(Frame& F) {
    unsigned char* const ws_ = launder_ws(F.ws);
    KArgs ka = kargs();
    const float* c_in = ka->in[1]; const float* cctx = ka->in[3]; const float* w_mod = ka->in[4]; const float* b_mod = ka->in[5];
    for (int u = F.bid; u < 2 * 96; u += F.G) {
        const int l = u / 96, cc = u % 96;
        LAS float* sv = (LAS float*)F.lds;
        LAS float* part = sv + 3072;
        for (int i = F.tid; i < 3072; i += NTHREADS) { const int v = i >> 10, k = i & 1023; const float x = (v < 2) ? c_in[v * 1024 + k] : cctx[k]; sv[i] = silu_f(x); }
        __syncthreads();
        float a0 = 0.f, a1 = 0.f, a2 = 0.f;
        const float* wp = w_mod + (size_t)l * 1024 * 6144 + cc * 64 + F.lane;
#pragma nounroll
        for (int k0 = 0; k0 < 128; k0 += 32) { float wv[32];
#pragma unroll
            for (int q = 0; q < 32; ++q) wv[q] = __builtin_nontemporal_load(wp + (size_t)(F.wave * 128 + k0 + q) * 6144);
#pragma unroll
            for (int q = 0; q < 32; ++q) { const int k = F.wave * 128 + k0 + q; a0 += sv[k] * wv[q]; a1 += sv[1024 + k] * wv[q]; a2 += sv[2048 + k] * wv[q]; } }
        part[(F.wave * 3 + 0) * 64 + F.lane] = a0; part[(F.wave * 3 + 1) * 64 + F.lane] = a1; part[(F.wave * 3 + 2) * 64 + F.lane] = a2;
        __syncthreads();
        if (F.tid < 192) { const int v = F.tid >> 6, j = F.tid & 63; float s = b_mod[l * 6144 + cc * 64 + j];
#pragma unroll
            for (int w = 0; w < 8; ++w) s += part[(w * 3 + v) * 64 + j];
            ((float*)(ws_ + WS_MOD))[(l * 3 + v) * 6144 + cc * 64 + j] = s; }
        __syncthreads();
    }
    for (int u = (F.G >= 256) ? F.bid - (F.G - 128) : F.bid; u >= 0 && u < 128; u += (F.G >= 256) ? 128 : F.G) s5_build_ops(F, ws_, ka, u >> 6, (u >> 2) & 15, u & 3);
    const int gid = F.bid * NTHREADS + F.tid;
    if (gid < 2048) { const int pos = gid >> 4, i = gid & 15; const double ang = (double)pos * pow(10000.0, -(double)i / 16.0);
        float* rp = (float*)(ws_ + WS_ROPE) + gid * 2; rp[0] = (float)cos(ang); rp[1] = (float)sin(ang); }
    if (gid >= 4096 && gid < 4096 + 3072) { const int i = gid - 4096, l = i / 1536, n = i % 1536; ((float*)(ws_ + WS_BINP))[l * 1536 + maprow(3, n & ~31) + (n & 31)] = ka->in[7][l * 1536 + n]; }
    {
        LAS float* scr = (LAS float*)(F.lds + F.wave * 16384);
        constexpr int S_IN = 16 * 48, S_OUT = 16 * 32, S_PW = 2 * 32, PER_S = S_IN + S_OUT + S_PW;
        for (int it = F.gw; it < 2 * PER_S; it += F.NGW) { const int l_ = it / PER_S; int r_ = it % PER_S; TItem T;
            if (r_ < S_IN) T = titem(ka->in[6] + (size_t)l_ * 1024 * 1536, 1024, 1536, (bf16*)(ws_ + WS_WIN) + (size_t)l_ * 1536 * 1024, 3, r_, F.lane);
            else if ((r_ -= S_IN) < S_OUT) T = titem(ka->in[25] + (size_t)l_ * 1024 * 1024, 1024, 1024, (bf16*)(ws_ + WS_WOUT) + (size_t)l_ * 1024 * 1024, 0, r_, F.lane);
            else { r_ -= S_OUT; const int w_ = r_ >> 5; T = titem(ka->in[w_ ? 23 : 17] + (size_t)l_ * 65536, 256, 256, (bf16*)(ws_ + WS_WPT_FWD) + (size_t)(l_ * 2 + w_) * 65536, 0, r_ & 31, F.lane); }
            float tc[32]; titem_load(T, tc); titem_finish(T, tc, scr, F.lane); }
    }
    __syncthreads();
    {
        LAS float* T = (LAS float*)F.lds;
        LAS unsigned* bc = (LAS unsigned*)(F.lds + 128 * 260 * 4);
        unsigned* ctr = (unsigned*)(ws_ + WS_CTR);
        constexpr int TPM = 64, TPE = 3 * TPM, NT_ALL = 2 * NE * TPE;
        const int lk = F.tid >> 6, ln4 = F.tid & 63;
        const int sn = F.tid >> 1, sq = F.tid & 1;
        struct Tl { const float* src; unsigned char* dst; int N, K; float sc; };
#define TILE_DECODE(t, X) do { const int le_ = (t) / TPE, r_ = (t) % TPE, which_ = r_ / TPM, ti_ = r_ % TPM; \
            if (which_ < 2) { const int kb_ = ti_ >> 3, nb_ = ti_ & 7; X.N = 2048; X.K = 1024; X.sc = 32.f; \
                X.src = ka->in[30 + which_] + (size_t)le_ * 1024 * 2048 + (size_t)(128 * kb_) * 2048 + 256 * nb_; \
                X.dst = ws_ + WS_WGU + (size_t)le_ * 4096 * 1024 + (size_t)(512 * nb_ + 128 * which_) * 1024 + 128 * kb_; } \
            else { const int kb_ = ti_ >> 2, nb_ = ti_ & 3; X.N = 1024; X.K = 2048; X.sc = 64.f; \
                X.src = ka->in[32] + (size_t)le_ * 2048 * 1024 + (size_t)(128 * kb_) * 1024 + 256 * nb_; \
                X.dst = ws_ + WS_WD + (size_t)le_ * 1024 * 2048 + (size_t)(256 * nb_) * 2048 + 128 * kb_; } } while (0)
#define TILE_LOAD(X, R) do { _Pragma("unroll") for (int i = 0; i < 16; ++i) R[i] = __builtin_nontemporal_load((const f32x4*)(X.src + (size_t)(lk + 8 * i) * X.N + 4 * ln4)); } while (0)
#define TILE_DRAW(t) do { __syncthreads(); if (F.tid == 0) bc[0] = __hip_atomic_fetch_add(ctr, 1u, __ATOMIC_RELAXED, __HIP_MEMORY_SCOPE_AGENT); __syncthreads(); t = (int)bc[0]; } while (0)
        int tcur, tnxt; Tl cur, nxt; f32x4 rc[16], rn[16];
        TILE_DRAW(tcur);
        if (tcur < NT_ALL) { TILE_DECODE(tcur, cur); TILE_LOAD(cur, rc);
            for (;;) {
                TILE_DRAW(tnxt);
                const bool has = tnxt < NT_ALL;
                if (has) { TILE_DECODE(tnxt, nxt); TILE_LOAD(nxt, rn); }
#pragma unroll
                for (int i = 0; i < 16; ++i) *(LAS f32x4*)(T + (lk + 8 * i) * 260 + 4 * ln4) = rc[i];
                __syncthreads();
                { const float sc = cur.sc; const LAS float* s = T + (64 * sq) * 260 + sn;
                    const int rowoff = (cur.K == 1024) ? (256 * (sn >> 7) + (sn & 127)) : sn;
                    unsigned char* o = cur.dst + (size_t)rowoff * cur.K + 64 * sq;
#pragma unroll
                    for (int q = 0; q < 4; ++q) { unsigned w[4];
#pragma unroll
                        for (int j = 0; j < 4; ++j) { const int k_ = 16 * q + 4 * j; w[j] = pack4_fp8(s[k_ * 260] * sc, s[(k_ + 1) * 260] * sc, s[(k_ + 2) * 260] * sc, s[(k_ + 3) * 260] * sc); }
                        *(v4u*)(o + 16 * q) = (v4u){w[0], w[1], w[2], w[3]}; } }
                if (!has) break;
                cur = nxt;
#pragma unroll
                for (int i = 0; i < 16; ++i) rc[i] = rn[i];
            } }
#undef TILE_DRAW
#undef TILE_LOAD
#undef TILE_DECODE
    }
}

__device__ __forceinline__ void row_load(const float* p, int lane, f32x4 (&v)[4]) {
#pragma unroll
    for (int j = 0; j < 4; ++j) v[j] = ((const f32x4*)p)[lane + 64 * j];
}
__device__ __forceinline__ void row_ln(f32x4 (&v)[4]) {
    float s = 0.f;
#pragma unroll
    for (int j = 0; j < 4; ++j) s += (v[j].x + v[j].y) + (v[j].z + v[j].w);
    const float mean = wave_sum(s) * (1.f / 1024.f); float s2 = 0.f;
#pragma unroll
    for (int j = 0; j < 4; ++j) { v[j] = v[j] - mean; s2 += (v[j].x * v[j].x + v[j].y * v[j].y) + (v[j].z * v[j].z + v[j].w * v[j].w); }
    const float rstd = 1.f / sqrtf(wave_sum(s2) * (1.f / 1024.f) + LN_EPS);
#pragma unroll
    for (int j = 0; j < 4; ++j) v[j] = v[j] * rstd;
}
__device__ __forceinline__ void row_store_bf16(bf16* p, int lane, const f32x4 (&v)[4]) {
#pragma unroll
    for (int j = 0; j < 4; ++j) { v2u o; o.x = pk2(v[j].x, v[j].y); o.y = pk2(v[j].z, v[j].w); ((v2u*)p)[lane + 64 * j] = o; }
}
__device__ __forceinline__ int row_mod_index(int r) { return r < NX ? (r >> 13) : 2; }
__device__ __forceinline__ void modulate_store(f32x4 (&v)[4], const float* shift, const float* scale, bf16* dst, int lane) {
    f32x4 o[4];
#pragma unroll
    for (int j = 0; j < 4; ++j) { const f32x4 sh = ((const f32x4*)shift)[lane + 64 * j], sc = ((const f32x4*)scale)[lane + 64 * j]; o[j] = v[j] * (sc + 1.f) + sh; }
    row_store_bf16(dst, lane, o);
}
__device__ __forceinline__ void ph_rows0(Frame& F) {
    unsigned char* const ws_ = launder_ws(F.ws);
    KArgs ka = kargs();
    const float* MOD = (const float*)(ws_ + WS_MOD); bf16* HX = (bf16*)(ws_ + WS_HX);
    for (int r = F.gw; r < NR; r += F.NGW) {
        const float* src = r < NX ? ka->in[0] + (size_t)r * 1024 : ka->in[2] + (size_t)(r - NX) * 1024;
        f32x4 v[4]; row_load(src, F.lane, v); row_ln(v);
        const float* m = MOD + (0 * 3 + row_mod_index(r)) * 6144;
        modulate_store(v, m, m + 1024, HX + (size_t)r * 1024, F.lane);
    }
}
constexpr int S5T = 32, S5R = 768, S5K = 768;
constexpr size_t WS_HCTX = 1 * MiB + 800 * KiB;
constexpr size_t WS_LB32 = 1 * MiB + 832 * KiB;
constexpr size_t WS_KT = 975 * MiB;
constexpr size_t WS_BE = 999 * MiB;
constexpr size_t WS_UC = 494 * MiB;
constexpr size_t WS_E = 512 * MiB;
constexpr size_t WS_Z = WS_HID + 100 * MiB;
constexpr size_t WS_CN = WS_Z + (size_t)NR * 256 * 2;
constexpr size_t WS_END2 = 1019 * MiB;

__device__ __forceinline__ void s5_build_ops(Frame& F, unsigned char* ws_, KArgs ka, int l, int g, int part) {
    LAS float* PW = (LAS float*)F.lds; LAS float* CM = PW + 8448; LAS float* BB = CM + 4096; LAS float* LAG = BB + 4096;
    __syncthreads();
    if (F.tid < 128) {
        const int d = F.tid >> 6, p = F.tid & 63; const int ldg = (l * 2 + d) * 16 + g;
        const double lr = ka->in[9][ldg * 64 + p], li = ka->in[10][ldg * 64 + p], dt = exp((double)ka->in[11][ldg]);
        const double zr = lr * dt, zi = li * dt, er = exp(zr), lbr = er * cos(zi), lbi = er * sin(zi);
        double pr = 1.0, pi = 0.0;
#pragma nounroll
        for (int tau = 0; tau <= 32; ++tau) { PW[((d * 33 + tau) * 64 + p) * 2] = (float)pr; PW[((d * 33 + tau) * 64 + p) * 2 + 1] = (float)pi; const double t = pr * lbr - pi * lbi; pi = pr * lbi + pi * lbr; pr = t; }
        const double nr = lbr - 1.0, ni = lbi, den = lr * lr + li * li, cr = (nr * lr + ni * li) / den, ci = (ni * lr - nr * li) / den;
        const float* bre = ka->in[12] + ((size_t)ldg * 64 + p) * 16; const float* bim = ka->in[13] + ((size_t)ldg * 64 + p) * 16;
        for (int c = 0; c < 16; ++c) { const double br = bre[c], bi = bim[c]; BB[((d * 64 + p) * 16 + c) * 2] = (float)(cr * br - ci * bi); BB[((d * 64 + p) * 16 + c) * 2 + 1] = (float)(cr * bi + ci * br); } }
    for (int i = F.tid; i < 2 * 16 * 64; i += NTHREADS) { const int d = i >> 10, r = i & 1023; const int ldg = (l * 2 + d) * 16 + g; CM[2 * i] = ka->in[14][(size_t)ldg * 1024 + r]; CM[2 * i + 1] = ka->in[15][(size_t)ldg * 1024 + r]; }
    __syncthreads();
    { const int it = F.tid, qh = it >> 8, d = (it >> 7) & 1, tau = (it >> 2) & 31, c = 4 * part + (it & 3);
        float acc[8];
#pragma unroll
        for (int q = 0; q < 8; ++q) acc[q] = 0.f;
#pragma nounroll
        for (int p = 0; p < 64; ++p) { const float cr = CM[((d * 16 + c) * 64 + p) * 2], ci = CM[((d * 16 + c) * 64 + p) * 2 + 1], pr = PW[((d * 33 + tau) * 64 + p) * 2], pi = PW[((d * 33 + tau) * 64 + p) * 2 + 1];
            const float wr = cr * pr - ci * pi, wi = cr * pi + ci * pr;
            const LAS f32x4* bp = (const LAS f32x4*)(BB + ((d * 64 + p) * 16 + 8 * qh) * 2);
#pragma unroll
            for (int q4 = 0; q4 < 4; ++q4) { const f32x4 b = bp[q4]; acc[2 * q4] += wr * b.x - wi * b.y; acc[2 * q4 + 1] += wr * b.z - wi * b.w; } }
#pragma unroll
        for (int q = 0; q < 8; ++q) LAG[((d * 32 + tau) * 16 + c) * 16 + 8 * qh + q] = acc[q]; }
    __syncthreads();
    const float* dsk = ka->in[16] + l * 256 + g * 16;
    bf16* KT = (bf16*)(ws_ + WS_KT) + ((size_t)(l * 16 + g) * 512) * S5K;
    for (int pc = F.tid; pc < 32 * 4 * 96; pc += NTHREADS) { const int r_ = pc / 96, q8 = pc % 96, j = r_ >> 2, c = 4 * part + (r_ & 3), row = j * 16 + c; float v[8];
        if (q8 < 64) { const int jp = q8 >> 1, c0 = (q8 & 1) * 8;
#pragma unroll
            for (int e = 0; e < 8; ++e) { float x = 0.f; if (j >= jp) x += LAG[((0 * 32 + (j - jp)) * 16 + c) * 16 + c0 + e]; if (j <= jp) x += LAG[((1 * 32 + (jp - j)) * 16 + c) * 16 + c0 + e]; if (j == jp && c == c0 + e) x += dsk[c]; v[e] = x; } }
        else { const int n0 = (q8 - 64) * 8, d = n0 >> 7, tau = d ? (32 - j) : (j + 1);
#pragma unroll
            for (int e = 0; e < 8; e += 2) { const int p = ((n0 & 127) + e) >> 1; const float cr = CM[((d * 16 + c) * 64 + p) * 2], ci = CM[((d * 16 + c) * 64 + p) * 2 + 1], pr = PW[((d * 33 + tau) * 64 + p) * 2], pi = PW[((d * 33 + tau) * 64 + p) * 2 + 1];
                v[e] = cr * pr - ci * pi; v[e + 1] = -(cr * pi + ci * pr); } }
        v4u o; o.x = pk2(v[0], v[1]); o.y = pk2(v[2], v[3]); o.z = pk2(v[4], v[5]); o.w = pk2(v[6], v[7]);
        *(v4u*)(KT + (size_t)row * S5K + q8 * 8) = o; }
    bf16* BE = (bf16*)(ws_ + WS_BE) + ((size_t)(l * 16 + g) * 256) * 512;
    for (int pc = F.tid; pc < 64 * 64; pc += NTHREADS) { const int n = 64 * part + (pc >> 6), q8 = pc & 63, d = n >> 7, p = (n & 127) >> 1, ri = n & 1, jp = q8 >> 1, c0 = (q8 & 1) * 8, tau = d ? jp : (31 - jp);
        const float pr = PW[((d * 33 + tau) * 64 + p) * 2], pi = PW[((d * 33 + tau) * 64 + p) * 2 + 1]; float v[8];
#pragma unroll
        for (int e = 0; e < 8; ++e) { const float br = BB[((d * 64 + p) * 16 + c0 + e) * 2], bi = BB[((d * 64 + p) * 16 + c0 + e) * 2 + 1]; v[e] = ri ? (pr * bi + pi * br) : (pr * br - pi * bi); }
        v4u o; o.x = pk2(v[0], v[1]); o.y = pk2(v[2], v[3]); o.z = pk2(v[4], v[5]); o.w = pk2(v[6], v[7]);
        *(v4u*)(BE + (size_t)n * 512 + q8 * 8) = o; }
    if (part == 0 && F.tid < 128) { const int d = F.tid >> 6, p = F.tid & 63; float* o = (float*)(ws_ + WS_LB32) + (((size_t)(l * 16 + g) * 2 + d) * 64 + p) * 2; o[0] = PW[((d * 33 + 32) * 64 + p) * 2]; o[1] = PW[((d * 33 + 32) * 64 + p) * 2 + 1]; }
    __syncthreads();
}
__device__ __forceinline__ void s5_carry_tile(Frame& F, int l, int g, int mt) {
    unsigned char* const ws_ = launder_ws(F.ws);
    if (mt < 2) {
        const int b = mt, seg = F.tid >> 7, d = (F.tid >> 6) & 1, p = F.tid & 63, dp = F.tid & 127;
        const float* lb = (const float*)(ws_ + WS_LB32) + (((size_t)(l * 16 + g) * 2 + d) * 64 + p) * 2; const float ar = lb[0], ai = lb[1];
        const float* E = (const float*)(ws_ + WS_E) + ((size_t)g * S5R) * 256 + d * 128 + 2 * p;
        bf16* UC = (bf16*)(ws_ + WS_UC) + ((size_t)g * S5R) * S5K + 512 + d * 128 + 2 * p;
        LAS float* Ls = (LAS float*)F.lds;
        float er[64], ei[64], cr[8], ci[8];
#pragma unroll
        for (int q = 0; q < 8; ++q) { const int R = 512 + b * 8 + (d ? 7 - q : q); const float2 e2 = *(const float2*)(E + (size_t)R * 256); cr[q] = e2.x; ci[q] = e2.y; }
        const int R0 = b * 256 + (d ? 255 - 64 * seg : 64 * seg); const long estep = d ? -256 : 256, ustep = d ? -(long)S5K : (long)S5K;
        { const float* ep = E + (size_t)R0 * 256;
#pragma unroll
          for (int q = 0; q < 64; ++q) { const float2 e2 = *(const float2*)ep; er[q] = e2.x; ei[q] = e2.y; ep += estep; } }
        float sr = 0.f, si = 0.f;
#pragma unroll
        for (int q = 0; q < 8; ++q) { const float nr = ar * sr - ai * si + cr[q], ni = ar * si + ai * sr + ci[q]; sr = nr; si = ni; }
        float lr = 0.f, li = 0.f;
#pragma unroll
        for (int q = 0; q < 64; ++q) { const float nr = ar * lr - ai * li + er[q], ni = ar * li + ai * lr + ei[q]; lr = nr; li = ni; }
        float pr = ar, pi = ai;
#pragma unroll
        for (int i = 0; i < 6; ++i) { const float t = pr * pr - pi * pi; pi = 2.f * pr * pi; pr = t; }
        Ls[(seg * 128 + dp) * 2] = lr; Ls[(seg * 128 + dp) * 2 + 1] = li;
        __syncthreads();
        for (int s_ = 0; s_ < seg; ++s_) { const float Lr = Ls[(s_ * 128 + dp) * 2], Li = Ls[(s_ * 128 + dp) * 2 + 1]; const float nr = pr * sr - pi * si + Lr, ni = pr * si + pi * sr + Li; sr = nr; si = ni; }
        { bf16* up = UC + (size_t)R0 * S5K;
#pragma unroll
          for (int q = 0; q < 64; ++q) { *(unsigned*)up = pk2(sr, si); up += ustep;
            const float nr = ar * sr - ai * si + er[q], ni = ar * si + ai * sr + ei[q]; sr = nr; si = ni; } }
    } else if (F.tid < 256) { const int b = F.tid >> 7, d = (F.tid >> 6) & 1, p = F.tid & 63;
        const float* lb = (const float*)(ws_ + WS_LB32) + (((size_t)(l * 16 + g) * 2 + d) * 64 + p) * 2; const float ar = lb[0], ai = lb[1];
        float sr = 0.f, si = 0.f;
        const float* E = (const float*)(ws_ + WS_E) + ((size_t)g * S5R) * 256 + d * 128 + 2 * p;
        bf16* UC = (bf16*)(ws_ + WS_UC) + ((size_t)g * S5R) * S5K + 512 + d * 128 + 2 * p;
        float er[8], ei[8];
#pragma unroll
        for (int q = 0; q < 8; ++q) { const int R = 512 + b * 8 + (d ? 7 - q : q); const float2 e2 = *(const float2*)(E + (size_t)R * 256); er[q] = e2.x; ei[q] = e2.y; }
#pragma unroll
        for (int q = 0; q < 8; ++q) { const int R = 512 + b * 8 + (d ? 7 - q : q); *(unsigned*)(UC + (size_t)R * S5K) = pk2(sr, si);
            const float nr = ar * sr - ai * si + er[q], ni = ar * si + ai * sr + ei[q]; sr = nr; si = ni; }
    }
    asm volatile("s_waitcnt vmcnt(0)" ::: "memory");
    __syncthreads();
}
typedef short bf16x8_t __attribute__((ext_vector_type(8)));
typedef short bf16x4_t __attribute__((ext_vector_type(4)));
typedef float f32x16 __attribute__((ext_vector_type(16)));
typedef unsigned u32x4_t __attribute__((ext_vector_type(4)));
constexpr int AT_KROW = 72, AT_VROW = 388;
constexpr int AT_KBYTES = 640 * AT_KROW * 2, AT_VBYTES = 64 * AT_VROW * 2, AT_SCR = AT_KBYTES + AT_VBYTES;
static_assert(AT_SCR + 8 * 64 * 4 <= LDS_BYTES, "attention LDS");
__device__ __forceinline__ int at_crow(int r, int h) { return (r & 3) + 8 * (r >> 2) + 4 * h; }
__device__ __forceinline__ float max16(const f32x16& s) { float a = fmaxf(fmaxf(s[0], s[1]), fmaxf(s[2], s[3])), b = fmaxf(fmaxf(s[4], s[5]), fmaxf(s[6], s[7])), c = fmaxf(fmaxf(s[8], s[9]), fmaxf(s[10], s[11])), d = fmaxf(fmaxf(s[12], s[13]), fmaxf(s[14], s[15])); return fmaxf(fmaxf(a, b), fmaxf(c, d)); }
__device__ __forceinline__ void ph_attn(Frame& F, int l, int ulo, int uhi, int wgi, int nwg) {
    unsigned char* const ws_ = launder_ws(F.ws);
    KArgs ka = kargs();
    const bf16* Q = (const bf16*)(ws_ + WS_Q); const bf16* K = (const bf16*)(ws_ + WS_K); const bf16* V = (const bf16*)(ws_ + WS_V);
    bf16* CAT = (bf16*)(ws_ + WS_CAT); const float* sink = ka->in[8] + l * 8;
    LAS bf16* Ks = (LAS bf16*)F.lds; LAS bf16* Vt = (LAS bf16*)(F.lds + AT_KBYTES); LAS float* scr = (LAS float*)(F.lds + AT_SCR) + F.wave * 64;
    const int lane = F.lane, l31 = lane & 31, h = lane >> 5, hh = F.wave >> 1, qh = F.wave & 1;
    for (int u = ulo + wgi; u < uhi; u += nwg) {
        int b, kvh, n, qrow0; bool win;
        if (u < 256) { b = u >> 7; kvh = (u >> 6) & 1; n = u & 63; win = true; qrow0 = b * SEQ + n * 128; }
        else { const int uc = u - 256; b = uc >> 2; kvh = (uc >> 1) & 1; n = uc & 1; win = false; qrow0 = NX + b * LCTX + n * 128; }
        __syncthreads();
#define AT_VT_WRITE(A_, B_, kp2_, ch_) do { LAS unsigned* vp_ = (LAS unsigned*)(Vt + ((ch_) * 8) * AT_VROW + 2 * (kp2_)); \
            vp_[0] = (A_.x & 0xffffu) | (B_.x << 16); vp_[AT_VROW / 2] = (A_.x >> 16) | (B_.x & 0xffff0000u); vp_[2 * (AT_VROW / 2)] = (A_.y & 0xffffu) | (B_.y << 16); vp_[3 * (AT_VROW / 2)] = (A_.y >> 16) | (B_.y & 0xffff0000u); \
            vp_[4 * (AT_VROW / 2)] = (A_.z & 0xffffu) | (B_.z << 16); vp_[5 * (AT_VROW / 2)] = (A_.z >> 16) | (B_.z & 0xffff0000u); vp_[6 * (AT_VROW / 2)] = (A_.w & 0xffffu) | (B_.w << 16); vp_[7 * (AT_VROW / 2)] = (A_.w >> 16) | (B_.w & 0xffff0000u); } while (0)
        int tid_ = F.tid; asm volatile("" : "+v"(tid_));
        {
            v4u kv[10], va[3], vb[3];
#pragma unroll
            for (int i = 0; i < 10; ++i) { kv[i] = (v4u){0u, 0u, 0u, 0u};
                if (win || i >= 6) { const int pc = tid_ + NTHREADS * i, row = pc >> 3, ch = pc & 7;
                    if (i < 6) { const int kp = 128 * (n - 1) + row; if (kp >= 0 && kp < SEQ) kv[i] = *(const v4u*)(K + ((size_t)(b * SEQ + kp)) * 128 + kvh * 64 + ch * 8); }
                    else kv[i] = *(const v4u*)(K + ((size_t)(NX + b * LCTX + row - 384)) * 128 + kvh * 64 + ch * 8); } }
            if (win) {
#pragma unroll
                for (int it = 0; it < 3; ++it) { const int idx = tid_ + NTHREADS * it, kp2 = idx >> 3, ch = idx & 7, kp = 128 * (n - 1) + 2 * kp2; va[it] = (v4u){0u, 0u, 0u, 0u}; vb[it] = va[it];
                    if (kp >= 0 && kp < SEQ) { const bf16* vsrc = V + ((size_t)(b * SEQ + kp)) * 128 + kvh * 64 + ch * 8; va[it] = *(const v4u*)vsrc; vb[it] = *(const v4u*)(vsrc + 128); } } }
#pragma unroll
            for (int i = 0; i < 10; ++i) if (win || i >= 6) { const int pc = tid_ + NTHREADS * i, row = pc >> 3, ch = pc & 7; *(LAS v4u*)(Ks + row * AT_KROW + ch * 8) = kv[i]; }
            if (win) {
#pragma unroll
                for (int it = 0; it < 3; ++it) { const int idx = tid_ + NTHREADS * it, kp2 = idx >> 3, ch = idx & 7; AT_VT_WRITE(va[it], vb[it], kp2, ch); } }
        }
        const int head = kvh * 4 + hh; const int qbase = qh * 64;
        bf16x8_t qf[2][4];
#pragma unroll
        for (int qb = 0; qb < 2; ++qb)
#pragma unroll
            for (int s = 0; s < 4; ++s) qf[qb][s] = *(const bf16x8_t*)(Q + ((size_t)(qrow0 + qbase + qb * 32 + l31)) * 512 + head * 64 + 16 * s + 8 * h);
        __syncthreads();
        const int qpos0 = n * 128 + qbase + l31;
        const int klo0 = max(qpos0 - 128, 0), klo1 = max(qpos0 + 32 - 128, 0); const unsigned span0 = (unsigned)(min(qpos0 + 128, SEQ - 1) - klo0), span1 = (unsigned)(min(qpos0 + 32 + 128, SEQ - 1) - klo1);
        const int wlo = win ? (qh ? 2 : 0) : 12, whi = win ? (qh ? 12 : 10) : 12;
#define AT_SCORES(st, S0, S1, MASKED, I0, I1) do { \
            const LAS bf16* kp_ = Ks + ((st) * 32 + l31) * AT_KROW + 8 * h; \
            _Pragma("unroll") for (int s = 0; s < 4; ++s) { const bf16x8_t kf = *(const LAS bf16x8_t*)(kp_ + 16 * s); \
                S0 = __builtin_amdgcn_mfma_f32_32x32x16_bf16(kf, qf[0][s], s ? S0 : (I0), 0, 0, 0); S1 = __builtin_amdgcn_mfma_f32_32x32x16_bf16(kf, qf[1][s], s ? S1 : (I1), 0, 0, 0); } \
            if ((MASKED) && (st) < 12 && ((st) < 4 || (st) >= 8)) { const int d0_ = 128 * (n - 1) + (st) * 32 + 4 * h - klo0, d1_ = d0_ + klo0 - klo1;     \
                _Pragma("unroll") for (int r = 0; r < 16; ++r) { const int c_ = (r & 3) + 8 * (r >> 2); \
                    if ((unsigned)(d0_ + c_) > span0) S0[r] = -1e30f; if ((unsigned)(d1_ + c_) > span1) S1[r] = -1e30f; } } \
        } while (0)
        const f32x16 Z16 = (f32x16){0.f,0.f,0.f,0.f,0.f,0.f,0.f,0.f,0.f,0.f,0.f,0.f,0.f,0.f,0.f,0.f};
        float m0 = -1e30f, m1 = -1e30f;
#pragma unroll 2
        for (int st = wlo; st < whi; ++st) { f32x16 S0, S1; AT_SCORES(st, S0, S1, false, Z16, Z16); m0 = fmaxf(m0, max16(S0)); m1 = fmaxf(m1, max16(S1)); }
#pragma unroll 2
        for (int st = 12; st < 20; ++st) { f32x16 S0, S1; AT_SCORES(st, S0, S1, false, Z16, Z16); m0 = fmaxf(m0, max16(S0)); m1 = fmaxf(m1, max16(S1)); }
        m0 = fmaxf(m0, __shfl_xor(m0, 32)); m1 = fmaxf(m1, __shfl_xor(m1, 32));
        const float sk = sink[head] * 1.4426950408889634f;
        m0 = fmaxf(m0, sk); m1 = fmaxf(m1, sk);
        float l0 = 0.f, l1 = 0.f; f32x16 O[2][2], NM0, NM1;
#pragma unroll
        for (int r = 0; r < 16; ++r) { NM0[r] = -m0; NM1[r] = -m1; }
#pragma unroll
        for (int a_ = 0; a_ < 2; ++a_)
#pragma unroll
            for (int b_ = 0; b_ < 2; ++b_) O[a_][b_] = (f32x16){0.f,0.f,0.f,0.f,0.f,0.f,0.f,0.f,0.f,0.f,0.f,0.f,0.f,0.f,0.f,0.f};
#define AT_PV(st, voff) do { f32x16 S0, S1; AT_SCORES(st, S0, S1, true, NM0, NM1);     \
            _Pragma("unroll") for (int r = 0; r < 16; ++r) { S0[r] = __builtin_amdgcn_exp2f(S0[r]); S1[r] = __builtin_amdgcn_exp2f(S1[r]);     l0 += S0[r]; l1 += S1[r]; } \
            _Pragma("unroll") for (int ks = 0; ks < 2; ++ks) { \
                u32x4_t pa0, pa1; \
                pa0.x = pg8::cvt_pk_bf16(S0[8 * ks + 0], S0[8 * ks + 1]); pa0.y = pg8::cvt_pk_bf16(S0[8 * ks + 2], S0[8 * ks + 3]); pa0.z = pg8::cvt_pk_bf16(S0[8 * ks + 4], S0[8 * ks + 5]); pa0.w = pg8::cvt_pk_bf16(S0[8 * ks + 6], S0[8 * ks + 7]); \
                pa1.x = pg8::cvt_pk_bf16(S1[8 * ks + 0], S1[8 * ks + 1]); pa1.y = pg8::cvt_pk_bf16(S1[8 * ks + 2], S1[8 * ks + 3]); pa1.z = pg8::cvt_pk_bf16(S1[8 * ks + 4], S1[8 * ks + 5]); pa1.w = pg8::cvt_pk_bf16(S1[8 * ks + 6], S1[8 * ks + 7]); \
                _Pragma("unroll") for (int db = 0; db < 2; ++db) { const LAS bf16* vp_ = Vt + (db * 32 + l31) * AT_VROW + (voff) + 16 * ks + 4 * h; \
                    const bf16x4_t lo_ = *(const LAS bf16x4_t*)vp_, hi_ = *(const LAS bf16x4_t*)(vp_ + 8); \
                    const bf16x8_t vf = (bf16x8_t){lo_[0], lo_[1], lo_[2], lo_[3], hi_[0], hi_[1], hi_[2], hi_[3]}; \
                    O[0][db] = __builtin_amdgcn_mfma_f32_32x32x16_bf16(__builtin_bit_cast(bf16x8_t, pa0), vf, O[0][db], 0, 0, 0); \
                    O[1][db] = __builtin_amdgcn_mfma_f32_32x32x16_bf16(__builtin_bit_cast(bf16x8_t, pa1), vf, O[1][db], 0, 0, 0); } } \
        } while (0)
        if (win) {
#pragma nounroll
            for (int st = wlo; st < whi; ++st) AT_PV(st, st * 32); }
        v4u ca[2], cb[2];
#pragma unroll
        for (int it = 0; it < 2; ++it) { const int idx = tid_ + NTHREADS * it, kp2 = idx >> 3, ch = idx & 7; const bf16* vsrc = V + ((size_t)(NX + b * LCTX + 2 * kp2)) * 128 + kvh * 64 + ch * 8; ca[it] = *(const v4u*)vsrc; cb[it] = *(const v4u*)(vsrc + 128); }
        __syncthreads();
#pragma unroll
        for (int it = 0; it < 2; ++it) { const int idx = tid_ + NTHREADS * it, kp2 = idx >> 3, ch = idx & 7; AT_VT_WRITE(ca[it], cb[it], kp2, ch); }
        __syncthreads();
#pragma nounroll
        for (int st = 12; st < 20; ++st) AT_PV(st, (st - 12) * 32);
#undef AT_PV
#undef AT_VT_WRITE
#undef AT_SCORES
        l0 += __shfl_xor(l0, 32); l1 += __shfl_xor(l1, 32);
        l0 += __builtin_amdgcn_exp2f(sk - m0); l1 += __builtin_amdgcn_exp2f(sk - m1);
        if (h == 0) { scr[l31] = 1.f / l0; scr[32 + l31] = 1.f / l1; }
        LDS_WAIT();
#pragma unroll
        for (int qb = 0; qb < 2; ++qb)
#pragma unroll
            for (int r = 0; r < 16; ++r) { const int qq = at_crow(r, h); const float inv = scr[qb * 32 + qq]; const size_t row = (size_t)(qrow0 + qbase + qb * 32 + qq);
#pragma unroll
                for (int db = 0; db < 2; ++db) CAT[row * 1024 + head * 64 + db * 32 + l31] = (bf16)f2bf(O[qb][db][r] * inv); }
    }
}
constexpr size_t WS_WPT = 5 * MiB + 512 * KiB;
__device__ __forceinline__ void ph_conv(Frame& F, int l, int tlo, int thi, int wgi, int nwg, unsigned* ctr) {
    unsigned char* const ws_ = launder_ws(F.ws);
    KArgs ka = kargs();
    const bf16* HG = (const bf16*)(ws_ + WS_HG); bf16* CN = (bf16*)(ws_ + WS_CN);
    LAS float* Hs = (LAS float*)F.lds; LAS float* Ws = Hs + 94 * 256;
    const int lane = F.lane, c4 = 4 * lane;
    __syncthreads();
    for (int i = F.tid; i < 31 * 256; i += NTHREADS) Ws[i] = ka->in[19][(size_t)l * 31 * 256 + i];
    const f32x4 bd = *(const f32x4*)(ka->in[20] + l * 256 + c4), lg = *(const f32x4*)(ka->in[21] + l * 256 + c4), lb = *(const f32x4*)(ka->in[22] + l * 256 + c4);
    LAS unsigned* bc = (LAS unsigned*)(F.lds + 131072);
#define CONV_DRAW(t) do { __syncthreads(); if (F.tid == 0) bc[0] = __hip_atomic_fetch_add(ctr, 1u, __ATOMIC_RELAXED, __HIP_MEMORY_SCOPE_AGENT); __syncthreads(); t = tlo + (int)bc[0]; } while (0)
    int tile = tlo + wgi; if (ctr) CONV_DRAW(tile);
    for (; tile < thi; ) {
        int t0, base, len;
        if (tile < 256) { t0 = (tile & 127) * 64; base = (tile >> 7) * SEQ; len = SEQ; } else { const int tc = tile - 256; t0 = (tc & 3) * 64; base = NX + (tc >> 2) * LCTX; len = LCTX; }
        __syncthreads();
        { v2u hw[12];
#pragma unroll
          for (int it = 0; it < 12; ++it) { const int idx = F.tid + NTHREADS * it, rr = idx >> 6, cc = (idx & 63) * 4, tt = t0 - 15 + rr; hw[it] = (v2u){0u, 0u};
              if (idx < 94 * 64 && tt >= 0 && tt < len) hw[it] = *(const v2u*)(HG + ((size_t)(base + tt)) * 256 + cc); }
#pragma unroll
          for (int it = 0; it < 12; ++it) { const int idx = F.tid + NTHREADS * it, rr = idx >> 6, cc = (idx & 63) * 4;
              if (idx < 94 * 64) *(LAS f32x4*)(Hs + rr * 256 + cc) = (f32x4){bflo(hw[it].x), bfhi(hw[it].x), bflo(hw[it].y), bfhi(hw[it].y)}; } }
        __syncthreads();
        {
            const int row0 = F.wave * 8; f32x4 acc[8], win[8];
#pragma unroll
            for (int i = 0; i < 8; ++i) acc[i] = bd;
#pragma unroll
            for (int i = 0; i < 7; ++i) win[i] = *(const LAS f32x4*)(Hs + (row0 + i) * 256 + c4);
#pragma unroll
            for (int k = 0; k < 31; ++k) { win[(k + 7) & 7] = *(const LAS f32x4*)(Hs + (row0 + k + 7) * 256 + c4); const f32x4 wv = *(const LAS f32x4*)(Ws + k * 256 + c4);
#pragma unroll
                for (int i = 0; i < 8; ++i) acc[i] += win[(k + i) & 7] * wv; }
#pragma unroll
            for (int i = 0; i < 8; ++i) {
                const float mean = wave_sum((acc[i].x + acc[i].y) + (acc[i].z + acc[i].w)) * (1.f / 256.f); const f32x4 dv = acc[i] - mean;
                const float var = wave_sum((dv.x * dv.x + dv.y * dv.y) + (dv.z * dv.z + dv.w * dv.w)) * (1.f / 256.f); const float rstd = 1.f / sqrtf(var + LN_EPS);
                const f32x4 y = dv * rstd * lg + lb;
                v2u o; o.x = pk2(silu_f(y.x), silu_f(y.y)); o.y = pk2(silu_f(y.z), silu_f(y.w));
                *(v2u*)(CN + ((size_t)(base + t0 + row0 + i)) * 256 + c4) = o; }
        }
        if (ctr) CONV_DRAW(tile); else tile += nwg;
    }
#undef CONV_DRAW
}
__device__ __forceinline__ int block_sum_i(Frame& F, int v, LAS int* red, int slot) {
    const int w = wave_sum_i(v); if (F.lane == 0) red[slot * 8 + F.wave] = w; __syncthreads();
    int s = 0;
#pragma unroll
    for (int i = 0; i < 8; ++i) s += red[slot * 8 + i];
    return s;
}
__device__ __forceinline__ int wave_incl_scan_i(int v) {
    v += __builtin_amdgcn_update_dpp(0, v, 0x111, 0xf, 0xf, true); v += __builtin_amdgcn_update_dpp(0, v, 0x112, 0xf, 0xf, true);
    v += __builtin_amdgcn_update_dpp(0, v, 0x114, 0xf, 0xf, true); v += __builtin_amdgcn_update_dpp(0, v, 0x118, 0xf, 0xf, true);
    v += __builtin_amdgcn_update_dpp(0, v, 0x142, 0xa, 0xf, false);
    v += __builtin_amdgcn_update_dpp(0, v, 0x143, 0xc, 0xf, false);
    return v;
}
__device__ __forceinline__ int block_excl_scan_i(Frame& F, int v, LAS int* red) {
    const int inc = wave_incl_scan_i(v);
    __syncthreads();
    if (F.lane == 63) red[F.wave] = inc;
    __syncthreads();
    int base = 0;
#pragma unroll
    for (int i = 0; i < 8; ++i) if (i < F.wave) base += red[i];
    return base + inc - v;
}
template <int N, int CAP> __device__ __forceinline__ void route_unit(Frame& F, const float* aff, int e, int rowbase, int slotbase) {
    unsigned char* const ws_ = launder_ws(F.ws);
    constexpr int EPT = (N >= NTHREADS) ? N / NTHREADS : 1;
    static_assert(EPT == 16 || EPT == 1, "route_unit");
    LAS unsigned* hist = (LAS unsigned*)F.lds; LAS int* red = (LAS int*)(F.lds + 4096);
    int* IDX = (int*)(ws_ + WS_IDX); float* GATE = (float*)(ws_ + WS_GATE); int* TOK = (int*)(ws_ + WS_TOKSLOT);
    const bool have = (EPT == 16) || F.tid < N; const int i0 = F.tid * EPT;
    unsigned k[EPT];
    if (EPT == 16) {
#pragma unroll
        for (int q = 0; q < 4; ++q) { const v4u w = ((const v4u*)(aff + i0))[q]; k[4 * q % EPT] = w.x; k[(4 * q + 1) % EPT] = w.y; k[(4 * q + 2) % EPT] = w.z; k[(4 * q + 3) % EPT] = w.w; }
    } else k[0] = have ? __builtin_bit_cast(unsigned, aff[i0]) : 0u;
    __syncthreads();
    unsigned prefix = 0u, pmask = 0u; int need = CAP, eqtot = 0;
#pragma nounroll
    for (int pass = 0; pass < 3; ++pass) { const int sh = 20 - 10 * pass;
        hist[F.tid] = 0u; hist[F.tid + NTHREADS] = 0u;
        __syncthreads();
        if (have) {
#pragma unroll
            for (int j = 0; j < EPT; ++j) if ((k[j] & pmask) == prefix) __hip_atomic_fetch_add(hist + ((k[j] >> sh) & 1023u), 1u, __ATOMIC_RELAXED, __HIP_MEMORY_SCOPE_WORKGROUP); }
        __syncthreads();
        if (F.wave == 0) {
            unsigned h[16];
#pragma unroll
            for (int q = 0; q < 4; ++q) { const v4u w = ((const LAS v4u*)(hist + 16 * F.lane))[q]; h[4 * q] = w.x; h[4 * q + 1] = w.y; h[4 * q + 2] = w.z; h[4 * q + 3] = w.w; }
            unsigned own = 0u;
#pragma unroll
            for (int q = 0; q < 16; ++q) own += h[q];
            const unsigned pre = (unsigned)wave_incl_scan_i((int)own), total = (unsigned)__builtin_amdgcn_readlane((int)pre, 63);
            unsigned a = total - pre;
            int dsel = -1; unsigned asel = 0u, esel = 0u;
#pragma unroll
            for (int q = 15; q >= 0; --q) { if (a < (unsigned)need && (unsigned)need <= a + h[q]) { dsel = 16 * F.lane + q; asel = a; esel = h[q]; } a += h[q]; }
            if (dsel >= 0) { red[16] = dsel; red[17] = (int)asel; red[18] = (int)esel; }
        }
        __syncthreads();
        const int dsel = red[16]; need -= red[17]; eqtot = red[18];
        prefix |= ((unsigned)dsel) << sh; pmask |= 1023u << sh;
    }
    const unsigned T = prefix;
    const bool alleq = (eqtot == need);
    int eqb = 0;
    if (!alleq) { int ceq = 0;
#pragma unroll
        for (int j = 0; j < EPT; ++j) ceq += (have && k[j] == T) ? 1 : 0;
        eqb = block_excl_scan_i(F, ceq, red); }
    int csel = 0, e2 = eqb; unsigned selm = 0u;
#pragma unroll
    for (int j = 0; j < EPT; ++j) { const bool iseq = (k[j] == T); const bool sel = have && ((k[j] > T) || (iseq && (alleq || e2 < need))); e2 += iseq ? 1 : 0; csel += sel ? 1 : 0; selm |= sel ? (1u << j) : 0u; }
    int pos = block_excl_scan_i(F, csel, red + 32);
    int tokv[EPT];
#pragma unroll
    for (int j = 0; j < EPT; ++j) { tokv[j] = -1;
        if ((selm >> j) & 1u) { const int slot = slotbase + pos; ++pos; IDX[slot] = rowbase + i0 + j; GATE[slot] = __builtin_bit_cast(float, k[j]); tokv[j] = slot; } }
    int* tp = TOK + (size_t)e * NR + rowbase + i0;
    if (EPT == 16) {
#pragma unroll
        for (int q = 0; q < 4; ++q) ((v4u*)tp)[q] = (v4u){(unsigned)tokv[4 * q % EPT], (unsigned)tokv[(4 * q + 1) % EPT], (unsigned)tokv[(4 * q + 2) % EPT], (unsigned)tokv[(4 * q + 3) % EPT]};
    } else if (have) tp[0] = tokv[0];
}
__device__ __forceinline__ void ph_route(Frame& F, bool last) {
    unsigned char* const ws_ = launder_ws(F.ws);
    const int nunits = last ? 32 : 64;
    for (int u = F.bid; u < nunits; u += F.G) {
        if (u < 32) { const int b = u >> 4, e = u & 15; route_unit<SEQ, CAPX>(F, (const float*)(ws_ + WS_AFF) + (size_t)u * SEQ, e, b * SEQ, e * SLOTS_E + b * CAPX); }
        else { const int uc = u - 32, b = uc >> 4, e = uc & 15; route_unit<LCTX, CAPC>(F, (const float*)(ws_ + WS_AFFC) + (size_t)uc * LCTX, e, NX + b * LCTX, e * SLOTS_E + 2 * CAPX + b * CAPC);
            if (b == 0 && F.tid < 192) { ((int*)(ws_ + WS_IDX))[e * SLOTS_E + 2 * CAPX + 2 * CAPC + F.tid] = 0; ((float*)(ws_ + WS_GATE))[e * SLOTS_E + 2 * CAPX + 2 * CAPC + F.tid] = 0.f; } }
    }
}
__device__ __forceinline__ void ln_pair(f32x4 (&v)[2][4]) {
    float s[2], q[2];
#pragma unroll
    for (int r = 0; r < 2; ++r) { s[r] = 0.f; q[r] = 0.f;
#pragma unroll
        for (int j = 0; j < 4; ++j) { s[r] += (v[r][j].x + v[r][j].y) + (v[r][j].z + v[r][j].w); q[r] += (v[r][j].x * v[r][j].x + v[r][j].y * v[r][j].y) + (v[r][j].z * v[r][j].z + v[r][j].w * v[r][j].w); } }
    s[0] = wave_sum(s[0]); s[1] = wave_sum(s[1]); q[0] = wave_sum(q[0]); q[1] = wave_sum(q[1]);
#pragma unroll
    for (int r = 0; r < 2; ++r) { const float mean = s[r] * (1.f / 1024.f), var = fmaxf(q[r] * (1.f / 1024.f) - mean * mean, 0.f), rstd = 1.f / sqrtf(var + LN_EPS);
#pragma unroll
        for (int j = 0; j < 4; ++j) v[r][j] = (v[r][j] - mean) * rstd; }
}
__device__ __forceinline__ void ph_rows_mid2(Frame& F, int l, bool last) {
    unsigned char* const ws_ = launder_ws(F.ws);
    KArgs ka = kargs();
    const float* MOD = (const float*)(ws_ + WS_MOD); const bf16* YMIX = (const bf16*)(ws_ + WS_YMIX);
    float* XMID = (float*)(ws_ + WS_XMID); bf16* H2 = (bf16*)(ws_ + WS_HX);
    const float* g1_ = ka->in[27] + l * 1024; const float* b1_ = ka->in[28] + l * 1024; const float* wr_ = ka->in[29] + (size_t)l * 1024 * 16;
    float* AFF = (float*)(ws_ + WS_AFF); float* AFFC = (float*)(ws_ + WS_AFFC);
    LAS float* Wp = (LAS float*)F.lds;
    const int lane = F.lane, nrows = last ? NX : NR;
    __syncthreads();
    for (int i = F.tid; i < 16 * 4 * 64; i += NTHREADS) { const int ji = i >> 8, q = (i >> 6) & 3, ln = i & 63, d = 4 * ln + 256 * (ji >> 2) + (ji & 3);
        *(LAS f32x4*)(Wp + (size_t)i * 4) = *(const f32x4*)(wr_ + (size_t)d * 16 + 4 * q); }
    __syncthreads();
    for (int r0 = 2 * F.gw; r0 < nrows; r0 += 2 * F.NGW) {
        const float* g1 = opq(g1_); const float* b1 = opq(b1_);
        const float* m = MOD + (l * 3 + row_mod_index(r0)) * 6144;
        f32x4 v[2][4];
#pragma unroll
        for (int r = 0; r < 2; ++r) { const int rr = r0 + r;
            const float* src = (l == 0) ? (rr < NX ? ka->in[0] + (size_t)rr * 1024 : ka->in[2] + (size_t)(rr - NX) * 1024) : (const float*)(ws_ + WS_XCUR) + (size_t)rr * 1024;
            f32x4 y[4]; row_load(src, lane, v[r]);
#pragma unroll
            for (int j = 0; j < 4; ++j) { const v2u w = ((const v2u*)(YMIX + (size_t)rr * 1024))[lane + 64 * j]; y[j] = (f32x4){bflo(w.x), bfhi(w.x), bflo(w.y), bfhi(w.y)}; }
#pragma unroll
            for (int j = 0; j < 4; ++j) { const f32x4 gt = ((const f32x4*)(m + 2048))[lane + 64 * j]; v[r][j] = v[r][j] * ALPHA + gt * y[j]; } }
        ln_pair(v);
#pragma unroll
        for (int j = 0; j < 4; ++j) { const f32x4 gg = ((const f32x4*)g1)[lane + 64 * j], bb = ((const f32x4*)b1)[lane + 64 * j];
#pragma unroll
            for (int r = 0; r < 2; ++r) v[r][j] = v[r][j] * gg + bb; }
        ln_pair(v);
#pragma unroll
        for (int j = 0; j < 4; ++j) { const f32x4 sh = ((const f32x4*)(m + 3072))[lane + 64 * j], sc = ((const f32x4*)(m + 4096))[lane + 64 * j];
#pragma unroll
            for (int r = 0; r < 2; ++r) v[r][j] = v[r][j] * (sc + 1.f) + sh; }
#pragma unroll
        for (int rr_ = 0; rr_ < 2; ++rr_)
#pragma unroll
            for (int j = 0; j < 4; ++j) ((unsigned*)((unsigned char*)H2 + (size_t)(r0 + rr_) * 1024))[lane + 64 * j] = pack4_fp8(v[rr_][j].x, v[rr_][j].y, v[rr_][j].z, v[rr_][j].w);
        __builtin_amdgcn_sched_barrier(0);
        typedef float f32x2 __attribute__((ext_vector_type(2)));
        f32x2 lg2[2][8];
#pragma unroll
        for (int r = 0; r < 2; ++r)
#pragma unroll
            for (int e = 0; e < 8; ++e) lg2[r][e] = (f32x2){0.f, 0.f};
#pragma unroll
        for (int j = 0; j < 4; ++j)
#pragma unroll
            for (int i = 0; i < 4; ++i) { const LAS float* wp = Wp + ((size_t)((j * 4 + i) * 4) * 64 + lane) * 4; const f32x2 h0 = (f32x2){v[0][j][i], v[0][j][i]}, h1 = (f32x2){v[1][j][i], v[1][j][i]};
#pragma unroll
                for (int q = 0; q < 4; ++q) { const f32x4 w = *(const LAS f32x4*)(wp + q * 256); const f32x2 wa = (f32x2){w.x, w.y}, wb = (f32x2){w.z, w.w};
                    lg2[0][2 * q] = __builtin_elementwise_fma(h0, wa, lg2[0][2 * q]); lg2[0][2 * q + 1] = __builtin_elementwise_fma(h0, wb, lg2[0][2 * q + 1]);
                    lg2[1][2 * q] = __builtin_elementwise_fma(h1, wa, lg2[1][2 * q]); lg2[1][2 * q + 1] = __builtin_elementwise_fma(h1, wb, lg2[1][2 * q + 1]); }
                if (i & 1) __builtin_amdgcn_sched_barrier(0); }
        float lg[2][16];
#pragma unroll
        for (int r = 0; r < 2; ++r)
#pragma unroll
            for (int e = 0; e < 16; ++e) lg[r][e] = lg2[r][e >> 1][e & 1];
        float fin[2];
#pragma unroll
        for (int r = 0; r < 2; ++r) {
            float a8[8], a4[4], a2[2];
            { const bool s = lane & 8;
#pragma unroll
              for (int e = 0; e < 8; ++e) { const float keep = s ? lg[r][e + 8] : lg[r][e], send = s ? lg[r][e] : lg[r][e + 8]; a8[e] = keep + dppf<DPP_RM>(send); } }
            { const bool s = lane & 4;
#pragma unroll
              for (int e = 0; e < 4; ++e) { const float keep = s ? a8[e + 4] : a8[e], send = s ? a8[e] : a8[e + 4]; a4[e] = keep + dppf<DPP_HM>(send); } }
            { const bool s = lane & 2;
#pragma unroll
              for (int e = 0; e < 2; ++e) { const float keep = s ? a4[e + 2] : a4[e], send = s ? a4[e] : a4[e + 2]; a2[e] = keep + dppf<DPP_X2>(send); } }
            { const bool s = lane & 1; const float keep = s ? a2[1] : a2[0], send = s ? a2[0] : a2[1]; fin[r] = xrow_sum(keep + dppf<DPP_X1>(send)); }
        }
        const int e = lane & 15;
#pragma unroll
        for (int r = 0; r < 2; ++r) { const float mx = row_max16(fin[r]);
            const float ex = expf(fin[r] - mx); const float den = row_sum16(ex);
            const int rr = r0 + r;
            if (lane < 16) { if (rr < NX) AFF[((size_t)(rr >> 13) * 16 + e) * SEQ + (rr & (SEQ - 1))] = ex / den; else AFFC[((size_t)((rr - NX) >> 8) * 16 + e) * LCTX + ((rr - NX) & (LCTX - 1))] = ex / den; } }
    }
}
__device__ __forceinline__ void ph_rows_final2(Frame& F, int l, bool last) {
    unsigned char* const ws_ = launder_ws(F.ws);
    KArgs ka = kargs();
    const float* MOD = (const float*)(ws_ + WS_MOD); const bf16* YMIX = (const bf16*)(ws_ + WS_YMIX);
    const int* TOK = (const int*)(ws_ + WS_TOKSLOT); const float* GATE = (const float*)(ws_ + WS_GATE); const bf16* YE = (const bf16*)(ws_ + WS_YEXP);
    const float* g1_ = ka->in[27] + l * 1024; const float* b1_ = ka->in[28] + l * 1024;
    const float* g2_ = ka->in[33] + l * 1024; const float* b2_ = ka->in[34] + l * 1024;
    const int lane = F.lane, nrows = last ? NX : NR;
    for (int r0 = 2 * F.gw; r0 < nrows; r0 += 2 * F.NGW) {
        const float* g1 = opq(g1_); const float* b1 = opq(b1_); const float* g2 = opq(g2_); const float* b2 = opq(b2_);
        const float* m = MOD + (l * 3 + row_mod_index(r0)) * 6144;
        f32x4 v[2][4];
#pragma unroll
        for (int r = 0; r < 2; ++r) { const int rr = r0 + r;
            const float* src = (l == 0) ? (rr < NX ? ka->in[0] + (size_t)rr * 1024 : ka->in[2] + (size_t)(rr - NX) * 1024) : (const float*)(ws_ + WS_XCUR) + (size_t)rr * 1024;
            f32x4 y[4]; row_load(src, lane, v[r]);
#pragma unroll
            for (int j = 0; j < 4; ++j) { const v2u w = ((const v2u*)(YMIX + (size_t)rr * 1024))[lane + 64 * j]; y[j] = (f32x4){bflo(w.x), bfhi(w.x), bflo(w.y), bfhi(w.y)}; }
#pragma unroll
            for (int j = 0; j < 4; ++j) { const f32x4 gt = ((const f32x4*)(m + 2048))[lane + 64 * j]; v[r][j] = v[r][j] * ALPHA + gt * y[j]; } }
        ln_pair(v);
#pragma unroll
        for (int j = 0; j < 4; ++j) { const f32x4 gg = ((const f32x4*)g1)[lane + 64 * j], bb = ((const f32x4*)b1)[lane + 64 * j];
#pragma unroll
            for (int r = 0; r < 2; ++r) v[r][j] = v[r][j] * gg + bb; }
        __builtin_amdgcn_sched_barrier(0);
#pragma unroll
        for (int r = 0; r < 2; ++r) { const int rr = r0 + r;
            int sl = -1; float gv = 0.f; if (lane < 16) { sl = TOK[(size_t)lane * NR + rr]; if (sl >= 0) gv = GATE[sl]; }
            f32x4 mo[4];
#pragma unroll
            for (int j = 0; j < 4; ++j) mo[j] = (f32x4){0.f, 0.f, 0.f, 0.f};
            unsigned long long bal = __ballot(sl >= 0);
            while (bal) { const int e = __builtin_ctzll(bal); bal &= bal - 1; const int s = __shfl(sl, e); const float g = __shfl(gv, e);
                const v2u* yp = (const v2u*)(YE + (size_t)s * 1024);
#pragma unroll
                for (int j = 0; j < 4; ++j) { const v2u w = yp[lane + 64 * j]; mo[j].x += g * bflo(w.x); mo[j].y += g * bfhi(w.x); mo[j].z += g * bflo(w.y); mo[j].w += g * bfhi(w.y); } }
#pragma unroll
            for (int j = 0; j < 4; ++j) { const f32x4 gt = ((const f32x4*)(m + 5120))[lane + 64 * j]; v[r][j] = v[r][j] * ALPHA + gt * mo[j]; } }
        ln_pair(v);
#pragma unroll
        for (int j = 0; j < 4; ++j) { const f32x4 gg = ((const f32x4*)g2)[lane + 64 * j], bb = ((const f32x4*)b2)[lane + 64 * j];
#pragma unroll
            for (int r = 0; r < 2; ++r) { v[r][j] = v[r][j] * gg + bb;
                float* dst = last ? ka->out + (size_t)(r0 + r) * 1024 : (float*)(ws_ + WS_XCUR) + (size_t)(r0 + r) * 1024; ((f32x4*)dst)[lane + 64 * j] = v[r][j]; } }
        if (!last) { ln_pair(v); const float* m1 = MOD + ((l + 1) * 3 + row_mod_index(r0)) * 6144;
            modulate_store(v[0], m1, m1 + 1024, (bf16*)(ws_ + WS_HX) + (size_t)r0 * 1024, lane); modulate_store(v[1], m1, m1 + 1024, (bf16*)(ws_ + WS_HX) + (size_t)(r0 + 1) * 1024, lane); }
    }
}
#define XB_TMO      128
#define XB_XCNT(j)  (256  + 64 * (j))
#define XB_XSUB(j)  (1280 + 64 * (j))
#define XB_XGEN(j)  (2304 + 64 * (j))
#define XB_TOP      3328
#define XB_TOPGEN   3392
#define XCD_BAR_WORDS 3456
#define XB_SPIN_CAP (1u << 18)

__device__ __forceinline__ unsigned xb_ld(unsigned* p)              { return __hip_atomic_load(p, __ATOMIC_RELAXED, __HIP_MEMORY_SCOPE_AGENT); }
__device__ __forceinline__ unsigned xb_add(unsigned* p, unsigned v) { return __hip_atomic_fetch_add(p, v, __ATOMIC_RELAXED, __HIP_MEMORY_SCOPE_AGENT); }
__device__ __forceinline__ unsigned xb_xcc_id() { return (unsigned)__builtin_amdgcn_s_getreg((3 << 11) | 20) & 0xFu; }
#define XB_SPIN(cond, bar) do { unsigned _sp = 0; while (cond) { __builtin_amdgcn_s_sleep(1); \
    if ((++_sp & 255u) == 0u) { if (xb_ld(&(bar)[XB_TMO])) break; if (_sp > XB_SPIN_CAP) { atomicAdd(&(bar)[XB_TMO], 1u); break; } } } } while (0)

struct XcdBarrier {
    unsigned* bar; unsigned x;
    volatile LAS unsigned* st;
    int wv;
};

__device__ __forceinline__ XcdBarrier xcd_barrier_post(unsigned* bar, volatile LAS unsigned* st) {
    XcdBarrier b; b.bar = bar; b.x = xb_xcc_id(); b.st = st;
    if (threadIdx.x == 0) (void)xb_add(&bar[XB_XCNT(b.x)], 1u);
    return b;
}
__device__ __forceinline__ void xcd_barrier_complete(unsigned* bar, unsigned x, unsigned& nloc, unsigned& nx) {
    const unsigned G = gridDim.x * gridDim.y * gridDim.z;
    unsigned sum, cnt, mine, sp = 0u;
    for (;;) {
        sum = 0u; cnt = 0u; mine = 0u;
#pragma unroll
        for (unsigned j = 0; j < 16; ++j) { const unsigned c = xb_ld(&bar[XB_XCNT(j)]); sum += c; cnt += (c > 0u) ? 1u : 0u; mine = (j == x) ? c : mine; }
        if (sum == G) break;
        __builtin_amdgcn_s_sleep(1);
        if ((++sp & 255u) == 0u) { if (xb_ld(&bar[XB_TMO])) break; if (sp > XB_SPIN_CAP) { atomicAdd(&bar[XB_TMO], 1u); break; } }
    }
    nloc = mine > 0u ? mine : 1u; nx = cnt > 0u ? cnt : 1u;
}

__device__ __forceinline__ void xcd_barrier(const XcdBarrier& b) {
    asm volatile("s_waitcnt vmcnt(0)" ::: "memory");
    __syncthreads();
    if (b.wv == 0 && pg8::lane_id() == 0) {
        unsigned* bar = b.bar;
        __builtin_amdgcn_s_waitcnt(0);
        unsigned nloc = b.st[0], nx = b.st[1];
        if (nloc == 0u) { xcd_barrier_complete(bar, b.x, nloc, nx); b.st[0] = nloc; b.st[1] = nx; }
        const unsigned old = xb_add(&bar[XB_XSUB(b.x)], 1u);
        const unsigned gen = old / nloc;
        if (old + 1u == (gen + 1u) * nloc) {
            __builtin_amdgcn_fence(__ATOMIC_RELEASE, "agent");
            asm volatile("s_waitcnt vmcnt(0)" ::: "memory");
            const unsigned og = xb_add(&bar[XB_TOP], 1u);
            const unsigned tg = og / nx;
            if (og + 1u == (tg + 1u) * nx) xb_add(&bar[XB_TOPGEN], 1u);
            else XB_SPIN(xb_ld(&bar[XB_TOPGEN]) == tg, bar);
            __builtin_amdgcn_fence(__ATOMIC_ACQUIRE, "agent");
            xb_add(&bar[XB_XGEN(b.x)], 1u);
            asm volatile("s_waitcnt vmcnt(0)" ::: "memory");
        } else {
            XB_SPIN(xb_ld(&bar[XB_XGEN(b.x)]) == gen, bar);
            __builtin_amdgcn_fence(__ATOMIC_ACQUIRE, "agent");
            asm volatile("s_waitcnt vmcnt(0)" ::: "memory");
        }
    }
    __syncthreads();
}

#ifndef MK_SPLIT
#define MK_SPLIT 0
#endif
#ifndef DUP_MASK
#define DUP_MASK 0u
#endif
#ifndef DUP_CNT
#define DUP_CNT 2
#endif
#define NREP(n) (((DUP_MASK >> (n)) & 1u) ? DUP_CNT : 1)
#define NREPP(n) (((DUP_MASK >> (16 + (n))) & 1u) ? 2 : 1)
constexpr int PPL = 11, NPH = 2 + PPL * DEPTH;
constexpr size_t WS_BAR = 0;
constexpr int MISC_OFF = LDS_BYTES - 64;
__device__ __forceinline__ void grid_seam(int k, int wv) {
    if (k + 1 >= kargs()->ph_hi) return;
    extern __shared__ __attribute__((aligned(16))) unsigned char lds[];
    XcdBarrier b; b.bar = (unsigned*)(kargs()->ws + WS_BAR); b.x = xb_xcc_id(); b.st = (volatile LAS unsigned*)((LAS unsigned char*)lds + MISC_OFF); b.wv = wv;
    xcd_barrier(b);
}
#define SEAM(k) grid_seam(k, wv)
#define IN(k) (kargs()->ph_lo <= (k) && (k) < kargs()->ph_hi)
__device__ __forceinline__ Frame make_frame(int wv) {
    extern __shared__ __attribute__((aligned(16))) unsigned char lds[];
    KArgs ka = kargs(); Frame F;
    F.lds = (LAS unsigned char*)lds; { int t_ = wv * 64 + pg8::lane_id(); asm volatile("" : "+v"(t_)); F.tid = t_; } F.lane = F.tid & 63; F.wave = wv;
    F.bid = blockIdx.x; F.G = ka->G; F.gw = F.bid * NWAVES + F.wave; F.NGW = F.G * NWAVES; F.ws = ka->ws; return F;
}
template <int l> __device__ __forceinline__ void run_layer(const int wv) {
        const bool last = (l == DEPTH - 1); const int k0 = 2 + PPL * l;
        if (IN(k0 + 0)) { for (int rep_ = 0; rep_ < NREP(0); ++rep_) { if (rep_) __syncthreads(); Frame F = make_frame(wv); unsigned char* const ws_ = F.ws;
            pg8::Gemm g{(const pg8::bf16_t*)(ws_ + WS_HX), (const pg8::bf16_t*)(ws_ + WS_WIN) + (size_t)l * INW * DM, NR, INW, DM, DM, DM};
            g.wv = F.wave;
            pg8::InProjOrder S; S.init(0, 256, F.G, F.bid);
            pg8::EpiInProj E{(const float*)(ws_ + WS_BINP) + l * INW, (const float*)(ws_ + WS_ROPE), (pg8::bf16_t*)(ws_ + WS_Q), (pg8::bf16_t*)(ws_ + WS_K), (pg8::bf16_t*)(ws_ + WS_V), (pg8::bf16_t*)(ws_ + WS_UC), (pg8::bf16_t*)(ws_ + WS_HG)};
            pg8::gemm_phase<pg8::EpiInProj, pg8::InProjOrder, PG8_ALIGN, PG8_SP2>(F.lds, g, S, E);
            } SEAM(k0 + 0); }
        if (IN(k0 + 1)) { for (int rep_ = 0; rep_ < NREP(1); ++rep_) { if (rep_) __syncthreads(); Frame F = make_frame(wv); unsigned char* const ws_ = F.ws;
            const int GB = (F.G * 140) / 256, nl = F.G - GB;
            if (F.bid < GB) {
                pg8::Gemm g{(const pg8::bf16_t*)(ws_ + WS_HX), (const pg8::bf16_t*)(ws_ + WS_WIN) + (size_t)l * INW * DM, NR, INW, DM, DM, DM};
                g.wv = F.wave;
                pg8::InProjOrder S; S.init(256, 140, GB, F.bid);
                pg8::EpiInProj E{(const float*)(ws_ + WS_BINP) + l * INW, (const float*)(ws_ + WS_ROPE), (pg8::bf16_t*)(ws_ + WS_Q), (pg8::bf16_t*)(ws_ + WS_K), (pg8::bf16_t*)(ws_ + WS_V), (pg8::bf16_t*)(ws_ + WS_UC), (pg8::bf16_t*)(ws_ + WS_HG)};
                pg8::gemm_phase<pg8::EpiInProj, pg8::InProjOrder, PG8_ALIGN, PG8_SP2>(F.lds, g, S, E);
            } else { const int w = F.bid - GB;
                if (w < 48) {
                    pg8::Gemm g{(const pg8::bf16_t*)(ws_ + WS_UC), (const pg8::bf16_t*)(ws_ + WS_BE) + (size_t)l * 16 * 256 * 512, 16 * S5R, 16 * 256, 512, S5K, 512};
                    g.wv = F.wave;
                    pg8::MoeOrder S; S.init(3, 1, 3, 16, nl < 48 ? nl : 48, w);
                    pg8::EpiF32G E{(float*)(ws_ + WS_E), 256, 1};
                    pg8::gemm_phase<pg8::EpiF32G, pg8::MoeOrder, PG8_ALIGN, PG8_SP2>(F.lds, g, S, E); }
                ph_conv(F, l, 0, last ? 256 : 264, 0, 0, (unsigned*)(ws_ + WS_CTR) + 4 + l);
            }
            } SEAM(k0 + 1); }
        if (IN(k0 + 2)) { for (int rep_ = 0; rep_ < NREP(2); ++rep_) { if (rep_) __syncthreads(); { Frame F = make_frame(wv); ph_attn(F, l, 0, 256, F.bid, F.G); } } SEAM(k0 + 2); }
        if (IN(k0 + 3)) { for (int rep_ = 0; rep_ < NREP(3); ++rep_) { if (rep_) __syncthreads(); Frame F = make_frame(wv); unsigned char* const ws_ = F.ws;
            pg8::Gemm g{(const pg8::bf16_t*)(ws_ + WS_UC), (const pg8::bf16_t*)(ws_ + WS_KT) + (size_t)l * 16 * 512 * S5K, 16 * S5R, 16 * 512, S5K, S5K, S5K};
            g.wv = F.wave;
            pg8::MoeOrder S; S.init(3, 2, 3, 16, F.G, F.bid);
            pg8::EpiS5Y E{(pg8::bf16_t*)(ws_ + WS_Z)};
            pg8::Unit u0;
            if (S.next(0, u0)) { s5_carry_tile(F, l, u0.pm / 3, u0.pm % 3);
                pg8::gemm_phase<pg8::EpiS5Y, pg8::MoeOrder, PG8_ALIGN, PG8_SP2>(F.lds, g, S, E); }
            else if (!last && F.bid >= 96 && F.bid < 104) ph_attn(F, l, 256, 264, F.bid - 96, 8);
            } SEAM(k0 + 3); }
        if (IN(k0 + 4)) { for (int rep_ = 0; rep_ < NREP(4); ++rep_) { if (rep_) __syncthreads(); Frame F = make_frame(wv); unsigned char* const ws_ = F.ws;
            pg8::Gemm g{(const pg8::bf16_t*)(ws_ + WS_Z), (const pg8::bf16_t*)(ws_ + WS_WPT) + (size_t)l * 2 * 65536, 2 * NR, 512, 256, 256, 256};
            g.wv = F.wave;
            pg8::MoeOrder S; S.init(last ? 64 : 66, 1, 66, 2, F.G, F.bid);
            pg8::EpiPW E{(pg8::bf16_t*)(ws_ + WS_CAT), (const pg8::bf16_t*)(ws_ + WS_Z), kargs()->in[18] + l * 256, kargs()->in[24] + l * 256, 66};
            pg8::gemm_phase<pg8::EpiPW, pg8::MoeOrder, PG8_ALIGN, PG8_SP2>(F.lds, g, S, E);
            } SEAM(k0 + 4); }
        if (IN(k0 + 5)) { for (int rep_ = 0; rep_ < NREP(5); ++rep_) { if (rep_) __syncthreads(); Frame F = make_frame(wv); unsigned char* const ws_ = F.ws;
            pg8::Gemm g{(const pg8::bf16_t*)(ws_ + WS_CAT), (const pg8::bf16_t*)(ws_ + WS_WOUT) + (size_t)l * DM * DM, NR, DM, DM, DM, DM};
            g.wv = F.wave;
            pg8::StaticOrder S; S.init(last ? NX : NR, DM, F.G, F.bid);
            pg8::EpiBf16B E{(pg8::bf16_t*)(ws_ + WS_YMIX), DM, kargs()->in[26] + l * DM};
            pg8::gemm_phase<pg8::EpiBf16B, pg8::StaticOrder, PG8_ALIGN, PG8_SP2>(F.lds, g, S, E);
            } SEAM(k0 + 5); }
        if (IN(k0 + 6)) { for (int rep_ = 0; rep_ < NREP(6); ++rep_) { if (rep_) __syncthreads(); { Frame F = make_frame(wv); ph_rows_mid2(F, l, last); } } SEAM(k0 + 6); }
        if (IN(k0 + 7)) { for (int rep_ = 0; rep_ < NREP(7); ++rep_) { if (rep_) __syncthreads(); { Frame F = make_frame(wv); ph_route(F, last); } } SEAM(k0 + 7);
        }
        const int MT = last ? 8 : 9;
        if (IN(k0 + 8)) { for (int rep_ = 0; rep_ < NREP(8); ++rep_) { if (rep_) __syncthreads(); Frame F = make_frame(wv); unsigned char* const ws_ = F.ws;
            pg8::Gemm g{(const pg8::bf16_t*)(ws_ + WS_HX), (const pg8::bf16_t*)(ws_ + WS_WGU + (size_t)l * NE * 4096 * 1024), NSLOT, NE * 4096, 512, 512, 512};
            g.wv = F.wave;
            pg8::MoeOrder S; S.init(MT, 16, 9, NE, F.G, F.bid, last ? -1 : 8);
            pg8::EpiSwiGLU8 E{ws_ + WS_HID, FF, 16, last ? -1 : 8, 9};
            pg8::gemm_phase_g8<pg8::EpiSwiGLU8, pg8::MoeOrder, PG8_ALIGN, PG8_SP2>(F.lds, g, S, E, (const int*)(ws_ + WS_IDX), 0x7a7a7a7a, 0x7f7f7f7f);
            } SEAM(k0 + 8); }
        if (IN(k0 + 9)) { for (int rep_ = 0; rep_ < NREP(9); ++rep_) { if (rep_) __syncthreads(); Frame F = make_frame(wv); unsigned char* const ws_ = F.ws;
            pg8::Gemm g{(const pg8::bf16_t*)(ws_ + WS_HID), (const pg8::bf16_t*)(ws_ + WS_WD + (size_t)l * NE * DM * FF), NSLOT, NE * DM, 1024, 1024, 1024};
            g.wv = F.wave;
            pg8::MoeOrder S; S.init(MT, 4, 9, NE, F.G, F.bid, last ? -1 : 8, !last);
            pg8::EpiBf16P E{(pg8::bf16_t*)(ws_ + WS_YEXP), DM, 4};
            pg8::gemm_phase_8<pg8::EpiBf16P, pg8::MoeOrder, PG8_ALIGN, PG8_SP2>(F.lds, g, S, E, 0x79797979, 0x7d7d7d7d);
            } SEAM(k0 + 9); }
        if (IN(k0 + 10)) { for (int rep_ = 0; rep_ < NREP(10); ++rep_) { if (rep_) __syncthreads(); { Frame F = make_frame(wv); ph_rows_final2(F, l, last); } } SEAM(k0 + 10); }
    }
__global__ void __launch_bounds__(NTHREADS, 2) mk_fwd(Args a) {
    { extern __shared__ __attribute__((aligned(16))) unsigned char lds[];
      if (threadIdx.x < 16) ((LAS unsigned*)((LAS unsigned char*)lds + MISC_OFF))[threadIdx.x] = 0u;
      __syncthreads();
      if (threadIdx.x == 0) (void)xb_add((unsigned*)(kargs()->ws + WS_BAR) + XB_XCNT(xb_xcc_id()), 1u); }
    int wv = __builtin_amdgcn_readfirstlane((int)(threadIdx.x >> 6)); asm volatile("" : "+s"(wv));
    if (kargs()->ph_hi < 0) cg::this_grid().sync();
    if (IN(0)) { for (int rep_ = 0; rep_ < NREPP(0); ++rep_) { if (rep_) __syncthreads(); Frame F = make_frame(wv); ph_prologue(F); } SEAM(0); }
    if (IN(1)) { for (int rep_ = 0; rep_ < NREPP(1); ++rep_) { if (rep_) __syncthreads(); Frame F = make_frame(wv); ph_rows0(F); } SEAM(1); }
    run_layer<0>(wv);
    run_layer<1>(wv);
}
#undef IN
#undef SEAM

extern "C" void kernel_launch(void* const* d_in, const int* in_sizes, int n_in, void* d_out, int out_size, void* d_ws, size_t ws_size, hipStream_t stream) {
    static int grid_blocks = 0;
    if (!grid_blocks) {
        int dev = 0, cus = 0, per_cu = 0;
        (void)hipGetDevice(&dev);
        (void)hipDeviceGetAttribute(&cus, hipDeviceAttributeMultiprocessorCount, dev);
        (void)hipFuncSetAttribute((const void*)mk_fwd, hipFuncAttributeMaxDynamicSharedMemorySize, LDS_BYTES);
        (void)hipOccupancyMaxActiveBlocksPerMultiprocessor(&per_cu, (const void*)mk_fwd, NTHREADS, LDS_BYTES);
        grid_blocks = (per_cu >= 1 && cus > 0) ? cus : -1;
        if (n_in != 35 || ws_size < WS_END) { fprintf(stderr, "kernel_launch: unexpected n_in %d or ws_size %zu (need %zu)\n", n_in, ws_size, (size_t)WS_END); grid_blocks = -1; }
        fprintf(stderr, "kernel_launch: cus %d per_cu %d ws %zu\n", cus, per_cu, ws_size);
    }
    if (grid_blocks < 0) return;
    (void)hipMemsetAsync((char*)d_ws + WS_BAR, 0, 32 * KiB, stream);
    Args a{};
    for (int i = 0; i < 35; ++i) a.in[i] = (const float*)d_in[i];
    a.out = (float*)d_out; a.ws = (unsigned char*)d_ws; a.G = grid_blocks;
#if MK_SPLIT
    for (int p = 0; p < NPH; ++p) { a.ph_lo = p; a.ph_hi = p + 1; void* args[] = {&a};
        hipError_t e = hipLaunchCooperativeKernel((const void*)mk_fwd, dim3(grid_blocks), dim3(NTHREADS), args, LDS_BYTES, stream);
        if (e != hipSuccess) { fprintf(stderr, "launch failed: %s\n", hipGetErrorString(e)); break; } }
#else
    a.ph_lo = 0; a.ph_hi = NPH; void* args[] = {&a};
    hipError_t e = hipLaunchCooperativeKernel((const void*)mk_fwd, dim3(grid_blocks), dim3(NTHREADS), args, LDS_BYTES, stream);
    if (e != hipSuccess) fprintf(stderr, "cooperative launch failed: %s (grid %d)\n", hipGetErrorString(e), grid_blocks);
#endif
}
```

```cpp
#include <hip/hip_runtime.h>
#include <hip/hip_cooperative_groups.h>
#include <cstdio>
#include <cstdint>
namespace cg = cooperative_groups;
namespace pg8 {
#define PG8_LAS __attribute__((address_space(3)))
typedef unsigned short bf16_t;
typedef short bf16x8 __attribute__((ext_vector_type(8)));
typedef float f32x4 __attribute__((ext_vector_type(4)));
typedef unsigned u32x4 __attribute__((ext_vector_type(4)));
constexpr int BM = 256, BK = 64, HALF = 128, HTB = HALF * BK * 2  , STAGE_BYTES = 8 * HTB, NXCD = 8, WGM = 8;

__host__ __device__ __forceinline__ int lds_byte(int r, int c) { const int st = (r >> 4) * 2 + (c >> 5), rr = r & 15, cc = c & 31, ob = rr * 64 + cc * 2; return st * 1024 + (ob ^ (((ob >> 9) & 1) << 5)); }
__host__ __device__ __forceinline__ void stage_rc(int b, int& R, int& C) { const int st = b / 1024, sb = b % 1024, swz = sb ^ (((sb >> 9) & 1) << 5); R = (st >> 1) * 16 + swz / 64; C = (st & 1) * 32 + (swz % 64) / 2; }
__host__ __device__ __forceinline__ int perm32(int rho) { const int n = rho >> 4, i = rho & 15; return 8 * (i >> 2) + 4 * n + (i & 3); }

struct Unit { int pm, pn; };
__device__ __forceinline__ int lane_id() { int r; asm volatile("v_mbcnt_lo_u32_b32 %0, -1, 0\n\tv_mbcnt_hi_u32_b32 %0, -1, %0" : "=v"(r)); return r; }
struct Gemm { const bf16_t* A; const bf16_t* Bt; int M, N, K, lda, ldb; int wv = 0; };

struct StaticOrder {
    int nM, nN, nwg, G, c;
    __host__ __device__ __forceinline__ void init(int M, int N, int G_, int c_) { nM = M / BM; nN = N / BM; nwg = nM * nN; G = G_; c = c_; }
    __host__ __device__ __forceinline__ bool next(int i, Unit& u) const {
        const long L = (long)i * G + c; if (L >= nwg) return false;
        int wgid = (int)L; { const int q = nwg / NXCD, r = nwg % NXCD, xcd = wgid % NXCD, off = wgid / NXCD; wgid = (xcd < r ? xcd * (q + 1) : r * (q + 1) + (xcd - r) * q) + off; }
        const int nig = WGM * nN, gid = wgid / nig, fm = gid * WGM, gsz = (nM - fm) < WGM ? (nM - fm) : WGM;
        u.pm = fm + ((wgid % nig) % gsz); u.pn = (wgid % nig) / gsz; return true;
    }
    __device__ __forceinline__ void a_ready(const Unit&) const {}
    __device__ __forceinline__ void done(const Unit&) const {}
    __device__ __forceinline__ int vrows(const Unit&) const { return BM; }
};

__device__ __forceinline__ unsigned cvt_pk_bf16(float lo, float hi) { unsigned r; asm volatile("v_cvt_pk_bf16_f32 %0, %1, %2" : "=v"(r) : "v"(lo), "v"(hi)); return r; }
typedef float f32x2 __attribute__((ext_vector_type(2)));
__device__ __forceinline__ f32x2 gelu_pk(f32x2 v) {
    const f32x2 av = __builtin_elementwise_abs(v), d = av * 0.2316418882f + 1.0f;
    f32x2 t; t.x = __builtin_amdgcn_rcpf(d.x); t.y = __builtin_amdgcn_rcpf(d.y);
    f32x2 q = t * 0.5307027145f + (-0.7265760135f); q = q * t + 0.7107068705f; q = q * t + (-0.142248368f); q = q * t + 0.127414796f; q = q * t;
    const f32x2 s = (v * v) * (-0.72134752044f);
    f32x2 e; e.x = __builtin_amdgcn_exp2f(s.x); e.y = __builtin_amdgcn_exp2f(s.y);
    const f32x2 m = v * (q * e), r = v - m;
    f32x2 o; o.x = v.x < 0.f ? m.x : r.x; o.y = v.y < 0.f ? m.y : r.y; return o;
}

typedef unsigned u32x2e __attribute__((ext_vector_type(2)));
__device__ __forceinline__ float silu_f(float x) { return x * __builtin_amdgcn_rcpf(1.f + __expf(-x)); }
struct EpiBf16P {
    static constexpr bool PERM = true, AFTER_DRAIN = false;
    bf16_t* O; int ldo; int ntpe;
    __device__ __forceinline__ void operator()(const f32x4 (&acc)[2][2][4][2], const Unit& u, int wr, int wc, int fr, int fq) const {
        const int row0 = u.pm * BM + wr * 64 + fr; const int col0 = (u.pn % ntpe) * BM + wc * 32 + 8 * fq;
#pragma unroll
        for (int ai = 0; ai < 2; ++ai)
#pragma unroll
            for (int m = 0; m < 4; ++m) { bf16_t* rowp = O + (size_t)(row0 + ai * HALF + m * 16) * ldo + col0;
#pragma unroll
                for (int bj = 0; bj < 2; ++bj) { const f32x4 v0 = acc[ai][bj][m][0], v1 = acc[ai][bj][m][1];
                    u32x4 w; w.x = cvt_pk_bf16(v0[0], v0[1]); w.y = cvt_pk_bf16(v0[2], v0[3]); w.z = cvt_pk_bf16(v1[0], v1[1]); w.w = cvt_pk_bf16(v1[2], v1[3]);
                    *(u32x4*)(rowp + bj * HALF) = w; } }
    }
};
struct EpiBf16B {
    static constexpr bool PERM = true, AFTER_DRAIN = false;
    bf16_t* O; int ldo; const float* bias;
    __device__ __forceinline__ void operator()(const f32x4 (&acc)[2][2][4][2], const Unit& u, int wr, int wc, int fr, int fq) const {
        const int row0 = u.pm * BM + wr * 64 + fr; const int col0 = u.pn * BM + wc * 32 + 8 * fq;
        f32x4 bv[2][2];
        { unsigned long long bp_ = (unsigned long long)bias; asm volatile("" : "+s"(bp_)); const float* bq = (const float*)bp_ + col0;
#pragma unroll
          for (int bj = 0; bj < 2; ++bj) { bv[bj][0] = *(const f32x4*)(bq + bj * HALF); bv[bj][1] = *(const f32x4*)(bq + bj * HALF + 4); } }
#pragma unroll
        for (int ai = 0; ai < 2; ++ai)
#pragma unroll
            for (int m = 0; m < 4; ++m) { bf16_t* rowp = O + (size_t)(row0 + ai * HALF + m * 16) * ldo + col0;
#pragma unroll
                for (int bj = 0; bj < 2; ++bj) {
                    const f32x4 v0 = acc[ai][bj][m][0] + bv[bj][0], v1 = acc[ai][bj][m][1] + bv[bj][1];
                    u32x4 w; w.x = cvt_pk_bf16(v0[0], v0[1]); w.y = cvt_pk_bf16(v0[2], v0[3]); w.z = cvt_pk_bf16(v1[0], v1[1]); w.w = cvt_pk_bf16(v1[2], v1[3]);
                    *(u32x4*)(rowp + bj * HALF) = w; } }
    }
};
__device__ __forceinline__ float sat_e4m3(float x) { return __builtin_amdgcn_fmed3f(x, -448.f, 448.f); }
__device__ __forceinline__ unsigned pack4_fp8(float a, float b, float c, float d) { int w = __builtin_amdgcn_cvt_pk_fp8_f32(sat_e4m3(a), sat_e4m3(b), 0, false); w = __builtin_amdgcn_cvt_pk_fp8_f32(sat_e4m3(c), sat_e4m3(d), w, true); return (unsigned)w; }
struct EpiSwiGLU8 {
    static constexpr bool PERM = true, AFTER_DRAIN = false;
    unsigned char* O; int ldo; int ntpe; int ctxpm, mstride;
    __device__ __forceinline__ void operator()(const f32x4 (&acc)[2][2][4][2], const Unit& u, int wr, int wc, int fr, int fq) const {
        const int row0 = u.pm * BM + wr * 64 + fr; const int col0 = (u.pn % ntpe) * HALF + wc * 32 + 8 * fq;
        const int vr = (ctxpm >= 0 && (u.pm % mstride) == ctxpm) ? 64 : BM;
#pragma unroll
        for (int ai = 0; ai < 2; ++ai) { if (wr * 64 + ai * HALF >= vr) continue;
#pragma unroll
            for (int m = 0; m < 4; ++m) { unsigned char* rowp = O + (size_t)(row0 + ai * HALF + m * 16) * ldo + col0;
                const f32x4 g0 = acc[ai][0][m][0], g1 = acc[ai][0][m][1], u0 = acc[ai][1][m][0] * 4.f, u1 = acc[ai][1][m][1] * 4.f;
                u32x2e w; w.x = pack4_fp8(silu_f(g0[0]) * u0[0], silu_f(g0[1]) * u0[1], silu_f(g0[2]) * u0[2], silu_f(g0[3]) * u0[3]);
                w.y = pack4_fp8(silu_f(g1[0]) * u1[0], silu_f(g1[1]) * u1[1], silu_f(g1[2]) * u1[2], silu_f(g1[3]) * u1[3]);
                *(u32x2e*)rowp = w; } }
    }
};
struct InProjOrder {
    int base, cnt, G, c;
    __device__ __forceinline__ void init(int base_, int cnt_, int G_, int c_) { base = base_; cnt = cnt_; G = G_; c = c_; }
    __device__ __forceinline__ bool next(int i, Unit& u) const {
        const long L = (long)i * G + c; if (L >= cnt) return false;
        int id = (int)L; { const int q = cnt / NXCD, r = cnt % NXCD, xcd = id % NXCD, off = id / NXCD; id = (xcd < r ? xcd * (q + 1) : r * (q + 1) + (xcd - r) * q) + off; }
        id += base; const bool hi = id >= 198; const int id2 = hi ? id - 198 : id;
        u.pm = id2 / 3; u.pn = (hi ? 0 : 3) + id2 % 3; return true;
    }
    __device__ __forceinline__ void a_ready(const Unit&) const {}
    __device__ __forceinline__ void done(const Unit&) const {}
    __device__ __forceinline__ int vrows(const Unit&) const { return BM; }
};
struct MoeOrder {
    int MT, NT, mstride, nwg, G, c, ctxpm, nx;
    __device__ __forceinline__ void init(int MT_, int NT_, int mstride_, int NE_, int G_, int c_, int ctxpm_ = -1, bool ctxlast = false) { MT = MT_; NT = NT_; mstride = mstride_; nwg = MT_ * NT_ * NE_; G = G_; c = c_; ctxpm = ctxpm_; nx = ctxlast ? (MT_ - 1) * NT_ * NE_ : 0; }
    __device__ __forceinline__ bool next(int i, Unit& u) const {
        const long L = (long)i * G + c; if (L >= nwg) return false;
        int id = (int)L;
        if (nx > 0) {
            if (id >= nx) { const int j = id - nx, e = j / NT; u.pm = e * mstride + (MT - 1); u.pn = e * NT + j % NT; return true; }
            { const int q = nx / NXCD, xcd = id % NXCD, off = id / NXCD; id = xcd * q + off; }
            const int upe = (MT - 1) * NT, e = id / upe, r2 = id % upe;
            u.pm = e * mstride + (r2 % (MT - 1)); u.pn = e * NT + (r2 / (MT - 1)); return true;
        }
        { const int q = nwg / NXCD, r = nwg % NXCD, xcd = id % NXCD, off = id / NXCD; id = (xcd < r ? xcd * (q + 1) : r * (q + 1) + (xcd - r) * q) + off; }
        const int upe = MT * NT, e = id / upe, r2 = id % upe;
        u.pm = e * mstride + (r2 % MT); u.pn = e * NT + (r2 / MT); return true;
    }
    __device__ __forceinline__ void a_ready(const Unit&) const {}
    __device__ __forceinline__ void done(const Unit&) const {}
    __device__ __forceinline__ int vrows(const Unit& u) const { return (ctxpm >= 0 && (u.pm % mstride) == ctxpm) ? 64 : BM; }
};
struct EpiF32G {
    static constexpr bool PERM = false, AFTER_DRAIN = false;
    float* C; int ldc; int ntpe;
    __device__ __forceinline__ void operator()(const f32x4 (&acc)[2][2][4][2], const Unit& u, int wr, int wc, int fr, int fq) const {
        const int row0 = u.pm * BM + wr * 64 + fr, col0 = (u.pn % ntpe) * BM + wc * 32 + 4 * fq;
#pragma unroll
        for (int ai = 0; ai < 2; ++ai)
#pragma unroll
            for (int m = 0; m < 4; ++m) { float* rowp = C + (size_t)(row0 + ai * HALF + m * 16) * ldc + col0;
#pragma unroll
                for (int bj = 0; bj < 2; ++bj)
#pragma unroll
                    for (int n = 0; n < 2; ++n) *(f32x4*)(rowp + bj * HALF + n * 16) = acc[ai][bj][m][n]; }
    }
};
__device__ __forceinline__ float gelu_tanh_e(float x) { const float u = 1.5957691216057308f * (x + 0.044715f * x * x * x); return x * __builtin_amdgcn_rcpf(1.f + __expf(-u)); }
struct EpiS5Y {
    static constexpr bool PERM = true, AFTER_DRAIN = false;
    bf16_t* Z;
    __device__ __forceinline__ void operator()(const f32x4 (&acc)[2][2][4][2], const Unit& u, int wr, int wc, int fr, int fq) const {
        const int g = u.pm / 3, R0 = (u.pm % 3) * BM + wr * 64 + fr, n0 = (u.pn & 1) * BM + wc * 32 + 8 * fq;
#pragma unroll
        for (int ai = 0; ai < 2; ++ai)
#pragma unroll
            for (int m = 0; m < 4; ++m) { const int R = R0 + ai * HALF + m * 16; if (R >= 528) continue;
                const int tok0 = (R < 512) ? ((R >> 8) * 8192 + 32 * (R & 255)) : (16384 + ((R - 512) >> 3) * 256 + 32 * ((R - 512) & 7));
#pragma unroll
                for (int bj = 0; bj < 2; ++bj) { const int n = n0 + bj * HALF, j = n >> 4, c0 = n & 15; const f32x4 v0 = acc[ai][bj][m][0], v1 = acc[ai][bj][m][1];
                    u32x4 w; w.x = cvt_pk_bf16(gelu_tanh_e(v0[0]), gelu_tanh_e(v0[1])); w.y = cvt_pk_bf16(gelu_tanh_e(v0[2]), gelu_tanh_e(v0[3])); w.z = cvt_pk_bf16(gelu_tanh_e(v1[0]), gelu_tanh_e(v1[1])); w.w = cvt_pk_bf16(gelu_tanh_e(v1[2]), gelu_tanh_e(v1[3]));
                    *(u32x4*)(Z + ((size_t)(tok0 + j)) * 256 + 16 * g + c0) = w; } }
    }
};
struct EpiPW {
    static constexpr bool PERM = true, AFTER_DRAIN = false;
    bf16_t* CAT; const bf16_t* Z; const float* bglu; const float* bpw; int mtpe;
    __device__ __forceinline__ void operator()(const f32x4 (&acc)[2][2][4][2], const Unit& u, int wr, int wc, int fr, int fq) const {
        const int grp = u.pn, row0 = (u.pm % mtpe) * BM + wr * 64 + fr, col0 = wc * 32 + 8 * fq; const float* bias = grp ? bpw : bglu;
#pragma unroll
        for (int ai = 0; ai < 2; ++ai)
#pragma unroll
            for (int m = 0; m < 4; ++m) { const size_t row = (size_t)(row0 + ai * HALF + m * 16);
#pragma unroll
                for (int bj = 0; bj < 2; ++bj) { const int col = col0 + bj * HALF;
                    unsigned long long bp_ = (unsigned long long)bias; asm volatile("" : "+s"(bp_)); const float* bq = (const float*)bp_ + col;
                    f32x4 v0 = acc[ai][bj][m][0] + *(const f32x4*)bq, v1 = acc[ai][bj][m][1] + *(const f32x4*)(bq + 4);
                    if (grp == 0) { const u32x4 zz = *(const u32x4*)(Z + row * 256 + col);
                        v0[0] = __builtin_bit_cast(float, zz.x << 16) * __builtin_amdgcn_rcpf(1.f + __expf(-v0[0])); v0[1] = __builtin_bit_cast(float, zz.x & 0xffff0000u) * __builtin_amdgcn_rcpf(1.f + __expf(-v0[1]));
                        v0[2] = __builtin_bit_cast(float, zz.y << 16) * __builtin_amdgcn_rcpf(1.f + __expf(-v0[2])); v0[3] = __builtin_bit_cast(float, zz.y & 0xffff0000u) * __builtin_amdgcn_rcpf(1.f + __expf(-v0[3]));
                        v1[0] = __builtin_bit_cast(float, zz.z << 16) * __builtin_amdgcn_rcpf(1.f + __expf(-v1[0])); v1[1] = __builtin_bit_cast(float, zz.z & 0xffff0000u) * __builtin_amdgcn_rcpf(1.f + __expf(-v1[1]));
                        v1[2] = __builtin_bit_cast(float, zz.w << 16) * __builtin_amdgcn_rcpf(1.f + __expf(-v1[2])); v1[3] = __builtin_bit_cast(float, zz.w & 0xffff0000u) * __builtin_amdgcn_rcpf(1.f + __expf(-v1[3])); }
                    u32x4 w; w.x = cvt_pk_bf16(v0[0], v0[1]); w.y = cvt_pk_bf16(v0[2], v0[3]); w.z = cvt_pk_bf16(v1[0], v1[1]); w.w = cvt_pk_bf16(v1[2], v1[3]);
                    *(u32x4*)(CAT + row * 1024 + 512 + grp * 256 + col) = w; }
                asm volatile("" ::: "memory"); }
    }
};
typedef unsigned u32x2 __attribute__((ext_vector_type(2)));
struct EpiInProj {
    static constexpr bool PERM = true, AFTER_DRAIN = false;
    const float* bias; const float* rope; bf16_t* Q; bf16_t* K; bf16_t* V; bf16_t* UC; bf16_t* HG;
    __device__ __forceinline__ void operator()(const f32x4 (&acc)[2][2][4][2], const Unit& u, int wr, int wc, int fr, int fq) const {
        const int pn = u.pn; const bool isx = u.pm < 64;
        f32x4 bv[2][2];
        { unsigned long long bp_ = (unsigned long long)bias; asm volatile("" : "+s"(bp_)); const float* bq = (const float*)bp_ + pn * BM + wc * 32 + 8 * fq;
#pragma unroll
          for (int bj = 0; bj < 2; ++bj) { bv[bj][0] = *(const f32x4*)(bq + bj * HALF); bv[bj][1] = *(const f32x4*)(bq + bj * HALF + 4); } }
        const bool rot = (pn <= 2) && isx; const int hi = fq >> 1, i0 = 8 * (fq & 1);
#pragma unroll
        for (int ai = 0; ai < 2; ++ai)
#pragma unroll
            for (int m = 0; m < 4; ++m) {
                const int r = u.pm * BM + ai * HALF + wr * 64 + m * 16 + fr;
                f32x4 v[2][2];
#pragma unroll
                for (int bj = 0; bj < 2; ++bj)
#pragma unroll
                    for (int n = 0; n < 2; ++n) v[bj][n] = acc[ai][bj][m][n] + bv[bj][n];
                if (pn <= 2) {
                    f32x4 cs[4];
                    if (rot) { const int t = r & 8191, pos = (wc & 1) ? (t & 63) : (t >> 6); const f32x4* rp = (const f32x4*)(rope + ((size_t)pos * 16 + i0) * 2);
#pragma unroll
                        for (int q = 0; q < 4; ++q) cs[q] = rp[q]; }
                    else {
#pragma unroll
                        for (int q = 0; q < 4; ++q) cs[q] = (f32x4){1.f, 0.f, 1.f, 0.f}; }
#pragma unroll
                    for (int bj = 0; bj < 2; ++bj) {
                        u32x4 w;
                        if (pn == 2 && bj == 1) {
                            w.x = cvt_pk_bf16(v[1][0][0], v[1][0][1]); w.y = cvt_pk_bf16(v[1][0][2], v[1][0][3]); w.z = cvt_pk_bf16(v[1][1][0], v[1][1][1]); w.w = cvt_pk_bf16(v[1][1][2], v[1][1][3]);
                            *(u32x4*)(V + (size_t)r * 128 + wc * 32 + 8 * fq) = w;
                        } else {
                            float o[8];
#pragma unroll
                            for (int n = 0; n < 2; ++n)
#pragma unroll
                                for (int e = 0; e < 4; ++e) { const float mine = v[bj][n][e], other = __shfl_xor(mine, 32); const int q = 2 * n + (e >> 1); const float c = cs[q][2 * (e & 1)], s = cs[q][2 * (e & 1) + 1];
                                    o[4 * n + e] = hi ? (mine * c + other * s) : (mine * c - other * s); }
                            const float qs = (pn == 2) ? 1.f : 0.18033688011112042f;
                            w.x = cvt_pk_bf16(o[0] * qs, o[1] * qs); w.y = cvt_pk_bf16(o[2] * qs, o[3] * qs); w.z = cvt_pk_bf16(o[4] * qs, o[5] * qs); w.w = cvt_pk_bf16(o[6] * qs, o[7] * qs);
                            bf16_t* op = (pn == 2) ? K + (size_t)r * 128 + wc * 32 + 8 * fq : Q + (size_t)r * 512 + pn * BM + bj * HALF + wc * 32 + 8 * fq;
                            *(u32x4*)op = w;
                        } }
                } else if (pn == 3) {
                    int R, j; if (isx) { const int t = r & 8191; R = (r >> 13) * 256 + (t >> 5); j = t & 31; } else { const int rc = r - 16384, t = rc & 255; R = 512 + (rc >> 8) * 8 + (t >> 5); j = t & 31; }
#pragma unroll
                    for (int bj = 0; bj < 2; ++bj) { const int g = 8 * bj + 2 * wc + (fq >> 1); u32x4 w;
                        w.x = cvt_pk_bf16(v[bj][0][0], v[bj][0][1]); w.y = cvt_pk_bf16(v[bj][0][2], v[bj][0][3]); w.z = cvt_pk_bf16(v[bj][1][0], v[bj][1][1]); w.w = cvt_pk_bf16(v[bj][1][2], v[bj][1][3]);
                        *(u32x4*)(UC + ((size_t)(g * 768 + R)) * 768 + j * 16 + 8 * (fq & 1)) = w; }
                } else {
                    u32x4 w; float hgv[8];
#pragma unroll
                    for (int n = 0; n < 2; ++n)
#pragma unroll
                        for (int e = 0; e < 4; ++e) hgv[4 * n + e] = v[0][n][e] * __builtin_amdgcn_rcpf(1.f + __expf(-v[1][n][e]));
                    w.x = cvt_pk_bf16(hgv[0], hgv[1]); w.y = cvt_pk_bf16(hgv[2], hgv[3]); w.z = cvt_pk_bf16(hgv[4], hgv[5]); w.w = cvt_pk_bf16(hgv[6], hgv[7]);
                    *(u32x4*)(HG + (size_t)r * 256 + (pn - 4) * HALF + wc * 32 + 8 * fq) = w;
                }
                asm volatile("" ::: "memory");
            }
    }
};
template <class Epi, class Sched, bool ALIGN_EPI = false, bool SP2 = false>
__device__ __forceinline__ void gemm_phase(PG8_LAS unsigned char* lds, const Gemm g, const Sched& S, const Epi& E) {
    int tid_ = g.wv * 64 + lane_id(); asm volatile("" : "+v"(tid_));
    const int tid = tid_, wid = __builtin_amdgcn_readfirstlane(tid >> 6), lane = tid & 63, wr = wid >> 2, wc = wid & 3, fr = lane & 15, fq = lane >> 4;
    const int K = g.K, nt = K / BK;
    unsigned voffA[2], voffB[2];
#pragma unroll
    for (int i = 0; i < 2; ++i) { int R, C; stage_rc(tid * 16 + i * 8192, R, C); const int Rb = Epi::PERM ? ((R & ~31) + perm32(R & 31)) : R;
        voffA[i] = (unsigned)(R * g.lda + C) * 2u; voffB[i] = (unsigned)(Rb * g.ldb + C) * 2u; }
    const size_t kstep = (size_t)(BK * 2);
    const size_t hstepA = (size_t)HALF * g.lda * 2, hstepB = (size_t)HALF * g.ldb * 2;
    const size_t tstepA = 2 * hstepA, tstepB = 2 * hstepB;
    const unsigned ldsw = (unsigned)wid * 1024u;
    const int aoff = lds_byte(wr * 64 + fr, fq * 8), boff = lds_byte(wc * 32 + fr, fq * 8);
#define PG8_SA(b, h) (((b) * 2 + (h)) * HTB)
#define PG8_SB(b, h) ((4 + (b) * 2 + (h)) * HTB)
#define PG8_STAGE(bufoff, gbase, voff) do { _Pragma("unroll") for (int _i = 0; _i < 2; ++_i) \
        __builtin_amdgcn_global_load_lds((const unsigned*)((const char*)(gbase) + (voff)[_i]), (PG8_LAS unsigned*)(lds + (bufoff) + ldsw + _i * 8192), 16, 0, 0); } while (0)
#define PG8_LDA(dst, b, h) do { _Pragma("unroll") for (int m = 0; m < 4; ++m) _Pragma("unroll") for (int k = 0; k < 2; ++k) dst[m][k] = *(const PG8_LAS bf16x8*)(lds + PG8_SA(b, h) + aoff + m * 2048 + k * 1024); } while (0)
#define PG8_LDB(dst, b, h) do { _Pragma("unroll") for (int n = 0; n < 2; ++n) _Pragma("unroll") for (int k = 0; k < 2; ++k) dst[n][k] = *(const PG8_LAS bf16x8*)(lds + PG8_SB(b, h) + boff + n * 2048 + k * 1024); } while (0)
#define PG8_MMA(ai, bj, At, Bt) do { __builtin_amdgcn_s_setprio(1); _Pragma("unroll") for (int m = 0; m < 4; ++m) _Pragma("unroll") for (int n = 0; n < 2; ++n) _Pragma("unroll") for (int k = 0; k < 2; ++k) \
        acc[ai][bj][m][n] = __builtin_amdgcn_mfma_f32_16x16x32_bf16(Bt[n][k], At[m][k], acc[ai][bj][m][n], 0, 0, 0); __builtin_amdgcn_s_setprio(0); } while (0)
#define PG8_WAIT_V(n) asm volatile("s_waitcnt vmcnt(" #n ")" ::: "memory")
#define PG8_WAIT_L(n) asm volatile("s_waitcnt lgkmcnt(" #n ")" ::: "memory")
#define PG8_BAR __builtin_amdgcn_s_barrier()
#define PG8_SCHED __builtin_amdgcn_sched_barrier(0)
    Unit cur, nxt; int ui = 0;
    if (!S.next(0, cur)) return;
    f32x4 acc[2][2][4][2];
#pragma unroll
    for (int a = 0; a < 2; ++a)
#pragma unroll
        for (int b = 0; b < 2; ++b)
#pragma unroll
            for (int m = 0; m < 4; ++m)
#pragma unroll
                for (int n = 0; n < 2; ++n) acc[a][b][m][n] = (f32x4){0.f, 0.f, 0.f, 0.f};
    bf16x8 At[4][2], B0[2][2], B1[2][2];
    const char* cA = (const char*)g.A + (size_t)cur.pm * tstepA; const char* cB = (const char*)g.Bt + (size_t)cur.pn * tstepB;
    S.a_ready(cur);
    if constexpr (SP2) {
        PG8_STAGE(PG8_SB(0, 0), cB, voffB); PG8_STAGE(PG8_SB(0, 1), cB + hstepB, voffB); PG8_STAGE(PG8_SA(0, 0), cA, voffA); PG8_STAGE(PG8_SA(0, 1), cA + hstepA, voffA);
        if (wr == 1) PG8_BAR;
        PG8_WAIT_V(2); PG8_BAR;
        PG8_STAGE(PG8_SB(1, 0), cB + kstep, voffB); PG8_STAGE(PG8_SA(1, 0), cA + kstep, voffA); PG8_STAGE(PG8_SB(1, 1), cB + hstepB + kstep, voffB);
        PG8_WAIT_V(6); PG8_BAR;
    } else {
        PG8_STAGE(PG8_SB(0, 0), cB, voffB); PG8_STAGE(PG8_SA(0, 0), cA, voffA); PG8_STAGE(PG8_SB(0, 1), cB + hstepB, voffB); PG8_STAGE(PG8_SA(0, 1), cA + hstepA, voffA);
        if (wr == 1) PG8_BAR;
        PG8_WAIT_V(4); PG8_BAR;
        PG8_STAGE(PG8_SB(1, 0), cB + kstep, voffB); PG8_STAGE(PG8_SA(1, 0), cA + kstep, voffA); PG8_STAGE(PG8_SB(1, 1), cB + hstepB + kstep, voffB);
        PG8_WAIT_V(6); PG8_BAR;
    }
    for (;;) {
        const bool has_next = S.next(ui + 1, nxt);
        const char* nA = has_next ? (const char*)g.A + (size_t)nxt.pm * tstepA : cA; const char* nB = has_next ? (const char*)g.Bt + (size_t)nxt.pn * tstepB : cB;
        for (int t = 0; t < nt; t += 2) {
            const bool last = (t == nt - 2);
            const char* a1 = cA + (size_t)(t + 1) * kstep;
            const char* a2 = last ? nA : cA + (size_t)(t + 2) * kstep; const char* b2 = last ? nB : cB + (size_t)(t + 2) * kstep;
            const char* a3 = a2 + kstep; const char* b3 = b2 + kstep;
            if (last && has_next) S.a_ready(nxt);
            if constexpr (SP2) {
            PG8_LDB(B0, 0, 0); PG8_LDB(B1, 0, 1); PG8_SCHED; PG8_LDA(At, 0, 0); PG8_STAGE(PG8_SA(1, 1), a1 + hstepA, voffA);
            PG8_WAIT_V(8); PG8_WAIT_L(0); PG8_BAR; PG8_MMA(0, 0, At, B0); PG8_MMA(0, 1, At, B1); PG8_BAR; PG8_SCHED;
            PG8_LDA(At, 0, 1); PG8_STAGE(PG8_SB(0, 0), b2, voffB); PG8_STAGE(PG8_SB(0, 1), b2 + hstepB, voffB); PG8_STAGE(PG8_SA(0, 0), a2, voffA);
            PG8_WAIT_V(8); PG8_WAIT_L(0); PG8_BAR; PG8_MMA(1, 0, At, B0); PG8_MMA(1, 1, At, B1); PG8_BAR; PG8_SCHED;
            PG8_LDB(B0, 1, 0); PG8_LDB(B1, 1, 1); PG8_SCHED; PG8_LDA(At, 1, 0); PG8_STAGE(PG8_SA(0, 1), a2 + hstepA, voffA);
            PG8_WAIT_V(8); PG8_WAIT_L(0); PG8_BAR; PG8_MMA(0, 0, At, B0); PG8_MMA(0, 1, At, B1); PG8_BAR; PG8_SCHED;
            PG8_LDA(At, 1, 1); PG8_STAGE(PG8_SB(1, 0), b3, voffB); PG8_STAGE(PG8_SB(1, 1), b3 + hstepB, voffB); PG8_STAGE(PG8_SA(1, 0), a3, voffA);
            PG8_WAIT_V(8); PG8_WAIT_L(0); PG8_BAR; PG8_MMA(1, 0, At, B0); PG8_MMA(1, 1, At, B1); PG8_BAR; PG8_SCHED;
            } else {
            PG8_LDB(B0, 0, 0); PG8_SCHED; PG8_LDA(At, 0, 0); PG8_STAGE(PG8_SA(1, 1), a1 + hstepA, voffA);
            PG8_WAIT_L(8); PG8_BAR; PG8_WAIT_L(0); PG8_MMA(0, 0, At, B0); PG8_BAR; PG8_SCHED;
            PG8_LDB(B1, 0, 1); PG8_STAGE(PG8_SB(0, 0), b2, voffB);
            PG8_BAR; PG8_WAIT_L(0); PG8_MMA(0, 1, At, B1); PG8_BAR;
            PG8_LDA(At, 0, 1); PG8_STAGE(PG8_SA(0, 0), a2, voffA);
            PG8_BAR; PG8_WAIT_L(0); PG8_MMA(1, 0, At, B0); PG8_BAR; PG8_SCHED;
            PG8_STAGE(PG8_SB(0, 1), b2 + hstepB, voffB);
            PG8_WAIT_V(6); PG8_BAR; PG8_MMA(1, 1, At, B1); PG8_BAR;
            PG8_LDB(B0, 1, 0); PG8_SCHED; PG8_LDA(At, 1, 0); PG8_STAGE(PG8_SA(0, 1), a2 + hstepA, voffA);
            PG8_WAIT_L(8); PG8_BAR; PG8_WAIT_L(0); PG8_MMA(0, 0, At, B0); PG8_BAR; PG8_SCHED;
            PG8_LDB(B1, 1, 1); PG8_STAGE(PG8_SB(1, 0), b3, voffB);
            PG8_BAR; PG8_WAIT_L(0); PG8_MMA(0, 1, At, B1); PG8_BAR;
            PG8_LDA(At, 1, 1); PG8_STAGE(PG8_SA(1, 0), a3, voffA);
            PG8_BAR; PG8_WAIT_L(0); PG8_MMA(1, 0, At, B0); PG8_BAR; PG8_SCHED;
            PG8_STAGE(PG8_SB(1, 1), b3 + hstepB, voffB);
            PG8_WAIT_V(6); PG8_BAR; PG8_MMA(1, 1, At, B1); PG8_BAR;
            }
        }
        if constexpr (ALIGN_EPI) { if (wr == 0) PG8_BAR; }
        if constexpr (!Epi::AFTER_DRAIN) { E(acc, cur, wr, wc, fr, fq); S.done(cur); }
        if (!has_next) break;
#pragma unroll
        for (int a = 0; a < 2; ++a)
#pragma unroll
            for (int b = 0; b < 2; ++b)
#pragma unroll
                for (int m = 0; m < 4; ++m)
#pragma unroll
                    for (int n = 0; n < 2; ++n) acc[a][b][m][n] = (f32x4){0.f, 0.f, 0.f, 0.f};
        cur = nxt; cA = nA; cB = nB; ++ui;
        if constexpr (ALIGN_EPI) { if (wr == 1) PG8_BAR; }
    }
    PG8_WAIT_V(0);
    if constexpr (!ALIGN_EPI) { if (wr == 0) PG8_BAR; }
    PG8_BAR;
    if constexpr (Epi::AFTER_DRAIN) { E.fused(acc, cur, wr, wc, fr, fq, lds, wid, lane); S.done(cur); }
#undef PG8_SA
#undef PG8_SB
#undef PG8_STAGE
#undef PG8_LDA
#undef PG8_LDB
#undef PG8_MMA
#undef PG8_WAIT_V
#undef PG8_WAIT_L
#undef PG8_BAR
#undef PG8_SCHED
}
typedef int v4i_t __attribute__((ext_vector_type(4)));
typedef int v8i_t __attribute__((ext_vector_type(8)));
#define PG8_CAT(x, y) __builtin_shufflevector(__builtin_bit_cast(v4i_t, x), __builtin_bit_cast(v4i_t, y), 0, 1, 2, 3, 4, 5, 6, 7)
template <class Epi, class Sched, bool ALIGN_EPI = false, bool SP2 = false>
__device__ __forceinline__ void gemm_phase_8(PG8_LAS unsigned char* lds, const Gemm g, const Sched& S, const Epi& E, const int sa, const int sb) {
    int tid_ = g.wv * 64 + lane_id(); asm volatile("" : "+v"(tid_));
    const int tid = tid_, wid = __builtin_amdgcn_readfirstlane(tid >> 6), lane = tid & 63, wr = wid >> 2, wc = wid & 3, fr = lane & 15, fq = lane >> 4;
    const int K = g.K, nt = K / BK;
    unsigned voffA[2], voffB[2];
#pragma unroll
    for (int i = 0; i < 2; ++i) { int R, C; stage_rc(tid * 16 + i * 8192, R, C); const int Rb = Epi::PERM ? ((R & ~31) + perm32(R & 31)) : R;
        voffA[i] = (unsigned)(R * g.lda + C) * 2u; voffB[i] = (unsigned)(Rb * g.ldb + C) * 2u; }
    const size_t kstep = (size_t)(BK * 2);
    const size_t hstepA = (size_t)HALF * g.lda * 2, hstepB = (size_t)HALF * g.ldb * 2;
    const size_t tstepA = 2 * hstepA, tstepB = 2 * hstepB;
    const unsigned ldsw = (unsigned)wid * 1024u;
    const int aoff8[2] = {lds_byte(wr * 64 + fr, 16 * fq), lds_byte(wr * 64 + fr, 16 * fq + 8)}, boff8[2] = {lds_byte(wc * 32 + fr, 16 * fq), lds_byte(wc * 32 + fr, 16 * fq + 8)};
#define PG8_SA(b, h) (((b) * 2 + (h)) * HTB)
#define PG8_SB(b, h) ((4 + (b) * 2 + (h)) * HTB)
#define PG8_STAGE(bufoff, gbase, voff) do { _Pragma("unroll") for (int _i = 0; _i < 2; ++_i) \
        __builtin_amdgcn_global_load_lds((const unsigned*)((const char*)(gbase) + (voff)[_i]), (PG8_LAS unsigned*)(lds + (bufoff) + ldsw + _i * 8192), 16, 0, 0); } while (0)
#define PG8_LDA(dst, b, h) do { _Pragma("unroll") for (int m = 0; m < 4; ++m) { const v4i_t lo_ = *(const PG8_LAS v4i_t*)(lds + PG8_SA(b, h) + aoff8[0] + m * 2048), hi_ = *(const PG8_LAS v4i_t*)(lds + PG8_SA(b, h) + aoff8[1] + m * 2048); dst[m] = __builtin_shufflevector(lo_, hi_, 0, 1, 2, 3, 4, 5, 6, 7); } } while (0)
#define PG8_LDB(dst, b, h) do { _Pragma("unroll") for (int n = 0; n < 2; ++n) { const v4i_t lo_ = *(const PG8_LAS v4i_t*)(lds + PG8_SB(b, h) + boff8[0] + n * 2048), hi_ = *(const PG8_LAS v4i_t*)(lds + PG8_SB(b, h) + boff8[1] + n * 2048); dst[n] = __builtin_shufflevector(lo_, hi_, 0, 1, 2, 3, 4, 5, 6, 7); } } while (0)
#define PG8_MMA(ai, bj, At, Bt) do { if ((ai) ? do1 : do0) { __builtin_amdgcn_s_setprio(1); _Pragma("unroll") for (int m = 0; m < 4; ++m) _Pragma("unroll") for (int n = 0; n < 2; ++n) \
        asm volatile("v_mfma_scale_f32_16x16x128_f8f6f4 %0, %1, %2, %0, %3, %4 op_sel_hi:[0,0,0]" : "+v"(acc[ai][bj][m][n]) : "v"(Bt[n]), "v"(At[m]), "v"(sa), "v"(sb)); __builtin_amdgcn_s_setprio(0); } } while (0)
#define PG8_WAIT_V(n) asm volatile("s_waitcnt vmcnt(" #n ")" ::: "memory")
#define PG8_WAIT_L(n) asm volatile("s_waitcnt lgkmcnt(" #n ")" ::: "memory")
#define PG8_BAR __builtin_amdgcn_s_barrier()
#define PG8_SCHED __builtin_amdgcn_sched_barrier(0)
    Unit cur, nxt; int ui = 0;
    if (!S.next(0, cur)) return;
    bool do0 = wr * 64 < S.vrows(cur), do1 = wr * 64 + HALF < S.vrows(cur);
    f32x4 acc[2][2][4][2];
#pragma unroll
    for (int a = 0; a < 2; ++a)
#pragma unroll
        for (int b = 0; b < 2; ++b)
#pragma unroll
            for (int m = 0; m < 4; ++m)
#pragma unroll
                for (int n = 0; n < 2; ++n) acc[a][b][m][n] = (f32x4){0.f, 0.f, 0.f, 0.f};
    v8i_t At[4], B0[2], B1[2];
    const char* cA = (const char*)g.A + (size_t)cur.pm * tstepA; const char* cB = (const char*)g.Bt + (size_t)cur.pn * tstepB;
    S.a_ready(cur);
    if constexpr (SP2) {
        PG8_STAGE(PG8_SB(0, 0), cB, voffB); PG8_STAGE(PG8_SB(0, 1), cB + hstepB, voffB); PG8_STAGE(PG8_SA(0, 0), cA, voffA); PG8_STAGE(PG8_SA(0, 1), cA + hstepA, voffA);
        if (wr == 1) PG8_BAR;
        PG8_WAIT_V(2); PG8_BAR;
        PG8_STAGE(PG8_SB(1, 0), cB + kstep, voffB); PG8_STAGE(PG8_SA(1, 0), cA + kstep, voffA); PG8_STAGE(PG8_SB(1, 1), cB + hstepB + kstep, voffB);
        PG8_WAIT_V(6); PG8_BAR;
    } else {
        PG8_STAGE(PG8_SB(0, 0), cB, voffB); PG8_STAGE(PG8_SA(0, 0), cA, voffA); PG8_STAGE(PG8_SB(0, 1), cB + hstepB, voffB); PG8_STAGE(PG8_SA(0, 1), cA + hstepA, voffA);
        if (wr == 1) PG8_BAR;
        PG8_WAIT_V(4); PG8_BAR;
        PG8_STAGE(PG8_SB(1, 0), cB + kstep, voffB); PG8_STAGE(PG8_SA(1, 0), cA + kstep, voffA); PG8_STAGE(PG8_SB(1, 1), cB + hstepB + kstep, voffB);
        PG8_WAIT_V(6); PG8_BAR;
    }
    for (;;) {
        const bool has_next = S.next(ui + 1, nxt);
        const char* nA = has_next ? (const char*)g.A + (size_t)nxt.pm * tstepA : cA; const char* nB = has_next ? (const char*)g.Bt + (size_t)nxt.pn * tstepB : cB;
        for (int t = 0; t < nt; t += 2) {
            const bool last = (t == nt - 2);
            const char* a1 = cA + (size_t)(t + 1) * kstep;
            const char* a2 = last ? nA : cA + (size_t)(t + 2) * kstep; const char* b2 = last ? nB : cB + (size_t)(t + 2) * kstep;
            const char* a3 = a2 + kstep; const char* b3 = b2 + kstep;
            if (last && has_next) S.a_ready(nxt);
            if constexpr (SP2) {
            PG8_LDB(B0, 0, 0); PG8_LDB(B1, 0, 1); PG8_SCHED; PG8_LDA(At, 0, 0); PG8_STAGE(PG8_SA(1, 1), a1 + hstepA, voffA);
            PG8_WAIT_V(8); PG8_WAIT_L(0); PG8_BAR; PG8_MMA(0, 0, At, B0); PG8_MMA(0, 1, At, B1); PG8_BAR; PG8_SCHED;
            PG8_LDA(At, 0, 1); PG8_STAGE(PG8_SB(0, 0), b2, voffB); PG8_STAGE(PG8_SB(0, 1), b2 + hstepB, voffB); PG8_STAGE(PG8_SA(0, 0), a2, voffA);
            PG8_WAIT_V(8); PG8_WAIT_L(0); PG8_BAR; PG8_MMA(1, 0, At, B0); PG8_MMA(1, 1, At, B1); PG8_BAR; PG8_SCHED;
            PG8_LDB(B0, 1, 0); PG8_LDB(B1, 1, 1); PG8_SCHED; PG8_LDA(At, 1, 0); PG8_STAGE(PG8_SA(0, 1), a2 + hstepA, voffA);
            PG8_WAIT_V(8); PG8_WAIT_L(0); PG8_BAR; PG8_MMA(0, 0, At, B0); PG8_MMA(0, 1, At, B1); PG8_BAR; PG8_SCHED;
            PG8_LDA(At, 1, 1); PG8_STAGE(PG8_SB(1, 0), b3, voffB); PG8_STAGE(PG8_SB(1, 1), b3 + hstepB, voffB); PG8_STAGE(PG8_SA(1, 0), a3, voffA);
            PG8_WAIT_V(8); PG8_WAIT_L(0); PG8_BAR; PG8_MMA(1, 0, At, B0); PG8_MMA(1, 1, At, B1); PG8_BAR; PG8_SCHED;
            } else {
            PG8_LDB(B0, 0, 0); PG8_SCHED; PG8_LDA(At, 0, 0); PG8_STAGE(PG8_SA(1, 1), a1 + hstepA, voffA);
            PG8_WAIT_L(8); PG8_BAR; PG8_WAIT_L(0); PG8_MMA(0, 0, At, B0); PG8_BAR; PG8_SCHED;
            PG8_LDB(B1, 0, 1); PG8_STAGE(PG8_SB(0, 0), b2, voffB);
            PG8_BAR; PG8_WAIT_L(0); PG8_MMA(0, 1, At, B1); PG8_BAR;
            PG8_LDA(At, 0, 1); PG8_STAGE(PG8_SA(0, 0), a2, voffA);
            PG8_BAR; PG8_WAIT_L(0); PG8_MMA(1, 0, At, B0); PG8_BAR; PG8_SCHED;
            PG8_STAGE(PG8_SB(0, 1), b2 + hstepB, voffB);
            PG8_WAIT_V(6); PG8_BAR; PG8_MMA(1, 1, At, B1); PG8_BAR;
            PG8_LDB(B0, 1, 0); PG8_SCHED; PG8_LDA(At, 1, 0); PG8_STAGE(PG8_SA(0, 1), a2 + hstepA, voffA);
            PG8_WAIT_L(8); PG8_BAR; PG8_WAIT_L(0); PG8_MMA(0, 0, At, B0); PG8_BAR; PG8_SCHED;
            PG8_LDB(B1, 1, 1); PG8_STAGE(PG8_SB(1, 0), b3, voffB);
            PG8_BAR; PG8_WAIT_L(0); PG8_MMA(0, 1, At, B1); PG8_BAR;
            PG8_LDA(At, 1, 1); PG8_STAGE(PG8_SA(1, 0), a3, voffA);
            PG8_BAR; PG8_WAIT_L(0); PG8_MMA(1, 0, At, B0); PG8_BAR; PG8_SCHED;
            PG8_STAGE(PG8_SB(1, 1), b3 + hstepB, voffB);
            PG8_WAIT_V(6); PG8_BAR; PG8_MMA(1, 1, At, B1); PG8_BAR;
            }
        }
        if constexpr (ALIGN_EPI) { if (wr == 0) PG8_BAR; }
        asm volatile("s_nop 15\n\ts_nop 15" ::: "memory"); __builtin_amdgcn_sched_barrier(0);
        if constexpr (!Epi::AFTER_DRAIN) { E(acc, cur, wr, wc, fr, fq); S.done(cur); }
        if (!has_next) break;
#pragma unroll
        for (int a = 0; a < 2; ++a)
#pragma unroll
            for (int b = 0; b < 2; ++b)
#pragma unroll
                for (int m = 0; m < 4; ++m)
#pragma unroll
                    for (int n = 0; n < 2; ++n) acc[a][b][m][n] = (f32x4){0.f, 0.f, 0.f, 0.f};
        cur = nxt; cA = nA; cB = nB; ++ui;
        do0 = wr * 64 < S.vrows(cur); do1 = wr * 64 + HALF < S.vrows(cur);
        if constexpr (ALIGN_EPI) { if (wr == 1) PG8_BAR; }
    }
    PG8_WAIT_V(0);
    if constexpr (!ALIGN_EPI) { if (wr == 0) PG8_BAR; }
    PG8_BAR;
    if constexpr (Epi::AFTER_DRAIN) { E.fused(acc, cur, wr, wc, fr, fq, lds, wid, lane); S.done(cur); }
#undef PG8_SA
#undef PG8_SB
#undef PG8_STAGE
#undef PG8_LDA
#undef PG8_LDB
#undef PG8_MMA
#undef PG8_WAIT_V
#undef PG8_WAIT_L
#undef PG8_BAR
#undef PG8_SCHED
}
template <class Epi, class Sched, bool ALIGN_EPI = false, bool SP2 = false>
__device__ __forceinline__ void gemm_phase_g8(PG8_LAS unsigned char* lds, const Gemm g, const Sched& S, const Epi& E, const int* gidx, const int sa, const int sb) {
    int tid_ = g.wv * 64 + lane_id(); asm volatile("" : "+v"(tid_));
    const int tid = tid_, wid = __builtin_amdgcn_readfirstlane(tid >> 6), lane = tid & 63, wr = wid >> 2, wc = wid & 3, fr = lane & 15, fq = lane >> 4;
    const int K = g.K, nt = K / BK;
    unsigned voffA[2], voffB[2];
#pragma unroll
    for (int i = 0; i < 2; ++i) { int R, C; stage_rc(tid * 16 + i * 8192, R, C); const int Rb = Epi::PERM ? ((R & ~31) + perm32(R & 31)) : R;
        voffA[i] = (unsigned)(R * g.lda + C) * 2u; voffB[i] = (unsigned)(Rb * g.ldb + C) * 2u; }
    int RA[2]; unsigned cAo[2];
#pragma unroll
    for (int i = 0; i < 2; ++i) { int R, C; stage_rc(tid * 16 + i * 8192, R, C); RA[i] = R; cAo[i] = (unsigned)C * 2u; }
    unsigned vcur[2][2], vnxt[2][2], vsel[2][2];
#define PG8_GOFF(pm_, dst) do { _Pragma("unroll") for (int h_ = 0; h_ < 2; ++h_) _Pragma("unroll") for (int i_ = 0; i_ < 2; ++i_) dst[h_][i_] = (unsigned)gidx[(pm_) * BM + h_ * HALF + RA[i_]] * (unsigned)(g.lda * 2) + cAo[i_]; } while (0)
    const size_t kstep = (size_t)(BK * 2);
    const size_t hstepA = (size_t)HALF * g.lda * 2, hstepB = (size_t)HALF * g.ldb * 2;
    const size_t tstepA = 2 * hstepA, tstepB = 2 * hstepB;
    const unsigned ldsw = (unsigned)wid * 1024u;
    const int aoff8[2] = {lds_byte(wr * 64 + fr, 16 * fq), lds_byte(wr * 64 + fr, 16 * fq + 8)}, boff8[2] = {lds_byte(wc * 32 + fr, 16 * fq), lds_byte(wc * 32 + fr, 16 * fq + 8)};
#define PG8_SA(b, h) (((b) * 2 + (h)) * HTB)
#define PG8_SB(b, h) ((4 + (b) * 2 + (h)) * HTB)
#define PG8_STAGE(bufoff, gbase, voff) do { _Pragma("unroll") for (int _i = 0; _i < 2; ++_i) \
        __builtin_amdgcn_global_load_lds((const unsigned*)((const char*)(gbase) + (voff)[_i]), (PG8_LAS unsigned*)(lds + (bufoff) + ldsw + _i * 8192), 16, 0, 0); } while (0)
#define PG8_LDA(dst, b, h) do { _Pragma("unroll") for (int m = 0; m < 4; ++m) { const v4i_t lo_ = *(const PG8_LAS v4i_t*)(lds + PG8_SA(b, h) + aoff8[0] + m * 2048), hi_ = *(const PG8_LAS v4i_t*)(lds + PG8_SA(b, h) + aoff8[1] + m * 2048); dst[m] = __builtin_shufflevector(lo_, hi_, 0, 1, 2, 3, 4, 5, 6, 7); } } while (0)
#define PG8_LDB(dst, b, h) do { _Pragma("unroll") for (int n = 0; n < 2; ++n) { const v4i_t lo_ = *(const PG8_LAS v4i_t*)(lds + PG8_SB(b, h) + boff8[0] + n * 2048), hi_ = *(const PG8_LAS v4i_t*)(lds + PG8_SB(b, h) + boff8[1] + n * 2048); dst[n] = __builtin_shufflevector(lo_, hi_, 0, 1, 2, 3, 4, 5, 6, 7); } } while (0)
#define PG8_MMA(ai, bj, At, Bt) do { if ((ai) ? do1 : do0) { __builtin_amdgcn_s_setprio(1); _Pragma("unroll") for (int m = 0; m < 4; ++m) _Pragma("unroll") for (int n = 0; n < 2; ++n) \
        asm volatile("v_mfma_scale_f32_16x16x128_f8f6f4 %0, %1, %2, %0, %3, %4 op_sel_hi:[0,0,0]" : "+v"(acc[ai][bj][m][n]) : "v"(Bt[n]), "v"(At[m]), "v"(sa), "v"(sb)); __builtin_amdgcn_s_setprio(0); } } while (0)
#define PG8_WAIT_V(n) asm volatile("s_waitcnt vmcnt(" #n ")" ::: "memory")
#define PG8_WAIT_L(n) asm volatile("s_waitcnt lgkmcnt(" #n ")" ::: "memory")
#define PG8_BAR __builtin_amdgcn_s_barrier()
#define PG8_SCHED __builtin_amdgcn_sched_barrier(0)
    Unit cur, nxt; int ui = 0;
    if (!S.next(0, cur)) return;
    bool do0 = wr * 64 < S.vrows(cur), do1 = wr * 64 + HALF < S.vrows(cur);
    f32x4 acc[2][2][4][2];
#pragma unroll
    for (int a = 0; a < 2; ++a)
#pragma unroll
        for (int b = 0; b < 2; ++b)
#pragma unroll
            for (int m = 0; m < 4; ++m)
#pragma unroll
                for (int n = 0; n < 2; ++n) acc[a][b][m][n] = (f32x4){0.f, 0.f, 0.f, 0.f};
    v8i_t At[4], B0[2], B1[2];
    const char* cA = (const char*)g.A; PG8_GOFF(cur.pm, vcur); const char* cB = (const char*)g.Bt + (size_t)cur.pn * tstepB;
    S.a_ready(cur);
    if constexpr (SP2) {
        PG8_STAGE(PG8_SB(0, 0), cB, voffB); PG8_STAGE(PG8_SB(0, 1), cB + hstepB, voffB); PG8_STAGE(PG8_SA(0, 0), cA, vcur[0]); PG8_STAGE(PG8_SA(0, 1), cA, vcur[1]);
        if (wr == 1) PG8_BAR;
        PG8_WAIT_V(2); PG8_BAR;
        PG8_STAGE(PG8_SB(1, 0), cB + kstep, voffB); PG8_STAGE(PG8_SA(1, 0), cA + kstep, vcur[0]); PG8_STAGE(PG8_SB(1, 1), cB + hstepB + kstep, voffB);
        PG8_WAIT_V(6); PG8_BAR;
    } else {
        PG8_STAGE(PG8_SB(0, 0), cB, voffB); PG8_STAGE(PG8_SA(0, 0), cA, vcur[0]); PG8_STAGE(PG8_SB(0, 1), cB + hstepB, voffB); PG8_STAGE(PG8_SA(0, 1), cA, vcur[1]);
        if (wr == 1) PG8_BAR;
        PG8_WAIT_V(4); PG8_BAR;
        PG8_STAGE(PG8_SB(1, 0), cB + kstep, voffB); PG8_STAGE(PG8_SA(1, 0), cA + kstep, vcur[0]); PG8_STAGE(PG8_SB(1, 1), cB + hstepB + kstep, voffB);
        PG8_WAIT_V(6); PG8_BAR;
    }
    for (;;) {
        const bool has_next = S.next(ui + 1, nxt);
        const char* nA = cA; if (has_next) PG8_GOFF(nxt.pm, vnxt); else { _Pragma("unroll") for (int h_ = 0; h_ < 2; ++h_) _Pragma("unroll") for (int i_ = 0; i_ < 2; ++i_) vnxt[h_][i_] = vcur[h_][i_]; } const char* nB = has_next ? (const char*)g.Bt + (size_t)nxt.pn * tstepB : cB;
        for (int t = 0; t < nt; t += 2) {
            const bool last = (t == nt - 2);
            _Pragma("unroll") for (int h_ = 0; h_ < 2; ++h_) _Pragma("unroll") for (int i_ = 0; i_ < 2; ++i_) vsel[h_][i_] = last ? vnxt[h_][i_] : vcur[h_][i_];
            const char* a1 = cA + (size_t)(t + 1) * kstep;
            const char* a2 = last ? nA : cA + (size_t)(t + 2) * kstep; const char* b2 = last ? nB : cB + (size_t)(t + 2) * kstep;
            const char* a3 = a2 + kstep; const char* b3 = b2 + kstep;
            if (last && has_next) S.a_ready(nxt);
            if constexpr (SP2) {
            PG8_LDB(B0, 0, 0); PG8_LDB(B1, 0, 1); PG8_SCHED; PG8_LDA(At, 0, 0); PG8_STAGE(PG8_SA(1, 1), a1, vcur[1]);
            PG8_WAIT_V(8); PG8_WAIT_L(0); PG8_BAR; PG8_MMA(0, 0, At, B0); PG8_MMA(0, 1, At, B1); PG8_BAR; PG8_SCHED;
            PG8_LDA(At, 0, 1); PG8_STAGE(PG8_SB(0, 0), b2, voffB); PG8_STAGE(PG8_SB(0, 1), b2 + hstepB, voffB); PG8_STAGE(PG8_SA(0, 0), a2, vsel[0]);
            PG8_WAIT_V(8); PG8_WAIT_L(0); PG8_BAR; PG8_MMA(1, 0, At, B0); PG8_MMA(1, 1, At, B1); PG8_BAR; PG8_SCHED;
            PG8_LDB(B0, 1, 0); PG8_LDB(B1, 1, 1); PG8_SCHED; PG8_LDA(At, 1, 0); PG8_STAGE(PG8_SA(0, 1), a2, vsel[1]);
            PG8_WAIT_V(8); PG8_WAIT_L(0); PG8_BAR; PG8_MMA(0, 0, At, B0); PG8_MMA(0, 1, At, B1); PG8_BAR; PG8_SCHED;
            PG8_LDA(At, 1, 1); PG8_STAGE(PG8_SB(1, 0), b3, voffB); PG8_STAGE(PG8_SB(1, 1), b3 + hstepB, voffB); PG8_STAGE(PG8_SA(1, 0), a3, vsel[0]);
            PG8_WAIT_V(8); PG8_WAIT_L(0); PG8_BAR; PG8_MMA(1, 0, At, B0); PG8_MMA(1, 1, At, B1); PG8_BAR; PG8_SCHED;
            } else {
            PG8_LDB(B0, 0, 0); PG8_SCHED; PG8_LDA(At, 0, 0); PG8_STAGE(PG8_SA(1, 1), a1, vcur[1]);
            PG8_WAIT_L(8); PG8_BAR; PG8_WAIT_L(0); PG8_MMA(0, 0, At, B0); PG8_BAR; PG8_SCHED;
            PG8_LDB(B1, 0, 1); PG8_STAGE(PG8_SB(0, 0), b2, voffB);
            PG8_BAR; PG8_WAIT_L(0); PG8_MMA(0, 1, At, B1); PG8_BAR;
            PG8_LDA(At, 0, 1); PG8_STAGE(PG8_SA(0, 0), a2, vsel[0]);
            PG8_BAR; PG8_WAIT_L(0); PG8_MMA(1, 0, At, B0); PG8_BAR; PG8_SCHED;
            PG8_STAGE(PG8_SB(0, 1), b2 + hstepB, voffB);
            PG8_WAIT_V(6); PG8_BAR; PG8_MMA(1, 1, At, B1); PG8_BAR;
            PG8_LDB(B0, 1, 0); PG8_SCHED; PG8_LDA(At, 1, 0); PG8_STAGE(PG8_SA(0, 1), a2, vsel[1]);
            PG8_WAIT_L(8); PG8_BAR; PG8_WAIT_L(0); PG8_MMA(0, 0, At, B0); PG8_BAR; PG8_SCHED;
            PG8_LDB(B1, 1, 1); PG8_STAGE(PG8_SB(1, 0), b3, voffB);
            PG8_BAR; PG8_WAIT_L(0); PG8_MMA(0, 1, At, B1); PG8_BAR;
            PG8_LDA(At, 1, 1); PG8_STAGE(PG8_SA(1, 0), a3, vsel[0]);
            PG8_BAR; PG8_WAIT_L(0); PG8_MMA(1, 0, At, B0); PG8_BAR; PG8_SCHED;
            PG8_STAGE(PG8_SB(1, 1), b3 + hstepB, voffB);
            PG8_WAIT_V(6); PG8_BAR; PG8_MMA(1, 1, At, B1); PG8_BAR;
            }
        }
        if constexpr (ALIGN_EPI) { if (wr == 0) PG8_BAR; }
        asm volatile("s_nop 15\n\ts_nop 15" ::: "memory"); __builtin_amdgcn_sched_barrier(0);
        if constexpr (!Epi::AFTER_DRAIN) { E(acc, cur, wr, wc, fr, fq); S.done(cur); }
        if (!has_next) break;
#pragma unroll
        for (int a = 0; a < 2; ++a)
#pragma unroll
            for (int b = 0; b < 2; ++b)
#pragma unroll
                for (int m = 0; m < 4; ++m)
#pragma unroll
                    for (int n = 0; n < 2; ++n) acc[a][b][m][n] = (f32x4){0.f, 0.f, 0.f, 0.f};
        cur = nxt; cA = nA; cB = nB; ++ui; _Pragma("unroll") for (int h_ = 0; h_ < 2; ++h_) _Pragma("unroll") for (int i_ = 0; i_ < 2; ++i_) vcur[h_][i_] = vnxt[h_][i_];
        do0 = wr * 64 < S.vrows(cur); do1 = wr * 64 + HALF < S.vrows(cur);
        if constexpr (ALIGN_EPI) { if (wr == 1) PG8_BAR; }
    }
    PG8_WAIT_V(0);
    if constexpr (!ALIGN_EPI) { if (wr == 0) PG8_BAR; }
    PG8_BAR;
    if constexpr (Epi::AFTER_DRAIN) { E.fused(acc, cur, wr, wc, fr, fq, lds, wid, lane); S.done(cur); }
#undef PG8_GOFF
#undef PG8_SA
#undef PG8_SB
#undef PG8_STAGE
#undef PG8_LDA
#undef PG8_LDB
#undef PG8_MMA
#undef PG8_WAIT_V
#undef PG8_WAIT_L
#undef PG8_BAR
#undef PG8_SCHED
}
#undef PG8_CAT
}
#ifndef PG8_SP2
#define PG8_SP2 true
#endif
#ifndef PG8_ALIGN
#define PG8_ALIGN true
#endif
constexpr int NB = 2, SEQ = 8192, DM = 1024, LCTX = 256, DEPTH = 2;
constexpr int NX = NB * SEQ, NC = NB * LCTX, NR = NX + NC;
constexpr int INW = 1536, NE = 16, FF = 2048, CAPX = 1024, CAPC = 32;
constexpr int SLOTS_E = 2304, NSLOT = NE * SLOTS_E;
constexpr float LN_EPS = 1e-5f, ALPHA = 1.41421356237309515f;
constexpr int NWAVES = 8, NTHREADS = 512;
constexpr int RING_BYTES = 131072, LDS_BYTES = 147456;

constexpr size_t MiB = 1u << 20, KiB = 1u << 10;
constexpr size_t WS_MOD = 1 * MiB;
constexpr size_t WS_ROPE = 1 * MiB + 160 * KiB;
constexpr size_t WS_LBAR = 1 * MiB + 192 * KiB;
constexpr size_t WS_BBAR = 1 * MiB + 256 * KiB;
constexpr size_t WS_BINP = 1 * MiB + 768 * KiB;
constexpr size_t WS_AFF = 2 * MiB;
constexpr size_t WS_AFFC = 3 * MiB;
constexpr size_t WS_IDX = 3 * MiB + 64 * KiB;
constexpr size_t WS_GATE = 3 * MiB + 256 * KiB;
constexpr size_t WS_TOKSLOT = 4 * MiB;
constexpr size_t WS_WIN = 6 * MiB;
constexpr size_t WS_WOUT = 12 * MiB;
constexpr size_t WS_WGU = 16 * MiB;
constexpr size_t WS_WD = 272 * MiB;
constexpr size_t WS_HX = 400 * MiB;
constexpr size_t WS_Q = 433 * MiB;
constexpr size_t WS_K = 450 * MiB;
constexpr size_t WS_V = 455 * MiB;
constexpr size_t WS_U = 460 * MiB;
constexpr size_t WS_HG = 477 * MiB;
constexpr size_t WS_YF = 494 * MiB;
constexpr size_t WS_YB = 511 * MiB;
constexpr size_t WS_CAT = 528 * MiB;
constexpr size_t WS_YMIX = 561 * MiB;
constexpr size_t WS_XS = 528 * MiB;
constexpr size_t WS_XMID = 627 * MiB;
constexpr size_t WS_XCUR = 693 * MiB;
constexpr size_t WS_HID = 759 * MiB;
constexpr size_t WS_PX = 759 * MiB;
constexpr size_t WS_YEXP = 903 * MiB;
constexpr size_t WS_END = 975 * MiB;

#define LAS __attribute__((address_space(3)))
typedef unsigned short bf16;
typedef unsigned v4u __attribute__((ext_vector_type(4)));
typedef unsigned v2u __attribute__((ext_vector_type(2)));
typedef float f32x4 __attribute__((ext_vector_type(4)));
#define LDS_WAIT() asm volatile("s_waitcnt lgkmcnt(0)" ::: "memory")
__device__ __forceinline__ unsigned f2bf(float f) { unsigned u = __builtin_bit_cast(unsigned, f); return (u + 0x7fffu + ((u >> 16) & 1u)) >> 16; }
__device__ __forceinline__ unsigned pk2(float lo, float hi) { return f2bf(lo) | (f2bf(hi) << 16); }
__device__ __forceinline__ float bflo(unsigned w) { return __builtin_bit_cast(float, w << 16); }
__device__ __forceinline__ float bfhi(unsigned w) { return __builtin_bit_cast(float, w & 0xffff0000u); }
__device__ __forceinline__ float bf2f(bf16 b) { return __builtin_bit_cast(float, ((unsigned)b) << 16); }
template <int CTRL> __device__ __forceinline__ float dppf(float x) { return __builtin_bit_cast(float, __builtin_amdgcn_update_dpp(0, __builtin_bit_cast(int, x), CTRL, 0xf, 0xf, true)); }
template <int CTRL> __device__ __forceinline__ int dppi(int x) { return __builtin_amdgcn_update_dpp(0, x, CTRL, 0xf, 0xf, true); }
constexpr int DPP_X1 = 0xB1, DPP_X2 = 0x4E, DPP_HM = 0x141, DPP_RM = 0x140;
__device__ __forceinline__ void swap16(float& a, float& b) { asm("s_nop 1\n\tv_permlane16_swap_b32 %0, %1" : "+v"(a), "+v"(b)); }
__device__ __forceinline__ void swap32(float& a, float& b) { asm("s_nop 1\n\tv_permlane32_swap_b32 %0, %1" : "+v"(a), "+v"(b)); }
__device__ __forceinline__ float xrow_sum(float v) { { float a = v, b = v; swap16(a, b); v = a + b; } { float a = v, b = v; swap32(a, b); v = a + b; } return v; }
__device__ __forceinline__ float row_sum16(float v) { v += dppf<DPP_X1>(v); v += dppf<DPP_X2>(v); v += dppf<DPP_HM>(v); v += dppf<DPP_RM>(v); return v; }
__device__ __forceinline__ float row_max16(float v) { v = fmaxf(v, dppf<DPP_X1>(v)); v = fmaxf(v, dppf<DPP_X2>(v)); v = fmaxf(v, dppf<DPP_HM>(v)); v = fmaxf(v, dppf<DPP_RM>(v)); return v; }
__device__ __forceinline__ float wave_sum(float v) { return xrow_sum(row_sum16(v)); }
__device__ __forceinline__ float wave_max(float v) { v = row_max16(v); { float a = v, b = v; swap16(a, b); v = fmaxf(a, b); } { float a = v, b = v; swap32(a, b); v = fmaxf(a, b); } return v; }
__device__ __forceinline__ int wave_sum_i(int v) {
    v += dppi<DPP_X1>(v); v += dppi<DPP_X2>(v); v += dppi<DPP_HM>(v); v += dppi<DPP_RM>(v);
    float f = __builtin_bit_cast(float, v);
    { float a = f, b = f; swap16(a, b); v = __builtin_bit_cast(int, a) + __builtin_bit_cast(int, b); f = __builtin_bit_cast(float, v); }
    { float a = f, b = f; swap32(a, b); v = __builtin_bit_cast(int, a) + __builtin_bit_cast(int, b); }
    return v;
}
__device__ __forceinline__ float sigmoid_f(float x) { return 1.f / (1.f + __expf(-x)); }
__device__ __forceinline__ float silu_f(float x) { return x / (1.f + __expf(-x)); }
__device__ __forceinline__ float gelu_tanh_f(float x) { const float u = 0.7978845608028654f * (x + 0.044715f * x * x * x); return 0.5f * x * (1.f + tanhf(u)); }

struct Args { const float* in[35]; float* out; unsigned char* ws; int ph_lo, ph_hi, G, pad; };
typedef const __attribute__((address_space(4))) Args* KArgs;
__device__ __forceinline__ KArgs kargs() { unsigned long long p = (unsigned long long)__builtin_amdgcn_kernarg_segment_ptr(); asm volatile("" : "+s"(p)); return (KArgs)p; }

__device__ __forceinline__ unsigned char* launder_ws(unsigned char* p) { unsigned long long v = (unsigned long long)p; asm volatile("" : "+s"(v)); return (unsigned char*)v; }
template <class T> __device__ __forceinline__ T* opq(T* p) { unsigned long long v = (unsigned long long)p; asm volatile("" : "+s"(v)); return (T*)v; }
struct Frame {
    LAS unsigned char* lds;
    int tid, lane, wave, bid, G, gw, NGW;
    unsigned char* ws;
};

__device__ __forceinline__ void s5_build_ops(Frame& F, unsigned char* ws_, KArgs ka, int l, int g);
constexpr size_t WS_WPT_FWD = 5 * MiB + 512 * KiB;
constexpr size_t WS_CTR = 16 * KiB;
__device__ __forceinline__ int maprow(int type, int n0) {
    if (type == 1) return 256 * (n0 >> 7) + (n0 & 127);
    if (type == 2) return 256 * (n0 >> 7) + 128 + (n0 & 127);
    if (type == 3) { if (n0 < 1024) return n0; if (n0 < 1280) { const int ch = n0 - 1024; return 1024 + 256 * (ch >> 7) + (ch & 127); } const int ch = n0 - 1280; return 1024 + 256 * (ch >> 7) + 128 + (ch & 127); }
    return n0;
}
struct TItem { const float* src; unsigned char* dst; int N, rowbytes, f8; float scale; };
__device__ __forceinline__ float sat_e4m3(float x) { return __builtin_amdgcn_fmed3f(x, -448.f, 448.f); }
__device__ __forceinline__ unsigned pack4_fp8(float a, float b, float c, float d) { int w = __builtin_amdgcn_cvt_pk_fp8_f32(sat_e4m3(a), sat_e4m3(b), 0, false); w = __builtin_amdgcn_cvt_pk_fp8_f32(sat_e4m3(c), sat_e4m3(d), w, true); return (unsigned)w; }
__device__ __forceinline__ TItem titem(const float* W, int K, int N, void* WT, int type, int item, int lane, int f8 = 0, float scale = 1.f) {
    const int nblk = N / 32, kb = item / nblk, nb = item % nblk, k0 = 64 * kb, n0 = 32 * nb;
    TItem t; t.src = W + (size_t)(k0 + (lane >> 5)) * N + n0 + (lane & 31); t.N = N; t.f8 = f8; t.scale = scale;
    t.rowbytes = f8 ? K : 2 * K; t.dst = (unsigned char*)WT + (size_t)maprow(type, n0) * t.rowbytes + (f8 ? k0 : 2 * k0); return t;
}
__device__ __forceinline__ void titem_load(const TItem& t, float (&tmp)[32]) {
#pragma unroll
    for (int i = 0; i < 32; ++i) tmp[i] = __builtin_nontemporal_load(t.src + (size_t)(2 * i) * t.N);
}
__device__ __forceinline__ void titem_finish(const TItem& t, const float (&tmp)[32], LAS float* scr, int lane) {
#pragma unroll
    for (int i = 0; i < 32; ++i) scr[(2 * i + (lane >> 5)) * 33 + (lane & 31)] = tmp[i];
    LDS_WAIT(); asm volatile("" ::: "memory");
    const int c = lane & 7;
#pragma unroll
    for (int j = 0; j < 4; ++j) { const int n = (lane >> 3) + 8 * j; const LAS float* s = scr + (8 * c) * 33 + n;
        if (t.f8) { const float sc = t.scale; v2u o; o.x = pack4_fp8(s[0 * 33] * sc, s[1 * 33] * sc, s[2 * 33] * sc, s[3 * 33] * sc); o.y = pack4_fp8(s[4 * 33] * sc, s[5 * 33] * sc, s[6 * 33] * sc, s[7 * 33] * sc);
            *(v2u*)(t.dst + (size_t)n * t.rowbytes + 8 * c) = o; }
        else { v4u o; o.x = pk2(s[0 * 33], s[1 * 33]); o.y = pk2(s[2 * 33], s[3 * 33]); o.z = pk2(s[4 * 33], s[5 * 33]); o.w = pk2(s[6 * 33], s[7 * 33]);
            *(v4u*)(t.dst + (size_t)n * t.rowbytes + 16 * c) = o; } }
    LDS_WAIT(); asm volatile("" ::: "memory");
}
__device__ __forceinline__ void ph_prologue(Frame& F) {
    unsigned char* const ws_ = launder_ws(F.ws);
    KArgs ka = kargs();
    const float* c_in = ka->in[1]; const float* cctx = ka->in[3]; const float* w_mod = ka->in[4]; const float* b_mod = ka->in[5];
    for (int u = F.bid; u < 2 * 96; u += F.G) {
        const int l = u / 96, cc = u % 96;
        LAS float* sv = (LAS float*)F.lds;
        LAS float* part = sv + 3072;
        for (int i = F.tid; i < 3072; i += NTHREADS) { const int v = i >> 10, k = i & 1023; const float x = (v < 2) ? c_in[v * 1024 + k] : cctx[k]; sv[i] = silu_f(x); }
        __syncthreads();
        float a0 = 0.f, a1 = 0.f, a2 = 0.f;
        const float* wp = w_mod + (size_t)l * 1024 * 6144 + cc * 64 + F.lane;
#pragma nounroll
        for (int k0 = 0; k0 < 128; k0 += 32) { float wv[32];
#pragma unroll
            for (int q = 0; q < 32; ++q) wv[q] = __builtin_nontemporal_load(wp + (size_t)(F.wave * 128 + k0 + q) * 6144);
#pragma unroll
            for (int q = 0; q < 32; ++q) { const int k = F.wave * 128 + k0 + q; a0 += sv[k] * wv[q]; a1 += sv[1024 + k] * wv[q]; a2 += sv[2048 + k] * wv[q]; } }
        part[(F.wave * 3 + 0) * 64 + F.lane] = a0; part[(F.wave * 3 + 1) * 64 + F.lane] = a1; part[(F.wave * 3 + 2) * 64 + F.lane] = a2;
        __syncthreads();
        if (F.tid < 192) { const int v = F.tid >> 6, j = F.tid & 63; float s = b_mod[l * 6144 + cc * 64 + j];
#pragma unroll
            for (int w = 0; w < 8; ++w) s += part[(w * 3 + v) * 64 + j];
            ((float*)(ws_ + WS_MOD))[(l * 3 + v) * 6144 + cc * 64 + j] = s; }
        __syncthreads();
    }
    if (F.bid >= 192 && F.bid < 224) { const int u = F.bid - 192; s5_build_ops(F, ws_, ka, u >> 4, u & 15); }
    const int gid = F.bid * NTHREADS + F.tid;
    if (gid < 2048) { const int pos = gid >> 4, i = gid & 15; const double ang = (double)pos * pow(10000.0, -(double)i / 16.0);
        float* rp = (float*)(ws_ + WS_ROPE) + gid * 2; rp[0] = (float)cos(ang); rp[1] = (float)sin(ang); }
    if (gid >= 4096 && gid < 4096 + 3072) { const int i = gid - 4096, l = i / 1536, n = i % 1536; ((float*)(ws_ + WS_BINP))[l * 1536 + maprow(3, n & ~31) + (n & 31)] = ka->in[7][l * 1536 + n]; }
    {
        LAS float* scr = (LAS float*)(F.lds + F.wave * 16384);
        constexpr int S_IN = 16 * 48, S_OUT = 16 * 32, S_PW = 2 * 32, PER_S = S_IN + S_OUT + S_PW;
        for (int it = F.gw; it < 2 * PER_S; it += F.NGW) { const int l_ = it / PER_S; int r_ = it % PER_S; TItem T;
            if (r_ < S_IN) T = titem(ka->in[6] + (size_t)l_ * 1024 * 1536, 1024, 1536, (bf16*)(ws_ + WS_WIN) + (size_t)l_ * 1536 * 1024, 3, r_, F.lane);
            else if ((r_ -= S_IN) < S_OUT) T = titem(ka->in[25] + (size_t)l_ * 1024 * 1024, 1024, 1024, (bf16*)(ws_ + WS_WOUT) + (size_t)l_ * 1024 * 1024, 0, r_, F.lane);
            else { r_ -= S_OUT; const int w_ = r_ >> 5; T = titem(ka->in[w_ ? 23 : 17] + (size_t)l_ * 65536, 256, 256, (bf16*)(ws_ + WS_WPT_FWD) + (size_t)(l_ * 2 + w_) * 65536, 0, r_ & 31, F.lane); }
            float tc[32]; titem_load(T, tc); titem_finish(T, tc, scr, F.lane); }
    }
    __syncthreads();
    {
        LAS float* T = (LAS float*)F.lds;
        LAS unsigned* bc = (LAS unsigned*)(F.lds + 128 * 260 * 4);
        unsigned* ctr = (unsigned*)(ws_ + WS_CTR);
        constexpr int TPM = 64, TPE = 3 * TPM, NT_ALL = 2 * NE * TPE;
        const int lk = F.tid >> 6, ln4 = F.tid & 63;
        const int sn = F.tid >> 1, sq = F.tid & 1;
        struct Tl { const float* src; unsigned char* dst; int N, K; float sc; };
#define TILE_DECODE(t, X) do { const int le_ = (t) / TPE, r_ = (t) % TPE, which_ = r_ / TPM, ti_ = r_ % TPM; \
            if (which_ < 2) { const int kb_ = ti_ >> 3, nb_ = ti_ & 7; X.N = 2048; X.K = 1024; X.sc = 32.f; \
                X.src = ka->in[30 + which_] + (size_t)le_ * 1024 * 2048 + (size_t)(128 * kb_) * 2048 + 256 * nb_; \
                X.dst = ws_ + WS_WGU + (size_t)le_ * 4096 * 1024 + (size_t)(512 * nb_ + 128 * which_) * 1024 + 128 * kb_; } \
            else { const int kb_ = ti_ >> 2, nb_ = ti_ & 3; X.N = 1024; X.K = 2048; X.sc = 64.f; \
                X.src = ka->in[32] + (size_t)le_ * 2048 * 1024 + (size_t)(128 * kb_) * 1024 + 256 * nb_; \
                X.dst = ws_ + WS_WD + (size_t)le_ * 1024 * 2048 + (size_t)(256 * nb_) * 2048 + 128 * kb_; } } while (0)
#define TILE_LOAD(X, R) do { _Pragma("unroll") for (int i = 0; i < 16; ++i) R[i] = __builtin_nontemporal_load((const f32x4*)(X.src + (size_t)(lk + 8 * i) * X.N + 4 * ln4)); } while (0)
#define TILE_DRAW(t) do { __syncthreads(); if (F.tid == 0) bc[0] = __hip_atomic_fetch_add(ctr, 1u, __ATOMIC_RELAXED, __HIP_MEMORY_SCOPE_AGENT); __syncthreads(); t = (int)bc[0]; } while (0)
        int tcur, tnxt; Tl cur, nxt; f32x4 rc[16], rn[16];
        TILE_DRAW(tcur);
        if (tcur < NT_ALL) { TILE_DECODE(tcur, cur); TILE_LOAD(cur, rc);
            for (;;) {
                TILE_DRAW(tnxt);
                const bool has = tnxt < NT_ALL;
                if (has) { TILE_DECODE(tnxt, nxt); TILE_LOAD(nxt, rn); }
#pragma unroll
                for (int i = 0; i < 16; ++i) *(LAS f32x4*)(T + (lk + 8 * i) * 260 + 4 * ln4) = rc[i];
                __syncthreads();
                { const float sc = cur.sc; const LAS float* s = T + (64 * sq) * 260 + sn;
                    const int rowoff = (cur.K == 1024) ? (256 * (sn >> 7) + (sn & 127)) : sn;
                    unsigned char* o = cur.dst + (size_t)rowoff * cur.K + 64 * sq;
#pragma unroll
                    for (int q = 0; q < 4; ++q) { unsigned w[4];
#pragma unroll
                        for (int j = 0; j < 4; ++j) { const int k_ = 16 * q + 4 * j; w[j] = pack4_fp8(s[k_ * 260] * sc, s[(k_ + 1) * 260] * sc, s[(k_ + 2) * 260] * sc, s[(k_ + 3) * 260] * sc); }
                        *(v4u*)(o + 16 * q) = (v4u){w[0], w[1], w[2], w[3]}; } }
                if (!has) break;
                cur = nxt;
#pragma unroll
                for (int i = 0; i < 16; ++i) rc[i] = rn[i];
            } }
#undef TILE_DRAW
#undef TILE_LOAD
#undef TILE_DECODE
    }
}

__device__ __forceinline__ void row_load(const float* p, int lane, f32x4 (&v)[4]) {
#pragma unroll
    for (int j = 0; j < 4; ++j) v[j] = ((const f32x4*)p)[lane + 64 * j];
}
__device__ __forceinline__ void row_ln(f32x4 (&v)[4]) {
    float s = 0.f;
#pragma unroll
    for (int j = 0; j < 4; ++j) s += (v[j].x + v[j].y) + (v[j].z + v[j].w);
    const float mean = wave_sum(s) * (1.f / 1024.f); float s2 = 0.f;
#pragma unroll
    for (int j = 0; j < 4; ++j) { v[j] = v[j] - mean; s2 += (v[j].x * v[j].x + v[j].y * v[j].y) + (v[j].z * v[j].z + v[j].w * v[j].w); }
    const float rstd = 1.f / sqrtf(wave_sum(s2) * (1.f / 1024.f) + LN_EPS);
#pragma unroll
    for (int j = 0; j < 4; ++j) v[j] = v[j] * rstd;
}
__device__ __forceinline__ void row_store_bf16(bf16* p, int lane, const f32x4 (&v)[4]) {
#pragma unroll
    for (int j = 0; j < 4; ++j) { v2u o; o.x = pk2(v[j].x, v[j].y); o.y = pk2(v[j].z, v[j].w); ((v2u*)p)[lane + 64 * j] = o; }
}
__device__ __forceinline__ int row_mod_index(int r) { return r < NX ? (r >> 13) : 2; }
__device__ __forceinline__ void modulate_store(f32x4 (&v)[4], const float* shift, const float* scale, bf16* dst, int lane) {
    f32x4 o[4];
#pragma unroll
    for (int j = 0; j < 4; ++j) { const f32x4 sh = ((const f32x4*)shift)[lane + 64 * j], sc = ((const f32x4*)scale)[lane + 64 * j]; o[j] = v[j] * (sc + 1.f) + sh; }
    row_store_bf16(dst, lane, o);
}
__device__ __forceinline__ void ph_rows0(Frame& F) {
    unsigned char* const ws_ = launder_ws(F.ws);
    KArgs ka = kargs();
    const float* MOD = (const float*)(ws_ + WS_MOD); bf16* HX = (bf16*)(ws_ + WS_HX);
    for (int r = F.gw; r < NR; r += F.NGW) {
        const float* src = r < NX ? ka->in[0] + (size_t)r * 1024 : ka->in[2] + (size_t)(r - NX) * 1024;
        f32x4 v[4]; row_load(src, F.lane, v); row_ln(v);
        const float* m = MOD + (0 * 3 + row_mod_index(r)) * 6144;
        modulate_store(v, m, m + 1024, HX + (size_t)r * 1024, F.lane);
    }
}
constexpr int S5T = 32, S5R = 768, S5K = 768;
constexpr size_t WS_HCTX = 1 * MiB + 800 * KiB;
constexpr size_t WS_LB32 = 1 * MiB + 832 * KiB;
constexpr size_t WS_KT = 975 * MiB;
constexpr size_t WS_BE = 999 * MiB;
constexpr size_t WS_UC = 494 * MiB;
constexpr size_t WS_E = 512 * MiB;
constexpr size_t WS_Z = WS_HID + 100 * MiB;
constexpr size_t WS_CN = WS_Z + (size_t)NR * 256 * 2;
constexpr size_t WS_END2 = 1019 * MiB;

__device__ __forceinline__ void s5_build_ops(Frame& F, unsigned char* ws_, KArgs ka, int l, int g) {
    LAS float* PW = (LAS float*)F.lds; LAS float* CM = PW + 8448; LAS float* BB = CM + 4096; LAS float* LAG = BB + 4096;
    __syncthreads();
    if (F.tid < 128) {
        const int d = F.tid >> 6, p = F.tid & 63; const int ldg = (l * 2 + d) * 16 + g;
        const double lr = ka->in[9][ldg * 64 + p], li = ka->in[10][ldg * 64 + p], dt = exp((double)ka->in[11][ldg]);
        const double zr = lr * dt, zi = li * dt, er = exp(zr), lbr = er * cos(zi), lbi = er * sin(zi);
        double pr = 1.0, pi = 0.0;
#pragma nounroll
        for (int tau = 0; tau <= 32; ++tau) { PW[((d * 33 + tau) * 64 + p) * 2] = (float)pr; PW[((d * 33 + tau) * 64 + p) * 2 + 1] = (float)pi; const double t = pr * lbr - pi * lbi; pi = pr * lbi + pi * lbr; pr = t; }
        const double nr = lbr - 1.0, ni = lbi, den = lr * lr + li * li, cr = (nr * lr + ni * li) / den, ci = (ni * lr - nr * li) / den;
        const float* bre = ka->in[12] + ((size_t)ldg * 64 + p) * 16; const float* bim = ka->in[13] + ((size_t)ldg * 64 + p) * 16;
        for (int c = 0; c < 16; ++c) { const double br = bre[c], bi = bim[c]; BB[((d * 64 + p) * 16 + c) * 2] = (float)(cr * br - ci * bi); BB[((d * 64 + p) * 16 + c) * 2 + 1] = (float)(cr * bi + ci * br); } }
    for (int i = F.tid; i < 2 * 16 * 64; i += NTHREADS) { const int d = i >> 10, r = i & 1023; const int ldg = (l * 2 + d) * 16 + g; CM[2 * i] = ka->in[14][(size_t)ldg * 1024 + r]; CM[2 * i + 1] = ka->in[15][(size_t)ldg * 1024 + r]; }
    __syncthreads();
    for (int it = F.tid; it < 2 * 32 * 16; it += NTHREADS) { const int d = it >> 9, tau = (it >> 4) & 31, c = it & 15;
        float acc[16];
#pragma unroll
        for (int q = 0; q < 16; ++q) acc[q] = 0.f;
        for (int p = 0; p < 64; ++p) { const float cr = CM[((d * 16 + c) * 64 + p) * 2], ci = CM[((d * 16 + c) * 64 + p) * 2 + 1], pr = PW[((d * 33 + tau) * 64 + p) * 2], pi = PW[((d * 33 + tau) * 64 + p) * 2 + 1];
            const float wr = cr * pr - ci * pi, wi = cr * pi + ci * pr;
#pragma unroll
            for (int q = 0; q < 16; ++q) acc[q] += wr * BB[((d * 64 + p) * 16 + q) * 2] - wi * BB[((d * 64 + p) * 16 + q) * 2 + 1]; }
#pragma unroll
        for (int q = 0; q < 16; ++q) LAG[((d * 32 + tau) * 16 + c) * 16 + q] = acc[q]; }
    __syncthreads();
    const float* dsk = ka->in[16] + l * 256 + g * 16;
    bf16* KT = (bf16*)(ws_ + WS_KT) + ((size_t)(l * 16 + g) * 512) * S5K;
    for (int pc = F.tid; pc < 512 * 96; pc += NTHREADS) { const int row = pc / 96, q8 = pc % 96, j = row >> 4, c = row & 15; float v[8];
        if (q8 < 64) { const int jp = q8 >> 1, c0 = (q8 & 1) * 8;
#pragma unroll
            for (int e = 0; e < 8; ++e) { float x = 0.f; if (j >= jp) x += LAG[((0 * 32 + (j - jp)) * 16 + c) * 16 + c0 + e]; if (j <= jp) x += LAG[((1 * 32 + (jp - j)) * 16 + c) * 16 + c0 + e]; if (j == jp && c == c0 + e) x += dsk[c]; v[e] = x; } }
        else { const int n0 = (q8 - 64) * 8, d = n0 >> 7, tau = d ? (32 - j) : (j + 1);
#pragma unroll
            for (int e = 0; e < 8; e += 2) { const int p = ((n0 & 127) + e) >> 1; const float cr = CM[((d * 16 + c) * 64 + p) * 2], ci = CM[((d * 16 + c) * 64 + p) * 2 + 1], pr = PW[((d * 33 + tau) * 64 + p) * 2], pi = PW[((d * 33 + tau) * 64 + p) * 2 + 1];
                v[e] = cr * pr - ci * pi; v[e + 1] = -(cr * pi + ci * pr); } }
        v4u o; o.x = pk2(v[0], v[1]); o.y = pk2(v[2], v[3]); o.z = pk2(v[4], v[5]); o.w = pk2(v[6], v[7]);
        *(v4u*)(KT + (size_t)row * S5K + q8 * 8) = o; }
    bf16* BE = (bf16*)(ws_ + WS_BE) + ((size_t)(l * 16 + g) * 256) * 512;
    for (int pc = F.tid; pc < 256 * 64; pc += NTHREADS) { const int n = pc >> 6, q8 = pc & 63, d = n >> 7, p = (n & 127) >> 1, ri = n & 1, jp = q8 >> 1, c0 = (q8 & 1) * 8, tau = d ? jp : (31 - jp);
        const float pr = PW[((d * 33 + tau) * 64 + p) * 2], pi = PW[((d * 33 + tau) * 64 + p) * 2 + 1]; float v[8];
#pragma unroll
        for (int e = 0; e < 8; ++e) { const float br = BB[((d * 64 + p) * 16 + c0 + e) * 2], bi = BB[((d * 64 + p) * 16 + c0 + e) * 2 + 1]; v[e] = ri ? (pr * bi + pi * br) : (pr * br - pi * bi); }
        v4u o; o.x = pk2(v[0], v[1]); o.y = pk2(v[2], v[3]); o.z = pk2(v[4], v[5]); o.w = pk2(v[6], v[7]);
        *(v4u*)(BE + (size_t)n * 512 + q8 * 8) = o; }
    if (F.tid < 128) { const int d = F.tid >> 6, p = F.tid & 63; float* o = (float*)(ws_ + WS_LB32) + (((size_t)(l * 16 + g) * 2 + d) * 64 + p) * 2; o[0] = PW[((d * 33 + 32) * 64 + p) * 2]; o[1] = PW[((d * 33 + 32) * 64 + p) * 2 + 1]; }
    __syncthreads();
}
__device__ __forceinline__ void s5_carry_tile(Frame& F, int l, int g, int mt) {
    unsigned char* const ws_ = launder_ws(F.ws);
    if (mt < 2) {
        const int b = mt, seg = F.tid >> 7, d = (F.tid >> 6) & 1, p = F.tid & 63, dp = F.tid & 127;
        const float* lb = (const float*)(ws_ + WS_LB32) + (((size_t)(l * 16 + g) * 2 + d) * 64 + p) * 2; const float ar = lb[0], ai = lb[1];
        const float* E = (const float*)(ws_ + WS_E) + ((size_t)g * S5R) * 256 + d * 128 + 2 * p;
        bf16* UC = (bf16*)(ws_ + WS_UC) + ((size_t)g * S5R) * S5K + 512 + d * 128 + 2 * p;
        LAS float* Ls = (LAS float*)F.lds;
        float er[64], ei[64], cr[8], ci[8];
#pragma unroll
        for (int q = 0; q < 8; ++q) { const int R = 512 + b * 8 + (d ? 7 - q : q); const float2 e2 = *(const float2*)(E + (size_t)R * 256); cr[q] = e2.x; ci[q] = e2.y; }
        const int R0 = b * 256 + (d ? 255 - 64 * seg : 64 * seg); const long estep = d ? -256 : 256, ustep = d ? -(long)S5K : (long)S5K;
        { const float* ep = E + (size_t)R0 * 256;
#pragma unroll
          for (int q = 0; q < 64; ++q) { const float2 e2 = *(const float2*)ep; er[q] = e2.x; ei[q] = e2.y; ep += estep; } }
        float sr = 0.f, si = 0.f;
#pragma unroll
        for (int q = 0; q < 8; ++q) { const float nr = ar * sr - ai * si + cr[q], ni = ar * si + ai * sr + ci[q]; sr = nr; si = ni; }
        float lr = 0.f, li = 0.f;
#pragma unroll
        for (int q = 0; q < 64; ++q) { const float nr = ar * lr - ai * li + er[q], ni = ar * li + ai * lr + ei[q]; lr = nr; li = ni; }
        float pr = ar, pi = ai;
#pragma unroll
        for (int i = 0; i < 6; ++i) { const float t = pr * pr - pi * pi; pi = 2.f * pr * pi; pr = t; }
        Ls[(seg * 128 + dp) * 2] = lr; Ls[(seg * 128 + dp) * 2 + 1] = li;
        __syncthreads();
        for (int s_ = 0; s_ < seg; ++s_) { const float Lr = Ls[(s_ * 128 + dp) * 2], Li = Ls[(s_ * 128 + dp) * 2 + 1]; const float nr = pr * sr - pi * si + Lr, ni = pr * si + pi * sr + Li; sr = nr; si = ni; }
        { bf16* up = UC + (size_t)R0 * S5K;
#pragma unroll
          for (int q = 0; q < 64; ++q) { *(unsigned*)up = pk2(sr, si); up += ustep;
            const float nr = ar * sr - ai * si + er[q], ni = ar * si + ai * sr + ei[q]; sr = nr; si = ni; } }
    } else if (F.tid < 256) { const int b = F.tid >> 7, d = (F.tid >> 6) & 1, p = F.tid & 63;
        const float* lb = (const float*)(ws_ + WS_LB32) + (((size_t)(l * 16 + g) * 2 + d) * 64 + p) * 2; const float ar = lb[0], ai = lb[1];
        float sr = 0.f, si = 0.f;
        const float* E = (const float*)(ws_ + WS_E) + ((size_t)g * S5R) * 256 + d * 128 + 2 * p;
        bf16* UC = (bf16*)(ws_ + WS_UC) + ((size_t)g * S5R) * S5K + 512 + d * 128 + 2 * p;
        float er[8], ei[8];
#pragma unroll
        for (int q = 0; q < 8; ++q) { const int R = 512 + b * 8 + (d ? 7 - q : q); const float2 e2 = *(const float2*)(E + (size_t)R * 256); er[q] = e2.x; ei[q] = e2.y; }
#pragma unroll
        for (int q = 0; q < 8; ++q) { const int R = 512 + b * 8 + (d ? 7 - q : q); *(unsigned*)(UC + (size_t)R * S5K) = pk2(sr, si);
            const float nr = ar * sr - ai * si + er[q], ni = ar * si + ai * sr + ei[q]; sr = nr; si = ni; }
    }
    asm volatile("s_waitcnt vmcnt(0)" ::: "memory");
    __syncthreads();
}
typedef short bf16x8_t __attribute__((ext_vector_type(8)));
typedef short bf16x4_t __attribute__((ext_vector_type(4)));
typedef float f32x16 __attribute__((ext_vector_type(16)));
typedef unsigned u32x4_t __attribute__((ext_vector_type(4)));
constexpr int AT_KROW = 72, AT_VROW = 388;
constexpr int AT_KBYTES = 640 * AT_KROW * 2, AT_VBYTES = 64 * AT_VROW * 2, AT_SCR = AT_KBYTES + AT_VBYTES;
static_assert(AT_SCR + 8 * 64 * 4 <= LDS_BYTES, "attention LDS");
__device__ __forceinline__ int at_crow(int r, int h) { return (r & 3) + 8 * (r >> 2) + 4 * h; }
__device__ __forceinline__ float max16(const f32x16& s) { float a = fmaxf(fmaxf(s[0], s[1]), fmaxf(s[2], s[3])), b = fmaxf(fmaxf(s[4], s[5]), fmaxf(s[6], s[7])), c = fmaxf(fmaxf(s[8], s[9]), fmaxf(s[10], s[11])), d = fmaxf(fmaxf(s[12], s[13]), fmaxf(s[14], s[15])); return fmaxf(fmaxf(a, b), fmaxf(c, d)); }
__device__ __forceinline__ void ph_attn(Frame& F, int l, int ulo, int uhi, int wgi, int nwg) {
    unsigned char* const ws_ = launder_ws(F.ws);
    KArgs ka = kargs();
    const bf16* Q = (const bf16*)(ws_ + WS_Q); const bf16* K = (const bf16*)(ws_ + WS_K); const bf16* V = (const bf16*)(ws_ + WS_V);
    bf16* CAT = (bf16*)(ws_ + WS_CAT); const float* sink = ka->in[8] + l * 8;
    LAS bf16* Ks = (LAS bf16*)F.lds; LAS bf16* Vt = (LAS bf16*)(F.lds + AT_KBYTES); LAS float* scr = (LAS float*)(F.lds + AT_SCR) + F.wave * 64;
    const int lane = F.lane, l31 = lane & 31, h = lane >> 5, hh = F.wave >> 1, qh = F.wave & 1;
    for (int u = ulo + wgi; u < uhi; u += nwg) {
        int b, kvh, n, qrow0; bool win;
        if (u < 256) { b = u >> 7; kvh = (u >> 6) & 1; n = u & 63; win = true; qrow0 = b * SEQ + n * 128; }
        else { const int uc = u - 256; b = uc >> 2; kvh = (uc >> 1) & 1; n = uc & 1; win = false; qrow0 = NX + b * LCTX + n * 128; }
        __syncthreads();
#define AT_VT_WRITE(A_, B_, kp2_, ch_) do { LAS unsigned* vp_ = (LAS unsigned*)(Vt + ((ch_) * 8) * AT_VROW + 2 * (kp2_)); \
            vp_[0] = (A_.x & 0xffffu) | (B_.x << 16); vp_[AT_VROW / 2] = (A_.x >> 16) | (B_.x & 0xffff0000u); vp_[2 * (AT_VROW / 2)] = (A_.y & 0xffffu) | (B_.y << 16); vp_[3 * (AT_VROW / 2)] = (A_.y >> 16) | (B_.y & 0xffff0000u); \
            vp_[4 * (AT_VROW / 2)] = (A_.z & 0xffffu) | (B_.z << 16); vp_[5 * (AT_VROW / 2)] = (A_.z >> 16) | (B_.z & 0xffff0000u); vp_[6 * (AT_VROW / 2)] = (A_.w & 0xffffu) | (B_.w << 16); vp_[7 * (AT_VROW / 2)] = (A_.w >> 16) | (B_.w & 0xffff0000u); } while (0)
        int tid_ = F.tid; asm volatile("" : "+v"(tid_));
        {
            v4u kv[10], va[3], vb[3];
#pragma unroll
            for (int i = 0; i < 10; ++i) { kv[i] = (v4u){0u, 0u, 0u, 0u};
                if (win || i >= 6) { const int pc = tid_ + NTHREADS * i, row = pc >> 3, ch = pc & 7;
                    if (i < 6) { const int kp = 128 * (n - 1) + row; if (kp >= 0 && kp < SEQ) kv[i] = *(const v4u*)(K + ((size_t)(b * SEQ + kp)) * 128 + kvh * 64 + ch * 8); }
                    else kv[i] = *(const v4u*)(K + ((size_t)(NX + b * LCTX + row - 384)) * 128 + kvh * 64 + ch * 8); } }
            if (win) {
#pragma unroll
                for (int it = 0; it < 3; ++it) { const int idx = tid_ + NTHREADS * it, kp2 = idx >> 3, ch = idx & 7, kp = 128 * (n - 1) + 2 * kp2; va[it] = (v4u){0u, 0u, 0u, 0u}; vb[it] = va[it];
                    if (kp >= 0 && kp < SEQ) { const bf16* vsrc = V + ((size_t)(b * SEQ + kp)) * 128 + kvh * 64 + ch * 8; va[it] = *(const v4u*)vsrc; vb[it] = *(const v4u*)(vsrc + 128); } } }
#pragma unroll
            for (int i = 0; i < 10; ++i) if (win || i >= 6) { const int pc = tid_ + NTHREADS * i, row = pc >> 3, ch = pc & 7; *(LAS v4u*)(Ks + row * AT_KROW + ch * 8) = kv[i]; }
            if (win) {
#pragma unroll
                for (int it = 0; it < 3; ++it) { const int idx = tid_ + NTHREADS * it, kp2 = idx >> 3, ch = idx & 7; AT_VT_WRITE(va[it], vb[it], kp2, ch); } }
        }
        const int head = kvh * 4 + hh; const int qbase = qh * 64;
        bf16x8_t qf[2][4];
#pragma unroll
        for (int qb = 0; qb < 2; ++qb)
#pragma unroll
            for (int s = 0; s < 4; ++s) qf[qb][s] = *(const bf16x8_t*)(Q + ((size_t)(qrow0 + qbase + qb * 32 + l31)) * 512 + head * 64 + 16 * s + 8 * h);
        __syncthreads();
        const int qpos0 = n * 128 + qbase + l31;
        const int klo0 = max(qpos0 - 128, 0), klo1 = max(qpos0 + 32 - 128, 0); const unsigned span0 = (unsigned)(min(qpos0 + 128, SEQ - 1) - klo0), span1 = (unsigned)(min(qpos0 + 32 + 128, SEQ - 1) - klo1);
        const int wlo = win ? (qh ? 2 : 0) : 12, whi = win ? (qh ? 12 : 10) : 12;
#define AT_SCORES(st, S0, S1, MASKED, I0, I1) do { \
            const LAS bf16* kp_ = Ks + ((st) * 32 + l31) * AT_KROW + 8 * h; \
            _Pragma("unroll") for (int s = 0; s < 4; ++s) { const bf16x8_t kf = *(const LAS bf16x8_t*)(kp_ + 16 * s); \
                S0 = __builtin_amdgcn_mfma_f32_32x32x16_bf16(kf, qf[0][s], s ? S0 : (I0), 0, 0, 0); S1 = __builtin_amdgcn_mfma_f32_32x32x16_bf16(kf, qf[1][s], s ? S1 : (I1), 0, 0, 0); } \
            if ((MASKED) && (st) < 12 && ((st) < 4 || (st) >= 8)) { const int d0_ = 128 * (n - 1) + (st) * 32 + 4 * h - klo0, d1_ = d0_ + klo0 - klo1;     \
                _Pragma("unroll") for (int r = 0; r < 16; ++r) { const int c_ = (r & 3) + 8 * (r >> 2); \
                    if ((unsigned)(d0_ + c_) > span0) S0[r] = -1e30f; if ((unsigned)(d1_ + c_) > span1) S1[r] = -1e30f; } } \
        } while (0)
        const f32x16 Z16 = (f32x16){0.f,0.f,0.f,0.f,0.f,0.f,0.f,0.f,0.f,0.f,0.f,0.f,0.f,0.f,0.f,0.f};
        float m0 = -1e30f, m1 = -1e30f;
#pragma unroll 2
        for (int st = wlo; st < whi; ++st) { f32x16 S0, S1; AT_SCORES(st, S0, S1, false, Z16, Z16); m0 = fmaxf(m0, max16(S0)); m1 = fmaxf(m1, max16(S1)); }
#pragma unroll 2
        for (int st = 12; st < 20; ++st) { f32x16 S0, S1; AT_SCORES(st, S0, S1, false, Z16, Z16); m0 = fmaxf(m0, max16(S0)); m1 = fmaxf(m1, max16(S1)); }
        m0 = fmaxf(m0, __shfl_xor(m0, 32)); m1 = fmaxf(m1, __shfl_xor(m1, 32));
        const float sk = sink[head] * 1.4426950408889634f;
        m0 = fmaxf(m0, sk); m1 = fmaxf(m1, sk);
        float l0 = 0.f, l1 = 0.f; f32x16 O[2][2], NM0, NM1;
#pragma unroll
        for (int r = 0; r < 16; ++r) { NM0[r] = -m0; NM1[r] = -m1; }
#pragma unroll
        for (int a_ = 0; a_ < 2; ++a_)
#pragma unroll
            for (int b_ = 0; b_ < 2; ++b_) O[a_][b_] = (f32x16){0.f,0.f,0.f,0.f,0.f,0.f,0.f,0.f,0.f,0.f,0.f,0.f,0.f,0.f,0.f,0.f};
#define AT_PV(st, voff) do { f32x16 S0, S1; AT_SCORES(st, S0, S1, true, NM0, NM1);     \
            _Pragma("unroll") for (int r = 0; r < 16; ++r) { S0[r] = __builtin_amdgcn_exp2f(S0[r]); S1[r] = __builtin_amdgcn_exp2f(S1[r]);     l0 += S0[r]; l1 += S1[r]; } \
            _Pragma("unroll") for (int ks = 0; ks < 2; ++ks) { \
                u32x4_t pa0, pa1; \
                pa0.x = pg8::cvt_pk_bf16(S0[8 * ks + 0], S0[8 * ks + 1]); pa0.y = pg8::cvt_pk_bf16(S0[8 * ks + 2], S0[8 * ks + 3]); pa0.z = pg8::cvt_pk_bf16(S0[8 * ks + 4], S0[8 * ks + 5]); pa0.w = pg8::cvt_pk_bf16(S0[8 * ks + 6], S0[8 * ks + 7]); \
                pa1.x = pg8::cvt_pk_bf16(S1[8 * ks + 0], S1[8 * ks + 1]); pa1.y = pg8::cvt_pk_bf16(S1[8 * ks + 2], S1[8 * ks + 3]); pa1.z = pg8::cvt_pk_bf16(S1[8 * ks + 4], S1[8 * ks + 5]); pa1.w = pg8::cvt_pk_bf16(S1[8 * ks + 6], S1[8 * ks + 7]); \
                _Pragma("unroll") for (int db = 0; db < 2; ++db) { const LAS bf16* vp_ = Vt + (db * 32 + l31) * AT_VROW + (voff) + 16 * ks + 4 * h; \
                    const bf16x4_t lo_ = *(const LAS bf16x4_t*)vp_, hi_ = *(const LAS bf16x4_t*)(vp_ + 8); \
                    const bf16x8_t vf = (bf16x8_t){lo_[0], lo_[1], lo_[2], lo_[3], hi_[0], hi_[1], hi_[2], hi_[3]}; \
                    O[0][db] = __builtin_amdgcn_mfma_f32_32x32x16_bf16(__builtin_bit_cast(bf16x8_t, pa0), vf, O[0][db], 0, 0, 0); \
                    O[1][db] = __builtin_amdgcn_mfma_f32_32x32x16_bf16(__builtin_bit_cast(bf16x8_t, pa1), vf, O[1][db], 0, 0, 0); } } \
        } while (0)
        if (win) {
#pragma nounroll
            for (int st = wlo; st < whi; ++st) AT_PV(st, st * 32); }
        v4u ca[2], cb[2];
#pragma unroll
        for (int it = 0; it < 2; ++it) { const int idx = tid_ + NTHREADS * it, kp2 = idx >> 3, ch = idx & 7; const bf16* vsrc = V + ((size_t)(NX + b * LCTX + 2 * kp2)) * 128 + kvh * 64 + ch * 8; ca[it] = *(const v4u*)vsrc; cb[it] = *(const v4u*)(vsrc + 128); }
        __syncthreads();
#pragma unroll
        for (int it = 0; it < 2; ++it) { const int idx = tid_ + NTHREADS * it, kp2 = idx >> 3, ch = idx & 7; AT_VT_WRITE(ca[it], cb[it], kp2, ch); }
        __syncthreads();
#pragma nounroll
        for (int st = 12; st < 20; ++st) AT_PV(st, (st - 12) * 32);
#undef AT_PV
#undef AT_VT_WRITE
#undef AT_SCORES
        l0 += __shfl_xor(l0, 32); l1 += __shfl_xor(l1, 32);
        l0 += __builtin_amdgcn_exp2f(sk - m0); l1 += __builtin_amdgcn_exp2f(sk - m1);
        if (h == 0) { scr[l31] = 1.f / l0; scr[32 + l31] = 1.f / l1; }
        LDS_WAIT();
#pragma unroll
        for (int qb = 0; qb < 2; ++qb)
#pragma unroll
            for (int r = 0; r < 16; ++r) { const int qq = at_crow(r, h); const float inv = scr[qb * 32 + qq]; const size_t row = (size_t)(qrow0 + qbase + qb * 32 + qq);
#pragma unroll
                for (int db = 0; db < 2; ++db) CAT[row * 1024 + head * 64 + db * 32 + l31] = (bf16)f2bf(O[qb][db][r] * inv); }
    }
}
constexpr size_t WS_WPT = 5 * MiB + 512 * KiB;
__device__ __forceinline__ void ph_conv(Frame& F, int l, int tlo, int thi, int wgi, int nwg, unsigned* ctr) {
    unsigned char* const ws_ = launder_ws(F.ws);
    KArgs ka = kargs();
    const bf16* HG = (const bf16*)(ws_ + WS_HG); bf16* CN = (bf16*)(ws_ + WS_CN);
    LAS float* Hs = (LAS float*)F.lds; LAS float* Ws = Hs + 94 * 256;
    const int lane = F.lane, c4 = 4 * lane;
    __syncthreads();
    for (int i = F.tid; i < 31 * 256; i += NTHREADS) Ws[i] = ka->in[19][(size_t)l * 31 * 256 + i];
    const f32x4 bd = *(const f32x4*)(ka->in[20] + l * 256 + c4), lg = *(const f32x4*)(ka->in[21] + l * 256 + c4), lb = *(const f32x4*)(ka->in[22] + l * 256 + c4);
    LAS unsigned* bc = (LAS unsigned*)(F.lds + 131072);
#define CONV_DRAW(t) do { __syncthreads(); if (F.tid == 0) bc[0] = __hip_atomic_fetch_add(ctr, 1u, __ATOMIC_RELAXED, __HIP_MEMORY_SCOPE_AGENT); __syncthreads(); t = tlo + (int)bc[0]; } while (0)
    int tile = tlo + wgi; if (ctr) CONV_DRAW(tile);
    for (; tile < thi; ) {
        int t0, base, len;
        if (tile < 256) { t0 = (tile & 127) * 64; base = (tile >> 7) * SEQ; len = SEQ; } else { const int tc = tile - 256; t0 = (tc & 3) * 64; base = NX + (tc >> 2) * LCTX; len = LCTX; }
        __syncthreads();
        { v2u hw[12];
#pragma unroll
          for (int it = 0; it < 12; ++it) { const int idx = F.tid + NTHREADS * it, rr = idx >> 6, cc = (idx & 63) * 4, tt = t0 - 15 + rr; hw[it] = (v2u){0u, 0u};
              if (idx < 94 * 64 && tt >= 0 && tt < len) hw[it] = *(const v2u*)(HG + ((size_t)(base + tt)) * 256 + cc); }
#pragma unroll
          for (int it = 0; it < 12; ++it) { const int idx = F.tid + NTHREADS * it, rr = idx >> 6, cc = (idx & 63) * 4;
              if (idx < 94 * 64) *(LAS f32x4*)(Hs + rr * 256 + cc) = (f32x4){bflo(hw[it].x), bfhi(hw[it].x), bflo(hw[it].y), bfhi(hw[it].y)}; } }
        __syncthreads();
        {
            const int row0 = F.wave * 8; f32x4 acc[8], win[8];
#pragma unroll
            for (int i = 0; i < 8; ++i) acc[i] = bd;
#pragma unroll
            for (int i = 0; i < 7; ++i) win[i] = *(const LAS f32x4*)(Hs + (row0 + i) * 256 + c4);
#pragma unroll
            for (int k = 0; k < 31; ++k) { win[(k + 7) & 7] = *(const LAS f32x4*)(Hs + (row0 + k + 7) * 256 + c4); const f32x4 wv = *(const LAS f32x4*)(Ws + k * 256 + c4);
#pragma unroll
                for (int i = 0; i < 8; ++i) acc[i] += win[(k + i) & 7] * wv; }
#pragma unroll
            for (int i = 0; i < 8; ++i) {
                const float mean = wave_sum((acc[i].x + acc[i].y) + (acc[i].z + acc[i].w)) * (1.f / 256.f); const f32x4 dv = acc[i] - mean;
                const float var = wave_sum((dv.x * dv.x + dv.y * dv.y) + (dv.z * dv.z + dv.w * dv.w)) * (1.f / 256.f); const float rstd = 1.f / sqrtf(var + LN_EPS);
                const f32x4 y = dv * rstd * lg + lb;
                v2u o; o.x = pk2(silu_f(y.x), silu_f(y.y)); o.y = pk2(silu_f(y.z), silu_f(y.w));
                *(v2u*)(CN + ((size_t)(base + t0 + row0 + i)) * 256 + c4) = o; }
        }
        if (ctr) CONV_DRAW(tile); else tile += nwg;
    }
#undef CONV_DRAW
}
__device__ __forceinline__ int block_sum_i(Frame& F, int v, LAS int* red, int slot) {
    const int w = wave_sum_i(v); if (F.lane == 0) red[slot * 8 + F.wave] = w; __syncthreads();
    int s = 0;
#pragma unroll
    for (int i = 0; i < 8; ++i) s += red[slot * 8 + i];
    return s;
}
__device__ __forceinline__ int wave_incl_scan_i(int v) {
    v += __builtin_amdgcn_update_dpp(0, v, 0x111, 0xf, 0xf, true); v += __builtin_amdgcn_update_dpp(0, v, 0x112, 0xf, 0xf, true);
    v += __builtin_amdgcn_update_dpp(0, v, 0x114, 0xf, 0xf, true); v += __builtin_amdgcn_update_dpp(0, v, 0x118, 0xf, 0xf, true);
    v += __builtin_amdgcn_update_dpp(0, v, 0x142, 0xa, 0xf, false);
    v += __builtin_amdgcn_update_dpp(0, v, 0x143, 0xc, 0xf, false);
    return v;
}
__device__ __forceinline__ int block_excl_scan_i(Frame& F, int v, LAS int* red) {
    const int inc = wave_incl_scan_i(v);
    __syncthreads();
    if (F.lane == 63) red[F.wave] = inc;
    __syncthreads();
    int base = 0;
#pragma unroll
    for (int i = 0; i < 8; ++i) if (i < F.wave) base += red[i];
    return base + inc - v;
}
template <int N, int CAP> __device__ __forceinline__ void route_unit(Frame& F, const float* aff, int e, int rowbase, int slotbase) {
    unsigned char* const ws_ = launder_ws(F.ws);
    constexpr int EPT = (N >= NTHREADS) ? N / NTHREADS : 1;
    static_assert(EPT == 16 || EPT == 1, "route_unit");
    LAS unsigned* hist = (LAS unsigned*)F.lds; LAS int* red = (LAS int*)(F.lds + 4096);
    int* IDX = (int*)(ws_ + WS_IDX); float* GATE = (float*)(ws_ + WS_GATE); int* TOK = (int*)(ws_ + WS_TOKSLOT);
    const bool have = (EPT == 16) || F.tid < N; const int i0 = F.tid * EPT;
    unsigned k[EPT];
    if (EPT == 16) {
#pragma unroll
        for (int q = 0; q < 4; ++q) { const v4u w = ((const v4u*)(aff + i0))[q]; k[4 * q % EPT] = w.x; k[(4 * q + 1) % EPT] = w.y; k[(4 * q + 2) % EPT] = w.z; k[(4 * q + 3) % EPT] = w.w; }
    } else k[0] = have ? __builtin_bit_cast(unsigned, aff[i0]) : 0u;
    __syncthreads();
    unsigned prefix = 0u, pmask = 0u; int need = CAP, eqtot = 0;
#pragma nounroll
    for (int pass = 0; pass < 3; ++pass) { const int sh = 20 - 10 * pass;
        hist[F.tid] = 0u; hist[F.tid + NTHREADS] = 0u;
        __syncthreads();
        if (have) {
#pragma unroll
            for (int j = 0; j < EPT; ++j) if ((k[j] & pmask) == prefix) __hip_atomic_fetch_add(hist + ((k[j] >> sh) & 1023u), 1u, __ATOMIC_RELAXED, __HIP_MEMORY_SCOPE_WORKGROUP); }
        __syncthreads();
        if (F.wave == 0) {
            unsigned h[16];
#pragma unroll
            for (int q = 0; q < 4; ++q) { const v4u w = ((const LAS v4u*)(hist + 16 * F.lane))[q]; h[4 * q] = w.x; h[4 * q + 1] = w.y; h[4 * q + 2] = w.z; h[4 * q + 3] = w.w; }
            unsigned own = 0u;
#pragma unroll
            for (int q = 0; q < 16; ++q) own += h[q];
            const unsigned pre = (unsigned)wave_incl_scan_i((int)own), total = (unsigned)__builtin_amdgcn_readlane((int)pre, 63);
            unsigned a = total - pre;
            int dsel = -1; unsigned asel = 0u, esel = 0u;
#pragma unroll
            for (int q = 15; q >= 0; --q) { if (a < (unsigned)need && (unsigned)need <= a + h[q]) { dsel = 16 * F.lane + q; asel = a; esel = h[q]; } a += h[q]; }
            if (dsel >= 0) { red[16] = dsel; red[17] = (int)asel; red[18] = (int)esel; }
        }
        __syncthreads();
        const int dsel = red[16]; need -= red[17]; eqtot = red[18];
        prefix |= ((unsigned)dsel) << sh; pmask |= 1023u << sh;
    }
    const unsigned T = prefix;
    const bool alleq = (eqtot == need);
    int eqb = 0;
    if (!alleq) { int ceq = 0;
#pragma unroll
        for (int j = 0; j < EPT; ++j) ceq += (have && k[j] == T) ? 1 : 0;
        eqb = block_excl_scan_i(F, ceq, red); }
    int csel = 0, e2 = eqb; unsigned selm = 0u;
#pragma unroll
    for (int j = 0; j < EPT; ++j) { const bool iseq = (k[j] == T); const bool sel = have && ((k[j] > T) || (iseq && (alleq || e2 < need))); e2 += iseq ? 1 : 0; csel += sel ? 1 : 0; selm |= sel ? (1u << j) : 0u; }
    int pos = block_excl_scan_i(F, csel, red + 32);
    int tokv[EPT];
#pragma unroll
    for (int j = 0; j < EPT; ++j) { tokv[j] = -1;
        if ((selm >> j) & 1u) { const int slot = slotbase + pos; ++pos; IDX[slot] = rowbase + i0 + j; GATE[slot] = __builtin_bit_cast(float, k[j]); tokv[j] = slot; } }
    int* tp = TOK + (size_t)e * NR + rowbase + i0;
    if (EPT == 16) {
#pragma unroll
        for (int q = 0; q < 4; ++q) ((v4u*)tp)[q] = (v4u){(unsigned)tokv[4 * q % EPT], (unsigned)tokv[(4 * q + 1) % EPT], (unsigned)tokv[(4 * q + 2) % EPT], (unsigned)tokv[(4 * q + 3) % EPT]};
    } else if (have) tp[0] = tokv[0];
}
__device__ __forceinline__ void ph_route(Frame& F, bool last) {
    unsigned char* const ws_ = launder_ws(F.ws);
    const int nunits = last ? 32 : 64;
    for (int u = F.bid; u < nunits; u += F.G) {
        if (u < 32) { const int b = u >> 4, e = u & 15; route_unit<SEQ, CAPX>(F, (const float*)(ws_ + WS_AFF) + (size_t)u * SEQ, e, b * SEQ, e * SLOTS_E + b * CAPX); }
        else { const int uc = u - 32, b = uc >> 4, e = uc & 15; route_unit<LCTX, CAPC>(F, (const float*)(ws_ + WS_AFFC) + (size_t)uc * LCTX, e, NX + b * LCTX, e * SLOTS_E + 2 * CAPX + b * CAPC);
            if (b == 0 && F.tid < 192) { ((int*)(ws_ + WS_IDX))[e * SLOTS_E + 2 * CAPX + 2 * CAPC + F.tid] = 0; ((float*)(ws_ + WS_GATE))[e * SLOTS_E + 2 * CAPX + 2 * CAPC + F.tid] = 0.f; } }
    }
}
__device__ __forceinline__ void ln_pair(f32x4 (&v)[2][4]) {
    float s[2], q[2];
#pragma unroll
    for (int r = 0; r < 2; ++r) { s[r] = 0.f; q[r] = 0.f;
#pragma unroll
        for (int j = 0; j < 4; ++j) { s[r] += (v[r][j].x + v[r][j].y) + (v[r][j].z + v[r][j].w); q[r] += (v[r][j].x * v[r][j].x + v[r][j].y * v[r][j].y) + (v[r][j].z * v[r][j].z + v[r][j].w * v[r][j].w); } }
    s[0] = wave_sum(s[0]); s[1] = wave_sum(s[1]); q[0] = wave_sum(q[0]); q[1] = wave_sum(q[1]);
#pragma unroll
    for (int r = 0; r < 2; ++r) { const float mean = s[r] * (1.f / 1024.f), var = fmaxf(q[r] * (1.f / 1024.f) - mean * mean, 0.f), rstd = 1.f / sqrtf(var + LN_EPS);
#pragma unroll
        for (int j = 0; j < 4; ++j) v[r][j] = (v[r][j] - mean) * rstd; }
}
__device__ __forceinline__ void ph_rows_mid2(Frame& F, int l, bool last) {
    unsigned char* const ws_ = launder_ws(F.ws);
    KArgs ka = kargs();
    const float* MOD = (const float*)(ws_ + WS_MOD); const bf16* YMIX = (const bf16*)(ws_ + WS_YMIX);
    float* XMID = (float*)(ws_ + WS_XMID); bf16* H2 = (bf16*)(ws_ + WS_HX);
    const float* g1_ = ka->in[27] + l * 1024; const float* b1_ = ka->in[28] + l * 1024; const float* wr_ = ka->in[29] + (size_t)l * 1024 * 16;
    float* AFF = (float*)(ws_ + WS_AFF); float* AFFC = (float*)(ws_ + WS_AFFC);
    LAS float* Wp = (LAS float*)F.lds;
    const int lane = F.lane, nrows = last ? NX : NR;
    __syncthreads();
    for (int i = F.tid; i < 16 * 4 * 64; i += NTHREADS) { const int ji = i >> 8, q = (i >> 6) & 3, ln = i & 63, d = 4 * ln + 256 * (ji >> 2) + (ji & 3);
        *(LAS f32x4*)(Wp + (size_t)i * 4) = *(const f32x4*)(wr_ + (size_t)d * 16 + 4 * q); }
    __syncthreads();
    for (int r0 = 2 * F.gw; r0 < nrows; r0 += 2 * F.NGW) {
        const float* g1 = opq(g1_); const float* b1 = opq(b1_);
        const float* m = MOD + (l * 3 + row_mod_index(r0)) * 6144;
        f32x4 v[2][4];
#pragma unroll
        for (int r = 0; r < 2; ++r) { const int rr = r0 + r;
            const float* src = (l == 0) ? (rr < NX ? ka->in[0] + (size_t)rr * 1024 : ka->in[2] + (size_t)(rr - NX) * 1024) : (const float*)(ws_ + WS_XCUR) + (size_t)rr * 1024;
            f32x4 y[4]; row_load(src, lane, v[r]);
#pragma unroll
            for (int j = 0; j < 4; ++j) { const v2u w = ((const v2u*)(YMIX + (size_t)rr * 1024))[lane + 64 * j]; y[j] = (f32x4){bflo(w.x), bfhi(w.x), bflo(w.y), bfhi(w.y)}; }
#pragma unroll
            for (int j = 0; j < 4; ++j) { const f32x4 gt = ((const f32x4*)(m + 2048))[lane + 64 * j]; v[r][j] = v[r][j] * ALPHA + gt * y[j]; } }
        ln_pair(v);
#pragma unroll
        for (int j = 0; j < 4; ++j) { const f32x4 gg = ((const f32x4*)g1)[lane + 64 * j], bb = ((const f32x4*)b1)[lane + 64 * j];
#pragma unroll
            for (int r = 0; r < 2; ++r) v[r][j] = v[r][j] * gg + bb; }
        ln_pair(v);
#pragma unroll
        for (int j = 0; j < 4; ++j) { const f32x4 sh = ((const f32x4*)(m + 3072))[lane + 64 * j], sc = ((const f32x4*)(m + 4096))[lane + 64 * j];
#pragma unroll
            for (int r = 0; r < 2; ++r) v[r][j] = v[r][j] * (sc + 1.f) + sh; }
#pragma unroll
        for (int rr_ = 0; rr_ < 2; ++rr_)
#pragma unroll
            for (int j = 0; j < 4; ++j) ((unsigned*)((unsigned char*)H2 + (size_t)(r0 + rr_) * 1024))[lane + 64 * j] = pack4_fp8(v[rr_][j].x, v[rr_][j].y, v[rr_][j].z, v[rr_][j].w);
        __builtin_amdgcn_sched_barrier(0);
        typedef float f32x2 __attribute__((ext_vector_type(2)));
        f32x2 lg2[2][8];
#pragma unroll
        for (int r = 0; r < 2; ++r)
#pragma unroll
            for (int e = 0; e < 8; ++e) lg2[r][e] = (f32x2){0.f, 0.f};
#pragma unroll
        for (int j = 0; j < 4; ++j)
#pragma unroll
            for (int i = 0; i < 4; ++i) { const LAS float* wp = Wp + ((size_t)((j * 4 + i) * 4) * 64 + lane) * 4; const f32x2 h0 = (f32x2){v[0][j][i], v[0][j][i]}, h1 = (f32x2){v[1][j][i], v[1][j][i]};
#pragma unroll
                for (int q = 0; q < 4; ++q) { const f32x4 w = *(const LAS f32x4*)(wp + q * 256); const f32x2 wa = (f32x2){w.x, w.y}, wb = (f32x2){w.z, w.w};
                    lg2[0][2 * q] = __builtin_elementwise_fma(h0, wa, lg2[0][2 * q]); lg2[0][2 * q + 1] = __builtin_elementwise_fma(h0, wb, lg2[0][2 * q + 1]);
                    lg2[1][2 * q] = __builtin_elementwise_fma(h1, wa, lg2[1][2 * q]); lg2[1][2 * q + 1] = __builtin_elementwise_fma(h1, wb, lg2[1][2 * q + 1]); }
                if (i & 1) __builtin_amdgcn_sched_barrier(0); }
        float lg[2][16];
#pragma unroll
        for (int r = 0; r < 2; ++r)
#pragma unroll
            for (int e = 0; e < 16; ++e) lg[r][e] = lg2[r][e >> 1][e & 1];
        float fin[2];
#pragma unroll
        for (int r = 0; r < 2; ++r) {
            float a8[8], a4[4], a2[2];
            { const bool s = lane & 8;
#pragma unroll
              for (int e = 0; e < 8; ++e) { const float keep = s ? lg[r][e + 8] : lg[r][e], send = s ? lg[r][e] : lg[r][e + 8]; a8[e] = keep + dppf<DPP_RM>(send); } }
            { const bool s = lane & 4;
#pragma unroll
              for (int e = 0; e < 4; ++e) { const float keep = s ? a8[e + 4] : a8[e], send = s ? a8[e] : a8[e + 4]; a4[e] = keep + dppf<DPP_HM>(send); } }
            { const bool s = lane & 2;
#pragma unroll
              for (int e = 0; e < 2; ++e) { const float keep = s ? a4[e + 2] : a4[e], send = s ? a4[e] : a4[e + 2]; a2[e] = keep + dppf<DPP_X2>(send); } }
            { const bool s = lane & 1; const float keep = s ? a2[1] : a2[0], send = s ? a2[0] : a2[1]; fin[r] = xrow_sum(keep + dppf<DPP_X1>(send)); }
        }
        const int e = lane & 15;
#pragma unroll
        for (int r = 0; r < 2; ++r) { const float mx = row_max16(fin[r]);
            const float ex = expf(fin[r] - mx); const float den = row_sum16(ex);
            const int rr = r0 + r;
            if (lane < 16) { if (rr < NX) AFF[((size_t)(rr >> 13) * 16 + e) * SEQ + (rr & (SEQ - 1))] = ex / den; else AFFC[((size_t)((rr - NX) >> 8) * 16 + e) * LCTX + ((rr - NX) & (LCTX - 1))] = ex / den; } }
    }
}
__device__ __forceinline__ void ph_rows_final2(Frame& F, int l, bool last) {
    unsigned char* const ws_ = launder_ws(F.ws);
    KArgs ka = kargs();
    const float* MOD = (const float*)(ws_ + WS_MOD); const bf16* YMIX = (const bf16*)(ws_ + WS_YMIX);
    const int* TOK = (const int*)(ws_ + WS_TOKSLOT); const float* GATE = (const float*)(ws_ + WS_GATE); const bf16* YE = (const bf16*)(ws_ + WS_YEXP);
    const float* g1_ = ka->in[27] + l * 1024; const float* b1_ = ka->in[28] + l * 1024;
    const float* g2_ = ka->in[33] + l * 1024; const float* b2_ = ka->in[34] + l * 1024;
    const int lane = F.lane, nrows = last ? NX : NR;
    for (int r0 = 2 * F.gw; r0 < nrows; r0 += 2 * F.NGW) {
        const float* g1 = opq(g1_); const float* b1 = opq(b1_); const float* g2 = opq(g2_); const float* b2 = opq(b2_);
        const float* m = MOD + (l * 3 + row_mod_index(r0)) * 6144;
        f32x4 v[2][4];
#pragma unroll
        for (int r = 0; r < 2; ++r) { const int rr = r0 + r;
            const float* src = (l == 0) ? (rr < NX ? ka->in[0] + (size_t)rr * 1024 : ka->in[2] + (size_t)(rr - NX) * 1024) : (const float*)(ws_ + WS_XCUR) + (size_t)rr * 1024;
            f32x4 y[4]; row_load(src, lane, v[r]);
#pragma unroll
            for (int j = 0; j < 4; ++j) { const v2u w = ((const v2u*)(YMIX + (size_t)rr * 1024))[lane + 64 * j]; y[j] = (f32x4){bflo(w.x), bfhi(w.x), bflo(w.y), bfhi(w.y)}; }
#pragma unroll
            for (int j = 0; j < 4; ++j) { const f32x4 gt = ((const f32x4*)(m + 2048))[lane + 64 * j]; v[r][j] = v[r][j] * ALPHA + gt * y[j]; } }
        ln_pair(v);
#pragma unroll
        for (int j = 0; j < 4; ++j) { const f32x4 gg = ((const f32x4*)g1)[lane + 64 * j], bb = ((const f32x4*)b1)[lane + 64 * j];
#pragma unroll
            for (int r = 0; r < 2; ++r) v[r][j] = v[r][j] * gg + bb; }
        __builtin_amdgcn_sched_barrier(0);
#pragma unroll
        for (int r = 0; r < 2; ++r) { const int rr = r0 + r;
            int sl = -1; float gv = 0.f; if (lane < 16) { sl = TOK[(size_t)lane * NR + rr]; if (sl >= 0) gv = GATE[sl]; }
            f32x4 mo[4];
#pragma unroll
            for (int j = 0; j < 4; ++j) mo[j] = (f32x4){0.f, 0.f, 0.f, 0.f};
            unsigned long long bal = __ballot(sl >= 0);
            while (bal) { const int e = __builtin_ctzll(bal); bal &= bal - 1; const int s = __shfl(sl, e); const float g = __shfl(gv, e);
                const v2u* yp = (const v2u*)(YE + (size_t)s * 1024);
#pragma unroll
                for (int j = 0; j < 4; ++j) { const v2u w = yp[lane + 64 * j]; mo[j].x += g * bflo(w.x); mo[j].y += g * bfhi(w.x); mo[j].z += g * bflo(w.y); mo[j].w += g * bfhi(w.y); } }
#pragma unroll
            for (int j = 0; j < 4; ++j) { const f32x4 gt = ((const f32x4*)(m + 5120))[lane + 64 * j]; v[r][j] = v[r][j] * ALPHA + gt * mo[j]; } }
        ln_pair(v);
#pragma unroll
        for (int j = 0; j < 4; ++j) { const f32x4 gg = ((const f32x4*)g2)[lane + 64 * j], bb = ((const f32x4*)b2)[lane + 64 * j];
#pragma unroll
            for (int r = 0; r < 2; ++r) { v[r][j] = v[r][j] * gg + bb;
                float* dst = last ? ka->out + (size_t)(r0 + r) * 1024 : (float*)(ws_ + WS_XCUR) + (size_t)(r0 + r) * 1024; ((f32x4*)dst)[lane + 64 * j] = v[r][j]; } }
        if (!last) { ln_pair(v); const float* m1 = MOD + ((l + 1) * 3 + row_mod_index(r0)) * 6144;
            modulate_store(v[0], m1, m1 + 1024, (bf16*)(ws_ + WS_HX) + (size_t)r0 * 1024, lane); modulate_store(v[1], m1, m1 + 1024, (bf16*)(ws_ + WS_HX) + (size_t)(r0 + 1) * 1024, lane); }
    }
}
#define XB_TMO      128
#define XB_XCNT(j)  (256  + 64 * (j))
#define XB_XSUB(j)  (1280 + 64 * (j))
#define XB_XGEN(j)  (2304 + 64 * (j))
#define XB_TOP      3328
#define XB_TOPGEN   3392
#define XCD_BAR_WORDS 3456
#define XB_SPIN_CAP (1u << 18)

__device__ __forceinline__ unsigned xb_ld(unsigned* p)              { return __hip_atomic_load(p, __ATOMIC_RELAXED, __HIP_MEMORY_SCOPE_AGENT); }
__device__ __forceinline__ unsigned xb_add(unsigned* p, unsigned v) { return __hip_atomic_fetch_add(p, v, __ATOMIC_RELAXED, __HIP_MEMORY_SCOPE_AGENT); }
__device__ __forceinline__ unsigned xb_xcc_id() { return (unsigned)__builtin_amdgcn_s_getreg((3 << 11) | 20) & 0xFu; }
#define XB_SPIN(cond, bar) do { unsigned _sp = 0; while (cond) { __builtin_amdgcn_s_sleep(1); \
    if ((++_sp & 255u) == 0u) { if (xb_ld(&(bar)[XB_TMO])) break; if (_sp > XB_SPIN_CAP) { atomicAdd(&(bar)[XB_TMO], 1u); break; } } } } while (0)

struct XcdBarrier {
    unsigned* bar; unsigned x;
    volatile LAS unsigned* st;
    int wv;
};

__device__ __forceinline__ XcdBarrier xcd_barrier_post(unsigned* bar, volatile LAS unsigned* st) {
    XcdBarrier b; b.bar = bar; b.x = xb_xcc_id(); b.st = st;
    if (threadIdx.x == 0) (void)xb_add(&bar[XB_XCNT(b.x)], 1u);
    return b;
}
__device__ __forceinline__ void xcd_barrier_complete(unsigned* bar, unsigned x, unsigned& nloc, unsigned& nx) {
    const unsigned G = gridDim.x * gridDim.y * gridDim.z;
    unsigned sum, cnt, mine, sp = 0u;
    for (;;) {
        sum = 0u; cnt = 0u; mine = 0u;
#pragma unroll
        for (unsigned j = 0; j < 16; ++j) { const unsigned c = xb_ld(&bar[XB_XCNT(j)]); sum += c; cnt += (c > 0u) ? 1u : 0u; mine = (j == x) ? c : mine; }
        if (sum == G) break;
        __builtin_amdgcn_s_sleep(1);
        if ((++sp & 255u) == 0u) { if (xb_ld(&bar[XB_TMO])) break; if (sp > XB_SPIN_CAP) { atomicAdd(&bar[XB_TMO], 1u); break; } }
    }
    nloc = mine > 0u ? mine : 1u; nx = cnt > 0u ? cnt : 1u;
}

__device__ __forceinline__ void xcd_barrier(const XcdBarrier& b) {
    asm volatile("s_waitcnt vmcnt(0)" ::: "memory");
    __syncthreads();
    if (b.wv == 0 && pg8::lane_id() == 0) {
        unsigned* bar = b.bar;
        __builtin_amdgcn_s_waitcnt(0);
        unsigned nloc = b.st[0], nx = b.st[1];
        if (nloc == 0u) { xcd_barrier_complete(bar, b.x, nloc, nx); b.st[0] = nloc; b.st[1] = nx; }
        const unsigned old = xb_add(&bar[XB_XSUB(b.x)], 1u);
        const unsigned gen = old / nloc;
        if (old + 1u == (gen + 1u) * nloc) {
            __builtin_amdgcn_fence(__ATOMIC_RELEASE, "agent");
            asm volatile("s_waitcnt vmcnt(0)" ::: "memory");
            const unsigned og = xb_add(&bar[XB_TOP], 1u);
            const unsigned tg = og / nx;
            if (og + 1u == (tg + 1u) * nx) xb_add(&bar[XB_TOPGEN], 1u);
            else XB_SPIN(xb_ld(&bar[XB_TOPGEN]) == tg, bar);
            __builtin_amdgcn_fence(__ATOMIC_ACQUIRE, "agent");
            xb_add(&bar[XB_XGEN(b.x)], 1u);
            asm volatile("s_waitcnt vmcnt(0)" ::: "memory");
        } else {
            XB_SPIN(xb_ld(&bar[XB_XGEN(b.x)]) == gen, bar);
            __builtin_amdgcn_fence(__ATOMIC_ACQUIRE, "agent");
            asm volatile("s_waitcnt vmcnt(0)" ::: "memory");
        }
    }
    __syncthreads();
}

#ifndef MK_SPLIT
#define MK_SPLIT 0
#endif
#ifndef DUP_MASK
#define DUP_MASK 0u
#endif
#ifndef DUP_CNT
#define DUP_CNT 2
#endif
#define NREP(n) (((DUP_MASK >> (n)) & 1u) ? DUP_CNT : 1)
#define NREPP(n) (((DUP_MASK >> (16 + (n))) & 1u) ? 2 : 1)
constexpr int PPL = 11, NPH = 2 + PPL * DEPTH;
constexpr size_t WS_BAR = 0;
constexpr int MISC_OFF = LDS_BYTES - 64;
__device__ __forceinline__ void grid_seam(int k, int wv) {
    if (k + 1 >= kargs()->ph_hi) return;
    extern __shared__ __attribute__((aligned(16))) unsigned char lds[];
    XcdBarrier b; b.bar = (unsigned*)(kargs()->ws + WS_BAR); b.x = xb_xcc_id(); b.st = (volatile LAS unsigned*)((LAS unsigned char*)lds + MISC_OFF); b.wv = wv;
    xcd_barrier(b);
}
#define SEAM(k) grid_seam(k, wv)
#define IN(k) (kargs()->ph_lo <= (k) && (k) < kargs()->ph_hi)
__device__ __forceinline__ Frame make_frame(int wv) {
    extern __shared__ __attribute__((aligned(16))) unsigned char lds[];
    KArgs ka = kargs(); Frame F;
    F.lds = (LAS unsigned char*)lds; { int t_ = wv * 64 + pg8::lane_id(); asm volatile("" : "+v"(t_)); F.tid = t_; } F.lane = F.tid & 63; F.wave = wv;
    F.bid = blockIdx.x; F.G = ka->G; F.gw = F.bid * NWAVES + F.wave; F.NGW = F.G * NWAVES; F.ws = ka->ws; return F;
}
template <int l> __device__ __forceinline__ void run_layer(const int wv) {
        const bool last = (l == DEPTH - 1); const int k0 = 2 + PPL * l;
        if (IN(k0 + 0)) { for (int rep_ = 0; rep_ < NREP(0); ++rep_) { if (rep_) __syncthreads(); Frame F = make_frame(wv); unsigned char* const ws_ = F.ws;
            pg8::Gemm g{(const pg8::bf16_t*)(ws_ + WS_HX), (const pg8::bf16_t*)(ws_ + WS_WIN) + (size_t)l * INW * DM, NR, INW, DM, DM, DM};
            g.wv = F.wave;
            pg8::InProjOrder S; S.init(0, 256, F.G, F.bid);
            pg8::EpiInProj E{(const float*)(ws_ + WS_BINP) + l * INW, (const float*)(ws_ + WS_ROPE), (pg8::bf16_t*)(ws_ + WS_Q), (pg8::bf16_t*)(ws_ + WS_K), (pg8::bf16_t*)(ws_ + WS_V), (pg8::bf16_t*)(ws_ + WS_UC), (pg8::bf16_t*)(ws_ + WS_HG)};
            pg8::gemm_phase<pg8::EpiInProj, pg8::InProjOrder, PG8_ALIGN, PG8_SP2>(F.lds, g, S, E);
            } SEAM(k0 + 0); }
        if (IN(k0 + 1)) { for (int rep_ = 0; rep_ < NREP(1); ++rep_) { if (rep_) __syncthreads(); Frame F = make_frame(wv); unsigned char* const ws_ = F.ws;
            const int GB = (F.G * 140) / 256, nl = F.G - GB;
            if (F.bid < GB) {
                pg8::Gemm g{(const pg8::bf16_t*)(ws_ + WS_HX), (const pg8::bf16_t*)(ws_ + WS_WIN) + (size_t)l * INW * DM, NR, INW, DM, DM, DM};
                g.wv = F.wave;
                pg8::InProjOrder S; S.init(256, 140, GB, F.bid);
                pg8::EpiInProj E{(const float*)(ws_ + WS_BINP) + l * INW, (const float*)(ws_ + WS_ROPE), (pg8::bf16_t*)(ws_ + WS_Q), (pg8::bf16_t*)(ws_ + WS_K), (pg8::bf16_t*)(ws_ + WS_V), (pg8::bf16_t*)(ws_ + WS_UC), (pg8::bf16_t*)(ws_ + WS_HG)};
                pg8::gemm_phase<pg8::EpiInProj, pg8::InProjOrder, PG8_ALIGN, PG8_SP2>(F.lds, g, S, E);
            } else { const int w = F.bid - GB;
                if (w < 48) {
                    pg8::Gemm g{(const pg8::bf16_t*)(ws_ + WS_UC), (const pg8::bf16_t*)(ws_ + WS_BE) + (size_t)l * 16 * 256 * 512, 16 * S5R, 16 * 256, 512, S5K, 512};
                    g.wv = F.wave;
                    pg8::MoeOrder S; S.init(3, 1, 3, 16, nl < 48 ? nl : 48, w);
                    pg8::EpiF32G E{(float*)(ws_ + WS_E), 256, 1};
                    pg8::gemm_phase<pg8::EpiF32G, pg8::MoeOrder, PG8_ALIGN, PG8_SP2>(F.lds, g, S, E); }
                ph_conv(F, l, 0, last ? 256 : 264, 0, 0, (unsigned*)(ws_ + WS_CTR) + 4 + l);
            }
            } SEAM(k0 + 1); }
        if (IN(k0 + 2)) { for (int rep_ = 0; rep_ < NREP(2); ++rep_) { if (rep_) __syncthreads(); { Frame F = make_frame(wv); ph_attn(F, l, 0, 256, F.bid, F.G); } } SEAM(k0 + 2); }
        if (IN(k0 + 3)) { for (int rep_ = 0; rep_ < NREP(3); ++rep_) { if (rep_) __syncthreads(); Frame F = make_frame(wv); unsigned char* const ws_ = F.ws;
            pg8::Gemm g{(const pg8::bf16_t*)(ws_ + WS_UC), (const pg8::bf16_t*)(ws_ + WS_KT) + (size_t)l * 16 * 512 * S5K, 16 * S5R, 16 * 512, S5K, S5K, S5K};
            g.wv = F.wave;
            pg8::MoeOrder S; S.init(3, 2, 3, 16, F.G, F.bid);
            pg8::EpiS5Y E{(pg8::bf16_t*)(ws_ + WS_Z)};
            pg8::Unit u0;
            if (S.next(0, u0)) { s5_carry_tile(F, l, u0.pm / 3, u0.pm % 3);
                pg8::gemm_phase<pg8::EpiS5Y, pg8::MoeOrder, PG8_ALIGN, PG8_SP2>(F.lds, g, S, E); }
            else if (!last && F.bid >= 96 && F.bid < 104) ph_attn(F, l, 256, 264, F.bid - 96, 8);
            } SEAM(k0 + 3); }
        if (IN(k0 + 4)) { for (int rep_ = 0; rep_ < NREP(4); ++rep_) { if (rep_) __syncthreads(); Frame F = make_frame(wv); unsigned char* const ws_ = F.ws;
            pg8::Gemm g{(const pg8::bf16_t*)(ws_ + WS_Z), (const pg8::bf16_t*)(ws_ + WS_WPT) + (size_t)l * 2 * 65536, 2 * NR, 512, 256, 256, 256};
            g.wv = F.wave;
            pg8::MoeOrder S; S.init(last ? 64 : 66, 1, 66, 2, F.G, F.bid);
            pg8::EpiPW E{(pg8::bf16_t*)(ws_ + WS_CAT), (const pg8::bf16_t*)(ws_ + WS_Z), kargs()->in[18] + l * 256, kargs()->in[24] + l * 256, 66};
            pg8::gemm_phase<pg8::EpiPW, pg8::MoeOrder, PG8_ALIGN, PG8_SP2>(F.lds, g, S, E);
            } SEAM(k0 + 4); }
        if (IN(k0 + 5)) { for (int rep_ = 0; rep_ < NREP(5); ++rep_) { if (rep_) __syncthreads(); Frame F = make_frame(wv); unsigned char* const ws_ = F.ws;
            pg8::Gemm g{(const pg8::bf16_t*)(ws_ + WS_CAT), (const pg8::bf16_t*)(ws_ + WS_WOUT) + (size_t)l * DM * DM, NR, DM, DM, DM, DM};
            g.wv = F.wave;
            pg8::StaticOrder S; S.init(last ? NX : NR, DM, F.G, F.bid);
            pg8::EpiBf16B E{(pg8::bf16_t*)(ws_ + WS_YMIX), DM, kargs()->in[26] + l * DM};
            pg8::gemm_phase<pg8::EpiBf16B, pg8::StaticOrder, PG8_ALIGN, PG8_SP2>(F.lds, g, S, E);
            } SEAM(k0 + 5); }
        if (IN(k0 + 6)) { for (int rep_ = 0; rep_ < NREP(6); ++rep_) { if (rep_) __syncthreads(); { Frame F = make_frame(wv); ph_rows_mid2(F, l, last); } } SEAM(k0 + 6); }
        if (IN(k0 + 7)) { for (int rep_ = 0; rep_ < NREP(7); ++rep_) { if (rep_) __syncthreads(); { Frame F = make_frame(wv); ph_route(F, last); } } SEAM(k0 + 7); }
        const int MT = last ? 8 : 9;
        if (IN(k0 + 8)) { for (int rep_ = 0; rep_ < NREP(8); ++rep_) { if (rep_) __syncthreads(); Frame F = make_frame(wv); unsigned char* const ws_ = F.ws;
            pg8::Gemm g{(const pg8::bf16_t*)(ws_ + WS_HX), (const pg8::bf16_t*)(ws_ + WS_WGU + (size_t)l * NE * 4096 * 1024), NSLOT, NE * 4096, 512, 512, 512};
            g.wv = F.wave;
            pg8::MoeOrder S; S.init(MT, 16, 9, NE, F.G, F.bid, last ? -1 : 8);
            pg8::EpiSwiGLU8 E{ws_ + WS_HID, FF, 16, last ? -1 : 8, 9};
            pg8::gemm_phase_g8<pg8::EpiSwiGLU8, pg8::MoeOrder, PG8_ALIGN, PG8_SP2>(F.lds, g, S, E, (const int*)(ws_ + WS_IDX), 0x7a7a7a7a, 0x7f7f7f7f);
            } SEAM(k0 + 8); }
        if (IN(k0 + 9)) { for (int rep_ = 0; rep_ < NREP(9); ++rep_) { if (rep_) __syncthreads(); Frame F = make_frame(wv); unsigned char* const ws_ = F.ws;
            pg8::Gemm g{(const pg8::bf16_t*)(ws_ + WS_HID), (const pg8::bf16_t*)(ws_ + WS_WD + (size_t)l * NE * DM * FF), NSLOT, NE * DM, 1024, 1024, 1024};
            g.wv = F.wave;
            pg8::MoeOrder S; S.init(MT, 4, 9, NE, F.G, F.bid, last ? -1 : 8, !last);
            pg8::EpiBf16P E{(pg8::bf16_t*)(ws_ + WS_YEXP), DM, 4};
            pg8::gemm_phase_8<pg8::EpiBf16P, pg8::MoeOrder, PG8_ALIGN, PG8_SP2>(F.lds, g, S, E, 0x79797979, 0x7d7d7d7d);
            } SEAM(k0 + 9); }
        if (IN(k0 + 10)) { for (int rep_ = 0; rep_ < NREP(10); ++rep_) { if (rep_) __syncthreads(); { Frame F = make_frame(wv); ph_rows_final2(F, l, last); } } SEAM(k0 + 10); }
    }
__global__ void __launch_bounds__(NTHREADS, 2) mk_fwd(Args a) {
    { extern __shared__ __attribute__((aligned(16))) unsigned char lds[];
      if (threadIdx.x < 16) ((LAS unsigned*)((LAS unsigned char*)lds + MISC_OFF))[threadIdx.x] = 0u;
      __syncthreads();
      if (threadIdx.x == 0) (void)xb_add((unsigned*)(kargs()->ws + WS_BAR) + XB_XCNT(xb_xcc_id()), 1u); }
    int wv = __builtin_amdgcn_readfirstlane((int)(threadIdx.x >> 6)); asm volatile("" : "+s"(wv));
    if (kargs()->ph_hi < 0) cg::this_grid().sync();
    if (IN(0)) { for (int rep_ = 0; rep_ < NREPP(0); ++rep_) { if (rep_) __syncthreads(); Frame F = make_frame(wv); ph_prologue(F); } SEAM(0); }
    if (IN(1)) { for (int rep_ = 0; rep_ < NREPP(1); ++rep_) { if (rep_) __syncthreads(); Frame F = make_frame(wv); ph_rows0(F); } SEAM(1); }
    run_layer<0>(wv);
    run_layer<1>(wv);
}
#undef IN
#undef SEAM

extern "C" void kernel_launch(void* const* d_in, const int* in_sizes, int n_in, void* d_out, int out_size, void* d_ws, size_t ws_size, hipStream_t stream) {
    static int grid_blocks = 0;
    if (!grid_blocks) {
        int dev = 0, cus = 0, per_cu = 0;
        (void)hipGetDevice(&dev);
        (void)hipDeviceGetAttribute(&cus, hipDeviceAttributeMultiprocessorCount, dev);
        (void)hipFuncSetAttribute((const void*)mk_fwd, hipFuncAttributeMaxDynamicSharedMemorySize, LDS_BYTES);
        (void)hipOccupancyMaxActiveBlocksPerMultiprocessor(&per_cu, (const void*)mk_fwd, NTHREADS, LDS_BYTES);
        grid_blocks = (per_cu >= 1 && cus > 0) ? cus : -1;
        if (n_in != 35 || ws_size < WS_END) { fprintf(stderr, "kernel_launch: unexpected n_in %d or ws_size %zu (need %zu)\n", n_in, ws_size, (size_t)WS_END); grid_blocks = -1; }
        fprintf(stderr, "kernel_launch: cus %d per_cu %d ws %zu\n", cus, per_cu, ws_size);
    }
    if (grid_blocks < 0) return;
    (void)hipMemsetAsync((char*)d_ws + WS_BAR, 0, 32 * KiB, stream);
    Args a{};
    for (int i = 0; i < 35; ++i) a.in[i] = (const float*)d_in[i];
    a.out = (float*)d_out; a.ws = (unsigned char*)d_ws; a.G = grid_blocks;
#if MK_SPLIT
    for (int p = 0; p < NPH; ++p) { a.ph_lo = p; a.ph_hi = p + 1; void* args[] = {&a};
        hipError_t e = hipLaunchCooperativeKernel((const void*)mk_fwd, dim3(grid_blocks), dim3(NTHREADS), args, LDS_BYTES, stream);
        if (e != hipSuccess) { fprintf(stderr, "launch failed: %s\n", hipGetErrorString(e)); break; } }
#else
    a.ph_lo = 0; a.ph_hi = NPH; void* args[] = {&a};
    hipError_t e = hipLaunchCooperativeKernel((const void*)mk_fwd, dim3(grid_blocks), dim3(NTHREADS), args, LDS_BYTES, stream);
    if (e != hipSuccess) fprintf(stderr, "cooperative launch failed: %s (grid %d)\n", hipGetErrorString(e), grid_blocks);
#endif
}
```

```cpp
#include <hip/hip_runtime.h>
#include <hip/hip_cooperative_groups.h>
#include <cstdio>
#include <cstdint>
namespace cg = cooperative_groups;
namespace pg8 {
#define PG8_LAS __attribute__((address_space(3)))
typedef unsigned short bf16_t;
typedef short bf16x8 __attribute__((ext_vector_type(8)));
typedef float f32x4 __attribute__((ext_vector_type(4)));
typedef unsigned u32x4 __attribute__((ext_vector_type(4)));
constexpr int BM = 256, BK = 64, HALF = 128, HTB = HALF * BK * 2  , STAGE_BYTES = 8 * HTB, NXCD = 8, WGM = 8;

__host__ __device__ __forceinline__ int lds_byte(int r, int c) { const int st = (r >> 4) * 2 + (c >> 5), rr = r & 15, cc = c & 31, ob = rr * 64 + cc * 2; return st * 1024 + (ob ^ (((ob >> 9) & 1) << 5)); }
__host__ __device__ __forceinline__ void stage_rc(int b, int& R, int& C) { const int st = b / 1024, sb = b % 1024, swz = sb ^ (((sb >> 9) & 1) << 5); R = (st >> 1) * 16 + swz / 64; C = (st & 1) * 32 + (swz % 64) / 2; }
__host__ __device__ __forceinline__ int perm32(int rho) { const int n = rho >> 4, i = rho & 15; return 8 * (i >> 2) + 4 * n + (i & 3); }

struct Unit { int pm, pn; };
__device__ __forceinline__ int lane_id() { int r; asm volatile("v_mbcnt_lo_u32_b32 %0, -1, 0\n\tv_mbcnt_hi_u32_b32 %0, -1, %0" : "=v"(r)); return r; }
struct Gemm { const bf16_t* A; const bf16_t* Bt; int M, N, K, lda, ldb; int wv = 0; };

struct StaticOrder {
    int nM, nN, nwg, G, c;
    __host__ __device__ __forceinline__ void init(int M, int N, int G_, int c_) { nM = M / BM; nN = N / BM; nwg = nM * nN; G = G_; c = c_; }
    __host__ __device__ __forceinline__ bool next(int i, Unit& u) const {
        const long L = (long)i * G + c; if (L >= nwg) return false;
        int wgid = (int)L; { const int q = nwg / NXCD, r = nwg % NXCD, xcd = wgid % NXCD, off = wgid / NXCD; wgid = (xcd < r ? xcd * (q + 1) : r * (q + 1) + (xcd - r) * q) + off; }
        const int nig = WGM * nN, gid = wgid / nig, fm = gid * WGM, gsz = (nM - fm) < WGM ? (nM - fm) : WGM;
        u.pm = fm + ((wgid % nig) % gsz); u.pn = (wgid % nig) / gsz; return true;
    }
    __device__ __forceinline__ void a_ready(const Unit&) const {}
    __device__ __forceinline__ void done(const Unit&) const {}
    __device__ __forceinline__ int vrows(const Unit&) const { return BM; }
};

__device__ __forceinline__ unsigned cvt_pk_bf16(float lo, float hi) { unsigned r; asm volatile("v_cvt_pk_bf16_f32 %0, %1, %2" : "=v"(r) : "v"(lo), "v"(hi)); return r; }
typedef float f32x2 __attribute__((ext_vector_type(2)));
__device__ __forceinline__ f32x2 gelu_pk(f32x2 v) {
    const f32x2 av = __builtin_elementwise_abs(v), d = av * 0.2316418882f + 1.0f;
    f32x2 t; t.x = __builtin_amdgcn_rcpf(d.x); t.y = __builtin_amdgcn_rcpf(d.y);
    f32x2 q = t * 0.5307027145f + (-0.7265760135f); q = q * t + 0.7107068705f; q = q * t + (-0.142248368f); q = q * t + 0.127414796f; q = q * t;
    const f32x2 s = (v * v) * (-0.72134752044f);
    f32x2 e; e.x = __builtin_amdgcn_exp2f(s.x); e.y = __builtin_amdgcn_exp2f(s.y);
    const f32x2 m = v * (q * e), r = v - m;
    f32x2 o; o.x = v.x < 0.f ? m.x : r.x; o.y = v.y < 0.f ? m.y : r.y; return o;
}

typedef unsigned u32x2e __attribute__((ext_vector_type(2)));
__device__ __forceinline__ float silu_f(float x) { return x * __builtin_amdgcn_rcpf(1.f + __expf(-x)); }
struct EpiBf16P {
    static constexpr bool PERM = true, AFTER_DRAIN = false;
    bf16_t* O; int ldo; int ntpe;
    __device__ __forceinline__ void operator()(const f32x4 (&acc)[2][2][4][2], const Unit& u, int wr, int wc, int fr, int fq) const {
        const int row0 = u.pm * BM + wr * 64 + fr; const int col0 = (u.pn % ntpe) * BM + wc * 32 + 8 * fq;
#pragma unroll
        for (int ai = 0; ai < 2; ++ai)
#pragma unroll
            for (int m = 0; m < 4; ++m) { bf16_t* rowp = O + (size_t)(row0 + ai * HALF + m * 16) * ldo + col0;
#pragma unroll
                for (int bj = 0; bj < 2; ++bj) { const f32x4 v0 = acc[ai][bj][m][0], v1 = acc[ai][bj][m][1];
                    u32x4 w; w.x = cvt_pk_bf16(v0[0], v0[1]); w.y = cvt_pk_bf16(v0[2], v0[3]); w.z = cvt_pk_bf16(v1[0], v1[1]); w.w = cvt_pk_bf16(v1[2], v1[3]);
                    *(u32x4*)(rowp + bj * HALF) = w; } }
    }
};
struct EpiBf16B {
    static constexpr bool PERM = true, AFTER_DRAIN = false;
    bf16_t* O; int ldo; const float* bias;
    __device__ __forceinline__ void operator()(const f32x4 (&acc)[2][2][4][2], const Unit& u, int wr, int wc, int fr, int fq) const {
        const int row0 = u.pm * BM + wr * 64 + fr; const int col0 = u.pn * BM + wc * 32 + 8 * fq;
        f32x4 bv[2][2];
        { unsigned long long bp_ = (unsigned long long)bias; asm volatile("" : "+s"(bp_)); const float* bq = (const float*)bp_ + col0;
#pragma unroll
          for (int bj = 0; bj < 2; ++bj) { bv[bj][0] = *(const f32x4*)(bq + bj * HALF); bv[bj][1] = *(const f32x4*)(bq + bj * HALF + 4); } }
#pragma unroll
        for (int ai = 0; ai < 2; ++ai)
#pragma unroll
            for (int m = 0; m < 4; ++m) { bf16_t* rowp = O + (size_t)(row0 + ai * HALF + m * 16) * ldo + col0;
#pragma unroll
                for (int bj = 0; bj < 2; ++bj) {
                    const f32x4 v0 = acc[ai][bj][m][0] + bv[bj][0], v1 = acc[ai][bj][m][1] + bv[bj][1];
                    u32x4 w; w.x = cvt_pk_bf16(v0[0], v0[1]); w.y = cvt_pk_bf16(v0[2], v0[3]); w.z = cvt_pk_bf16(v1[0], v1[1]); w.w = cvt_pk_bf16(v1[2], v1[3]);
                    *(u32x4*)(rowp + bj * HALF) = w; } }
    }
};
__device__ __forceinline__ float sat_e4m3(float x) { return __builtin_amdgcn_fmed3f(x, -448.f, 448.f); }
__device__ __forceinline__ unsigned pack4_fp8(float a, float b, float c, float d) { int w = __builtin_amdgcn_cvt_pk_fp8_f32(sat_e4m3(a), sat_e4m3(b), 0, false); w = __builtin_amdgcn_cvt_pk_fp8_f32(sat_e4m3(c), sat_e4m3(d), w, true); return (unsigned)w; }
struct EpiSwiGLU8 {
    static constexpr bool PERM = true, AFTER_DRAIN = false;
    unsigned char* O; int ldo; int ntpe; int ctxpm, mstride;
    __device__ __forceinline__ void operator()(const f32x4 (&acc)[2][2][4][2], const Unit& u, int wr, int wc, int fr, int fq) const {
        const int row0 = u.pm * BM + wr * 64 + fr; const int col0 = (u.pn % ntpe) * HALF + wc * 32 + 8 * fq;
        const int vr = (ctxpm >= 0 && (u.pm % mstride) == ctxpm) ? 64 : BM;
#pragma unroll
        for (int ai = 0; ai < 2; ++ai) { if (wr * 64 + ai * HALF >= vr) continue;
#pragma unroll
            for (int m = 0; m < 4; ++m) { unsigned char* rowp = O + (size_t)(row0 + ai * HALF + m * 16) * ldo + col0;
                const f32x4 g0 = acc[ai][0][m][0], g1 = acc[ai][0][m][1], u0 = acc[ai][1][m][0] * 4.f, u1 = acc[ai][1][m][1] * 4.f;
                u32x2e w; w.x = pack4_fp8(silu_f(g0[0]) * u0[0], silu_f(g0[1]) * u0[1], silu_f(g0[2]) * u0[2], silu_f(g0[3]) * u0[3]);
                w.y = pack4_fp8(silu_f(g1[0]) * u1[0], silu_f(g1[1]) * u1[1], silu_f(g1[2]) * u1[2], silu_f(g1[3]) * u1[3]);
                *(u32x2e*)rowp = w; } }
    }
};
struct InProjOrder {
    int base, cnt, G, c;
    __device__ __forceinline__ void init(int base_, int cnt_, int G_, int c_) { base = base_; cnt = cnt_; G = G_; c = c_; }
    __device__ __forceinline__ bool next(int i, Unit& u) const {
        const long L = (long)i * G + c; if (L >= cnt) return false;
        int id = (int)L; { const int q = cnt / NXCD, r = cnt % NXCD, xcd = id % NXCD, off = id / NXCD; id = (xcd < r ? xcd * (q + 1) : r * (q + 1) + (xcd - r) * q) + off; }
        id += base; const bool hi = id >= 198; const int id2 = hi ? id - 198 : id;
        u.pm = id2 / 3; u.pn = (hi ? 0 : 3) + id2 % 3; return true;
    }
    __device__ __forceinline__ void a_ready(const Unit&) const {}
    __device__ __forceinline__ void done(const Unit&) const {}
    __device__ __forceinline__ int vrows(const Unit&) const { return BM; }
};
struct MoeOrder {
    int MT, NT, mstride, nwg, G, c, ctxpm, nx;
    __device__ __forceinline__ void init(int MT_, int NT_, int mstride_, int NE_, int G_, int c_, int ctxpm_ = -1, bool ctxlast = false) { MT = MT_; NT = NT_; mstride = mstride_; nwg = MT_ * NT_ * NE_; G = G_; c = c_; ctxpm = ctxpm_; nx = ctxlast ? (MT_ - 1) * NT_ * NE_ : 0; }
    __device__ __forceinline__ bool next(int i, Unit& u) const {
        const long L = (long)i * G + c; if (L >= nwg) return false;
        int id = (int)L;
        if (nx > 0) {
            if (id >= nx) { const int j = id - nx, e = j / NT; u.pm = e * mstride + (MT - 1); u.pn = e * NT + j % NT; return true; }
            { const int q = nx / NXCD, xcd = id % NXCD, off = id / NXCD; id = xcd * q + off; }
            const int upe = (MT - 1) * NT, e = id / upe, r2 = id % upe;
            u.pm = e * mstride + (r2 % (MT - 1)); u.pn = e * NT + (r2 / (MT - 1)); return true;
        }
        { const int q = nwg / NXCD, r = nwg % NXCD, xcd = id % NXCD, off = id / NXCD; id = (xcd < r ? xcd * (q + 1) : r * (q + 1) + (xcd - r) * q) + off; }
        const int upe = MT * NT, e = id / upe, r2 = id % upe;
        u.pm = e * mstride + (r2 % MT); u.pn = e * NT + (r2 / MT); return true;
    }
    __device__ __forceinline__ void a_ready(const Unit&) const {}
    __device__ __forceinline__ void done(const Unit&) const {}
    __device__ __forceinline__ int vrows(const Unit& u) const { return (ctxpm >= 0 && (u.pm % mstride) == ctxpm) ? 64 : BM; }
};
struct EpiF32G {
    static constexpr bool PERM = false, AFTER_DRAIN = false;
    float* C; int ldc; int ntpe;
    __device__ __forceinline__ void operator()(const f32x4 (&acc)[2][2][4][2], const Unit& u, int wr, int wc, int fr, int fq) const {
        const int row0 = u.pm * BM + wr * 64 + fr, col0 = (u.pn % ntpe) * BM + wc * 32 + 4 * fq;
#pragma unroll
        for (int ai = 0; ai < 2; ++ai)
#pragma unroll
            for (int m = 0; m < 4; ++m) { float* rowp = C + (size_t)(row0 + ai * HALF + m * 16) * ldc + col0;
#pragma unroll
                for (int bj = 0; bj < 2; ++bj)
#pragma unroll
                    for (int n = 0; n < 2; ++n) *(f32x4*)(rowp + bj * HALF + n * 16) = acc[ai][bj][m][n]; }
    }
};
__device__ __forceinline__ float gelu_tanh_e(float x) { const float u = 1.5957691216057308f * (x + 0.044715f * x * x * x); return x * __builtin_amdgcn_rcpf(1.f + __expf(-u)); }
struct EpiS5Y {
    static constexpr bool PERM = true, AFTER_DRAIN = false;
    bf16_t* Z; int half;
    __device__ __forceinline__ void operator()(const f32x4 (&acc)[2][2][4][2], const Unit& u, int wr, int wc, int fr, int fq) const {
        const int g = u.pm / 3, R0 = (u.pm % 3) * BM + wr * 64 + fr, n0 = (u.pn & 1) * BM + wc * 32 + 8 * fq;
#pragma unroll
        for (int ai = 0; ai < 2; ++ai) { if (half >= 0 && ai != half) continue;
#pragma unroll
            for (int m = 0; m < 4; ++m) { const int R = R0 + ai * HALF + m * 16; if (R >= 528) continue;
                const int tok0 = (R < 512) ? ((R >> 8) * 8192 + 32 * (R & 255)) : (16384 + ((R - 512) >> 3) * 256 + 32 * ((R - 512) & 7));
#pragma unroll
                for (int bj = 0; bj < 2; ++bj) { const int n = n0 + bj * HALF, j = n >> 4, c0 = n & 15; const f32x4 v0 = acc[ai][bj][m][0], v1 = acc[ai][bj][m][1];
                    u32x4 w; w.x = cvt_pk_bf16(gelu_tanh_e(v0[0]), gelu_tanh_e(v0[1])); w.y = cvt_pk_bf16(gelu_tanh_e(v0[2]), gelu_tanh_e(v0[3])); w.z = cvt_pk_bf16(gelu_tanh_e(v1[0]), gelu_tanh_e(v1[1])); w.w = cvt_pk_bf16(gelu_tanh_e(v1[2]), gelu_tanh_e(v1[3]));
                    *(u32x4*)(Z + ((size_t)(tok0 + j)) * 256 + 16 * g + c0) = w; } } }
    }
};
struct EpiPW {
    static constexpr bool PERM = true, AFTER_DRAIN = false;
    bf16_t* CAT; const bf16_t* Z; const float* bglu; const float* bpw; int mtpe;
    __device__ __forceinline__ void operator()(const f32x4 (&acc)[2][2][4][2], const Unit& u, int wr, int wc, int fr, int fq) const {
        const int grp = u.pn, row0 = (u.pm % mtpe) * BM + wr * 64 + fr, col0 = wc * 32 + 8 * fq; const float* bias = grp ? bpw : bglu;
#pragma unroll
        for (int ai = 0; ai < 2; ++ai)
#pragma unroll
            for (int m = 0; m < 4; ++m) { const size_t row = (size_t)(row0 + ai * HALF + m * 16);
#pragma unroll
                for (int bj = 0; bj < 2; ++bj) { const int col = col0 + bj * HALF;
                    unsigned long long bp_ = (unsigned long long)bias; asm volatile("" : "+s"(bp_)); const float* bq = (const float*)bp_ + col;
                    f32x4 v0 = acc[ai][bj][m][0] + *(const f32x4*)bq, v1 = acc[ai][bj][m][1] + *(const f32x4*)(bq + 4);
                    if (grp == 0) { const u32x4 zz = *(const u32x4*)(Z + row * 256 + col);
                        v0[0] = __builtin_bit_cast(float, zz.x << 16) * __builtin_amdgcn_rcpf(1.f + __expf(-v0[0])); v0[1] = __builtin_bit_cast(float, zz.x & 0xffff0000u) * __builtin_amdgcn_rcpf(1.f + __expf(-v0[1]));
                        v0[2] = __builtin_bit_cast(float, zz.y << 16) * __builtin_amdgcn_rcpf(1.f + __expf(-v0[2])); v0[3] = __builtin_bit_cast(float, zz.y & 0xffff0000u) * __builtin_amdgcn_rcpf(1.f + __expf(-v0[3]));
                        v1[0] = __builtin_bit_cast(float, zz.z << 16) * __builtin_amdgcn_rcpf(1.f + __expf(-v1[0])); v1[1] = __builtin_bit_cast(float, zz.z & 0xffff0000u) * __builtin_amdgcn_rcpf(1.f + __expf(-v1[1]));
                        v1[2] = __builtin_bit_cast(float, zz.w << 16) * __builtin_amdgcn_rcpf(1.f + __expf(-v1[2])); v1[3] = __builtin_bit_cast(float, zz.w & 0xffff0000u) * __builtin_amdgcn_rcpf(1.f + __expf(-v1[3])); }
                    u32x4 w; w.x = cvt_pk_bf16(v0[0], v0[1]); w.y = cvt_pk_bf16(v0[2], v0[3]); w.z = cvt_pk_bf16(v1[0], v1[1]); w.w = cvt_pk_bf16(v1[2], v1[3]);
                    *(u32x4*)(CAT + row * 1024 + 512 + grp * 256 + col) = w; }
                asm volatile("" ::: "memory"); }
    }
};
typedef unsigned u32x2 __attribute__((ext_vector_type(2)));
struct EpiInProj {
    static constexpr bool PERM = true, AFTER_DRAIN = false;
    const float* bias; const float* rope; bf16_t* Q; bf16_t* K; bf16_t* V; bf16_t* UC; bf16_t* HG;
    __device__ __forceinline__ void operator()(const f32x4 (&acc)[2][2][4][2], const Unit& u, int wr, int wc, int fr, int fq) const {
        const int pn = u.pn; const bool isx = u.pm < 64;
        f32x4 bv[2][2];
        { unsigned long long bp_ = (unsigned long long)bias; asm volatile("" : "+s"(bp_)); const float* bq = (const float*)bp_ + pn * BM + wc * 32 + 8 * fq;
#pragma unroll
          for (int bj = 0; bj < 2; ++bj) { bv[bj][0] = *(const f32x4*)(bq + bj * HALF); bv[bj][1] = *(const f32x4*)(bq + bj * HALF + 4); } }
        const bool rot = (pn <= 2) && isx; const int hi = fq >> 1, i0 = 8 * (fq & 1);
#pragma unroll
        for (int ai = 0; ai < 2; ++ai)
#pragma unroll
            for (int m = 0; m < 4; ++m) {
                const int r = u.pm * BM + ai * HALF + wr * 64 + m * 16 + fr;
                f32x4 v[2][2];
#pragma unroll
                for (int bj = 0; bj < 2; ++bj)
#pragma unroll
                    for (int n = 0; n < 2; ++n) v[bj][n] = acc[ai][bj][m][n] + bv[bj][n];
                if (pn <= 2) {
                    f32x4 cs[4];
                    if (rot) { const int t = r & 8191, pos = (wc & 1) ? (t & 63) : (t >> 6); const f32x4* rp = (const f32x4*)(rope + ((size_t)pos * 16 + i0) * 2);
#pragma unroll
                        for (int q = 0; q < 4; ++q) cs[q] = rp[q]; }
                    else {
#pragma unroll
                        for (int q = 0; q < 4; ++q) cs[q] = (f32x4){1.f, 0.f, 1.f, 0.f}; }
#pragma unroll
                    for (int bj = 0; bj < 2; ++bj) {
                        u32x4 w;
                        if (pn == 2 && bj == 1) {
                            w.x = cvt_pk_bf16(v[1][0][0], v[1][0][1]); w.y = cvt_pk_bf16(v[1][0][2], v[1][0][3]); w.z = cvt_pk_bf16(v[1][1][0], v[1][1][1]); w.w = cvt_pk_bf16(v[1][1][2], v[1][1][3]);
                            *(u32x4*)(V + (size_t)r * 128 + wc * 32 + 8 * fq) = w;
                        } else {
                            float o[8];
#pragma unroll
                            for (int n = 0; n < 2; ++n)
#pragma unroll
                                for (int e = 0; e < 4; ++e) { const float mine = v[bj][n][e], other = __shfl_xor(mine, 32); const int q = 2 * n + (e >> 1); const float c = cs[q][2 * (e & 1)], s = cs[q][2 * (e & 1) + 1];
                                    o[4 * n + e] = hi ? (mine * c + other * s) : (mine * c - other * s); }
                            const float qs = (pn == 2) ? 1.f : 0.18033688011112042f;
                            w.x = cvt_pk_bf16(o[0] * qs, o[1] * qs); w.y = cvt_pk_bf16(o[2] * qs, o[3] * qs); w.z = cvt_pk_bf16(o[4] * qs, o[5] * qs); w.w = cvt_pk_bf16(o[6] * qs, o[7] * qs);
                            bf16_t* op = (pn == 2) ? K + (size_t)r * 128 + wc * 32 + 8 * fq : Q + (size_t)r * 512 + pn * BM + bj * HALF + wc * 32 + 8 * fq;
                            *(u32x4*)op = w;
                        } }
                } else if (pn == 3) {
                    int R, j; if (isx) { const int t = r & 8191; R = (r >> 13) * 256 + (t >> 5); j = t & 31; } else { const int rc = r - 16384, t = rc & 255; R = 512 + (rc >> 8) * 8 + (t >> 5); j = t & 31; }
#pragma unroll
                    for (int bj = 0; bj < 2; ++bj) { const int g = 8 * bj + 2 * wc + (fq >> 1); u32x4 w;
                        w.x = cvt_pk_bf16(v[bj][0][0], v[bj][0][1]); w.y = cvt_pk_bf16(v[bj][0][2], v[bj][0][3]); w.z = cvt_pk_bf16(v[bj][1][0], v[bj][1][1]); w.w = cvt_pk_bf16(v[bj][1][2], v[bj][1][3]);
                        *(u32x4*)(UC + ((size_t)(g * 768 + R)) * 768 + j * 16 + 8 * (fq & 1)) = w; }
                } else {
                    u32x4 w; float hgv[8];
#pragma unroll
                    for (int n = 0; n < 2; ++n)
#pragma unroll
                        for (int e = 0; e < 4; ++e) hgv[4 * n + e] = v[0][n][e] * __builtin_amdgcn_rcpf(1.f + __expf(-v[1][n][e]));
                    w.x = cvt_pk_bf16(hgv[0], hgv[1]); w.y = cvt_pk_bf16(hgv[2], hgv[3]); w.z = cvt_pk_bf16(hgv[4], hgv[5]); w.w = cvt_pk_bf16(hgv[6], hgv[7]);
                    *(u32x4*)(HG + (size_t)r * 256 + (pn - 4) * HALF + wc * 32 + 8 * fq) = w;
                }
                asm volatile("" ::: "memory");
            }
    }
};
template <class Epi, class Sched, bool ALIGN_EPI = false, bool SP2 = false>
__device__ __forceinline__ void gemm_phase(PG8_LAS unsigned char* lds, const Gemm g, const Sched& S, const Epi& E) {
    int tid_ = g.wv * 64 + lane_id(); asm volatile("" : "+v"(tid_));
    const int tid = tid_, wid = __builtin_amdgcn_readfirstlane(tid >> 6), lane = tid & 63, wr = wid >> 2, wc = wid & 3, fr = lane & 15, fq = lane >> 4;
    const int K = g.K, nt = K / BK;
    unsigned voffA[2], voffB[2];
#pragma unroll
    for (int i = 0; i < 2; ++i) { int R, C; stage_rc(tid * 16 + i * 8192, R, C); const int Rb = Epi::PERM ? ((R & ~31) + perm32(R & 31)) : R;
        voffA[i] = (unsigned)(R * g.lda + C) * 2u; voffB[i] = (unsigned)(Rb * g.ldb + C) * 2u; }
    const size_t kstep = (size_t)(BK * 2);
    const size_t hstepA = (size_t)HALF * g.lda * 2, hstepB = (size_t)HALF * g.ldb * 2;
    const size_t tstepA = 2 * hstepA, tstepB = 2 * hstepB;
    const unsigned ldsw = (unsigned)wid * 1024u;
    const int aoff = lds_byte(wr * 64 + fr, fq * 8), boff = lds_byte(wc * 32 + fr, fq * 8);
#define PG8_SA(b, h) (((b) * 2 + (h)) * HTB)
#define PG8_SB(b, h) ((4 + (b) * 2 + (h)) * HTB)
#define PG8_STAGE(bufoff, gbase, voff) do { _Pragma("unroll") for (int _i = 0; _i < 2; ++_i) \
        __builtin_amdgcn_global_load_lds((const unsigned*)((const char*)(gbase) + (voff)[_i]), (PG8_LAS unsigned*)(lds + (bufoff) + ldsw + _i * 8192), 16, 0, 0); } while (0)
#define PG8_LDA(dst, b, h) do { _Pragma("unroll") for (int m = 0; m < 4; ++m) _Pragma("unroll") for (int k = 0; k < 2; ++k) dst[m][k] = *(const PG8_LAS bf16x8*)(lds + PG8_SA(b, h) + aoff + m * 2048 + k * 1024); } while (0)
#define PG8_LDB(dst, b, h) do { _Pragma("unroll") for (int n = 0; n < 2; ++n) _Pragma("unroll") for (int k = 0; k < 2; ++k) dst[n][k] = *(const PG8_LAS bf16x8*)(lds + PG8_SB(b, h) + boff + n * 2048 + k * 1024); } while (0)
#define PG8_MMA(ai, bj, At, Bt) do { __builtin_amdgcn_s_setprio(1); _Pragma("unroll") for (int m = 0; m < 4; ++m) _Pragma("unroll") for (int n = 0; n < 2; ++n) _Pragma("unroll") for (int k = 0; k < 2; ++k) \
        acc[ai][bj][m][n] = __builtin_amdgcn_mfma_f32_16x16x32_bf16(Bt[n][k], At[m][k], acc[ai][bj][m][n], 0, 0, 0); __builtin_amdgcn_s_setprio(0); } while (0)
#define PG8_WAIT_V(n) asm volatile("s_waitcnt vmcnt(" #n ")" ::: "memory")
#define PG8_WAIT_L(n) asm volatile("s_waitcnt lgkmcnt(" #n ")" ::: "memory")
#define PG8_BAR __builtin_amdgcn_s_barrier()
#define PG8_SCHED __builtin_amdgcn_sched_barrier(0)
    Unit cur, nxt; int ui = 0;
    if (!S.next(0, cur)) return;
    f32x4 acc[2][2][4][2];
#pragma unroll
    for (int a = 0; a < 2; ++a)
#pragma unroll
        for (int b = 0; b < 2; ++b)
#pragma unroll
            for (int m = 0; m < 4; ++m)
#pragma unroll
                for (int n = 0; n < 2; ++n) acc[a][b][m][n] = (f32x4){0.f, 0.f, 0.f, 0.f};
    bf16x8 At[4][2], B0[2][2], B1[2][2];
    const char* cA = (const char*)g.A + (size_t)cur.pm * tstepA; const char* cB = (const char*)g.Bt + (size_t)cur.pn * tstepB;
    S.a_ready(cur);
    if constexpr (SP2) {
        PG8_STAGE(PG8_SB(0, 0), cB, voffB); PG8_STAGE(PG8_SB(0, 1), cB + hstepB, voffB); PG8_STAGE(PG8_SA(0, 0), cA, voffA); PG8_STAGE(PG8_SA(0, 1), cA + hstepA, voffA);
        if (wr == 1) PG8_BAR;
        PG8_WAIT_V(2); PG8_BAR;
        PG8_STAGE(PG8_SB(1, 0), cB + kstep, voffB); PG8_STAGE(PG8_SA(1, 0), cA + kstep, voffA); PG8_STAGE(PG8_SB(1, 1), cB + hstepB + kstep, voffB);
        PG8_WAIT_V(6); PG8_BAR;
    } else {
        PG8_STAGE(PG8_SB(0, 0), cB, voffB); PG8_STAGE(PG8_SA(0, 0), cA, voffA); PG8_STAGE(PG8_SB(0, 1), cB + hstepB, voffB); PG8_STAGE(PG8_SA(0, 1), cA + hstepA, voffA);
        if (wr == 1) PG8_BAR;
        PG8_WAIT_V(4); PG8_BAR;
        PG8_STAGE(PG8_SB(1, 0), cB + kstep, voffB); PG8_STAGE(PG8_SA(1, 0), cA + kstep, voffA); PG8_STAGE(PG8_SB(1, 1), cB + hstepB + kstep, voffB);
        PG8_WAIT_V(6); PG8_BAR;
    }
    for (;;) {
        const bool has_next = S.next(ui + 1, nxt);
        const char* nA = has_next ? (const char*)g.A + (size_t)nxt.pm * tstepA : cA; const char* nB = has_next ? (const char*)g.Bt + (size_t)nxt.pn * tstepB : cB;
        for (int t = 0; t < nt; t += 2) {
            const bool last = (t == nt - 2);
            const char* a1 = cA + (size_t)(t + 1) * kstep;
            const char* a2 = last ? nA : cA + (size_t)(t + 2) * kstep; const char* b2 = last ? nB : cB + (size_t)(t + 2) * kstep;
            const char* a3 = a2 + kstep; const char* b3 = b2 + kstep;
            if (last && has_next) S.a_ready(nxt);
            if constexpr (SP2) {
            PG8_LDB(B0, 0, 0); PG8_LDB(B1, 0, 1); PG8_SCHED; PG8_LDA(At, 0, 0); PG8_STAGE(PG8_SA(1, 1), a1 + hstepA, voffA);
            PG8_WAIT_V(8); PG8_WAIT_L(0); PG8_BAR; PG8_MMA(0, 0, At, B0); PG8_MMA(0, 1, At, B1); PG8_BAR; PG8_SCHED;
            PG8_LDA(At, 0, 1); PG8_STAGE(PG8_SB(0, 0), b2, voffB); PG8_STAGE(PG8_SB(0, 1), b2 + hstepB, voffB); PG8_STAGE(PG8_SA(0, 0), a2, voffA);
            PG8_WAIT_V(8); PG8_WAIT_L(0); PG8_BAR; PG8_MMA(1, 0, At, B0); PG8_MMA(1, 1, At, B1); PG8_BAR; PG8_SCHED;
            PG8_LDB(B0, 1, 0); PG8_LDB(B1, 1, 1); PG8_SCHED; PG8_LDA(At, 1, 0); PG8_STAGE(PG8_SA(0, 1), a2 + hstepA, voffA);
            PG8_WAIT_V(8); PG8_WAIT_L(0); PG8_BAR; PG8_MMA(0, 0, At, B0); PG8_MMA(0, 1, At, B1); PG8_BAR; PG8_SCHED;
            PG8_LDA(At, 1, 1); PG8_STAGE(PG8_SB(1, 0), b3, voffB); PG8_STAGE(PG8_SB(1, 1), b3 + hstepB, voffB); PG8_STAGE(PG8_SA(1, 0), a3, voffA);
            PG8_WAIT_V(8); PG8_WAIT_L(0); PG8_BAR; PG8_MMA(1, 0, At, B0); PG8_MMA(1, 1, At, B1); PG8_BAR; PG8_SCHED;
            } else {
            PG8_LDB(B0, 0, 0); PG8_SCHED; PG8_LDA(At, 0, 0); PG8_STAGE(PG8_SA(1, 1), a1 + hstepA, voffA);
            PG8_WAIT_L(8); PG8_BAR; PG8_WAIT_L(0); PG8_MMA(0, 0, At, B0); PG8_BAR; PG8_SCHED;
            PG8_LDB(B1, 0, 1); PG8_STAGE(PG8_SB(0, 0), b2, voffB);
            PG8_BAR; PG8_WAIT_L(0); PG8_MMA(0, 1, At, B1); PG8_BAR;
            PG8_LDA(At, 0, 1); PG8_STAGE(PG8_SA(0, 0), a2, voffA);
            PG8_BAR; PG8_WAIT_L(0); PG8_MMA(1, 0, At, B0); PG8_BAR; PG8_SCHED;
            PG8_STAGE(PG8_SB(0, 1), b2 + hstepB, voffB);
            PG8_WAIT_V(6); PG8_BAR; PG8_MMA(1, 1, At, B1); PG8_BAR;
            PG8_LDB(B0, 1, 0); PG8_SCHED; PG8_LDA(At, 1, 0); PG8_STAGE(PG8_SA(0, 1), a2 + hstepA, voffA);
            PG8_WAIT_L(8); PG8_BAR; PG8_WAIT_L(0); PG8_MMA(0, 0, At, B0); PG8_BAR; PG8_SCHED;
            PG8_LDB(B1, 1, 1); PG8_STAGE(PG8_SB(1, 0), b3, voffB);
            PG8_BAR; PG8_WAIT_L(0); PG8_MMA(0, 1, At, B1); PG8_BAR;
            PG8_LDA(At, 1, 1); PG8_STAGE(PG8_SA(1, 0), a3, voffA);
            PG8_BAR; PG8_WAIT_L(0); PG8_MMA(1, 0, At, B0); PG8_BAR; PG8_SCHED;
            PG8_STAGE(PG8_SB(1, 1), b3 + hstepB, voffB);
            PG8_WAIT_V(6); PG8_BAR; PG8_MMA(1, 1, At, B1); PG8_BAR;
            }
        }
        if constexpr (ALIGN_EPI) { if (wr == 0) PG8_BAR; }
        if constexpr (!Epi::AFTER_DRAIN) { E(acc, cur, wr, wc, fr, fq); S.done(cur); }
        if (!has_next) break;
#pragma unroll
        for (int a = 0; a < 2; ++a)
#pragma unroll
            for (int b = 0; b < 2; ++b)
#pragma unroll
                for (int m = 0; m < 4; ++m)
#pragma unroll
                    for (int n = 0; n < 2; ++n) acc[a][b][m][n] = (f32x4){0.f, 0.f, 0.f, 0.f};
        cur = nxt; cA = nA; cB = nB; ++ui;
        if constexpr (ALIGN_EPI) { if (wr == 1) PG8_BAR; }
    }
    PG8_WAIT_V(0);
    if constexpr (!ALIGN_EPI) { if (wr == 0) PG8_BAR; }
    PG8_BAR;
    if constexpr (Epi::AFTER_DRAIN) { E.fused(acc, cur, wr, wc, fr, fq, lds, wid, lane); S.done(cur); }
#undef PG8_SA
#undef PG8_SB
#undef PG8_STAGE
#undef PG8_LDA
#undef PG8_LDB
#undef PG8_MMA
#undef PG8_WAIT_V
#undef PG8_WAIT_L
#undef PG8_BAR
#undef PG8_SCHED
}
typedef int v4i_t __attribute__((ext_vector_type(4)));
typedef int v8i_t __attribute__((ext_vector_type(8)));
#define PG8_CAT(x, y) __builtin_shufflevector(__builtin_bit_cast(v4i_t, x), __builtin_bit_cast(v4i_t, y), 0, 1, 2, 3, 4, 5, 6, 7)
template <class Epi, class Sched, bool ALIGN_EPI = false, bool SP2 = false>
__device__ __forceinline__ void gemm_phase_8(PG8_LAS unsigned char* lds, const Gemm g, const Sched& S, const Epi& E, const int sa, const int sb) {
    int tid_ = g.wv * 64 + lane_id(); asm volatile("" : "+v"(tid_));
    const int tid = tid_, wid = __builtin_amdgcn_readfirstlane(tid >> 6), lane = tid & 63, wr = wid >> 2, wc = wid & 3, fr = lane & 15, fq = lane >> 4;
    const int K = g.K, nt = K / BK;
    unsigned voffA[2], voffB[2];
#pragma unroll
    for (int i = 0; i < 2; ++i) { int R, C; stage_rc(tid * 16 + i * 8192, R, C); const int Rb = Epi::PERM ? ((R & ~31) + perm32(R & 31)) : R;
        voffA[i] = (unsigned)(R * g.lda + C) * 2u; voffB[i] = (unsigned)(Rb * g.ldb + C) * 2u; }
    const size_t kstep = (size_t)(BK * 2);
    const size_t hstepA = (size_t)HALF * g.lda * 2, hstepB = (size_t)HALF * g.ldb * 2;
    const size_t tstepA = 2 * hstepA, tstepB = 2 * hstepB;
    const unsigned ldsw = (unsigned)wid * 1024u;
    const int aoff8[2] = {lds_byte(wr * 64 + fr, 16 * fq), lds_byte(wr * 64 + fr, 16 * fq + 8)}, boff8[2] = {lds_byte(wc * 32 + fr, 16 * fq), lds_byte(wc * 32 + fr, 16 * fq + 8)};
#define PG8_SA(b, h) (((b) * 2 + (h)) * HTB)
#define PG8_SB(b, h) ((4 + (b) * 2 + (h)) * HTB)
#define PG8_STAGE(bufoff, gbase, voff) do { _Pragma("unroll") for (int _i = 0; _i < 2; ++_i) \
        __builtin_amdgcn_global_load_lds((const unsigned*)((const char*)(gbase) + (voff)[_i]), (PG8_LAS unsigned*)(lds + (bufoff) + ldsw + _i * 8192), 16, 0, 0); } while (0)
#define PG8_LDA(dst, b, h) do { _Pragma("unroll") for (int m = 0; m < 4; ++m) { const v4i_t lo_ = *(const PG8_LAS v4i_t*)(lds + PG8_SA(b, h) + aoff8[0] + m * 2048), hi_ = *(const PG8_LAS v4i_t*)(lds + PG8_SA(b, h) + aoff8[1] + m * 2048); dst[m] = __builtin_shufflevector(lo_, hi_, 0, 1, 2, 3, 4, 5, 6, 7); } } while (0)
#define PG8_LDB(dst, b, h) do { _Pragma("unroll") for (int n = 0; n < 2; ++n) { const v4i_t lo_ = *(const PG8_LAS v4i_t*)(lds + PG8_SB(b, h) + boff8[0] + n * 2048), hi_ = *(const PG8_LAS v4i_t*)(lds + PG8_SB(b, h) + boff8[1] + n * 2048); dst[n] = __builtin_shufflevector(lo_, hi_, 0, 1, 2, 3, 4, 5, 6, 7); } } while (0)
#define PG8_MMA(ai, bj, At, Bt) do { if ((ai) ? do1 : do0) { __builtin_amdgcn_s_setprio(1); _Pragma("unroll") for (int m = 0; m < 4; ++m) _Pragma("unroll") for (int n = 0; n < 2; ++n) \
        asm volatile("v_mfma_scale_f32_16x16x128_f8f6f4 %0, %1, %2, %0, %3, %4 op_sel_hi:[0,0,0]" : "+v"(acc[ai][bj][m][n]) : "v"(Bt[n]), "v"(At[m]), "v"(sa), "v"(sb)); __builtin_amdgcn_s_setprio(0); } } while (0)
#define PG8_WAIT_V(n) asm volatile("s_waitcnt vmcnt(" #n ")" ::: "memory")
#define PG8_WAIT_L(n) asm volatile("s_waitcnt lgkmcnt(" #n ")" ::: "memory")
#define PG8_BAR __builtin_amdgcn_s_barrier()
#define PG8_SCHED __builtin_amdgcn_sched_barrier(0)
    Unit cur, nxt; int ui = 0;
    if (!S.next(0, cur)) return;
    bool do0 = wr * 64 < S.vrows(cur), do1 = wr * 64 + HALF < S.vrows(cur);
    f32x4 acc[2][2][4][2];
#pragma unroll
    for (int a = 0; a < 2; ++a)
#pragma unroll
        for (int b = 0; b < 2; ++b)
#pragma unroll
            for (int m = 0; m < 4; ++m)
#pragma unroll
                for (int n = 0; n < 2; ++n) acc[a][b][m][n] = (f32x4){0.f, 0.f, 0.f, 0.f};
    v8i_t At[4], B0[2], B1[2];
    const char* cA = (const char*)g.A + (size_t)cur.pm * tstepA; const char* cB = (const char*)g.Bt + (size_t)cur.pn * tstepB;
    S.a_ready(cur);
    if constexpr (SP2) {
        PG8_STAGE(PG8_SB(0, 0), cB, voffB); PG8_STAGE(PG8_SB(0, 1), cB + hstepB, voffB); PG8_STAGE(PG8_SA(0, 0), cA, voffA); PG8_STAGE(PG8_SA(0, 1), cA + hstepA, voffA);
        if (wr == 1) PG8_BAR;
        PG8_WAIT_V(2); PG8_BAR;
        PG8_STAGE(PG8_SB(1, 0), cB + kstep, voffB); PG8_STAGE(PG8_SA(1, 0), cA + kstep, voffA); PG8_STAGE(PG8_SB(1, 1), cB + hstepB + kstep, voffB);
        PG8_WAIT_V(6); PG8_BAR;
    } else {
        PG8_STAGE(PG8_SB(0, 0), cB, voffB); PG8_STAGE(PG8_SA(0, 0), cA, voffA); PG8_STAGE(PG8_SB(0, 1), cB + hstepB, voffB); PG8_STAGE(PG8_SA(0, 1), cA + hstepA, voffA);
        if (wr == 1) PG8_BAR;
        PG8_WAIT_V(4); PG8_BAR;
        PG8_STAGE(PG8_SB(1, 0), cB + kstep, voffB); PG8_STAGE(PG8_SA(1, 0), cA + kstep, voffA); PG8_STAGE(PG8_SB(1, 1), cB + hstepB + kstep, voffB);
        PG8_WAIT_V(6); PG8_BAR;
    }
    for (;;) {
        const bool has_next = S.next(ui + 1, nxt);
        const char* nA = has_next ? (const char*)g.A + (size_t)nxt.pm * tstepA : cA; const char* nB = has_next ? (const char*)g.Bt + (size_t)nxt.pn * tstepB : cB;
        for (int t = 0; t < nt; t += 2) {
            const bool last = (t == nt - 2);
            const char* a1 = cA + (size_t)(t + 1) * kstep;
            const char* a2 = last ? nA : cA + (size_t)(t + 2) * kstep; const char* b2 = last ? nB : cB + (size_t)(t + 2) * kstep;
            const char* a3 = a2 + kstep; const char* b3 = b2 + kstep;
            if (last && has_next) S.a_ready(nxt);
            if constexpr (SP2) {
            PG8_LDB(B0, 0, 0); PG8_LDB(B1, 0, 1); PG8_SCHED; PG8_LDA(At, 0, 0); PG8_STAGE(PG8_SA(1, 1), a1 + hstepA, voffA);
            PG8_WAIT_V(8); PG8_WAIT_L(0); PG8_BAR; PG8_MMA(0, 0, At, B0); PG8_MMA(0, 1, At, B1); PG8_BAR; PG8_SCHED;
            PG8_LDA(At, 0, 1); PG8_STAGE(PG8_SB(0, 0), b2, voffB); PG8_STAGE(PG8_SB(0, 1), b2 + hstepB, voffB); PG8_STAGE(PG8_SA(0, 0), a2, voffA);
            PG8_WAIT_V(8); PG8_WAIT_L(0); PG8_BAR; PG8_MMA(1, 0, At, B0); PG8_MMA(1, 1, At, B1); PG8_BAR; PG8_SCHED;
            PG8_LDB(B0, 1, 0); PG8_LDB(B1, 1, 1); PG8_SCHED; PG8_LDA(At, 1, 0); PG8_STAGE(PG8_SA(0, 1), a2 + hstepA, voffA);
            PG8_WAIT_V(8); PG8_WAIT_L(0); PG8_BAR; PG8_MMA(0, 0, At, B0); PG8_MMA(0, 1, At, B1); PG8_BAR; PG8_SCHED;
            PG8_LDA(At, 1, 1); PG8_STAGE(PG8_SB(1, 0), b3, voffB); PG8_STAGE(PG8_SB(1, 1), b3 + hstepB, voffB); PG8_STAGE(PG8_SA(1, 0), a3, voffA);
            PG8_WAIT_V(8); PG8_WAIT_L(0); PG8_BAR; PG8_MMA(1, 0, At, B0); PG8_MMA(1, 1, At, B1); PG8_BAR; PG8_SCHED;
            } else {
            PG8_LDB(B0, 0, 0); PG8_SCHED; PG8_LDA(At, 0, 0); PG8_STAGE(PG8_SA(1, 1), a1 + hstepA, voffA);
            PG8_WAIT_L(8); PG8_BAR; PG8_WAIT_L(0); PG8_MMA(0, 0, At, B0); PG8_BAR; PG8_SCHED;
            PG8_LDB(B1, 0, 1); PG8_STAGE(PG8_SB(0, 0), b2, voffB);
            PG8_BAR; PG8_WAIT_L(0); PG8_MMA(0, 1, At, B1); PG8_BAR;
            PG8_LDA(At, 0, 1); PG8_STAGE(PG8_SA(0, 0), a2, voffA);
            PG8_BAR; PG8_WAIT_L(0); PG8_MMA(1, 0, At, B0); PG8_BAR; PG8_SCHED;
            PG8_STAGE(PG8_SB(0, 1), b2 + hstepB, voffB);
            PG8_WAIT_V(6); PG8_BAR; PG8_MMA(1, 1, At, B1); PG8_BAR;
            PG8_LDB(B0, 1, 0); PG8_SCHED; PG8_LDA(At, 1, 0); PG8_STAGE(PG8_SA(0, 1), a2 + hstepA, voffA);
            PG8_WAIT_L(8); PG8_BAR; PG8_WAIT_L(0); PG8_MMA(0, 0, At, B0); PG8_BAR; PG8_SCHED;
            PG8_LDB(B1, 1, 1); PG8_STAGE(PG8_SB(1, 0), b3, voffB);
            PG8_BAR; PG8_WAIT_L(0); PG8_MMA(0, 1, At, B1); PG8_BAR;
            PG8_LDA(At, 1, 1); PG8_STAGE(PG8_SA(1, 0), a3, voffA);
            PG8_BAR; PG8_WAIT_L(0); PG8_MMA(1, 0, At, B0); PG8_BAR; PG8_SCHED;
            PG8_STAGE(PG8_SB(1, 1), b3 + hstepB, voffB);
            PG8_WAIT_V(6); PG8_BAR; PG8_MMA(1, 1, At, B1); PG8_BAR;
            }
        }
        if constexpr (ALIGN_EPI) { if (wr == 0) PG8_BAR; }
        asm volatile("s_nop 15\n\ts_nop 15" ::: "memory"); __builtin_amdgcn_sched_barrier(0);
        if constexpr (!Epi::AFTER_DRAIN) { E(acc, cur, wr, wc, fr, fq); S.done(cur); }
        if (!has_next) break;
#pragma unroll
        for (int a = 0; a < 2; ++a)
#pragma unroll
            for (int b = 0; b < 2; ++b)
#pragma unroll
                for (int m = 0; m < 4; ++m)
#pragma unroll
                    for (int n = 0; n < 2; ++n) acc[a][b][m][n] = (f32x4){0.f, 0.f, 0.f, 0.f};
        cur = nxt; cA = nA; cB = nB; ++ui;
        do0 = wr * 64 < S.vrows(cur); do1 = wr * 64 + HALF < S.vrows(cur);
        if constexpr (ALIGN_EPI) { if (wr == 1) PG8_BAR; }
    }
    PG8_WAIT_V(0);
    if constexpr (!ALIGN_EPI) { if (wr == 0) PG8_BAR; }
    PG8_BAR;
    if constexpr (Epi::AFTER_DRAIN) { E.fused(acc, cur, wr, wc, fr, fq, lds, wid, lane); S.done(cur); }
#undef PG8_SA
#undef PG8_SB
#undef PG8_STAGE
#undef PG8_LDA
#undef PG8_LDB
#undef PG8_MMA
#undef PG8_WAIT_V
#undef PG8_WAIT_L
#undef PG8_BAR
#undef PG8_SCHED
}
template <class Epi, class Sched, bool ALIGN_EPI = false, bool SP2 = false>
__device__ __forceinline__ void gemm_phase_g8(PG8_LAS unsigned char* lds, const Gemm g, const Sched& S, const Epi& E, const int* gidx, const int sa, const int sb) {
    int tid_ = g.wv * 64 + lane_id(); asm volatile("" : "+v"(tid_));
    const int tid = tid_, wid = __builtin_amdgcn_readfirstlane(tid >> 6), lane = tid & 63, wr = wid >> 2, wc = wid & 3, fr = lane & 15, fq = lane >> 4;
    const int K = g.K, nt = K / BK;
    unsigned voffA[2], voffB[2];
#pragma unroll
    for (int i = 0; i < 2; ++i) { int R, C; stage_rc(tid * 16 + i * 8192, R, C); const int Rb = Epi::PERM ? ((R & ~31) + perm32(R & 31)) : R;
        voffA[i] = (unsigned)(R * g.lda + C) * 2u; voffB[i] = (unsigned)(Rb * g.ldb + C) * 2u; }
    int RA[2]; unsigned cAo[2];
#pragma unroll
    for (int i = 0; i < 2; ++i) { int R, C; stage_rc(tid * 16 + i * 8192, R, C); RA[i] = R; cAo[i] = (unsigned)C * 2u; }
    unsigned vcur[2][2], vnxt[2][2], vsel[2][2];
#define PG8_GOFF(pm_, dst) do { _Pragma("unroll") for (int h_ = 0; h_ < 2; ++h_) _Pragma("unroll") for (int i_ = 0; i_ < 2; ++i_) dst[h_][i_] = (unsigned)gidx[(pm_) * BM + h_ * HALF + RA[i_]] * (unsigned)(g.lda * 2) + cAo[i_]; } while (0)
    const size_t kstep = (size_t)(BK * 2);
    const size_t hstepA = (size_t)HALF * g.lda * 2, hstepB = (size_t)HALF * g.ldb * 2;
    const size_t tstepA = 2 * hstepA, tstepB = 2 * hstepB;
    const unsigned ldsw = (unsigned)wid * 1024u;
    const int aoff8[2] = {lds_byte(wr * 64 + fr, 16 * fq), lds_byte(wr * 64 + fr, 16 * fq + 8)}, boff8[2] = {lds_byte(wc * 32 + fr, 16 * fq), lds_byte(wc * 32 + fr, 16 * fq + 8)};
#define PG8_SA(b, h) (((b) * 2 + (h)) * HTB)
#define PG8_SB(b, h) ((4 + (b) * 2 + (h)) * HTB)
#define PG8_STAGE(bufoff, gbase, voff) do { _Pragma("unroll") for (int _i = 0; _i < 2; ++_i) \
        __builtin_amdgcn_global_load_lds((const unsigned*)((const char*)(gbase) + (voff)[_i]), (PG8_LAS unsigned*)(lds + (bufoff) + ldsw + _i * 8192), 16, 0, 0); } while (0)
#define PG8_LDA(dst, b, h) do { _Pragma("unroll") for (int m = 0; m < 4; ++m) { const v4i_t lo_ = *(const PG8_LAS v4i_t*)(lds + PG8_SA(b, h) + aoff8[0] + m * 2048), hi_ = *(const PG8_LAS v4i_t*)(lds + PG8_SA(b, h) + aoff8[1] + m * 2048); dst[m] = __builtin_shufflevector(lo_, hi_, 0, 1, 2, 3, 4, 5, 6, 7); } } while (0)
#define PG8_LDB(dst, b, h) do { _Pragma("unroll") for (int n = 0; n < 2; ++n) { const v4i_t lo_ = *(const PG8_LAS v4i_t*)(lds + PG8_SB(b, h) + boff8[0] + n * 2048), hi_ = *(const PG8_LAS v4i_t*)(lds + PG8_SB(b, h) + boff8[1] + n * 2048); dst[n] = __builtin_shufflevector(lo_, hi_, 0, 1, 2, 3, 4, 5, 6, 7); } } while (0)
#define PG8_MMA(ai, bj, At, Bt) do { if ((ai) ? do1 : do0) { __builtin_amdgcn_s_setprio(1); _Pragma("unroll") for (int m = 0; m < 4; ++m) _Pragma("unroll") for (int n = 0; n < 2; ++n) \
        asm volatile("v_mfma_scale_f32_16x16x128_f8f6f4 %0, %1, %2, %0, %3, %4 op_sel_hi:[0,0,0]" : "+v"(acc[ai][bj][m][n]) : "v"(Bt[n]), "v"(At[m]), "v"(sa), "v"(sb)); __builtin_amdgcn_s_setprio(0); } } while (0)
#define PG8_WAIT_V(n) asm volatile("s_waitcnt vmcnt(" #n ")" ::: "memory")
#define PG8_WAIT_L(n) asm volatile("s_waitcnt lgkmcnt(" #n ")" ::: "memory")
#define PG8_BAR __builtin_amdgcn_s_barrier()
#define PG8_SCHED __builtin_amdgcn_sched_barrier(0)
    Unit cur, nxt; int ui = 0;
    if (!S.next(0, cur)) return;
    bool do0 = wr * 64 < S.vrows(cur), do1 = wr * 64 + HALF < S.vrows(cur);
    f32x4 acc[2][2][4][2];
#pragma unroll
    for (int a = 0; a < 2; ++a)
#pragma unroll
        for (int b = 0; b < 2; ++b)
#pragma unroll
            for (int m = 0; m < 4; ++m)
#pragma unroll
                for (int n = 0; n < 2; ++n) acc[a][b][m][n] = (f32x4){0.f, 0.f, 0.f, 0.f};
    v8i_t At[4], B0[2], B1[2];
    const char* cA = (const char*)g.A; PG8_GOFF(cur.pm, vcur); const char* cB = (const char*)g.Bt + (size_t)cur.pn * tstepB;
    S.a_ready(cur);
    if constexpr (SP2) {
        PG8_STAGE(PG8_SB(0, 0), cB, voffB); PG8_STAGE(PG8_SB(0, 1), cB + hstepB, voffB); PG8_STAGE(PG8_SA(0, 0), cA, vcur[0]); PG8_STAGE(PG8_SA(0, 1), cA, vcur[1]);
        if (wr == 1) PG8_BAR;
        PG8_WAIT_V(2); PG8_BAR;
        PG8_STAGE(PG8_SB(1, 0), cB + kstep, voffB); PG8_STAGE(PG8_SA(1, 0), cA + kstep, vcur[0]); PG8_STAGE(PG8_SB(1, 1), cB + hstepB + kstep, voffB);
        PG8_WAIT_V(6); PG8_BAR;
    } else {
        PG8_STAGE(PG8_SB(0, 0), cB, voffB); PG8_STAGE(PG8_SA(0, 0), cA, vcur[0]); PG8_STAGE(PG8_SB(0, 1), cB + hstepB, voffB); PG8_STAGE(PG8_SA(0, 1), cA, vcur[1]);
        if (wr == 1) PG8_BAR;
        PG8_WAIT_V(4); PG8_BAR;
        PG8_STAGE(PG8_SB(1, 0), cB + kstep, voffB); PG8_STAGE(PG8_SA(1, 0), cA + kstep, vcur[0]); PG8_STAGE(PG8_SB(1, 1), cB + hstepB + kstep, voffB);
        PG8_WAIT_V(6); PG8_BAR;
    }
    for (;;) {
        const bool has_next = S.next(ui + 1, nxt);
        const char* nA = cA; if (has_next) PG8_GOFF(nxt.pm, vnxt); else { _Pragma("unroll") for (int h_ = 0; h_ < 2; ++h_) _Pragma("unroll") for (int i_ = 0; i_ < 2; ++i_) vnxt[h_][i_] = vcur[h_][i_]; } const char* nB = has_next ? (const char*)g.Bt + (size_t)nxt.pn * tstepB : cB;
        for (int t = 0; t < nt; t += 2) {
            const bool last = (t == nt - 2);
            _Pragma("unroll") for (int h_ = 0; h_ < 2; ++h_) _Pragma("unroll") for (int i_ = 0; i_ < 2; ++i_) vsel[h_][i_] = last ? vnxt[h_][i_] : vcur[h_][i_];
            const char* a1 = cA + (size_t)(t + 1) * kstep;
            const char* a2 = last ? nA : cA + (size_t)(t + 2) * kstep; const char* b2 = last ? nB : cB + (size_t)(t + 2) * kstep;
            const char* a3 = a2 + kstep; const char* b3 = b2 + kstep;
            if (last && has_next) S.a_ready(nxt);
            if constexpr (SP2) {
            PG8_LDB(B0, 0, 0); PG8_LDB(B1, 0, 1); PG8_SCHED; PG8_LDA(At, 0, 0); PG8_STAGE(PG8_SA(1, 1), a1, vcur[1]);
            PG8_WAIT_V(8); PG8_WAIT_L(0); PG8_BAR; PG8_MMA(0, 0, At, B0); PG8_MMA(0, 1, At, B1); PG8_BAR; PG8_SCHED;
            PG8_LDA(At, 0, 1); PG8_STAGE(PG8_SB(0, 0), b2, voffB); PG8_STAGE(PG8_SB(0, 1), b2 + hstepB, voffB); PG8_STAGE(PG8_SA(0, 0), a2, vsel[0]);
            PG8_WAIT_V(8); PG8_WAIT_L(0); PG8_BAR; PG8_MMA(1, 0, At, B0); PG8_MMA(1, 1, At, B1); PG8_BAR; PG8_SCHED;
            PG8_LDB(B0, 1, 0); PG8_LDB(B1, 1, 1); PG8_SCHED; PG8_LDA(At, 1, 0); PG8_STAGE(PG8_SA(0, 1), a2, vsel[1]);
            PG8_WAIT_V(8); PG8_WAIT_L(0); PG8_BAR; PG8_MMA(0, 0, At, B0); PG8_MMA(0, 1, At, B1); PG8_BAR; PG8_SCHED;
            PG8_LDA(At, 1, 1); PG8_STAGE(PG8_SB(1, 0), b3, voffB); PG8_STAGE(PG8_SB(1, 1), b3 + hstepB, voffB); PG8_STAGE(PG8_SA(1, 0), a3, vsel[0]);
            PG8_WAIT_V(8); PG8_WAIT_L(0); PG8_BAR; PG8_MMA(1, 0, At, B0); PG8_MMA(1, 1, At, B1); PG8_BAR; PG8_SCHED;
            } else {
            PG8_LDB(B0, 0, 0); PG8_SCHED; PG8_LDA(At, 0, 0); PG8_STAGE(PG8_SA(1, 1), a1, vcur[1]);
            PG8_WAIT_L(8); PG8_BAR; PG8_WAIT_L(0); PG8_MMA(0, 0, At, B0); PG8_BAR; PG8_SCHED;
            PG8_LDB(B1, 0, 1); PG8_STAGE(PG8_SB(0, 0), b2, voffB);
            PG8_BAR; PG8_WAIT_L(0); PG8_MMA(0, 1, At, B1); PG8_BAR;
            PG8_LDA(At, 0, 1); PG8_STAGE(PG8_SA(0, 0), a2, vsel[0]);
            PG8_BAR; PG8_WAIT_L(0); PG8_MMA(1, 0, At, B0); PG8_BAR; PG8_SCHED;
            PG8_STAGE(PG8_SB(0, 1), b2 + hstepB, voffB);
            PG8_WAIT_V(6); PG8_BAR; PG8_MMA(1, 1, At, B1); PG8_BAR;
            PG8_LDB(B0, 1, 0); PG8_SCHED; PG8_LDA(At, 1, 0); PG8_STAGE(PG8_SA(0, 1), a2, vsel[1]);
            PG8_WAIT_L(8); PG8_BAR; PG8_WAIT_L(0); PG8_MMA(0, 0, At, B0); PG8_BAR; PG8_SCHED;
            PG8_LDB(B1, 1, 1); PG8_STAGE(PG8_SB(1, 0), b3, voffB);
            PG8_BAR; PG8_WAIT_L(0); PG8_MMA(0, 1, At, B1); PG8_BAR;
            PG8_LDA(At, 1, 1); PG8_STAGE(PG8_SA(1, 0), a3, vsel[0]);
            PG8_BAR; PG8_WAIT_L(0); PG8_MMA(1, 0, At, B0); PG8_BAR; PG8_SCHED;
            PG8_STAGE(PG8_SB(1, 1), b3 + hstepB, voffB);
            PG8_WAIT_V(6); PG8_BAR; PG8_MMA(1, 1, At, B1); PG8_BAR;
            }
        }
        if constexpr (ALIGN_EPI) { if (wr == 0) PG8_BAR; }
        asm volatile("s_nop 15\n\ts_nop 15" ::: "memory"); __builtin_amdgcn_sched_barrier(0);
        if constexpr (!Epi::AFTER_DRAIN) { E(acc, cur, wr, wc, fr, fq); S.done(cur); }
        if (!has_next) break;
#pragma unroll
        for (int a = 0; a < 2; ++a)
#pragma unroll
            for (int b = 0; b < 2; ++b)
#pragma unroll
                for (int m = 0; m < 4; ++m)
#pragma unroll
                    for (int n = 0; n < 2; ++n) acc[a][b][m][n] = (f32x4){0.f, 0.f, 0.f, 0.f};
        cur = nxt; cA = nA; cB = nB; ++ui; _Pragma("unroll") for (int h_ = 0; h_ < 2; ++h_) _Pragma("unroll") for (int i_ = 0; i_ < 2; ++i_) vcur[h_][i_] = vnxt[h_][i_];
        do0 = wr * 64 < S.vrows(cur); do1 = wr * 64 + HALF < S.vrows(cur);
        if constexpr (ALIGN_EPI) { if (wr == 1) PG8_BAR; }
    }
    PG8_WAIT_V(0);
    if constexpr (!ALIGN_EPI) { if (wr == 0) PG8_BAR; }
    PG8_BAR;
    if constexpr (Epi::AFTER_DRAIN) { E.fused(acc, cur, wr, wc, fr, fq, lds, wid, lane); S.done(cur); }
#undef PG8_GOFF
#undef PG8_SA
#undef PG8_SB
#undef PG8_STAGE
#undef PG8_LDA
#undef PG8_LDB
#undef PG8_MMA
#undef PG8_WAIT_V
#undef PG8_WAIT_L
#undef PG8_BAR
#undef PG8_SCHED
}
#undef PG8_CAT
}
#ifndef PG8_SP2
#define PG8_SP2 true
#endif
#ifndef PG8_ALIGN
#define PG8_ALIGN true
#endif
constexpr int NB = 2, SEQ = 8192, DM = 1024, LCTX = 256, DEPTH = 2;
constexpr int NX = NB * SEQ, NC = NB * LCTX, NR = NX + NC;
constexpr int INW = 1536, NE = 16, FF = 2048, CAPX = 1024, CAPC = 32;
constexpr int SLOTS_E = 2304, NSLOT = NE * SLOTS_E;
constexpr float LN_EPS = 1e-5f, ALPHA = 1.41421356237309515f;
constexpr int NWAVES = 8, NTHREADS = 512;
constexpr int RING_BYTES = 131072, LDS_BYTES = 147456;

constexpr size_t MiB = 1u << 20, KiB = 1u << 10;
constexpr size_t WS_MOD = 1 * MiB;
constexpr size_t WS_ROPE = 1 * MiB + 160 * KiB;
constexpr size_t WS_LBAR = 1 * MiB + 192 * KiB;
constexpr size_t WS_BBAR = 1 * MiB + 256 * KiB;
constexpr size_t WS_BINP = 1 * MiB + 768 * KiB;
constexpr size_t WS_AFF = 2 * MiB;
constexpr size_t WS_AFFC = 3 * MiB;
constexpr size_t WS_IDX = 3 * MiB + 64 * KiB;
constexpr size_t WS_GATE = 3 * MiB + 256 * KiB;
constexpr size_t WS_TOKSLOT = 4 * MiB;
constexpr size_t WS_WIN = 6 * MiB;
constexpr size_t WS_WOUT = 12 * MiB;
constexpr size_t WS_WGU = 16 * MiB;
constexpr size_t WS_WD = 272 * MiB;
constexpr size_t WS_HX = 400 * MiB;
constexpr size_t WS_Q = 433 * MiB;
constexpr size_t WS_K = 450 * MiB;
constexpr size_t WS_V = 455 * MiB;
constexpr size_t WS_U = 460 * MiB;
constexpr size_t WS_HG = 477 * MiB;
constexpr size_t WS_YF = 494 * MiB;
constexpr size_t WS_YB = 511 * MiB;
constexpr size_t WS_CAT = 528 * MiB;
constexpr size_t WS_YMIX = 561 * MiB;
constexpr size_t WS_XS = 528 * MiB;
constexpr size_t WS_XMID = 627 * MiB;
constexpr size_t WS_XCUR = 693 * MiB;
constexpr size_t WS_HID = 759 * MiB;
constexpr size_t WS_PX = 759 * MiB;
constexpr size_t WS_YEXP = 903 * MiB;
constexpr size_t WS_END = 975 * MiB;

#define LAS __attribute__((address_space(3)))
typedef unsigned short bf16;
typedef unsigned v4u __attribute__((ext_vector_type(4)));
typedef unsigned v2u __attribute__((ext_vector_type(2)));
typedef float f32x4 __attribute__((ext_vector_type(4)));
#define LDS_WAIT() asm volatile("s_waitcnt lgkmcnt(0)" ::: "memory")
__device__ __forceinline__ unsigned f2bf(float f) { unsigned u = __builtin_bit_cast(unsigned, f); return (u + 0x7fffu + ((u >> 16) & 1u)) >> 16; }
__device__ __forceinline__ unsigned pk2(float lo, float hi) { return f2bf(lo) | (f2bf(hi) << 16); }
__device__ __forceinline__ float bflo(unsigned w) { return __builtin_bit_cast(float, w << 16); }
__device__ __forceinline__ float bfhi(unsigned w) { return __builtin_bit_cast(float, w & 0xffff0000u); }
__device__ __forceinline__ float bf2f(bf16 b) { return __builtin_bit_cast(float, ((unsigned)b) << 16); }
template <int CTRL> __device__ __forceinline__ float dppf(float x) { return __builtin_bit_cast(float, __builtin_amdgcn_update_dpp(0, __builtin_bit_cast(int, x), CTRL, 0xf, 0xf, true)); }
template <int CTRL> __device__ __forceinline__ int dppi(int x) { return __builtin_amdgcn_update_dpp(0, x, CTRL, 0xf, 0xf, true); }
constexpr int DPP_X1 = 0xB1, DPP_X2 = 0x4E, DPP_HM = 0x141, DPP_RM = 0x140;
__device__ __forceinline__ void swap16(float& a, float& b) { asm("s_nop 1\n\tv_permlane16_swap_b32 %0, %1" : "+v"(a), "+v"(b)); }
__device__ __forceinline__ void swap32(float& a, float& b) { asm("s_nop 1\n\tv_permlane32_swap_b32 %0, %1" : "+v"(a), "+v"(b)); }
__device__ __forceinline__ float xrow_sum(float v) { { float a = v, b = v; swap16(a, b); v = a + b; } { float a = v, b = v; swap32(a, b); v = a + b; } return v; }
__device__ __forceinline__ float row_sum16(float v) { v += dppf<DPP_X1>(v); v += dppf<DPP_X2>(v); v += dppf<DPP_HM>(v); v += dppf<DPP_RM>(v); return v; }
__device__ __forceinline__ float row_max16(float v) { v = fmaxf(v, dppf<DPP_X1>(v)); v = fmaxf(v, dppf<DPP_X2>(v)); v = fmaxf(v, dppf<DPP_HM>(v)); v = fmaxf(v, dppf<DPP_RM>(v)); return v; }
__device__ __forceinline__ float wave_sum(float v) { return xrow_sum(row_sum16(v)); }
__device__ __forceinline__ float wave_max(float v) { v = row_max16(v); { float a = v, b = v; swap16(a, b); v = fmaxf(a, b); } { float a = v, b = v; swap32(a, b); v = fmaxf(a, b); } return v; }
__device__ __forceinline__ int wave_sum_i(int v) {
    v += dppi<DPP_X1>(v); v += dppi<DPP_X2>(v); v += dppi<DPP_HM>(v); v += dppi<DPP_RM>(v);
    float f = __builtin_bit_cast(float, v);
    { float a = f, b = f; swap16(a, b); v = __builtin_bit_cast(int, a) + __builtin_bit_cast(int, b); f = __builtin_bit_cast(float, v); }
    { float a = f, b = f; swap32(a, b); v = __builtin_bit_cast(int, a) + __builtin_bit_cast(int, b); }
    return v;
}
__device__ __forceinline__ float sigmoid_f(float x) { return 1.f / (1.f + __expf(-x)); }
__device__ __forceinline__ float silu_f(float x) { return x / (1.f + __expf(-x)); }
__device__ __forceinline__ float gelu_tanh_f(float x) { const float u = 0.7978845608028654f * (x + 0.044715f * x * x * x); return 0.5f * x * (1.f + tanhf(u)); }

struct Args { const float* in[35]; float* out; unsigned char* ws; int ph_lo, ph_hi, G, pad; };
typedef const __attribute__((address_space(4))) Args* KArgs;
__device__ __forceinline__ KArgs kargs() { unsigned long long p = (unsigned long long)__builtin_amdgcn_kernarg_segment_ptr(); asm volatile("" : "+s"(p)); return (KArgs)p; }

__device__ __forceinline__ unsigned char* launder_ws(unsigned char* p) { unsigned long long v = (unsigned long long)p; asm volatile("" : "+s"(v)); return (unsigned char*)v; }
template <class T> __device__ __forceinline__ T* opq(T* p) { unsigned long long v = (unsigned long long)p; asm volatile("" : "+s"(v)); return (T*)v; }
struct Frame {
    LAS unsigned char* lds;
    int tid, lane, wave, bid, G, gw, NGW;
    unsigned char* ws;
};

__device__ __forceinline__ void s5_build_ops(Frame& F, unsigned char* ws_, KArgs ka, int l, int g);
constexpr size_t WS_WPT_FWD = 5 * MiB + 512 * KiB;
constexpr size_t WS_CTR = 16 * KiB;
__device__ __forceinline__ int maprow(int type, int n0) {
    if (type == 1) return 256 * (n0 >> 7) + (n0 & 127);
    if (type == 2) return 256 * (n0 >> 7) + 128 + (n0 & 127);
    if (type == 3) { if (n0 < 1024) return n0; if (n0 < 1280) { const int ch = n0 - 1024; return 1024 + 256 * (ch >> 7) + (ch & 127); } const int ch = n0 - 1280; return 1024 + 256 * (ch >> 7) + 128 + (ch & 127); }
    return n0;
}
struct TItem { const float* src; unsigned char* dst; int N, rowbytes, f8; float scale; };
__device__ __forceinline__ float sat_e4m3(float x) { return __builtin_amdgcn_fmed3f(x, -448.f, 448.f); }
__device__ __forceinline__ unsigned pack4_fp8(float a, float b, float c, float d) { int w = __builtin_amdgcn_cvt_pk_fp8_f32(sat_e4m3(a), sat_e4m3(b), 0, false); w = __builtin_amdgcn_cvt_pk_fp8_f32(sat_e4m3(c), sat_e4m3(d), w, true); return (unsigned)w; }
__device__ __forceinline__ TItem titem(const float* W, int K, int N, void* WT, int type, int item, int lane, int f8 = 0, float scale = 1.f) {
    const int nblk = N / 32, kb = item / nblk, nb = item % nblk, k0 = 64 * kb, n0 = 32 * nb;
    TItem t; t.src = W + (size_t)(k0 + (lane >> 5)) * N + n0 + (lane & 31); t.N = N; t.f8 = f8; t.scale = scale;
    t.rowbytes = f8 ? K : 2 * K; t.dst = (unsigned char*)WT + (size_t)maprow(type, n0) * t.rowbytes + (f8 ? k0 : 2 * k0); return t;
}
__device__ __forceinline__ void titem_load(const TItem& t, float (&tmp)[32]) {
#pragma unroll
    for (int i = 0; i < 32; ++i) tmp[i] = __builtin_nontemporal_load(t.src + (size_t)(2 * i) * t.N);
}
__device__ __forceinline__ void titem_finish(const TItem& t, const float (&tmp)[32], LAS float* scr, int lane) {
#pragma unroll
    for (int i = 0; i < 32; ++i) scr[(2 * i + (lane >> 5)) * 33 + (lane & 31)] = tmp[i];
    LDS_WAIT(); asm volatile("" ::: "memory");
    const int c = lane & 7;
#pragma unroll
    for (int j = 0; j < 4; ++j) { const int n = (lane >> 3) + 8 * j; const LAS float* s = scr + (8 * c) * 33 + n;
        if (t.f8) { const float sc = t.scale; v2u o; o.x = pack4_fp8(s[0 * 33] * sc, s[1 * 33] * sc, s[2 * 33] * sc, s[3 * 33] * sc); o.y = pack4_fp8(s[4 * 33] * sc, s[5 * 33] * sc, s[6 * 33] * sc, s[7 * 33] * sc);
            *(v2u*)(t.dst + (size_t)n * t.rowbytes + 8 * c) = o; }
        else { v4u o; o.x = pk2(s[0 * 33], s[1 * 33]); o.y = pk2(s[2 * 33], s[3 * 33]); o.z = pk2(s[4 * 33], s[5 * 33]); o.w = pk2(s[6 * 33], s[7 * 33]);
            *(v4u*)(t.dst + (size_t)n * t.rowbytes + 16 * c) = o; } }
    LDS_WAIT(); asm volatile("" ::: "memory");
}
__device__ __forceinline__ void ph_prologue(Frame& F) {
    unsigned char* const ws_ = launder_ws(F.ws);
    KArgs ka = kargs();
    const float* c_in = ka->in[1]; const float* cctx = ka->in[3]; const float* w_mod = ka->in[4]; const float* b_mod = ka->in[5];
    for (int u = F.bid; u < 2 * 96; u += F.G) {
        const int l = u / 96, cc = u % 96;
        LAS float* sv = (LAS float*)F.lds;
        LAS float* part = sv + 3072;
        for (int i = F.tid; i < 3072; i += NTHREADS) { const int v = i >> 10, k = i & 1023; const float x = (v < 2) ? c_in[v * 1024 + k] : cctx[k]; sv[i] = silu_f(x); }
        __syncthreads();
        float a0 = 0.f, a1 = 0.f, a2 = 0.f;
        const float* wp = w_mod + (size_t)l * 1024 * 6144 + cc * 64 + F.lane;
#pragma nounroll
        for (int k0 = 0; k0 < 128; k0 += 32) { float wv[32];
#pragma unroll
            for (int q = 0; q < 32; ++q) wv[q] = __builtin_nontemporal_load(wp + (size_t)(F.wave * 128 + k0 + q) * 6144);
#pragma unroll
            for (int q = 0; q < 32; ++q) { const int k = F.wave * 128 + k0 + q; a0 += sv[k] * wv[q]; a1 += sv[1024 + k] * wv[q]; a2 += sv[2048 + k] * wv[q]; } }
        part[(F.wave * 3 + 0) * 64 + F.lane] = a0; part[(F.wave * 3 + 1) * 64 + F.lane] = a1; part[(F.wave * 3 + 2) * 64 + F.lane] = a2;
        __syncthreads();
        if (F.tid < 192) { const int v = F.tid >> 6, j = F.tid & 63; float s = b_mod[l * 6144 + cc * 64 + j];
#pragma unroll
            for (int w = 0; w < 8; ++w) s += part[(w * 3 + v) * 64 + j];
            ((float*)(ws_ + WS_MOD))[(l * 3 + v) * 6144 + cc * 64 + j] = s; }
        __syncthreads();
    }
    if (F.bid >= 192 && F.bid < 224) { const int u = F.bid - 192; s5_build_ops(F, ws_, ka, u >> 4, u & 15); }
    const int gid = F.bid * NTHREADS + F.tid;
    if (gid < 2048) { const int pos = gid >> 4, i = gid & 15; const double ang = (double)pos * pow(10000.0, -(double)i / 16.0);
        float* rp = (float*)(ws_ + WS_ROPE) + gid * 2; rp[0] = (float)cos(ang); rp[1] = (float)sin(ang); }
    if (gid >= 4096 && gid < 4096 + 3072) { const int i = gid - 4096, l = i / 1536, n = i % 1536; ((float*)(ws_ + WS_BINP))[l * 1536 + maprow(3, n & ~31) + (n & 31)] = ka->in[7][l * 1536 + n]; }
    {
        LAS float* scr = (LAS float*)(F.lds + F.wave * 16384);
        constexpr int S_IN = 16 * 48, S_OUT = 16 * 32, S_PW = 2 * 32, PER_S = S_IN + S_OUT + S_PW;
        for (int it = F.gw; it < 2 * PER_S; it += F.NGW) { const int l_ = it / PER_S; int r_ = it % PER_S; TItem T;
            if (r_ < S_IN) T = titem(ka->in[6] + (size_t)l_ * 1024 * 1536, 1024, 1536, (bf16*)(ws_ + WS_WIN) + (size_t)l_ * 1536 * 1024, 3, r_, F.lane);
            else if ((r_ -= S_IN) < S_OUT) T = titem(ka->in[25] + (size_t)l_ * 1024 * 1024, 1024, 1024, (bf16*)(ws_ + WS_WOUT) + (size_t)l_ * 1024 * 1024, 0, r_, F.lane);
            else { r_ -= S_OUT; const int w_ = r_ >> 5; T = titem(ka->in[w_ ? 23 : 17] + (size_t)l_ * 65536, 256, 256, (bf16*)(ws_ + WS_WPT_FWD) + (size_t)(l_ * 2 + w_) * 65536, 0, r_ & 31, F.lane); }
            float tc[32]; titem_load(T, tc); titem_finish(T, tc, scr, F.lane); }
    }
    __syncthreads();
    {
        LAS float* T = (LAS float*)F.lds;
        LAS unsigned* bc = (LAS unsigned*)(F.lds + 128 * 260 * 4);
        unsigned* ctr = (unsigned*)(ws_ + WS_CTR);
        constexpr int TPM = 64, TPE = 3 * TPM, NT_ALL = 2 * NE * TPE;
        const int lk = F.tid >> 6, ln4 = F.tid & 63;
        const int sn = F.tid >> 1, sq = F.tid & 1;
        struct Tl { const float* src; unsigned char* dst; int N, K; float sc; };
#define TILE_DECODE(t, X) do { const int le_ = (t) / TPE, r_ = (t) % TPE, which_ = r_ / TPM, ti_ = r_ % TPM; \
            if (which_ < 2) { const int kb_ = ti_ >> 3, nb_ = ti_ & 7; X.N = 2048; X.K = 1024; X.sc = 32.f; \
                X.src = ka->in[30 + which_] + (size_t)le_ * 1024 * 2048 + (size_t)(128 * kb_) * 2048 + 256 * nb_; \
                X.dst = ws_ + WS_WGU + (size_t)le_ * 4096 * 1024 + (size_t)(512 * nb_ + 128 * which_) * 1024 + 128 * kb_; } \
            else { const int kb_ = ti_ >> 2, nb_ = ti_ & 3; X.N = 1024; X.K = 2048; X.sc = 64.f; \
                X.src = ka->in[32] + (size_t)le_ * 2048 * 1024 + (size_t)(128 * kb_) * 1024 + 256 * nb_; \
                X.dst = ws_ + WS_WD + (size_t)le_ * 1024 * 2048 + (size_t)(256 * nb_) * 2048 + 128 * kb_; } } while (0)
#define TILE_LOAD(X, R) do { _Pragma("unroll") for (int i = 0; i < 16; ++i) R[i] = __builtin_nontemporal_load((const f32x4*)(X.src + (size_t)(lk + 8 * i) * X.N + 4 * ln4)); } while (0)
#define TILE_DRAW(t) do { __syncthreads(); if (F.tid == 0) bc[0] = __hip_atomic_fetch_add(ctr, 1u, __ATOMIC_RELAXED, __HIP_MEMORY_SCOPE_AGENT); __syncthreads(); t = (int)bc[0]; } while (0)
        int tcur, tnxt; Tl cur, nxt; f32x4 rc[16], rn[16];
        TILE_DRAW(tcur);
        if (tcur < NT_ALL) { TILE_DECODE(tcur, cur); TILE_LOAD(cur, rc);
            for (;;) {
                TILE_DRAW(tnxt);
                const bool has = tnxt < NT_ALL;
                if (has) { TILE_DECODE(tnxt, nxt); TILE_LOAD(nxt, rn); }
#pragma unroll
                for (int i = 0; i < 16; ++i) *(LAS f32x4*)(T + (lk + 8 * i) * 260 + 4 * ln4) = rc[i];
                __syncthreads();
                { const float sc = cur.sc; const LAS float* s = T + (64 * sq) * 260 + sn;
                    const int rowoff = (cur.K == 1024) ? (256 * (sn >> 7) + (sn & 127)) : sn;
                    unsigned char* o = cur.dst + (size_t)rowoff * cur.K + 64 * sq;
#pragma unroll
                    for (int q = 0; q < 4; ++q) { unsigned w[4];
#pragma unroll
                        for (int j = 0; j < 4; ++j) { const int k_ = 16 * q + 4 * j; w[j] = pack4_fp8(s[k_ * 260] * sc, s[(k_ + 1) * 260] * sc, s[(k_ + 2) * 260] * sc, s[(k_ + 3) * 260] * sc); }
                        *(v4u*)(o + 16 * q) = (v4u){w[0], w[1], w[2], w[3]}; } }
                if (!has) break;
                cur = nxt;
#pragma unroll
                for (int i = 0; i < 16; ++i) rc[i] = rn[i];
            } }
#undef TILE_DRAW
#undef TILE_LOAD
#undef TILE_DECODE
    }
}

__device__ __forceinline__ void row_load(const float* p, int lane, f32x4 (&v)[4]) {
#pragma unroll
    for (int j = 0; j < 4; ++j) v[j] = ((const f32x4*)p)[lane + 64 * j];
}
__device__ __forceinline__ void row_ln(f32x4 (&v)[4]) {
    float s = 0.f;
#pragma unroll
    for (int j = 0; j < 4; ++j) s += (v[j].x + v[j].y) + (v[j].z + v[j].w);
    const float mean = wave_sum(s) * (1.f / 1024.f); float s2 = 0.f;
#pragma unroll
    for (int j = 0; j < 4; ++j) { v[j] = v[j] - mean; s2 += (v[j].x * v[j].x + v[j].y * v[j].y) + (v[j].z * v[j].z + v[j].w * v[j].w); }
    const float rstd = 1.f / sqrtf(wave_sum(s2) * (1.f / 1024.f) + LN_EPS);
#pragma unroll
    for (int j = 0; j < 4; ++j) v[j] = v[j] * rstd;
}
__device__ __forceinline__ void row_store_bf16(bf16* p, int lane, const f32x4 (&v)[4]) {
#pragma unroll
    for (int j = 0; j < 4; ++j) { v2u o; o.x = pk2(v[j].x, v[j].y); o.y = pk2(v[j].z, v[j].w); ((v2u*)p)[lane + 64 * j] = o; }
}
__device__ __forceinline__ int row_mod_index(int r) { return r < NX ? (r >> 13) : 2; }
__device__ __forceinline__ void modulate_store(f32x4 (&v)[4], const float* shift, const float* scale, bf16* dst, int lane) {
    f32x4 o[4];
#pragma unroll
    for (int j = 0; j < 4; ++j) { const f32x4 sh = ((const f32x4*)shift)[lane + 64 * j], sc = ((const f32x4*)scale)[lane + 64 * j]; o[j] = v[j] * (sc + 1.f) + sh; }
    row_store_bf16(dst, lane, o);
}
__device__ __forceinline__ void ph_rows0(Frame& F) {
    unsigned char* const ws_ = launder_ws(F.ws);
    KArgs ka = kargs();
    const float* MOD = (const float*)(ws_ + WS_MOD); bf16* HX = (bf16*)(ws_ + WS_HX);
    for (int r = F.gw; r < NR; r += F.NGW) {
        const float* src = r < NX ? ka->in[0] + (size_t)r * 1024 : ka->in[2] + (size_t)(r - NX) * 1024;
        f32x4 v[4]; row_load(src, F.lane, v); row_ln(v);
        const float* m = MOD + (0 * 3 + row_mod_index(r)) * 6144;
        modulate_store(v, m, m + 1024, HX + (size_t)r * 1024, F.lane);
    }
}
constexpr int S5T = 32, S5R = 768, S5K = 768;
constexpr size_t WS_HCTX = 1 * MiB + 800 * KiB;
constexpr size_t WS_LB32 = 1 * MiB + 832 * KiB;
constexpr size_t WS_KT = 975 * MiB;
constexpr size_t WS_BE = 999 * MiB;
constexpr size_t WS_UC = 494 * MiB;
constexpr size_t WS_E = 512 * MiB;
constexpr size_t WS_Z = WS_HID + 100 * MiB;
constexpr size_t WS_CN = WS_Z + (size_t)NR * 256 * 2;
constexpr size_t WS_END2 = 1019 * MiB;

__device__ __forceinline__ void s5_build_ops(Frame& F, unsigned char* ws_, KArgs ka, int l, int g) {
    LAS float* PW = (LAS float*)F.lds; LAS float* CM = PW + 8448; LAS float* BB = CM + 4096; LAS float* LAG = BB + 4096;
    __syncthreads();
    if (F.tid < 128) {
        const int d = F.tid >> 6, p = F.tid & 63; const int ldg = (l * 2 + d) * 16 + g;
        const double lr = ka->in[9][ldg * 64 + p], li = ka->in[10][ldg * 64 + p], dt = exp((double)ka->in[11][ldg]);
        const double zr = lr * dt, zi = li * dt, er = exp(zr), lbr = er * cos(zi), lbi = er * sin(zi);
        double pr = 1.0, pi = 0.0;
#pragma nounroll
        for (int tau = 0; tau <= 32; ++tau) { PW[((d * 33 + tau) * 64 + p) * 2] = (float)pr; PW[((d * 33 + tau) * 64 + p) * 2 + 1] = (float)pi; const double t = pr * lbr - pi * lbi; pi = pr * lbi + pi * lbr; pr = t; }
        const double nr = lbr - 1.0, ni = lbi, den = lr * lr + li * li, cr = (nr * lr + ni * li) / den, ci = (ni * lr - nr * li) / den;
        const float* bre = ka->in[12] + ((size_t)ldg * 64 + p) * 16; const float* bim = ka->in[13] + ((size_t)ldg * 64 + p) * 16;
        for (int c = 0; c < 16; ++c) { const double br = bre[c], bi = bim[c]; BB[((d * 64 + p) * 16 + c) * 2] = (float)(cr * br - ci * bi); BB[((d * 64 + p) * 16 + c) * 2 + 1] = (float)(cr * bi + ci * br); } }
    for (int i = F.tid; i < 2 * 16 * 64; i += NTHREADS) { const int d = i >> 10, r = i & 1023; const int ldg = (l * 2 + d) * 16 + g; CM[2 * i] = ka->in[14][(size_t)ldg * 1024 + r]; CM[2 * i + 1] = ka->in[15][(size_t)ldg * 1024 + r]; }
    __syncthreads();
    for (int it = F.tid; it < 2 * 32 * 16; it += NTHREADS) { const int d = it >> 9, tau = (it >> 4) & 31, c = it & 15;
        float acc[16];
#pragma unroll
        for (int q = 0; q < 16; ++q) acc[q] = 0.f;
        for (int p = 0; p < 64; ++p) { const float cr = CM[((d * 16 + c) * 64 + p) * 2], ci = CM[((d * 16 + c) * 64 + p) * 2 + 1], pr = PW[((d * 33 + tau) * 64 + p) * 2], pi = PW[((d * 33 + tau) * 64 + p) * 2 + 1];
            const float wr = cr * pr - ci * pi, wi = cr * pi + ci * pr;
#pragma unroll
            for (int q = 0; q < 16; ++q) acc[q] += wr * BB[((d * 64 + p) * 16 + q) * 2] - wi * BB[((d * 64 + p) * 16 + q) * 2 + 1]; }
#pragma unroll
        for (int q = 0; q < 16; ++q) LAG[((d * 32 + tau) * 16 + c) * 16 + q] = acc[q]; }
    __syncthreads();
    const float* dsk = ka->in[16] + l * 256 + g * 16;
    bf16* KT = (bf16*)(ws_ + WS_KT) + ((size_t)(l * 16 + g) * 512) * S5K;
    for (int pc = F.tid; pc < 512 * 96; pc += NTHREADS) { const int row = pc / 96, q8 = pc % 96, j = row >> 4, c = row & 15; float v[8];
        if (q8 < 64) { const int jp = q8 >> 1, c0 = (q8 & 1) * 8;
#pragma unroll
            for (int e = 0; e < 8; ++e) { float x = 0.f; if (j >= jp) x += LAG[((0 * 32 + (j - jp)) * 16 + c) * 16 + c0 + e]; if (j <= jp) x += LAG[((1 * 32 + (jp - j)) * 16 + c) * 16 + c0 + e]; if (j == jp && c == c0 + e) x += dsk[c]; v[e] = x; } }
        else { const int n0 = (q8 - 64) * 8, d = n0 >> 7, tau = d ? (32 - j) : (j + 1);
#pragma unroll
            for (int e = 0; e < 8; e += 2) { const int p = ((n0 & 127) + e) >> 1; const float cr = CM[((d * 16 + c) * 64 + p) * 2], ci = CM[((d * 16 + c) * 64 + p) * 2 + 1], pr = PW[((d * 33 + tau) * 64 + p) * 2], pi = PW[((d * 33 + tau) * 64 + p) * 2 + 1];
                v[e] = cr * pr - ci * pi; v[e + 1] = -(cr * pi + ci * pr); } }
        v4u o; o.x = pk2(v[0], v[1]); o.y = pk2(v[2], v[3]); o.z = pk2(v[4], v[5]); o.w = pk2(v[6], v[7]);
        *(v4u*)(KT + (size_t)row * S5K + q8 * 8) = o; }
    bf16* BE = (bf16*)(ws_ + WS_BE) + ((size_t)(l * 16 + g) * 256) * 512;
    for (int pc = F.tid; pc < 256 * 64; pc += NTHREADS) { const int n = pc >> 6, q8 = pc & 63, d = n >> 7, p = (n & 127) >> 1, ri = n & 1, jp = q8 >> 1, c0 = (q8 & 1) * 8, tau = d ? jp : (31 - jp);
        const float pr = PW[((d * 33 + tau) * 64 + p) * 2], pi = PW[((d * 33 + tau) * 64 + p) * 2 + 1]; float v[8];
#pragma unroll
        for (int e = 0; e < 8; ++e) { const float br = BB[((d * 64 + p) * 16 + c0 + e) * 2], bi = BB[((d * 64 + p) * 16 + c0 + e) * 2 + 1]; v[e] = ri ? (pr * bi + pi * br) : (pr * br - pi * bi); }
        v4u o; o.x = pk2(v[0], v[1]); o.y = pk2(v[2], v[3]); o.z = pk2(v[4], v[5]); o.w = pk2(v[6], v[7]);
        *(v4u*)(BE + (size_t)n * 512 + q8 * 8) = o; }
    if (F.tid < 128) { const int d = F.tid >> 6, p = F.tid & 63; float* o = (float*)(ws_ + WS_LB32) + (((size_t)(l * 16 + g) * 2 + d) * 64 + p) * 2; o[0] = PW[((d * 33 + 32) * 64 + p) * 2]; o[1] = PW[((d * 33 + 32) * 64 + p) * 2 + 1]; }
    __syncthreads();
}
__device__ __forceinline__ void s5_carry_tile(Frame& F, int l, int g, int mt) {
    unsigned char* const ws_ = launder_ws(F.ws);
    if (mt < 2) {
        const int b = mt, seg = F.tid >> 7, d = (F.tid >> 6) & 1, p = F.tid & 63, dp = F.tid & 127;
        const float* lb = (const float*)(ws_ + WS_LB32) + (((size_t)(l * 16 + g) * 2 + d) * 64 + p) * 2; const float ar = lb[0], ai = lb[1];
        const float* E = (const float*)(ws_ + WS_E) + ((size_t)g * S5R) * 256 + d * 128 + 2 * p;
        bf16* UC = (bf16*)(ws_ + WS_UC) + ((size_t)g * S5R) * S5K + 512 + d * 128 + 2 * p;
        LAS float* Ls = (LAS float*)F.lds;
        float er[64], ei[64], cr[8], ci[8];
#pragma unroll
        for (int q = 0; q < 8; ++q) { const int R = 512 + b * 8 + (d ? 7 - q : q); const float2 e2 = *(const float2*)(E + (size_t)R * 256); cr[q] = e2.x; ci[q] = e2.y; }
        const int R0 = b * 256 + (d ? 255 - 64 * seg : 64 * seg); const long estep = d ? -256 : 256, ustep = d ? -(long)S5K : (long)S5K;
        { const float* ep = E + (size_t)R0 * 256;
#pragma unroll
          for (int q = 0; q < 64; ++q) { const float2 e2 = *(const float2*)ep; er[q] = e2.x; ei[q] = e2.y; ep += estep; } }
        float sr = 0.f, si = 0.f;
#pragma unroll
        for (int q = 0; q < 8; ++q) { const float nr = ar * sr - ai * si + cr[q], ni = ar * si + ai * sr + ci[q]; sr = nr; si = ni; }
        float lr = 0.f, li = 0.f;
#pragma unroll
        for (int q = 0; q < 64; ++q) { const float nr = ar * lr - ai * li + er[q], ni = ar * li + ai * lr + ei[q]; lr = nr; li = ni; }
        float pr = ar, pi = ai;
#pragma unroll
        for (int i = 0; i < 6; ++i) { const float t = pr * pr - pi * pi; pi = 2.f * pr * pi; pr = t; }
        Ls[(seg * 128 + dp) * 2] = lr; Ls[(seg * 128 + dp) * 2 + 1] = li;
        __syncthreads();
        for (int s_ = 0; s_ < seg; ++s_) { const float Lr = Ls[(s_ * 128 + dp) * 2], Li = Ls[(s_ * 128 + dp) * 2 + 1]; const float nr = pr * sr - pi * si + Lr, ni = pr * si + pi * sr + Li; sr = nr; si = ni; }
        { bf16* up = UC + (size_t)R0 * S5K;
#pragma unroll
          for (int q = 0; q < 64; ++q) { *(unsigned*)up = pk2(sr, si); up += ustep;
            const float nr = ar * sr - ai * si + er[q], ni = ar * si + ai * sr + ei[q]; sr = nr; si = ni; } }
    } else if (F.tid < 256) { const int b = F.tid >> 7, d = (F.tid >> 6) & 1, p = F.tid & 63;
        const float* lb = (const float*)(ws_ + WS_LB32) + (((size_t)(l * 16 + g) * 2 + d) * 64 + p) * 2; const float ar = lb[0], ai = lb[1];
        float sr = 0.f, si = 0.f;
        const float* E = (const float*)(ws_ + WS_E) + ((size_t)g * S5R) * 256 + d * 128 + 2 * p;
        bf16* UC = (bf16*)(ws_ + WS_UC) + ((size_t)g * S5R) * S5K + 512 + d * 128 + 2 * p;
        float er[8], ei[8];
#pragma unroll
        for (int q = 0; q < 8; ++q) { const int R = 512 + b * 8 + (d ? 7 - q : q); const float2 e2 = *(const float2*)(E + (size_t)R * 256); er[q] = e2.x; ei[q] = e2.y; }
#pragma unroll
        for (int q = 0; q < 8; ++q) { const int R = 512 + b * 8 + (d ? 7 - q : q); *(unsigned*)(UC + (size_t)R * S5K) = pk2(sr, si);
            const float nr = ar * sr - ai * si + er[q], ni = ar * si + ai * sr + ei[q]; sr = nr; si = ni; }
    }
    asm volatile("s_waitcnt vmcnt(0)" ::: "memory");
    __syncthreads();
}
typedef short bf16x8_t __attribute__((ext_vector_type(8)));
typedef short bf16x4_t __attribute__((ext_vector_type(4)));
typedef float f32x16 __attribute__((ext_vector_type(16)));
typedef unsigned u32x4_t __attribute__((ext_vector_type(4)));
constexpr int AT_KROW = 72, AT_VROW = 388;
constexpr int AT_KBYTES = 640 * AT_KROW * 2, AT_VBYTES = 64 * AT_VROW * 2, AT_SCR = AT_KBYTES + AT_VBYTES;
static_assert(AT_SCR + 8 * 64 * 4 <= LDS_BYTES, "attention LDS");
__device__ __forceinline__ int at_crow(int r, int h) { return (r & 3) + 8 * (r >> 2) + 4 * h; }
__device__ __forceinline__ float mx2(float a, float b, float inf) { return __builtin_amdgcn_fmed3f(a, b, inf); }
__device__ __forceinline__ float max16(const f32x16& s, float inf) { const float a = mx2(mx2(s[0], s[1], inf), mx2(s[2], s[3], inf), inf), b = mx2(mx2(s[4], s[5], inf), mx2(s[6], s[7], inf), inf), c = mx2(mx2(s[8], s[9], inf), mx2(s[10], s[11], inf), inf), d = mx2(mx2(s[12], s[13], inf), mx2(s[14], s[15], inf), inf); return mx2(mx2(a, b, inf), mx2(c, d, inf), inf); }
__device__ __forceinline__ void ph_attn(Frame& F, int l, int ulo, int uhi, int wgi, int nwg) {
    unsigned char* const ws_ = launder_ws(F.ws);
    KArgs ka = kargs();
    const bf16* Q = (const bf16*)(ws_ + WS_Q); const bf16* K = (const bf16*)(ws_ + WS_K); const bf16* V = (const bf16*)(ws_ + WS_V);
    bf16* CAT = (bf16*)(ws_ + WS_CAT); const float* sink = ka->in[8] + l * 8;
    LAS bf16* Ks = (LAS bf16*)F.lds; LAS bf16* Vt = (LAS bf16*)(F.lds + AT_KBYTES); LAS float* scr = (LAS float*)(F.lds + AT_SCR) + F.wave * 64;
    const int lane = F.lane, l31 = lane & 31, h = lane >> 5, hh = F.wave >> 1, qh = F.wave & 1;
    for (int u = ulo + wgi; u < uhi; u += nwg) {
        int b, kvh, n, qrow0; bool win;
        if (u < 256) { b = u >> 7; kvh = (u >> 6) & 1; n = u & 63; win = true; qrow0 = b * SEQ + n * 128; }
        else { const int uc = u - 256; b = uc >> 2; kvh = (uc >> 1) & 1; n = uc & 1; win = false; qrow0 = NX + b * LCTX + n * 128; }
        __syncthreads();
#define AT_VT_WRITE(A_, B_, kp2_, ch_) do { LAS unsigned* vp_ = (LAS unsigned*)(Vt + ((ch_) * 8) * AT_VROW + 2 * (kp2_)); \
            vp_[0] = (A_.x & 0xffffu) | (B_.x << 16); vp_[AT_VROW / 2] = (A_.x >> 16) | (B_.x & 0xffff0000u); vp_[2 * (AT_VROW / 2)] = (A_.y & 0xffffu) | (B_.y << 16); vp_[3 * (AT_VROW / 2)] = (A_.y >> 16) | (B_.y & 0xffff0000u); \
            vp_[4 * (AT_VROW / 2)] = (A_.z & 0xffffu) | (B_.z << 16); vp_[5 * (AT_VROW / 2)] = (A_.z >> 16) | (B_.z & 0xffff0000u); vp_[6 * (AT_VROW / 2)] = (A_.w & 0xffffu) | (B_.w << 16); vp_[7 * (AT_VROW / 2)] = (A_.w >> 16) | (B_.w & 0xffff0000u); } while (0)
        int tid_ = F.tid; asm volatile("" : "+v"(tid_));
        {
            v4u kv[10], va[3], vb[3];
#pragma unroll
            for (int i = 0; i < 10; ++i) { kv[i] = (v4u){0u, 0u, 0u, 0u};
                if (win || i >= 6) { const int pc = tid_ + NTHREADS * i, row = pc >> 3, ch = pc & 7;
                    if (i < 6) { const int kp = 128 * (n - 1) + row; if (kp >= 0 && kp < SEQ) kv[i] = *(const v4u*)(K + ((size_t)(b * SEQ + kp)) * 128 + kvh * 64 + ch * 8); }
                    else kv[i] = *(const v4u*)(K + ((size_t)(NX + b * LCTX + row - 384)) * 128 + kvh * 64 + ch * 8); } }
            if (win) {
#pragma unroll
                for (int it = 0; it < 3; ++it) { const int idx = tid_ + NTHREADS * it, kp2 = idx >> 3, ch = idx & 7, kp = 128 * (n - 1) + 2 * kp2; va[it] = (v4u){0u, 0u, 0u, 0u}; vb[it] = va[it];
                    if (kp >= 0 && kp < SEQ) { const bf16* vsrc = V + ((size_t)(b * SEQ + kp)) * 128 + kvh * 64 + ch * 8; va[it] = *(const v4u*)vsrc; vb[it] = *(const v4u*)(vsrc + 128); } } }
#pragma unroll
            for (int i = 0; i < 10; ++i) if (win || i >= 6) { const int pc = tid_ + NTHREADS * i, row = pc >> 3, ch = pc & 7; *(LAS v4u*)(Ks + row * AT_KROW + ch * 8) = kv[i]; }
            if (win) {
#pragma unroll
                for (int it = 0; it < 3; ++it) { const int idx = tid_ + NTHREADS * it, kp2 = idx >> 3, ch = idx & 7; AT_VT_WRITE(va[it], vb[it], kp2, ch); } }
        }
        const int head = kvh * 4 + hh; const int qbase = qh * 64;
        bf16x8_t qf[2][4];
#pragma unroll
        for (int qb = 0; qb < 2; ++qb)
#pragma unroll
            for (int s = 0; s < 4; ++s) qf[qb][s] = *(const bf16x8_t*)(Q + ((size_t)(qrow0 + qbase + qb * 32 + l31)) * 512 + head * 64 + 16 * s + 8 * h);
        __syncthreads();
        const int qpos0 = n * 128 + qbase + l31;
        const int klo0 = max(qpos0 - 128, 0), klo1 = max(qpos0 + 32 - 128, 0); const unsigned span0 = (unsigned)(min(qpos0 + 128, SEQ - 1) - klo0), span1 = (unsigned)(min(qpos0 + 32 + 128, SEQ - 1) - klo1);
        const int wlo = win ? (qh ? 2 : 0) : 12, whi = win ? (qh ? 12 : 10) : 12;
#define AT_SCORES(st, S0, S1, MASKED, I0, I1) do { \
            const LAS bf16* kp_ = Ks + ((st) * 32 + l31) * AT_KROW + 8 * h; \
            _Pragma("unroll") for (int s = 0; s < 4; ++s) { const bf16x8_t kf = *(const LAS bf16x8_t*)(kp_ + 16 * s); \
                S0 = __builtin_amdgcn_mfma_f32_32x32x16_bf16(kf, qf[0][s], s ? S0 : (I0), 0, 0, 0); S1 = __builtin_amdgcn_mfma_f32_32x32x16_bf16(kf, qf[1][s], s ? S1 : (I1), 0, 0, 0); } \
            if ((MASKED) && (st) < 12 && ((st) < 4 || (st) >= 8)) { const int d0_ = 128 * (n - 1) + (st) * 32 + 4 * h - klo0, d1_ = d0_ + klo0 - klo1;     \
                _Pragma("unroll") for (int r = 0; r < 16; ++r) { const int c_ = (r & 3) + 8 * (r >> 2); \
                    if ((unsigned)(d0_ + c_) > span0) S0[r] = -1e30f; if ((unsigned)(d1_ + c_) > span1) S1[r] = -1e30f; } } \
        } while (0)
        const f32x16 Z16 = (f32x16){0.f,0.f,0.f,0.f,0.f,0.f,0.f,0.f,0.f,0.f,0.f,0.f,0.f,0.f,0.f,0.f};
        float m0 = -1e30f, m1 = -1e30f, INF_ = __builtin_inff(); asm volatile("" : "+v"(INF_));
#define AT_KLOAD(st, KF) do { const LAS bf16* kp_ = Ks + ((st) * 32 + l31) * AT_KROW + 8 * h; _Pragma("unroll") for (int s = 0; s < 4; ++s) KF[s] = *(const LAS bf16x8_t*)(kp_ + 16 * s); } while (0)
#define AT_QK(KF, S0, S1, I0, I1) do { _Pragma("unroll") for (int s = 0; s < 4; ++s) { S0 = __builtin_amdgcn_mfma_f32_32x32x16_bf16(KF[s], qf[0][s], s ? S0 : (I0), 0, 0, 0); S1 = __builtin_amdgcn_mfma_f32_32x32x16_bf16(KF[s], qf[1][s], s ? S1 : (I1), 0, 0, 0); } } while (0)
        const int nw = whi - wlo, nt = nw + 8;
#define AT_STOF(j) ((j) < nw ? wlo + (j) : 12 + (j) - nw)
        { bf16x8_t kA[4], kB[4]; f32x16 Sa0, Sa1, Sb0, Sb1;
        AT_KLOAD(AT_STOF(0), kA);
#pragma nounroll
        for (int j = 0; j < nt; j += 2) {
            AT_KLOAD(AT_STOF(j + 1), kB);
            __builtin_amdgcn_sched_barrier(0);
            AT_QK(kA, Sa0, Sa1, Z16, Z16);
            __builtin_amdgcn_sched_barrier(0);
            if (j + 2 < nt) AT_KLOAD(AT_STOF(j + 2), kA);
            __builtin_amdgcn_sched_barrier(0);
            AT_QK(kB, Sb0, Sb1, Z16, Z16);
            m0 = mx2(m0, max16(Sa0, INF_), INF_); m1 = mx2(m1, max16(Sa1, INF_), INF_);
            __builtin_amdgcn_sched_barrier(0);
            m0 = mx2(m0, max16(Sb0, INF_), INF_); m1 = mx2(m1, max16(Sb1, INF_), INF_);
        } }
        m0 = fmaxf(m0, __shfl_xor(m0, 32)); m1 = fmaxf(m1, __shfl_xor(m1, 32));
        const float sk = sink[head] * 1.4426950408889634f;
        m0 = fmaxf(m0, sk); m1 = fmaxf(m1, sk);
        float l0 = 0.f, l1 = 0.f; f32x16 O[2][2], NM0, NM1;
#pragma unroll
        for (int r = 0; r < 16; ++r) { NM0[r] = -m0; NM1[r] = -m1; }
#pragma unroll
        for (int a_ = 0; a_ < 2; ++a_)
#pragma unroll
            for (int b_ = 0; b_ < 2; ++b_) O[a_][b_] = (f32x16){0.f,0.f,0.f,0.f,0.f,0.f,0.f,0.f,0.f,0.f,0.f,0.f,0.f,0.f,0.f,0.f};
#define AT_PV(st, voff) do { f32x16 S0, S1; AT_SCORES(st, S0, S1, true, NM0, NM1);     \
            _Pragma("unroll") for (int r = 0; r < 16; ++r) { S0[r] = __builtin_amdgcn_exp2f(S0[r]); S1[r] = __builtin_amdgcn_exp2f(S1[r]);     l0 += S0[r]; l1 += S1[r]; } \
            _Pragma("unroll") for (int ks = 0; ks < 2; ++ks) { \
                u32x4_t pa0, pa1; \
                pa0.x = pg8::cvt_pk_bf16(S0[8 * ks + 0], S0[8 * ks + 1]); pa0.y = pg8::cvt_pk_bf16(S0[8 * ks + 2], S0[8 * ks + 3]); pa0.z = pg8::cvt_pk_bf16(S0[8 * ks + 4], S0[8 * ks + 5]); pa0.w = pg8::cvt_pk_bf16(S0[8 * ks + 6], S0[8 * ks + 7]); \
                pa1.x = pg8::cvt_pk_bf16(S1[8 * ks + 0], S1[8 * ks + 1]); pa1.y = pg8::cvt_pk_bf16(S1[8 * ks + 2], S1[8 * ks + 3]); pa1.z = pg8::cvt_pk_bf16(S1[8 * ks + 4], S1[8 * ks + 5]); pa1.w = pg8::cvt_pk_bf16(S1[8 * ks + 6], S1[8 * ks + 7]); \
                _Pragma("unroll") for (int db = 0; db < 2; ++db) { const LAS bf16* vp_ = Vt + (db * 32 + l31) * AT_VROW + (voff) + 16 * ks + 4 * h; \
                    const bf16x4_t lo_ = *(const LAS bf16x4_t*)vp_, hi_ = *(const LAS bf16x4_t*)(vp_ + 8); \
                    const bf16x8_t vf = (bf16x8_t){lo_[0], lo_[1], lo_[2], lo_[3], hi_[0], hi_[1], hi_[2], hi_[3]}; \
                    O[0][db] = __builtin_amdgcn_mfma_f32_32x32x16_bf16(__builtin_bit_cast(bf16x8_t, pa0), vf, O[0][db], 0, 0, 0); \
                    O[1][db] = __builtin_amdgcn_mfma_f32_32x32x16_bf16(__builtin_bit_cast(bf16x8_t, pa1), vf, O[1][db], 0, 0, 0); } } \
        } while (0)
        if (win) {
#pragma nounroll
            for (int st = wlo; st < whi; ++st) AT_PV(st, st * 32); }
        v4u ca[2], cb[2];
#pragma unroll
        for (int it = 0; it < 2; ++it) { const int idx = tid_ + NTHREADS * it, kp2 = idx >> 3, ch = idx & 7; const bf16* vsrc = V + ((size_t)(NX + b * LCTX + 2 * kp2)) * 128 + kvh * 64 + ch * 8; ca[it] = *(const v4u*)vsrc; cb[it] = *(const v4u*)(vsrc + 128); }
        __syncthreads();
#pragma unroll
        for (int it = 0; it < 2; ++it) { const int idx = tid_ + NTHREADS * it, kp2 = idx >> 3, ch = idx & 7; AT_VT_WRITE(ca[it], cb[it], kp2, ch); }
        __syncthreads();
#pragma nounroll
        for (int st = 12; st < 20; ++st) AT_PV(st, (st - 12) * 32);
#undef AT_PV
#undef AT_VT_WRITE
#undef AT_SCORES
#undef AT_KLOAD
#undef AT_QK
#undef AT_STOF
        l0 += __shfl_xor(l0, 32); l1 += __shfl_xor(l1, 32);
        l0 += __builtin_amdgcn_exp2f(sk - m0); l1 += __builtin_amdgcn_exp2f(sk - m1);
        if (h == 0) { scr[l31] = 1.f / l0; scr[32 + l31] = 1.f / l1; }
        LDS_WAIT();
#pragma unroll
        for (int qb = 0; qb < 2; ++qb)
#pragma unroll
            for (int r = 0; r < 16; ++r) { const int qq = at_crow(r, h); const float inv = scr[qb * 32 + qq]; const size_t row = (size_t)(qrow0 + qbase + qb * 32 + qq);
#pragma unroll
                for (int db = 0; db < 2; ++db) CAT[row * 1024 + head * 64 + db * 32 + l31] = (bf16)f2bf(O[qb][db][r] * inv); }
    }
}
constexpr size_t WS_WPT = 5 * MiB + 512 * KiB;
__device__ __forceinline__ void ph_conv(Frame& F, int l, int tlo, int thi, int wgi, int nwg, unsigned* ctr) {
    unsigned char* const ws_ = launder_ws(F.ws);
    KArgs ka = kargs();
    const bf16* HG = (const bf16*)(ws_ + WS_HG); bf16* CN = (bf16*)(ws_ + WS_CN);
    LAS float* Hs = (LAS float*)F.lds; LAS float* Ws = Hs + 94 * 256;
    const int lane = F.lane, c4 = 4 * lane;
    __syncthreads();
    for (int i = F.tid; i < 31 * 256; i += NTHREADS) Ws[i] = ka->in[19][(size_t)l * 31 * 256 + i];
    const f32x4 bd = *(const f32x4*)(ka->in[20] + l * 256 + c4), lg = *(const f32x4*)(ka->in[21] + l * 256 + c4), lb = *(const f32x4*)(ka->in[22] + l * 256 + c4);
    LAS unsigned* bc = (LAS unsigned*)(F.lds + 131072);
#define CONV_DRAW(t) do { __syncthreads(); if (F.tid == 0) bc[0] = __hip_atomic_fetch_add(ctr, 1u, __ATOMIC_RELAXED, __HIP_MEMORY_SCOPE_AGENT); __syncthreads(); t = tlo + (int)bc[0]; } while (0)
    int tile = tlo + wgi; if (ctr) CONV_DRAW(tile);
    for (; tile < thi; ) {
        int t0, base, len;
        if (tile < 256) { t0 = (tile & 127) * 64; base = (tile >> 7) * SEQ; len = SEQ; } else { const int tc = tile - 256; t0 = (tc & 3) * 64; base = NX + (tc >> 2) * LCTX; len = LCTX; }
        __syncthreads();
        { v2u hw[12];
#pragma unroll
          for (int it = 0; it < 12; ++it) { const int idx = F.tid + NTHREADS * it, rr = idx >> 6, cc = (idx & 63) * 4, tt = t0 - 15 + rr; hw[it] = (v2u){0u, 0u};
              if (idx < 94 * 64 && tt >= 0 && tt < len) hw[it] = *(const v2u*)(HG + ((size_t)(base + tt)) * 256 + cc); }
#pragma unroll
          for (int it = 0; it < 12; ++it) { const int idx = F.tid + NTHREADS * it, rr = idx >> 6, cc = (idx & 63) * 4;
              if (idx < 94 * 64) *(LAS f32x4*)(Hs + rr * 256 + cc) = (f32x4){bflo(hw[it].x), bfhi(hw[it].x), bflo(hw[it].y), bfhi(hw[it].y)}; } }
        __syncthreads();
        {
            const int row0 = F.wave * 8; f32x4 acc[8], win[8];
#pragma unroll
            for (int i = 0; i < 8; ++i) acc[i] = bd;
#pragma unroll
            for (int i = 0; i < 7; ++i) win[i] = *(const LAS f32x4*)(Hs + (row0 + i) * 256 + c4);
#pragma unroll
            for (int k = 0; k < 31; ++k) { win[(k + 7) & 7] = *(const LAS f32x4*)(Hs + (row0 + k + 7) * 256 + c4); const f32x4 wv = *(const LAS f32x4*)(Ws + k * 256 + c4);
#pragma unroll
                for (int i = 0; i < 8; ++i) acc[i] += win[(k + i) & 7] * wv; }
#pragma unroll
            for (int i = 0; i < 8; ++i) {
                const float mean = wave_sum((acc[i].x + acc[i].y) + (acc[i].z + acc[i].w)) * (1.f / 256.f); const f32x4 dv = acc[i] - mean;
                const float var = wave_sum((dv.x * dv.x + dv.y * dv.y) + (dv.z * dv.z + dv.w * dv.w)) * (1.f / 256.f); const float rstd = 1.f / sqrtf(var + LN_EPS);
                const f32x4 y = dv * rstd * lg + lb;
                v2u o; o.x = pk2(silu_f(y.x), silu_f(y.y)); o.y = pk2(silu_f(y.z), silu_f(y.w));
                *(v2u*)(CN + ((size_t)(base + t0 + row0 + i)) * 256 + c4) = o; }
        }
        if (ctr) CONV_DRAW(tile); else tile += nwg;
    }
#undef CONV_DRAW
}
__device__ __forceinline__ int block_sum_i(Frame& F, int v, LAS int* red, int slot) {
    const int w = wave_sum_i(v); if (F.lane == 0) red[slot * 8 + F.wave] = w; __syncthreads();
    int s = 0;
#pragma unroll
    for (int i = 0; i < 8; ++i) s += red[slot * 8 + i];
    return s;
}
__device__ __forceinline__ int wave_incl_scan_i(int v) {
    v += __builtin_amdgcn_update_dpp(0, v, 0x111, 0xf, 0xf, true); v += __builtin_amdgcn_update_dpp(0, v, 0x112, 0xf, 0xf, true);
    v += __builtin_amdgcn_update_dpp(0, v, 0x114, 0xf, 0xf, true); v += __builtin_amdgcn_update_dpp(0, v, 0x118, 0xf, 0xf, true);
    v += __builtin_amdgcn_update_dpp(0, v, 0x142, 0xa, 0xf, false);
    v += __builtin_amdgcn_update_dpp(0, v, 0x143, 0xc, 0xf, false);
    return v;
}
__device__ __forceinline__ int block_excl_scan_i(Frame& F, int v, LAS int* red) {
    const int inc = wave_incl_scan_i(v);
    __syncthreads();
    if (F.lane == 63) red[F.wave] = inc;
    __syncthreads();
    int base = 0;
#pragma unroll
    for (int i = 0; i < 8; ++i) if (i < F.wave) base += red[i];
    return base + inc - v;
}
template <int N, int CAP> __device__ __forceinline__ void route_unit(Frame& F, const float* aff, int e, int rowbase, int slotbase) {
    unsigned char* const ws_ = launder_ws(F.ws);
    constexpr int EPT = (N >= NTHREADS) ? N / NTHREADS : 1;
    static_assert(EPT == 16 || EPT == 1, "route_unit");
    LAS unsigned* hist = (LAS unsigned*)F.lds; LAS int* red = (LAS int*)(F.lds + 4096);
    int* IDX = (int*)(ws_ + WS_IDX); float* GATE = (float*)(ws_ + WS_GATE); int* TOK = (int*)(ws_ + WS_TOKSLOT);
    const bool have = (EPT == 16) || F.tid < N; const int i0 = F.tid * EPT;
    unsigned k[EPT];
    if (EPT == 16) {
#pragma unroll
        for (int q = 0; q < 4; ++q) { const v4u w = ((const v4u*)(aff + i0))[q]; k[4 * q % EPT] = w.x; k[(4 * q + 1) % EPT] = w.y; k[(4 * q + 2) % EPT] = w.z; k[(4 * q + 3) % EPT] = w.w; }
    } else k[0] = have ? __builtin_bit_cast(unsigned, aff[i0]) : 0u;
    __syncthreads();
    unsigned prefix = 0u, pmask = 0u; int need = CAP, eqtot = 0;
#pragma nounroll
    for (int pass = 0; pass < 3; ++pass) { const int sh = 20 - 10 * pass;
        hist[F.tid] = 0u; hist[F.tid + NTHREADS] = 0u;
        __syncthreads();
        if (have) {
#pragma unroll
            for (int j = 0; j < EPT; ++j) if ((k[j] & pmask) == prefix) __hip_atomic_fetch_add(hist + ((k[j] >> sh) & 1023u), 1u, __ATOMIC_RELAXED, __HIP_MEMORY_SCOPE_WORKGROUP); }
        __syncthreads();
        if (F.wave == 0) {
            unsigned h[16];
#pragma unroll
            for (int q = 0; q < 4; ++q) { const v4u w = ((const LAS v4u*)(hist + 16 * F.lane))[q]; h[4 * q] = w.x; h[4 * q + 1] = w.y; h[4 * q + 2] = w.z; h[4 * q + 3] = w.w; }
            unsigned own = 0u;
#pragma unroll
            for (int q = 0; q < 16; ++q) own += h[q];
            const unsigned pre = (unsigned)wave_incl_scan_i((int)own), total = (unsigned)__builtin_amdgcn_readlane((int)pre, 63);
            unsigned a = total - pre;
            int dsel = -1; unsigned asel = 0u, esel = 0u;
#pragma unroll
            for (int q = 15; q >= 0; --q) { if (a < (unsigned)need && (unsigned)need <= a + h[q]) { dsel = 16 * F.lane + q; asel = a; esel = h[q]; } a += h[q]; }
            if (dsel >= 0) { red[16] = dsel; red[17] = (int)asel; red[18] = (int)esel; }
        }
        __syncthreads();
        const int dsel = red[16]; need -= red[17]; eqtot = red[18];
        prefix |= ((unsigned)dsel) << sh; pmask |= 1023u << sh;
    }
    const unsigned T = prefix;
    const bool alleq = (eqtot == need);
    int eqb = 0;
    if (!alleq) { int ceq = 0;
#pragma unroll
        for (int j = 0; j < EPT; ++j) ceq += (have && k[j] == T) ? 1 : 0;
        eqb = block_excl_scan_i(F, ceq, red); }
    int csel = 0, e2 = eqb; unsigned selm = 0u;
#pragma unroll
    for (int j = 0; j < EPT; ++j) { const bool iseq = (k[j] == T); const bool sel = have && ((k[j] > T) || (iseq && (alleq || e2 < need))); e2 += iseq ? 1 : 0; csel += sel ? 1 : 0; selm |= sel ? (1u << j) : 0u; }
    int pos = block_excl_scan_i(F, csel, red + 32);
    int tokv[EPT];
#pragma unroll
    for (int j = 0; j < EPT; ++j) { tokv[j] = -1;
        if ((selm >> j) & 1u) { const int slot = slotbase + pos; ++pos; IDX[slot] = rowbase + i0 + j; GATE[slot] = __builtin_bit_cast(float, k[j]); tokv[j] = slot; } }
    int* tp = TOK + (size_t)e * NR + rowbase + i0;
    if (EPT == 16) {
#pragma unroll
        for (int q = 0; q < 4; ++q) ((v4u*)tp)[q] = (v4u){(unsigned)tokv[4 * q % EPT], (unsigned)tokv[(4 * q + 1) % EPT], (unsigned)tokv[(4 * q + 2) % EPT], (unsigned)tokv[(4 * q + 3) % EPT]};
    } else if (have) tp[0] = tokv[0];
}
__device__ __forceinline__ void ph_route(Frame& F, bool last) {
    unsigned char* const ws_ = launder_ws(F.ws);
    const int nunits = last ? 32 : 64;
    for (int u = F.bid; u < nunits; u += F.G) {
        if (u < 32) { const int b = u >> 4, e = u & 15; route_unit<SEQ, CAPX>(F, (const float*)(ws_ + WS_AFF) + (size_t)u * SEQ, e, b * SEQ, e * SLOTS_E + b * CAPX); }
        else { const int uc = u - 32, b = uc >> 4, e = uc & 15; route_unit<LCTX, CAPC>(F, (const float*)(ws_ + WS_AFFC) + (size_t)uc * LCTX, e, NX + b * LCTX, e * SLOTS_E + 2 * CAPX + b * CAPC);
            if (b == 0 && F.tid < 192) { ((int*)(ws_ + WS_IDX))[e * SLOTS_E + 2 * CAPX + 2 * CAPC + F.tid] = 0; ((float*)(ws_ + WS_GATE))[e * SLOTS_E + 2 * CAPX + 2 * CAPC + F.tid] = 0.f; } }
    }
}
__device__ __forceinline__ void ln_pair(f32x4 (&v)[2][4]) {
    float s[2], q[2];
#pragma unroll
    for (int r = 0; r < 2; ++r) { s[r] = 0.f; q[r] = 0.f;
#pragma unroll
        for (int j = 0; j < 4; ++j) { s[r] += (v[r][j].x + v[r][j].y) + (v[r][j].z + v[r][j].w); q[r] += (v[r][j].x * v[r][j].x + v[r][j].y * v[r][j].y) + (v[r][j].z * v[r][j].z + v[r][j].w * v[r][j].w); } }
    s[0] = wave_sum(s[0]); s[1] = wave_sum(s[1]); q[0] = wave_sum(q[0]); q[1] = wave_sum(q[1]);
#pragma unroll
    for (int r = 0; r < 2; ++r) { const float mean = s[r] * (1.f / 1024.f), var = fmaxf(q[r] * (1.f / 1024.f) - mean * mean, 0.f), rstd = 1.f / sqrtf(var + LN_EPS);
#pragma unroll
        for (int j = 0; j < 4; ++j) v[r][j] = (v[r][j] - mean) * rstd; }
}
__device__ __forceinline__ void ph_rows_mid2(Frame& F, int l, bool last) {
    unsigned char* const ws_ = launder_ws(F.ws);
    KArgs ka = kargs();
    const float* MOD = (const float*)(ws_ + WS_MOD); const bf16* YMIX = (const bf16*)(ws_ + WS_YMIX);
    float* XMID = (float*)(ws_ + WS_XMID); bf16* H2 = (bf16*)(ws_ + WS_HX);
    const float* g1_ = ka->in[27] + l * 1024; const float* b1_ = ka->in[28] + l * 1024; const float* wr_ = ka->in[29] + (size_t)l * 1024 * 16;
    float* AFF = (float*)(ws_ + WS_AFF); float* AFFC = (float*)(ws_ + WS_AFFC);
    LAS float* Wp = (LAS float*)F.lds;
    const int lane = F.lane, nrows = last ? NX : NR;
    __syncthreads();
    for (int i = F.tid; i < 16 * 4 * 64; i += NTHREADS) { const int ji = i >> 8, q = (i >> 6) & 3, ln = i & 63, d = 4 * ln + 256 * (ji >> 2) + (ji & 3);
        *(LAS f32x4*)(Wp + (size_t)i * 4) = *(const f32x4*)(wr_ + (size_t)d * 16 + 4 * q); }
    __syncthreads();
    for (int r0 = 2 * F.gw; r0 < nrows; r0 += 2 * F.NGW) {
        const float* g1 = opq(g1_); const float* b1 = opq(b1_);
        const float* m = MOD + (l * 3 + row_mod_index(r0)) * 6144;
        f32x4 v[2][4];
#pragma unroll
        for (int r = 0; r < 2; ++r) { const int rr = r0 + r;
            const float* src = (l == 0) ? (rr < NX ? ka->in[0] + (size_t)rr * 1024 : ka->in[2] + (size_t)(rr - NX) * 1024) : (const float*)(ws_ + WS_XCUR) + (size_t)rr * 1024;
            f32x4 y[4]; row_load(src, lane, v[r]);
#pragma unroll
            for (int j = 0; j < 4; ++j) { const v2u w = ((const v2u*)(YMIX + (size_t)rr * 1024))[lane + 64 * j]; y[j] = (f32x4){bflo(w.x), bfhi(w.x), bflo(w.y), bfhi(w.y)}; }
#pragma unroll
            for (int j = 0; j < 4; ++j) { const f32x4 gt = ((const f32x4*)(m + 2048))[lane + 64 * j]; v[r][j] = v[r][j] * ALPHA + gt * y[j]; } }
        ln_pair(v);
#pragma unroll
        for (int j = 0; j < 4; ++j) { const f32x4 gg = ((const f32x4*)g1)[lane + 64 * j], bb = ((const f32x4*)b1)[lane + 64 * j];
#pragma unroll
            for (int r = 0; r < 2; ++r) v[r][j] = v[r][j] * gg + bb; }
        ln_pair(v);
#pragma unroll
        for (int j = 0; j < 4; ++j) { const f32x4 sh = ((const f32x4*)(m + 3072))[lane + 64 * j], sc = ((const f32x4*)(m + 4096))[lane + 64 * j];
#pragma unroll
            for (int r = 0; r < 2; ++r) v[r][j] = v[r][j] * (sc + 1.f) + sh; }
#pragma unroll
        for (int rr_ = 0; rr_ < 2; ++rr_)
#pragma unroll
            for (int j = 0; j < 4; ++j) ((unsigned*)((unsigned char*)H2 + (size_t)(r0 + rr_) * 1024))[lane + 64 * j] = pack4_fp8(v[rr_][j].x, v[rr_][j].y, v[rr_][j].z, v[rr_][j].w);
        __builtin_amdgcn_sched_barrier(0);
        typedef float f32x2 __attribute__((ext_vector_type(2)));
        f32x2 lg2[2][8];
#pragma unroll
        for (int r = 0; r < 2; ++r)
#pragma unroll
            for (int e = 0; e < 8; ++e) lg2[r][e] = (f32x2){0.f, 0.f};
#pragma unroll
        for (int j = 0; j < 4; ++j)
#pragma unroll
            for (int i = 0; i < 4; ++i) { const LAS float* wp = Wp + ((size_t)((j * 4 + i) * 4) * 64 + lane) * 4; const f32x2 h0 = (f32x2){v[0][j][i], v[0][j][i]}, h1 = (f32x2){v[1][j][i], v[1][j][i]};
#pragma unroll
                for (int q = 0; q < 4; ++q) { const f32x4 w = *(const LAS f32x4*)(wp + q * 256); const f32x2 wa = (f32x2){w.x, w.y}, wb = (f32x2){w.z, w.w};
                    lg2[0][2 * q] = __builtin_elementwise_fma(h0, wa, lg2[0][2 * q]); lg2[0][2 * q + 1] = __builtin_elementwise_fma(h0, wb, lg2[0][2 * q + 1]);
                    lg2[1][2 * q] = __builtin_elementwise_fma(h1, wa, lg2[1][2 * q]); lg2[1][2 * q + 1] = __builtin_elementwise_fma(h1, wb, lg2[1][2 * q + 1]); }
                if (i & 1) __builtin_amdgcn_sched_barrier(0); }
        float lg[2][16];
#pragma unroll
        for (int r = 0; r < 2; ++r)
#pragma unroll
            for (int e = 0; e < 16; ++e) lg[r][e] = lg2[r][e >> 1][e & 1];
        float fin[2];
#pragma unroll
        for (int r = 0; r < 2; ++r) {
            float a8[8], a4[4], a2[2];
            { const bool s = lane & 8;
#pragma unroll
              for (int e = 0; e < 8; ++e) { const float keep = s ? lg[r][e + 8] : lg[r][e], send = s ? lg[r][e] : lg[r][e + 8]; a8[e] = keep + dppf<DPP_RM>(send); } }
            { const bool s = lane & 4;
#pragma unroll
              for (int e = 0; e < 4; ++e) { const float keep = s ? a8[e + 4] : a8[e], send = s ? a8[e] : a8[e + 4]; a4[e] = keep + dppf<DPP_HM>(send); } }
            { const bool s = lane & 2;
#pragma unroll
              for (int e = 0; e < 2; ++e) { const float keep = s ? a4[e + 2] : a4[e], send = s ? a4[e] : a4[e + 2]; a2[e] = keep + dppf<DPP_X2>(send); } }
            { const bool s = lane & 1; const float keep = s ? a2[1] : a2[0], send = s ? a2[0] : a2[1]; fin[r] = xrow_sum(keep + dppf<DPP_X1>(send)); }
        }
        const int e = lane & 15;
#pragma unroll
        for (int r = 0; r < 2; ++r) { const float mx = row_max16(fin[r]);
            const float ex = expf(fin[r] - mx); const float den = row_sum16(ex);
            const int rr = r0 + r;
            if (lane < 16) { if (rr < NX) AFF[((size_t)(rr >> 13) * 16 + e) * SEQ + (rr & (SEQ - 1))] = ex / den; else AFFC[((size_t)((rr - NX) >> 8) * 16 + e) * LCTX + ((rr - NX) & (LCTX - 1))] = ex / den; } }
    }
}
__device__ __forceinline__ void ph_rows_final2(Frame& F, int l, bool last) {
    unsigned char* const ws_ = launder_ws(F.ws);
    KArgs ka = kargs();
    const float* MOD = (const float*)(ws_ + WS_MOD); const bf16* YMIX = (const bf16*)(ws_ + WS_YMIX);
    const int* TOK = (const int*)(ws_ + WS_TOKSLOT); const float* GATE = (const float*)(ws_ + WS_GATE); const bf16* YE = (const bf16*)(ws_ + WS_YEXP);
    const float* g1_ = ka->in[27] + l * 1024; const float* b1_ = ka->in[28] + l * 1024;
    const float* g2_ = ka->in[33] + l * 1024; const float* b2_ = ka->in[34] + l * 1024;
    const int lane = F.lane, nrows = last ? NX : NR;
    for (int r0 = 2 * F.gw; r0 < nrows; r0 += 2 * F.NGW) {
        const float* g1 = opq(g1_); const float* b1 = opq(b1_); const float* g2 = opq(g2_); const float* b2 = opq(b2_);
        const float* m = MOD + (l * 3 + row_mod_index(r0)) * 6144;
        f32x4 v[2][4];
#pragma unroll
        for (int r = 0; r < 2; ++r) { const int rr = r0 + r;
            const float* src = (l == 0) ? (rr < NX ? ka->in[0] + (size_t)rr * 1024 : ka->in[2] + (size_t)(rr - NX) * 1024) : (const float*)(ws_ + WS_XCUR) + (size_t)rr * 1024;
            f32x4 y[4]; row_load(src, lane, v[r]);
#pragma unroll
            for (int j = 0; j < 4; ++j) { const v2u w = ((const v2u*)(YMIX + (size_t)rr * 1024))[lane + 64 * j]; y[j] = (f32x4){bflo(w.x), bfhi(w.x), bflo(w.y), bfhi(w.y)}; }
#pragma unroll
            for (int j = 0; j < 4; ++j) { const f32x4 gt = ((const f32x4*)(m + 2048))[lane + 64 * j]; v[r][j] = v[r][j] * ALPHA + gt * y[j]; } }
        ln_pair(v);
#pragma unroll
        for (int j = 0; j < 4; ++j) { const f32x4 gg = ((const f32x4*)g1)[lane + 64 * j], bb = ((const f32x4*)b1)[lane + 64 * j];
#pragma unroll
            for (int r = 0; r < 2; ++r) v[r][j] = v[r][j] * gg + bb; }
        __builtin_amdgcn_sched_barrier(0);
#pragma unroll
        for (int r = 0; r < 2; ++r) { const int rr = r0 + r;
            int sl = -1; float gv = 0.f; if (lane < 16) { sl = TOK[(size_t)lane * NR + rr]; if (sl >= 0) gv = GATE[sl]; }
            f32x4 mo[4];
#pragma unroll
            for (int j = 0; j < 4; ++j) mo[j] = (f32x4){0.f, 0.f, 0.f, 0.f};
            unsigned long long bal = __ballot(sl >= 0);
            while (bal) { const int e = __builtin_ctzll(bal); bal &= bal - 1; const int s = __shfl(sl, e); const float g = __shfl(gv, e);
                const v2u* yp = (const v2u*)(YE + (size_t)s * 1024);
#pragma unroll
                for (int j = 0; j < 4; ++j) { const v2u w = yp[lane + 64 * j]; mo[j].x += g * bflo(w.x); mo[j].y += g * bfhi(w.x); mo[j].z += g * bflo(w.y); mo[j].w += g * bfhi(w.y); } }
#pragma unroll
            for (int j = 0; j < 4; ++j) { const f32x4 gt = ((const f32x4*)(m + 5120))[lane + 64 * j]; v[r][j] = v[r][j] * ALPHA + gt * mo[j]; } }
        ln_pair(v);
#pragma unroll
        for (int j = 0; j < 4; ++j) { const f32x4 gg = ((const f32x4*)g2)[lane + 64 * j], bb = ((const f32x4*)b2)[lane + 64 * j];
#pragma unroll
            for (int r = 0; r < 2; ++r) { v[r][j] = v[r][j] * gg + bb;
                float* dst = last ? ka->out + (size_t)(r0 + r) * 1024 : (float*)(ws_ + WS_XCUR) + (size_t)(r0 + r) * 1024; ((f32x4*)dst)[lane + 64 * j] = v[r][j]; } }
        if (!last) { ln_pair(v); const float* m1 = MOD + ((l + 1) * 3 + row_mod_index(r0)) * 6144;
            modulate_store(v[0], m1, m1 + 1024, (bf16*)(ws_ + WS_HX) + (size_t)r0 * 1024, lane); modulate_store(v[1], m1, m1 + 1024, (bf16*)(ws_ + WS_HX) + (size_t)(r0 + 1) * 1024, lane); }
    }
}
#define XB_TMO      128
#define XB_XCNT(j)  (256  + 64 * (j))
#define XB_XSUB(j)  (1280 + 64 * (j))
#define XB_XGEN(j)  (2304 + 64 * (j))
#define XB_TOP      3328
#define XB_TOPGEN   3392
#define XCD_BAR_WORDS 3456
#define XB_SPIN_CAP (1u << 18)

__device__ __forceinline__ unsigned xb_ld(unsigned* p)              { return __hip_atomic_load(p, __ATOMIC_RELAXED, __HIP_MEMORY_SCOPE_AGENT); }
__device__ __forceinline__ unsigned xb_add(unsigned* p, unsigned v) { return __hip_atomic_fetch_add(p, v, __ATOMIC_RELAXED, __HIP_MEMORY_SCOPE_AGENT); }
__device__ __forceinline__ unsigned xb_xcc_id() { return (unsigned)__builtin_amdgcn_s_getreg((3 << 11) | 20) & 0xFu; }
#define XB_SPIN(cond, bar) do { unsigned _sp = 0; while (cond) { __builtin_amdgcn_s_sleep(1); \
    if ((++_sp & 255u) == 0u) { if (xb_ld(&(bar)[XB_TMO])) break; if (_sp > XB_SPIN_CAP) { atomicAdd(&(bar)[XB_TMO], 1u); break; } } } } while (0)

struct XcdBarrier {
    unsigned* bar; unsigned x;
    volatile LAS unsigned* st;
    int wv;
};

__device__ __forceinline__ XcdBarrier xcd_barrier_post(unsigned* bar, volatile LAS unsigned* st) {
    XcdBarrier b; b.bar = bar; b.x = xb_xcc_id(); b.st = st;
    if (threadIdx.x == 0) (void)xb_add(&bar[XB_XCNT(b.x)], 1u);
    return b;
}
__device__ __forceinline__ void xcd_barrier_complete(unsigned* bar, unsigned x, unsigned& nloc, unsigned& nx) {
    const unsigned G = gridDim.x * gridDim.y * gridDim.z;
    unsigned sum, cnt, mine, sp = 0u;
    for (;;) {
        sum = 0u; cnt = 0u; mine = 0u;
#pragma unroll
        for (unsigned j = 0; j < 16; ++j) { const unsigned c = xb_ld(&bar[XB_XCNT(j)]); sum += c; cnt += (c > 0u) ? 1u : 0u; mine = (j == x) ? c : mine; }
        if (sum == G) break;
        __builtin_amdgcn_s_sleep(1);
        if ((++sp & 255u) == 0u) { if (xb_ld(&bar[XB_TMO])) break; if (sp > XB_SPIN_CAP) { atomicAdd(&bar[XB_TMO], 1u); break; } }
    }
    nloc = mine > 0u ? mine : 1u; nx = cnt > 0u ? cnt : 1u;
}

__device__ __forceinline__ void xcd_barrier(const XcdBarrier& b) {
    asm volatile("s_waitcnt vmcnt(0)" ::: "memory");
    __syncthreads();
    if (b.wv == 0 && pg8::lane_id() == 0) {
        unsigned* bar = b.bar;
        __builtin_amdgcn_s_waitcnt(0);
        unsigned nloc = b.st[0], nx = b.st[1];
        if (nloc == 0u) { xcd_barrier_complete(bar, b.x, nloc, nx); b.st[0] = nloc; b.st[1] = nx; }
        const unsigned old = xb_add(&bar[XB_XSUB(b.x)], 1u);
        const unsigned gen = old / nloc;
        if (old + 1u == (gen + 1u) * nloc) {
            __builtin_amdgcn_fence(__ATOMIC_RELEASE, "agent");
            asm volatile("s_waitcnt vmcnt(0)" ::: "memory");
            const unsigned og = xb_add(&bar[XB_TOP], 1u);
            const unsigned tg = og / nx;
            if (og + 1u == (tg + 1u) * nx) xb_add(&bar[XB_TOPGEN], 1u);
            else XB_SPIN(xb_ld(&bar[XB_TOPGEN]) == tg, bar);
            __builtin_amdgcn_fence(__ATOMIC_ACQUIRE, "agent");
            xb_add(&bar[XB_XGEN(b.x)], 1u);
            asm volatile("s_waitcnt vmcnt(0)" ::: "memory");
        } else {
            XB_SPIN(xb_ld(&bar[XB_XGEN(b.x)]) == gen, bar);
            __builtin_amdgcn_fence(__ATOMIC_ACQUIRE, "agent");
            asm volatile("s_waitcnt vmcnt(0)" ::: "memory");
        }
    }
    __syncthreads();
}

#ifndef MK_SPLIT
#define MK_SPLIT 0
#endif
#ifndef DUP_MASK
#define DUP_MASK 0u
#endif
#ifndef DUP_CNT
#define DUP_CNT 2
#endif
#define NREP(n) (((DUP_MASK >> (n)) & 1u) ? DUP_CNT : 1)
#define NREPP(n) (((DUP_MASK >> (16 + (n))) & 1u) ? 2 : 1)
constexpr int PPL = 11, NPH = 2 + PPL * DEPTH;
constexpr size_t WS_BAR = 0;
constexpr int MISC_OFF = LDS_BYTES - 64;
__device__ __forceinline__ void grid_seam(int k, int wv) {
    if (k + 1 >= kargs()->ph_hi) return;
    extern __shared__ __attribute__((aligned(16))) unsigned char lds[];
    XcdBarrier b; b.bar = (unsigned*)(kargs()->ws + WS_BAR); b.x = xb_xcc_id(); b.st = (volatile LAS unsigned*)((LAS unsigned char*)lds + MISC_OFF); b.wv = wv;
    xcd_barrier(b);
}
#define SEAM(k) grid_seam(k, wv)
#define IN(k) (kargs()->ph_lo <= (k) && (k) < kargs()->ph_hi)
__device__ __forceinline__ Frame make_frame(int wv) {
    extern __shared__ __attribute__((aligned(16))) unsigned char lds[];
    KArgs ka = kargs(); Frame F;
    F.lds = (LAS unsigned char*)lds; { int t_ = wv * 64 + pg8::lane_id(); asm volatile("" : "+v"(t_)); F.tid = t_; } F.lane = F.tid & 63; F.wave = wv;
    F.bid = blockIdx.x; F.G = ka->G; F.gw = F.bid * NWAVES + F.wave; F.NGW = F.G * NWAVES; F.ws = ka->ws; return F;
}
template <int l> __device__ __forceinline__ void run_layer(const int wv) {
        const bool last = (l == DEPTH - 1); const int k0 = 2 + PPL * l;
        if (IN(k0 + 0)) { for (int rep_ = 0; rep_ < NREP(0); ++rep_) { if (rep_) __syncthreads(); Frame F = make_frame(wv); unsigned char* const ws_ = F.ws;
            pg8::Gemm g{(const pg8::bf16_t*)(ws_ + WS_HX), (const pg8::bf16_t*)(ws_ + WS_WIN) + (size_t)l * INW * DM, NR, INW, DM, DM, DM};
            g.wv = F.wave;
            pg8::InProjOrder S; S.init(0, 256, F.G, F.bid);
            pg8::EpiInProj E{(const float*)(ws_ + WS_BINP) + l * INW, (const float*)(ws_ + WS_ROPE), (pg8::bf16_t*)(ws_ + WS_Q), (pg8::bf16_t*)(ws_ + WS_K), (pg8::bf16_t*)(ws_ + WS_V), (pg8::bf16_t*)(ws_ + WS_UC), (pg8::bf16_t*)(ws_ + WS_HG)};
            pg8::gemm_phase<pg8::EpiInProj, pg8::InProjOrder, PG8_ALIGN, PG8_SP2>(F.lds, g, S, E);
            } SEAM(k0 + 0); }
        if (IN(k0 + 1)) { for (int rep_ = 0; rep_ < NREP(1); ++rep_) { if (rep_) __syncthreads(); Frame F = make_frame(wv); unsigned char* const ws_ = F.ws;
            const int GB = (F.G * 140) / 256, nl = F.G - GB;
            if (F.bid < GB) {
                pg8::Gemm g{(const pg8::bf16_t*)(ws_ + WS_HX), (const pg8::bf16_t*)(ws_ + WS_WIN) + (size_t)l * INW * DM, NR, INW, DM, DM, DM};
                g.wv = F.wave;
                pg8::InProjOrder S; S.init(256, 140, GB, F.bid);
                pg8::EpiInProj E{(const float*)(ws_ + WS_BINP) + l * INW, (const float*)(ws_ + WS_ROPE), (pg8::bf16_t*)(ws_ + WS_Q), (pg8::bf16_t*)(ws_ + WS_K), (pg8::bf16_t*)(ws_ + WS_V), (pg8::bf16_t*)(ws_ + WS_UC), (pg8::bf16_t*)(ws_ + WS_HG)};
                pg8::gemm_phase<pg8::EpiInProj, pg8::InProjOrder, PG8_ALIGN, PG8_SP2>(F.lds, g, S, E);
            } else { const int w = F.bid - GB;
                if (w < 48) {
                    pg8::Gemm g{(const pg8::bf16_t*)(ws_ + WS_UC), (const pg8::bf16_t*)(ws_ + WS_BE) + (size_t)l * 16 * 256 * 512, 16 * S5R, 16 * 256, 512, S5K, 512};
                    g.wv = F.wave;
                    pg8::MoeOrder S; S.init(3, 1, 3, 16, nl < 48 ? nl : 48, w);
                    pg8::EpiF32G E{(float*)(ws_ + WS_E), 256, 1};
                    pg8::gemm_phase<pg8::EpiF32G, pg8::MoeOrder, PG8_ALIGN, PG8_SP2>(F.lds, g, S, E); }
                ph_conv(F, l, 0, last ? 256 : 264, 0, 0, (unsigned*)(ws_ + WS_CTR) + 4 + l);
            }
            } SEAM(k0 + 1); }
        if (IN(k0 + 2)) { for (int rep_ = 0; rep_ < NREP(2); ++rep_) { if (rep_) __syncthreads(); { Frame F = make_frame(wv); ph_attn(F, l, 0, 256, F.bid, F.G); } } SEAM(k0 + 2); }
        if (IN(k0 + 3)) { for (int rep_ = 0; rep_ < NREP(3); ++rep_) { if (rep_) __syncthreads(); Frame F = make_frame(wv); unsigned char* const ws_ = F.ws;
            pg8::Gemm g{(const pg8::bf16_t*)(ws_ + WS_UC), (const pg8::bf16_t*)(ws_ + WS_KT) + (size_t)l * 16 * 512 * S5K, 16 * S5R, 16 * 512, S5K, S5K, S5K};
            g.wv = F.wave;
            const bool twin = F.G >= 224 && F.bid >= 128 && F.bid < 224;
            pg8::MoeOrder S; S.init(3, 2, 3, 16, F.G, twin ? F.bid - 128 : F.bid);
            pg8::EpiS5Y E{(pg8::bf16_t*)(ws_ + WS_Z), (F.G >= 224) ? (twin ? 1 : 0) : -1};
            pg8::Unit u0;
            if ((twin || F.bid < 128) && S.next(0, u0)) { s5_carry_tile(F, l, u0.pm / 3, u0.pm % 3);
                pg8::gemm_phase<pg8::EpiS5Y, pg8::MoeOrder, PG8_ALIGN, PG8_SP2>(F.lds, g, S, E); }
            else if (!last && F.bid >= 96 && F.bid < 104) ph_attn(F, l, 256, 264, F.bid - 96, 8);
            } SEAM(k0 + 3); }
        if (IN(k0 + 4)) { for (int rep_ = 0; rep_ < NREP(4); ++rep_) { if (rep_) __syncthreads(); Frame F = make_frame(wv); unsigned char* const ws_ = F.ws;
            pg8::Gemm g{(const pg8::bf16_t*)(ws_ + WS_Z), (const pg8::bf16_t*)(ws_ + WS_WPT) + (size_t)l * 2 * 65536, 2 * NR, 512, 256, 256, 256};
            g.wv = F.wave;
            pg8::MoeOrder S; S.init(last ? 64 : 66, 1, 66, 2, F.G, F.bid);
            pg8::EpiPW E{(pg8::bf16_t*)(ws_ + WS_CAT), (const pg8::bf16_t*)(ws_ + WS_Z), kargs()->in[18] + l * 256, kargs()->in[24] + l * 256, 66};
            pg8::gemm_phase<pg8::EpiPW, pg8::MoeOrder, PG8_ALIGN, PG8_SP2>(F.lds, g, S, E);
            } SEAM(k0 + 4); }
        if (IN(k0 + 5)) { for (int rep_ = 0; rep_ < NREP(5); ++rep_) { if (rep_) __syncthreads(); Frame F = make_frame(wv); unsigned char* const ws_ = F.ws;
            pg8::Gemm g{(const pg8::bf16_t*)(ws_ + WS_CAT), (const pg8::bf16_t*)(ws_ + WS_WOUT) + (size_t)l * DM * DM, NR, DM, DM, DM, DM};
            g.wv = F.wave;
            pg8::StaticOrder S; S.init(last ? NX : NR, DM, F.G, F.bid);
            pg8::EpiBf16B E{(pg8::bf16_t*)(ws_ + WS_YMIX), DM, kargs()->in[26] + l * DM};
            pg8::gemm_phase<pg8::EpiBf16B, pg8::StaticOrder, PG8_ALIGN, PG8_SP2>(F.lds, g, S, E);
            } SEAM(k0 + 5); }
        if (IN(k0 + 6)) { for (int rep_ = 0; rep_ < NREP(6); ++rep_) { if (rep_) __syncthreads(); { Frame F = make_frame(wv); ph_rows_mid2(F, l, last); } } SEAM(k0 + 6); }
        if (IN(k0 + 7)) { for (int rep_ = 0; rep_ < NREP(7); ++rep_) { if (rep_) __syncthreads(); { Frame F = make_frame(wv); ph_route(F, last); } } SEAM(k0 + 7); }
        const int MT = last ? 8 : 9;
        if (IN(k0 + 8)) { for (int rep_ = 0; rep_ < NREP(8); ++rep_) { if (rep_) __syncthreads(); Frame F = make_frame(wv); unsigned char* const ws_ = F.ws;
            pg8::Gemm g{(const pg8::bf16_t*)(ws_ + WS_HX), (const pg8::bf16_t*)(ws_ + WS_WGU + (size_t)l * NE * 4096 * 1024), NSLOT, NE * 4096, 512, 512, 512};
            g.wv = F.wave;
            pg8::MoeOrder S; S.init(MT, 16, 9, NE, F.G, F.bid, last ? -1 : 8);
            pg8::EpiSwiGLU8 E{ws_ + WS_HID, FF, 16, last ? -1 : 8, 9};
            pg8::gemm_phase_g8<pg8::EpiSwiGLU8, pg8::MoeOrder, PG8_ALIGN, PG8_SP2>(F.lds, g, S, E, (const int*)(ws_ + WS_IDX), 0x7a7a7a7a, 0x7f7f7f7f);
            } SEAM(k0 + 8); }
        if (IN(k0 + 9)) { for (int rep_ = 0; rep_ < NREP(9); ++rep_) { if (rep_) __syncthreads(); Frame F = make_frame(wv); unsigned char* const ws_ = F.ws;
            pg8::Gemm g{(const pg8::bf16_t*)(ws_ + WS_HID), (const pg8::bf16_t*)(ws_ + WS_WD + (size_t)l * NE * DM * FF), NSLOT, NE * DM, 1024, 1024, 1024};
            g.wv = F.wave;
            pg8::MoeOrder S; S.init(MT, 4, 9, NE, F.G, F.bid, last ? -1 : 8, !last);
            pg8::EpiBf16P E{(pg8::bf16_t*)(ws_ + WS_YEXP), DM, 4};
            pg8::gemm_phase_8<pg8::EpiBf16P, pg8::MoeOrder, PG8_ALIGN, PG8_SP2>(F.lds, g, S, E, 0x79797979, 0x7d7d7d7d);
            } SEAM(k0 + 9); }
        if (IN(k0 + 10)) { for (int rep_ = 0; rep_ < NREP(10); ++rep_) { if (rep_) __syncthreads(); { Frame F = make_frame(wv); ph_rows_final2(F, l, last); } } SEAM(k0 + 10); }
    }
__global__ void __launch_bounds__(NTHREADS, 2) mk_fwd(Args a) {
    { extern __shared__ __attribute__((aligned(16))) unsigned char lds[];
      if (threadIdx.x < 16) ((LAS unsigned*)((LAS unsigned char*)lds + MISC_OFF))[threadIdx.x] = 0u;
      __syncthreads();
      if (threadIdx.x == 0) (void)xb_add((unsigned*)(kargs()->ws + WS_BAR) + XB_XCNT(xb_xcc_id()), 1u); }
    int wv = __builtin_amdgcn_readfirstlane((int)(threadIdx.x >> 6)); asm volatile("" : "+s"(wv));
    if (kargs()->ph_hi < 0) cg::this_grid().sync();
    if (IN(0)) { for (int rep_ = 0; rep_ < NREPP(0); ++rep_) { if (rep_) __syncthreads(); Frame F = make_frame(wv); ph_prologue(F); } SEAM(0); }
    if (IN(1)) { for (int rep_ = 0; rep_ < NREPP(1); ++rep_) { if (rep_) __syncthreads(); Frame F = make_frame(wv); ph_rows0(F); } SEAM(1); }
    run_layer<0>(wv);
    run_layer<1>(wv);
}
#undef IN
#undef SEAM

extern "C" void kernel_launch(void* const* d_in, const int* in_sizes, int n_in, void* d_out, int out_size, void* d_ws, size_t ws_size, hipStream_t stream) {
    static int grid_blocks = 0;
    if (!grid_blocks) {
        int dev = 0, cus = 0, per_cu = 0;
        (void)hipGetDevice(&dev);
        (void)hipDeviceGetAttribute(&cus, hipDeviceAttributeMultiprocessorCount, dev);
        (void)hipFuncSetAttribute((const void*)mk_fwd, hipFuncAttributeMaxDynamicSharedMemorySize, LDS_BYTES);
        (void)hipOccupancyMaxActiveBlocksPerMultiprocessor(&per_cu, (const void*)mk_fwd, NTHREADS, LDS_BYTES);
        grid_blocks = (per_cu >= 1 && cus > 0) ? cus : -1;
        if (n_in != 35 || ws_size < WS_END) { fprintf(stderr, "kernel_launch: unexpected n_in %d or ws_size %zu (need %zu)\n", n_in, ws_size, (size_t)WS_END); grid_blocks = -1; }
        fprintf(stderr, "kernel_launch: cus %d per_cu %d ws %zu\n", cus, per_cu, ws_size);
    }
    if (grid_blocks < 0) return;
    (void)hipMemsetAsync((char*)d_ws + WS_BAR, 0, 32 * KiB, stream);
    Args a{};
    for (int i = 0; i < 35; ++i) a.in[i] = (const float*)d_in[i];
    a.out = (float*)d_out; a.ws = (unsigned char*)d_ws; a.G = grid_blocks;
#if MK_SPLIT
    for (int p = 0; p < NPH; ++p) { a.ph_lo = p; a.ph_hi = p + 1; void* args[] = {&a};
        hipError_t e = hipLaunchCooperativeKernel((const void*)mk_fwd, dim3(grid_blocks), dim3(NTHREADS), args, LDS_BYTES, stream);
        if (e != hipSuccess) { fprintf(stderr, "launch failed: %s\n", hipGetErrorString(e)); break; } }
#else
    a.ph_lo = 0; a.ph_hi = NPH; void* args[] = {&a};
    hipError_t e = hipLaunchCooperativeKernel((const void*)mk_fwd, dim3(grid_blocks), dim3(NTHREADS), args, LDS_BYTES, stream);
    if (e != hipSuccess) fprintf(stderr, "cooperative launch failed: %s (grid %d)\n", hipGetErrorString(e), grid_blocks);
#endif
}
```

```cpp
#include <hip/hip_runtime.h>
#include <hip/hip_cooperative_groups.h>
#include <cstdio>
#include <cstdint>
namespace cg = cooperative_groups;
namespace pg8 {
#define PG8_LAS __attribute__((address_space(3)))
typedef unsigned short bf16_t;
typedef short bf16x8 __attribute__((ext_vector_type(8)));
typedef float f32x4 __attribute__((ext_vector_type(4)));
typedef unsigned u32x4 __attribute__((ext_vector_type(4)));
constexpr int BM = 256, BK = 64, HALF = 128, HTB = HALF * BK * 2  , STAGE_BYTES = 8 * HTB, NXCD = 8, WGM = 8;

__host__ __device__ __forceinline__ int lds_byte(int r, int c) { const int st = (r >> 4) * 2 + (c >> 5), rr = r & 15, cc = c & 31, ob = rr * 64 + cc * 2; return st * 1024 + (ob ^ (((ob >> 9) & 1) << 5)); }
__host__ __device__ __forceinline__ void stage_rc(int b, int& R, int& C) { const int st = b / 1024, sb = b % 1024, swz = sb ^ (((sb >> 9) & 1) << 5); R = (st >> 1) * 16 + swz / 64; C = (st & 1) * 32 + (swz % 64) / 2; }
__host__ __device__ __forceinline__ int perm32(int rho) { const int n = rho >> 4, i = rho & 15; return 8 * (i >> 2) + 4 * n + (i & 3); }

struct Unit { int pm, pn; };
__device__ __forceinline__ int lane_id() { int r; asm volatile("v_mbcnt_lo_u32_b32 %0, -1, 0\n\tv_mbcnt_hi_u32_b32 %0, -1, %0" : "=v"(r)); return r; }
struct Gemm { const bf16_t* A; const bf16_t* Bt; int M, N, K, lda, ldb; int wv = 0; };

struct StaticOrder {
    int nM, nN, nwg, G, c;
    __host__ __device__ __forceinline__ void init(int M, int N, int G_, int c_) { nM = M / BM; nN = N / BM; nwg = nM * nN; G = G_; c = c_; }
    __host__ __device__ __forceinline__ bool next(int i, Unit& u) const {
        const long L = (long)i * G + c; if (L >= nwg) return false;
        int wgid = (int)L; { const int q = nwg / NXCD, r = nwg % NXCD, xcd = wgid % NXCD, off = wgid / NXCD; wgid = (xcd < r ? xcd * (q + 1) : r * (q + 1) + (xcd - r) * q) + off; }
        const int nig = WGM * nN, gid = wgid / nig, fm = gid * WGM, gsz = (nM - fm) < WGM ? (nM - fm) : WGM;
        u.pm = fm + ((wgid % nig) % gsz); u.pn = (wgid % nig) / gsz; return true;
    }
    __device__ __forceinline__ void a_ready(const Unit&) const {}
    __device__ __forceinline__ void done(const Unit&) const {}
    __device__ __forceinline__ int vrows(const Unit&) const { return BM; }
};

__device__ __forceinline__ unsigned cvt_pk_bf16(float lo, float hi) { unsigned r; asm volatile("v_cvt_pk_bf16_f32 %0, %1, %2" : "=v"(r) : "v"(lo), "v"(hi)); return r; }
typedef float f32x2 __attribute__((ext_vector_type(2)));
__device__ __forceinline__ f32x2 gelu_pk(f32x2 v) {
    const f32x2 av = __builtin_elementwise_abs(v), d = av * 0.2316418882f + 1.0f;
    f32x2 t; t.x = __builtin_amdgcn_rcpf(d.x); t.y = __builtin_amdgcn_rcpf(d.y);
    f32x2 q = t * 0.5307027145f + (-0.7265760135f); q = q * t + 0.7107068705f; q = q * t + (-0.142248368f); q = q * t + 0.127414796f; q = q * t;
    const f32x2 s = (v * v) * (-0.72134752044f);
    f32x2 e; e.x = __builtin_amdgcn_exp2f(s.x); e.y = __builtin_amdgcn_exp2f(s.y);
    const f32x2 m = v * (q * e), r = v - m;
    f32x2 o; o.x = v.x < 0.f ? m.x : r.x; o.y = v.y < 0.f ? m.y : r.y; return o;
}

typedef unsigned u32x2e __attribute__((ext_vector_type(2)));
__device__ __forceinline__ float silu_f(float x) { return x * __builtin_amdgcn_rcpf(1.f + __expf(-x)); }
struct EpiBf16P {
    static constexpr bool PERM = true, AFTER_DRAIN = false;
    bf16_t* O; int ldo; int ntpe;
    __device__ __forceinline__ void operator()(const f32x4 (&acc)[2][2][4][2], const Unit& u, int wr, int wc, int fr, int fq) const {
        const int row0 = u.pm * BM + wr * 64 + fr; const int col0 = (u.pn % ntpe) * BM + wc * 32 + 8 * fq;
#pragma unroll
        for (int ai = 0; ai < 2; ++ai)
#pragma unroll
            for (int m = 0; m < 4; ++m) { bf16_t* rowp = O + (size_t)(row0 + ai * HALF + m * 16) * ldo + col0;
#pragma unroll
                for (int bj = 0; bj < 2; ++bj) { const f32x4 v0 = acc[ai][bj][m][0], v1 = acc[ai][bj][m][1];
                    u32x4 w; w.x = cvt_pk_bf16(v0[0], v0[1]); w.y = cvt_pk_bf16(v0[2], v0[3]); w.z = cvt_pk_bf16(v1[0], v1[1]); w.w = cvt_pk_bf16(v1[2], v1[3]);
                    *(u32x4*)(rowp + bj * HALF) = w; } }
    }
};
struct EpiBf16B {
    static constexpr bool PERM = true, AFTER_DRAIN = false;
    bf16_t* O; int ldo; const float* bias;
    __device__ __forceinline__ void operator()(const f32x4 (&acc)[2][2][4][2], const Unit& u, int wr, int wc, int fr, int fq) const {
        const int row0 = u.pm * BM + wr * 64 + fr; const int col0 = u.pn * BM + wc * 32 + 8 * fq;
        f32x4 bv[2][2];
        { unsigned long long bp_ = (unsigned long long)bias; asm volatile("" : "+s"(bp_)); const float* bq = (const float*)bp_ + col0;
#pragma unroll
          for (int bj = 0; bj < 2; ++bj) { bv[bj][0] = *(const f32x4*)(bq + bj * HALF); bv[bj][1] = *(const f32x4*)(bq + bj * HALF + 4); } }
#pragma unroll
        for (int ai = 0; ai < 2; ++ai)
#pragma unroll
            for (int m = 0; m < 4; ++m) { bf16_t* rowp = O + (size_t)(row0 + ai * HALF + m * 16) * ldo + col0;
#pragma unroll
                for (int bj = 0; bj < 2; ++bj) {
                    const f32x4 v0 = acc[ai][bj][m][0] + bv[bj][0], v1 = acc[ai][bj][m][1] + bv[bj][1];
                    u32x4 w; w.x = cvt_pk_bf16(v0[0], v0[1]); w.y = cvt_pk_bf16(v0[2], v0[3]); w.z = cvt_pk_bf16(v1[0], v1[1]); w.w = cvt_pk_bf16(v1[2], v1[3]);
                    *(u32x4*)(rowp + bj * HALF) = w; } }
    }
};
__device__ __forceinline__ float sat_e4m3(float x) { return __builtin_amdgcn_fmed3f(x, -448.f, 448.f); }
__device__ __forceinline__ unsigned pack4_fp8(float a, float b, float c, float d) { int w = __builtin_amdgcn_cvt_pk_fp8_f32(sat_e4m3(a), sat_e4m3(b), 0, false); w = __builtin_amdgcn_cvt_pk_fp8_f32(sat_e4m3(c), sat_e4m3(d), w, true); return (unsigned)w; }
struct EpiSwiGLU8 {
    static constexpr bool PERM = true, AFTER_DRAIN = false;
    unsigned char* O; int ldo; int ntpe; int ctxpm, mstride;
    __device__ __forceinline__ void operator()(const f32x4 (&acc)[2][2][4][2], const Unit& u, int wr, int wc, int fr, int fq) const {
        const int row0 = u.pm * BM + wr * 64 + fr; const int col0 = (u.pn % ntpe) * HALF + wc * 32 + 8 * fq;
        const int vr = (ctxpm >= 0 && (u.pm % mstride) == ctxpm) ? 64 : BM;
#pragma unroll
        for (int ai = 0; ai < 2; ++ai) { if (wr * 64 + ai * HALF >= vr) continue;
#pragma unroll
            for (int m = 0; m < 4; ++m) { unsigned char* rowp = O + (size_t)(row0 + ai * HALF + m * 16) * ldo + col0;
                const f32x4 g0 = acc[ai][0][m][0], g1 = acc[ai][0][m][1], u0 = acc[ai][1][m][0] * 4.f, u1 = acc[ai][1][m][1] * 4.f;
                u32x2e w; w.x = pack4_fp8(silu_f(g0[0]) * u0[0], silu_f(g0[1]) * u0[1], silu_f(g0[2]) * u0[2], silu_f(g0[3]) * u0[3]);
                w.y = pack4_fp8(silu_f(g1[0]) * u1[0], silu_f(g1[1]) * u1[1], silu_f(g1[2]) * u1[2], silu_f(g1[3]) * u1[3]);
                *(u32x2e*)rowp = w; } }
    }
};
struct InProjOrder {
    int base, cnt, G, c;
    __device__ __forceinline__ void init(int base_, int cnt_, int G_, int c_) { base = base_; cnt = cnt_; G = G_; c = c_; }
    __device__ __forceinline__ bool next(int i, Unit& u) const {
        const long L = (long)i * G + c; if (L >= cnt) return false;
        int id = (int)L; { const int q = cnt / NXCD, r = cnt % NXCD, xcd = id % NXCD, off = id / NXCD; id = (xcd < r ? xcd * (q + 1) : r * (q + 1) + (xcd - r) * q) + off; }
        id += base; const bool hi = id >= 198; const int id2 = hi ? id - 198 : id;
        u.pm = id2 / 3; u.pn = (hi ? 0 : 3) + id2 % 3; return true;
    }
    __device__ __forceinline__ void a_ready(const Unit&) const {}
    __device__ __forceinline__ void done(const Unit&) const {}
    __device__ __forceinline__ int vrows(const Unit&) const { return BM; }
};
struct MoeOrder {
    int MT, NT, mstride, nwg, G, c, ctxpm, nx;
    __device__ __forceinline__ void init(int MT_, int NT_, int mstride_, int NE_, int G_, int c_, int ctxpm_ = -1, bool ctxlast = false) { MT = MT_; NT = NT_; mstride = mstride_; nwg = MT_ * NT_ * NE_; G = G_; c = c_; ctxpm = ctxpm_; nx = ctxlast ? (MT_ - 1) * NT_ * NE_ : 0; }
    __device__ __forceinline__ bool next(int i, Unit& u) const {
        const long L = (long)i * G + c; if (L >= nwg) return false;
        int id = (int)L;
        if (nx > 0) {
            if (id >= nx) { const int j = id - nx, e = j / NT; u.pm = e * mstride + (MT - 1); u.pn = e * NT + j % NT; return true; }
            { const int q = nx / NXCD, xcd = id % NXCD, off = id / NXCD; id = xcd * q + off; }
            const int upe = (MT - 1) * NT, e = id / upe, r2 = id % upe;
            u.pm = e * mstride + (r2 % (MT - 1)); u.pn = e * NT + (r2 / (MT - 1)); return true;
        }
        { const int q = nwg / NXCD, r = nwg % NXCD, xcd = id % NXCD, off = id / NXCD; id = (xcd < r ? xcd * (q + 1) : r * (q + 1) + (xcd - r) * q) + off; }
        const int upe = MT * NT, e = id / upe, r2 = id % upe;
        u.pm = e * mstride + (r2 % MT); u.pn = e * NT + (r2 / MT); return true;
    }
    __device__ __forceinline__ void a_ready(const Unit&) const {}
    __device__ __forceinline__ void done(const Unit&) const {}
    __device__ __forceinline__ int vrows(const Unit& u) const { return (ctxpm >= 0 && (u.pm % mstride) == ctxpm) ? 64 : BM; }
};
struct EpiF32G {
    static constexpr bool PERM = false, AFTER_DRAIN = false;
    float* C; int ldc; int ntpe;
    __device__ __forceinline__ void operator()(const f32x4 (&acc)[2][2][4][2], const Unit& u, int wr, int wc, int fr, int fq) const {
        const int row0 = u.pm * BM + wr * 64 + fr, col0 = (u.pn % ntpe) * BM + wc * 32 + 4 * fq;
#pragma unroll
        for (int ai = 0; ai < 2; ++ai)
#pragma unroll
            for (int m = 0; m < 4; ++m) { float* rowp = C + (size_t)(row0 + ai * HALF + m * 16) * ldc + col0;
#pragma unroll
                for (int bj = 0; bj < 2; ++bj)
#pragma unroll
                    for (int n = 0; n < 2; ++n) *(f32x4*)(rowp + bj * HALF + n * 16) = acc[ai][bj][m][n]; }
    }
};
__device__ __forceinline__ float gelu_tanh_e(float x) { const float u = 1.5957691216057308f * (x + 0.044715f * x * x * x); return x * __builtin_amdgcn_rcpf(1.f + __expf(-u)); }
struct EpiS5Y {
    static constexpr bool PERM = true, AFTER_DRAIN = false;
    bf16_t* Z; int half;
    __device__ __forceinline__ void operator()(const f32x4 (&acc)[2][2][4][2], const Unit& u, int wr, int wc, int fr, int fq) const {
        const int g = u.pm / 3, R0 = (u.pm % 3) * BM + wr * 64 + fr, n0 = (u.pn & 1) * BM + wc * 32 + 8 * fq;
#pragma unroll
        for (int ai = 0; ai < 2; ++ai) { if (half >= 0 && ai != half) continue;
#pragma unroll
            for (int m = 0; m < 4; ++m) { const int R = R0 + ai * HALF + m * 16; if (R >= 528) continue;
                const int tok0 = (R < 512) ? ((R >> 8) * 8192 + 32 * (R & 255)) : (16384 + ((R - 512) >> 3) * 256 + 32 * ((R - 512) & 7));
#pragma unroll
                for (int bj = 0; bj < 2; ++bj) { const int n = n0 + bj * HALF, j = n >> 4, c0 = n & 15; const f32x4 v0 = acc[ai][bj][m][0], v1 = acc[ai][bj][m][1];
                    u32x4 w; w.x = cvt_pk_bf16(gelu_tanh_e(v0[0]), gelu_tanh_e(v0[1])); w.y = cvt_pk_bf16(gelu_tanh_e(v0[2]), gelu_tanh_e(v0[3])); w.z = cvt_pk_bf16(gelu_tanh_e(v1[0]), gelu_tanh_e(v1[1])); w.w = cvt_pk_bf16(gelu_tanh_e(v1[2]), gelu_tanh_e(v1[3]));
                    *(u32x4*)(Z + ((size_t)(tok0 + j)) * 256 + 16 * g + c0) = w; } } }
    }
};
struct EpiPW {
    static constexpr bool PERM = true, AFTER_DRAIN = false;
    bf16_t* CAT; const bf16_t* Z; const float* bglu; const float* bpw; int mtpe;
    __device__ __forceinline__ void operator()(const f32x4 (&acc)[2][2][4][2], const Unit& u, int wr, int wc, int fr, int fq) const {
        const int grp = u.pn, row0 = (u.pm % mtpe) * BM + wr * 64 + fr, col0 = wc * 32 + 8 * fq; const float* bias = grp ? bpw : bglu;
#pragma unroll
        for (int ai = 0; ai < 2; ++ai)
#pragma unroll
            for (int m = 0; m < 4; ++m) { const size_t row = (size_t)(row0 + ai * HALF + m * 16);
#pragma unroll
                for (int bj = 0; bj < 2; ++bj) { const int col = col0 + bj * HALF;
                    unsigned long long bp_ = (unsigned long long)bias; asm volatile("" : "+s"(bp_)); const float* bq = (const float*)bp_ + col;
                    f32x4 v0 = acc[ai][bj][m][0] + *(const f32x4*)bq, v1 = acc[ai][bj][m][1] + *(const f32x4*)(bq + 4);
                    if (grp == 0) { const u32x4 zz = *(const u32x4*)(Z + row * 256 + col);
                        v0[0] = __builtin_bit_cast(float, zz.x << 16) * __builtin_amdgcn_rcpf(1.f + __expf(-v0[0])); v0[1] = __builtin_bit_cast(float, zz.x & 0xffff0000u) * __builtin_amdgcn_rcpf(1.f + __expf(-v0[1]));
                        v0[2] = __builtin_bit_cast(float, zz.y << 16) * __builtin_amdgcn_rcpf(1.f + __expf(-v0[2])); v0[3] = __builtin_bit_cast(float, zz.y & 0xffff0000u) * __builtin_amdgcn_rcpf(1.f + __expf(-v0[3]));
                        v1[0] = __builtin_bit_cast(float, zz.z << 16) * __builtin_amdgcn_rcpf(1.f + __expf(-v1[0])); v1[1] = __builtin_bit_cast(float, zz.z & 0xffff0000u) * __builtin_amdgcn_rcpf(1.f + __expf(-v1[1]));
                        v1[2] = __builtin_bit_cast(float, zz.w << 16) * __builtin_amdgcn_rcpf(1.f + __expf(-v1[2])); v1[3] = __builtin_bit_cast(float, zz.w & 0xffff0000u) * __builtin_amdgcn_rcpf(1.f + __expf(-v1[3])); }
                    u32x4 w; w.x = cvt_pk_bf16(v0[0], v0[1]); w.y = cvt_pk_bf16(v0[2], v0[3]); w.z = cvt_pk_bf16(v1[0], v1[1]); w.w = cvt_pk_bf16(v1[2], v1[3]);
                    *(u32x4*)(CAT + row * 1024 + 512 + grp * 256 + col) = w; }
                asm volatile("" ::: "memory"); }
    }
};
typedef unsigned u32x2 __attribute__((ext_vector_type(2)));
struct EpiInProj {
    static constexpr bool PERM = true, AFTER_DRAIN = false;
    const float* bias; const float* rope; bf16_t* Q; bf16_t* K; bf16_t* V; bf16_t* UC; bf16_t* HG;
    __device__ __forceinline__ void operator()(const f32x4 (&acc)[2][2][4][2], const Unit& u, int wr, int wc, int fr, int fq) const {
        const int pn = u.pn; const bool isx = u.pm < 64;
        f32x4 bv[2][2];
        { unsigned long long bp_ = (unsigned long long)bias; asm volatile("" : "+s"(bp_)); const float* bq = (const float*)bp_ + pn * BM + wc * 32 + 8 * fq;
#pragma unroll
          for (int bj = 0; bj < 2; ++bj) { bv[bj][0] = *(const f32x4*)(bq + bj * HALF); bv[bj][1] = *(const f32x4*)(bq + bj * HALF + 4); } }
        const bool rot = (pn <= 2) && isx; const int hi = fq >> 1, i0 = 8 * (fq & 1);
#pragma unroll
        for (int ai = 0; ai < 2; ++ai)
#pragma unroll
            for (int m = 0; m < 4; ++m) {
                const int r = u.pm * BM + ai * HALF + wr * 64 + m * 16 + fr;
                f32x4 v[2][2];
#pragma unroll
                for (int bj = 0; bj < 2; ++bj)
#pragma unroll
                    for (int n = 0; n < 2; ++n) v[bj][n] = acc[ai][bj][m][n] + bv[bj][n];
                if (pn <= 2) {
                    f32x4 cs[4];
                    if (rot) { const int t = r & 8191, pos = (wc & 1) ? (t & 63) : (t >> 6); const f32x4* rp = (const f32x4*)(rope + ((size_t)pos * 16 + i0) * 2);
#pragma unroll
                        for (int q = 0; q < 4; ++q) cs[q] = rp[q]; }
                    else {
#pragma unroll
                        for (int q = 0; q < 4; ++q) cs[q] = (f32x4){1.f, 0.f, 1.f, 0.f}; }
#pragma unroll
                    for (int bj = 0; bj < 2; ++bj) {
                        u32x4 w;
                        if (pn == 2 && bj == 1) {
                            w.x = cvt_pk_bf16(v[1][0][0], v[1][0][1]); w.y = cvt_pk_bf16(v[1][0][2], v[1][0][3]); w.z = cvt_pk_bf16(v[1][1][0], v[1][1][1]); w.w = cvt_pk_bf16(v[1][1][2], v[1][1][3]);
                            *(u32x4*)(V + (size_t)r * 128 + wc * 32 + 8 * fq) = w;
                        } else {
                            float o[8];
#pragma unroll
                            for (int n = 0; n < 2; ++n)
#pragma unroll
                                for (int e = 0; e < 4; ++e) { const float mine = v[bj][n][e], other = __shfl_xor(mine, 32); const int q = 2 * n + (e >> 1); const float c = cs[q][2 * (e & 1)], s = cs[q][2 * (e & 1) + 1];
                                    o[4 * n + e] = hi ? (mine * c + other * s) : (mine * c - other * s); }
                            const float qs = (pn == 2) ? 1.f : 0.18033688011112042f;
                            w.x = cvt_pk_bf16(o[0] * qs, o[1] * qs); w.y = cvt_pk_bf16(o[2] * qs, o[3] * qs); w.z = cvt_pk_bf16(o[4] * qs, o[5] * qs); w.w = cvt_pk_bf16(o[6] * qs, o[7] * qs);
                            bf16_t* op = (pn == 2) ? K + (size_t)r * 128 + wc * 32 + 8 * fq : Q + (size_t)r * 512 + pn * BM + bj * HALF + wc * 32 + 8 * fq;
                            *(u32x4*)op = w;
                        } }
                } else if (pn == 3) {
                    int R, j; if (isx) { const int t = r & 8191; R = (r >> 13) * 256 + (t >> 5); j = t & 31; } else { const int rc = r - 16384, t = rc & 255; R = 512 + (rc >> 8) * 8 + (t >> 5); j = t & 31; }
#pragma unroll
                    for (int bj = 0; bj < 2; ++bj) { const int g = 8 * bj + 2 * wc + (fq >> 1); u32x4 w;
                        w.x = cvt_pk_bf16(v[bj][0][0], v[bj][0][1]); w.y = cvt_pk_bf16(v[bj][0][2], v[bj][0][3]); w.z = cvt_pk_bf16(v[bj][1][0], v[bj][1][1]); w.w = cvt_pk_bf16(v[bj][1][2], v[bj][1][3]);
                        *(u32x4*)(UC + ((size_t)(g * 768 + R)) * 768 + j * 16 + 8 * (fq & 1)) = w; }
                } else {
                    u32x4 w; float hgv[8];
#pragma unroll
                    for (int n = 0; n < 2; ++n)
#pragma unroll
                        for (int e = 0; e < 4; ++e) hgv[4 * n + e] = v[0][n][e] * __builtin_amdgcn_rcpf(1.f + __expf(-v[1][n][e]));
                    w.x = cvt_pk_bf16(hgv[0], hgv[1]); w.y = cvt_pk_bf16(hgv[2], hgv[3]); w.z = cvt_pk_bf16(hgv[4], hgv[5]); w.w = cvt_pk_bf16(hgv[6], hgv[7]);
                    *(u32x4*)(HG + (size_t)r * 256 + (pn - 4) * HALF + wc * 32 + 8 * fq) = w;
                }
                asm volatile("" ::: "memory");
            }
    }
};
template <class Epi, class Sched, bool ALIGN_EPI = false, bool SP2 = false>
__device__ __forceinline__ void gemm_phase(PG8_LAS unsigned char* lds, const Gemm g, const Sched& S, const Epi& E) {
    int tid_ = g.wv * 64 + lane_id(); asm volatile("" : "+v"(tid_));
    const int tid = tid_, wid = __builtin_amdgcn_readfirstlane(tid >> 6), lane = tid & 63, wr = wid >> 2, wc = wid & 3, fr = lane & 15, fq = lane >> 4;
    const int K = g.K, nt = K / BK;
    unsigned voffA[2], voffB[2];
#pragma unroll
    for (int i = 0; i < 2; ++i) { int R, C; stage_rc(tid * 16 + i * 8192, R, C); const int Rb = Epi::PERM ? ((R & ~31) + perm32(R & 31)) : R;
        voffA[i] = (unsigned)(R * g.lda + C) * 2u; voffB[i] = (unsigned)(Rb * g.ldb + C) * 2u; }
    const size_t kstep = (size_t)(BK * 2);
    const size_t hstepA = (size_t)HALF * g.lda * 2, hstepB = (size_t)HALF * g.ldb * 2;
    const size_t tstepA = 2 * hstepA, tstepB = 2 * hstepB;
    const unsigned ldsw = (unsigned)wid * 1024u;
    const int aoff = lds_byte(wr * 64 + fr, fq * 8), boff = lds_byte(wc * 32 + fr, fq * 8);
#define PG8_SA(b, h) (((b) * 2 + (h)) * HTB)
#define PG8_SB(b, h) ((4 + (b) * 2 + (h)) * HTB)
#define PG8_STAGE(bufoff, gbase, voff) do { _Pragma("unroll") for (int _i = 0; _i < 2; ++_i) \
        __builtin_amdgcn_global_load_lds((const unsigned*)((const char*)(gbase) + (voff)[_i]), (PG8_LAS unsigned*)(lds + (bufoff) + ldsw + _i * 8192), 16, 0, 0); } while (0)
#define PG8_LDA(dst, b, h) do { _Pragma("unroll") for (int m = 0; m < 4; ++m) _Pragma("unroll") for (int k = 0; k < 2; ++k) dst[m][k] = *(const PG8_LAS bf16x8*)(lds + PG8_SA(b, h) + aoff + m * 2048 + k * 1024); } while (0)
#define PG8_LDB(dst, b, h) do { _Pragma("unroll") for (int n = 0; n < 2; ++n) _Pragma("unroll") for (int k = 0; k < 2; ++k) dst[n][k] = *(const PG8_LAS bf16x8*)(lds + PG8_SB(b, h) + boff + n * 2048 + k * 1024); } while (0)
#define PG8_MMA(ai, bj, At, Bt) do { __builtin_amdgcn_s_setprio(1); _Pragma("unroll") for (int m = 0; m < 4; ++m) _Pragma("unroll") for (int n = 0; n < 2; ++n) _Pragma("unroll") for (int k = 0; k < 2; ++k) \
        acc[ai][bj][m][n] = __builtin_amdgcn_mfma_f32_16x16x32_bf16(Bt[n][k], At[m][k], acc[ai][bj][m][n], 0, 0, 0); __builtin_amdgcn_s_setprio(0); } while (0)
#define PG8_WAIT_V(n) asm volatile("s_waitcnt vmcnt(" #n ")" ::: "memory")
#define PG8_WAIT_L(n) asm volatile("s_waitcnt lgkmcnt(" #n ")" ::: "memory")
#define PG8_BAR __builtin_amdgcn_s_barrier()
#define PG8_SCHED __builtin_amdgcn_sched_barrier(0)
    Unit cur, nxt; int ui = 0;
    if (!S.next(0, cur)) return;
    f32x4 acc[2][2][4][2];
#pragma unroll
    for (int a = 0; a < 2; ++a)
#pragma unroll
        for (int b = 0; b < 2; ++b)
#pragma unroll
            for (int m = 0; m < 4; ++m)
#pragma unroll
                for (int n = 0; n < 2; ++n) acc[a][b][m][n] = (f32x4){0.f, 0.f, 0.f, 0.f};
    bf16x8 At[4][2], B0[2][2], B1[2][2];
    const char* cA = (const char*)g.A + (size_t)cur.pm * tstepA; const char* cB = (const char*)g.Bt + (size_t)cur.pn * tstepB;
    S.a_ready(cur);
    if constexpr (SP2) {
        PG8_STAGE(PG8_SB(0, 0), cB, voffB); PG8_STAGE(PG8_SB(0, 1), cB + hstepB, voffB); PG8_STAGE(PG8_SA(0, 0), cA, voffA); PG8_STAGE(PG8_SA(0, 1), cA + hstepA, voffA);
        if (wr == 1) PG8_BAR;
        PG8_WAIT_V(2); PG8_BAR;
        PG8_STAGE(PG8_SB(1, 0), cB + kstep, voffB); PG8_STAGE(PG8_SA(1, 0), cA + kstep, voffA); PG8_STAGE(PG8_SB(1, 1), cB + hstepB + kstep, voffB);
        PG8_WAIT_V(6); PG8_BAR;
    } else {
        PG8_STAGE(PG8_SB(0, 0), cB, voffB); PG8_STAGE(PG8_SA(0, 0), cA, voffA); PG8_STAGE(PG8_SB(0, 1), cB + hstepB, voffB); PG8_STAGE(PG8_SA(0, 1), cA + hstepA, voffA);
        if (wr == 1) PG8_BAR;
        PG8_WAIT_V(4); PG8_BAR;
        PG8_STAGE(PG8_SB(1, 0), cB + kstep, voffB); PG8_STAGE(PG8_SA(1, 0), cA + kstep, voffA); PG8_STAGE(PG8_SB(1, 1), cB + hstepB + kstep, voffB);
        PG8_WAIT_V(6); PG8_BAR;
    }
    for (;;) {
        const bool has_next = S.next(ui + 1, nxt);
        const char* nA = has_next ? (const char*)g.A + (size_t)nxt.pm * tstepA : cA; const char* nB = has_next ? (const char*)g.Bt + (size_t)nxt.pn * tstepB : cB;
        for (int t = 0; t < nt; t += 2) {
            const bool last = (t == nt - 2);
            const char* a1 = cA + (size_t)(t + 1) * kstep;
            const char* a2 = last ? nA : cA + (size_t)(t + 2) * kstep; const char* b2 = last ? nB : cB + (size_t)(t + 2) * kstep;
            const char* a3 = a2 + kstep; const char* b3 = b2 + kstep;
            if (last && has_next) S.a_ready(nxt);
            if constexpr (SP2) {
            PG8_LDB(B0, 0, 0); PG8_LDB(B1, 0, 1); PG8_SCHED; PG8_LDA(At, 0, 0); PG8_STAGE(PG8_SA(1, 1), a1 + hstepA, voffA);
            PG8_WAIT_V(8); PG8_WAIT_L(0); PG8_BAR; PG8_MMA(0, 0, At, B0); PG8_MMA(0, 1, At, B1); PG8_BAR; PG8_SCHED;
            PG8_LDA(At, 0, 1); PG8_STAGE(PG8_SB(0, 0), b2, voffB); PG8_STAGE(PG8_SB(0, 1), b2 + hstepB, voffB); PG8_STAGE(PG8_SA(0, 0), a2, voffA);
            PG8_WAIT_V(8); PG8_WAIT_L(0); PG8_BAR; PG8_MMA(1, 0, At, B0); PG8_MMA(1, 1, At, B1); PG8_BAR; PG8_SCHED;
            PG8_LDB(B0, 1, 0); PG8_LDB(B1, 1, 1); PG8_SCHED; PG8_LDA(At, 1, 0); PG8_STAGE(PG8_SA(0, 1), a2 + hstepA, voffA);
            PG8_WAIT_V(8); PG8_WAIT_L(0); PG8_BAR; PG8_MMA(0, 0, At, B0); PG8_MMA(0, 1, At, B1); PG8_BAR; PG8_SCHED;
            PG8_LDA(At, 1, 1); PG8_STAGE(PG8_SB(1, 0), b3, voffB); PG8_STAGE(PG8_SB(1, 1), b3 + hstepB, voffB); PG8_STAGE(PG8_SA(1, 0), a3, voffA);
            PG8_WAIT_V(8); PG8_WAIT_L(0); PG8_BAR; PG8_MMA(1, 0, At, B0); PG8_MMA(1, 1, At, B1); PG8_BAR; PG8_SCHED;
            } else {
            PG8_LDB(B0, 0, 0); PG8_SCHED; PG8_LDA(At, 0, 0); PG8_STAGE(PG8_SA(1, 1), a1 + hstepA, voffA);
            PG8_WAIT_L(8); PG8_BAR; PG8_WAIT_L(0); PG8_MMA(0, 0, At, B0); PG8_BAR; PG8_SCHED;
            PG8_LDB(B1, 0, 1); PG8_STAGE(PG8_SB(0, 0), b2, voffB);
            PG8_BAR; PG8_WAIT_L(0); PG8_MMA(0, 1, At, B1); PG8_BAR;
            PG8_LDA(At, 0, 1); PG8_STAGE(PG8_SA(0, 0), a2, voffA);
            PG8_BAR; PG8_WAIT_L(0); PG8_MMA(1, 0, At, B0); PG8_BAR; PG8_SCHED;
            PG8_STAGE(PG8_SB(0, 1), b2 + hstepB, voffB);
            PG8_WAIT_V(6); PG8_BAR; PG8_MMA(1, 1, At, B1); PG8_BAR;
            PG8_LDB(B0, 1, 0); PG8_SCHED; PG8_LDA(At, 1, 0); PG8_STAGE(PG8_SA(0, 1), a2 + hstepA, voffA);
            PG8_WAIT_L(8); PG8_BAR; PG8_WAIT_L(0); PG8_MMA(0, 0, At, B0); PG8_BAR; PG8_SCHED;
            PG8_LDB(B1, 1, 1); PG8_STAGE(PG8_SB(1, 0), b3, voffB);
            PG8_BAR; PG8_WAIT_L(0); PG8_MMA(0, 1, At, B1); PG8_BAR;
            PG8_LDA(At, 1, 1); PG8_STAGE(PG8_SA(1, 0), a3, voffA);
            PG8_BAR; PG8_WAIT_L(0); PG8_MMA(1, 0, At, B0); PG8_BAR; PG8_SCHED;
            PG8_STAGE(PG8_SB(1, 1), b3 + hstepB, voffB);
            PG8_WAIT_V(6); PG8_BAR; PG8_MMA(1, 1, At, B1); PG8_BAR;
            }
        }
        if constexpr (ALIGN_EPI) { if (wr == 0) PG8_BAR; }
        if constexpr (!Epi::AFTER_DRAIN) { E(acc, cur, wr, wc, fr, fq); S.done(cur); }
        if (!has_next) break;
#pragma unroll
        for (int a = 0; a < 2; ++a)
#pragma unroll
            for (int b = 0; b < 2; ++b)
#pragma unroll
                for (int m = 0; m < 4; ++m)
#pragma unroll
                    for (int n = 0; n < 2; ++n) acc[a][b][m][n] = (f32x4){0.f, 0.f, 0.f, 0.f};
        cur = nxt; cA = nA; cB = nB; ++ui;
        if constexpr (ALIGN_EPI) { if (wr == 1) PG8_BAR; }
    }
    PG8_WAIT_V(0);
    if constexpr (!ALIGN_EPI) { if (wr == 0) PG8_BAR; }
    PG8_BAR;
    if constexpr (Epi::AFTER_DRAIN) { E.fused(acc, cur, wr, wc, fr, fq, lds, wid, lane); S.done(cur); }
#undef PG8_SA
#undef PG8_SB
#undef PG8_STAGE
#undef PG8_LDA
#undef PG8_LDB
#undef PG8_MMA
#undef PG8_WAIT_V
#undef PG8_WAIT_L
#undef PG8_BAR
#undef PG8_SCHED
}
typedef int v4i_t __attribute__((ext_vector_type(4)));
typedef int v8i_t __attribute__((ext_vector_type(8)));
#define PG8_CAT(x, y) __builtin_shufflevector(__builtin_bit_cast(v4i_t, x), __builtin_bit_cast(v4i_t, y), 0, 1, 2, 3, 4, 5, 6, 7)
template <class Epi, class Sched, bool ALIGN_EPI = false, bool SP2 = false>
__device__ __forceinline__ void gemm_phase_8(PG8_LAS unsigned char* lds, const Gemm g, const Sched& S, const Epi& E, const int sa, const int sb) {
    int tid_ = g.wv * 64 + lane_id(); asm volatile("" : "+v"(tid_));
    const int tid = tid_, wid = __builtin_amdgcn_readfirstlane(tid >> 6), lane = tid & 63, wr = wid >> 2, wc = wid & 3, fr = lane & 15, fq = lane >> 4;
    const int K = g.K, nt = K / BK;
    unsigned voffA[2], voffB[2];
#pragma unroll
    for (int i = 0; i < 2; ++i) { int R, C; stage_rc(tid * 16 + i * 8192, R, C); const int Rb = Epi::PERM ? ((R & ~31) + perm32(R & 31)) : R;
        voffA[i] = (unsigned)(R * g.lda + C) * 2u; voffB[i] = (unsigned)(Rb * g.ldb + C) * 2u; }
    const size_t kstep = (size_t)(BK * 2);
    const size_t hstepA = (size_t)HALF * g.lda * 2, hstepB = (size_t)HALF * g.ldb * 2;
    const size_t tstepA = 2 * hstepA, tstepB = 2 * hstepB;
    const unsigned ldsw = (unsigned)wid * 1024u;
    const int aoff8[2] = {lds_byte(wr * 64 + fr, 16 * fq), lds_byte(wr * 64 + fr, 16 * fq + 8)}, boff8[2] = {lds_byte(wc * 32 + fr, 16 * fq), lds_byte(wc * 32 + fr, 16 * fq + 8)};
#define PG8_SA(b, h) (((b) * 2 + (h)) * HTB)
#define PG8_SB(b, h) ((4 + (b) * 2 + (h)) * HTB)
#define PG8_STAGE(bufoff, gbase, voff) do { _Pragma("unroll") for (int _i = 0; _i < 2; ++_i) \
        __builtin_amdgcn_global_load_lds((const unsigned*)((const char*)(gbase) + (voff)[_i]), (PG8_LAS unsigned*)(lds + (bufoff) + ldsw + _i * 8192), 16, 0, 0); } while (0)
#define PG8_LDA(dst, b, h) do { _Pragma("unroll") for (int m = 0; m < 4; ++m) { const v4i_t lo_ = *(const PG8_LAS v4i_t*)(lds + PG8_SA(b, h) + aoff8[0] + m * 2048), hi_ = *(const PG8_LAS v4i_t*)(lds + PG8_SA(b, h) + aoff8[1] + m * 2048); dst[m] = __builtin_shufflevector(lo_, hi_, 0, 1, 2, 3, 4, 5, 6, 7); } } while (0)
#define PG8_LDB(dst, b, h) do { _Pragma("unroll") for (int n = 0; n < 2; ++n) { const v4i_t lo_ = *(const PG8_LAS v4i_t*)(lds + PG8_SB(b, h) + boff8[0] + n * 2048), hi_ = *(const PG8_LAS v4i_t*)(lds + PG8_SB(b, h) + boff8[1] + n * 2048); dst[n] = __builtin_shufflevector(lo_, hi_, 0, 1, 2, 3, 4, 5, 6, 7); } } while (0)
#define PG8_MMA(ai, bj, At, Bt) do { if ((ai) ? do1 : do0) { __builtin_amdgcn_s_setprio(1); _Pragma("unroll") for (int m = 0; m < 4; ++m) _Pragma("unroll") for (int n = 0; n < 2; ++n) \
        asm volatile("v_mfma_scale_f32_16x16x128_f8f6f4 %0, %1, %2, %0, %3, %4 op_sel_hi:[0,0,0]" : "+v"(acc[ai][bj][m][n]) : "v"(Bt[n]), "v"(At[m]), "v"(sa), "v"(sb)); __builtin_amdgcn_s_setprio(0); } } while (0)
#define PG8_WAIT_V(n) asm volatile("s_waitcnt vmcnt(" #n ")" ::: "memory")
#define PG8_WAIT_L(n) asm volatile("s_waitcnt lgkmcnt(" #n ")" ::: "memory")
#define PG8_BAR __builtin_amdgcn_s_barrier()
#define PG8_SCHED __builtin_amdgcn_sched_barrier(0)
    Unit cur, nxt; int ui = 0;
    if (!S.next(0, cur)) return;
    bool do0 = wr * 64 < S.vrows(cur), do1 = wr * 64 + HALF < S.vrows(cur);
    f32x4 acc[2][2][4][2];
#pragma unroll
    for (int a = 0; a < 2; ++a)
#pragma unroll
        for (int b = 0; b < 2; ++b)
#pragma unroll
            for (int m = 0; m < 4; ++m)
#pragma unroll
                for (int n = 0; n < 2; ++n) acc[a][b][m][n] = (f32x4){0.f, 0.f, 0.f, 0.f};
    v8i_t At[4], B0[2], B1[2];
    const char* cA = (const char*)g.A + (size_t)cur.pm * tstepA; const char* cB = (const char*)g.Bt + (size_t)cur.pn * tstepB;
    S.a_ready(cur);
    if constexpr (SP2) {
        PG8_STAGE(PG8_SB(0, 0), cB, voffB); PG8_STAGE(PG8_SB(0, 1), cB + hstepB, voffB); PG8_STAGE(PG8_SA(0, 0), cA, voffA); PG8_STAGE(PG8_SA(0, 1), cA + hstepA, voffA);
        if (wr == 1) PG8_BAR;
        PG8_WAIT_V(2); PG8_BAR;
        PG8_STAGE(PG8_SB(1, 0), cB + kstep, voffB); PG8_STAGE(PG8_SA(1, 0), cA + kstep, voffA); PG8_STAGE(PG8_SB(1, 1), cB + hstepB + kstep, voffB);
        PG8_WAIT_V(6); PG8_BAR;
    } else {
        PG8_STAGE(PG8_SB(0, 0), cB, voffB); PG8_STAGE(PG8_SA(0, 0), cA, voffA); PG8_STAGE(PG8_SB(0, 1), cB + hstepB, voffB); PG8_STAGE(PG8_SA(0, 1), cA + hstepA, voffA);
        if (wr == 1) PG8_BAR;
        PG8_WAIT_V(4); PG8_BAR;
        PG8_STAGE(PG8_SB(1, 0), cB + kstep, voffB); PG8_STAGE(PG8_SA(1, 0), cA + kstep, voffA); PG8_STAGE(PG8_SB(1, 1), cB + hstepB + kstep, voffB);
        PG8_WAIT_V(6); PG8_BAR;
    }
    for (;;) {
        const bool has_next = S.next(ui + 1, nxt);
        const char* nA = has_next ? (const char*)g.A + (size_t)nxt.pm * tstepA : cA; const char* nB = has_next ? (const char*)g.Bt + (size_t)nxt.pn * tstepB : cB;
        for (int t = 0; t < nt; t += 2) {
            const bool last = (t == nt - 2);
            const char* a1 = cA + (size_t)(t + 1) * kstep;
            const char* a2 = last ? nA : cA + (size_t)(t + 2) * kstep; const char* b2 = last ? nB : cB + (size_t)(t + 2) * kstep;
            const char* a3 = a2 + kstep; const char* b3 = b2 + kstep;
            if (last && has_next) S.a_ready(nxt);
            if constexpr (SP2) {
            PG8_LDB(B0, 0, 0); PG8_LDB(B1, 0, 1); PG8_SCHED; PG8_LDA(At, 0, 0); PG8_STAGE(PG8_SA(1, 1), a1 + hstepA, voffA);
            PG8_WAIT_V(8); PG8_WAIT_L(0); PG8_BAR; PG8_MMA(0, 0, At, B0); PG8_MMA(0, 1, At, B1); PG8_BAR; PG8_SCHED;
            PG8_LDA(At, 0, 1); PG8_STAGE(PG8_SB(0, 0), b2, voffB); PG8_STAGE(PG8_SB(0, 1), b2 + hstepB, voffB); PG8_STAGE(PG8_SA(0, 0), a2, voffA);
            PG8_WAIT_V(8); PG8_WAIT_L(0); PG8_BAR; PG8_MMA(1, 0, At, B0); PG8_MMA(1, 1, At, B1); PG8_BAR; PG8_SCHED;
            PG8_LDB(B0, 1, 0); PG8_LDB(B1, 1, 1); PG8_SCHED; PG8_LDA(At, 1, 0); PG8_STAGE(PG8_SA(0, 1), a2 + hstepA, voffA);
            PG8_WAIT_V(8); PG8_WAIT_L(0); PG8_BAR; PG8_MMA(0, 0, At, B0); PG8_MMA(0, 1, At, B1); PG8_BAR; PG8_SCHED;
            PG8_LDA(At, 1, 1); PG8_STAGE(PG8_SB(1, 0), b3, voffB); PG8_STAGE(PG8_SB(1, 1), b3 + hstepB, voffB); PG8_STAGE(PG8_SA(1, 0), a3, voffA);
            PG8_WAIT_V(8); PG8_WAIT_L(0); PG8_BAR; PG8_MMA(1, 0, At, B0); PG8_MMA(1, 1, At, B1); PG8_BAR; PG8_SCHED;
            } else {
            PG8_LDB(B0, 0, 0); PG8_SCHED; PG8_LDA(At, 0, 0); PG8_STAGE(PG8_SA(1, 1), a1 + hstepA, voffA);
            PG8_WAIT_L(8); PG8_BAR; PG8_WAIT_L(0); PG8_MMA(0, 0, At, B0); PG8_BAR; PG8_SCHED;
            PG8_LDB(B1, 0, 1); PG8_STAGE(PG8_SB(0, 0), b2, voffB);
            PG8_BAR; PG8_WAIT_L(0); PG8_MMA(0, 1, At, B1); PG8_BAR;
            PG8_LDA(At, 0, 1); PG8_STAGE(PG8_SA(0, 0), a2, voffA);
            PG8_BAR; PG8_WAIT_L(0); PG8_MMA(1, 0, At, B0); PG8_BAR; PG8_SCHED;
            PG8_STAGE(PG8_SB(0, 1), b2 + hstepB, voffB);
            PG8_WAIT_V(6); PG8_BAR; PG8_MMA(1, 1, At, B1); PG8_BAR;
            PG8_LDB(B0, 1, 0); PG8_SCHED; PG8_LDA(At, 1, 0); PG8_STAGE(PG8_SA(0, 1), a2 + hstepA, voffA);
            PG8_WAIT_L(8); PG8_BAR; PG8_WAIT_L(0); PG8_MMA(0, 0, At, B0); PG8_BAR; PG8_SCHED;
            PG8_LDB(B1, 1, 1); PG8_STAGE(PG8_SB(1, 0), b3, voffB);
            PG8_BAR; PG8_WAIT_L(0); PG8_MMA(0, 1, At, B1); PG8_BAR;
            PG8_LDA(At, 1, 1); PG8_STAGE(PG8_SA(1, 0), a3, voffA);
            PG8_BAR; PG8_WAIT_L(0); PG8_MMA(1, 0, At, B0); PG8_BAR; PG8_SCHED;
            PG8_STAGE(PG8_SB(1, 1), b3 + hstepB, voffB);
            PG8_WAIT_V(6); PG8_BAR; PG8_MMA(1, 1, At, B1); PG8_BAR;
            }
        }
        if constexpr (ALIGN_EPI) { if (wr == 0) PG8_BAR; }
        asm volatile("s_nop 15\n\ts_nop 15" ::: "memory"); __builtin_amdgcn_sched_barrier(0);
        if constexpr (!Epi::AFTER_DRAIN) { E(acc, cur, wr, wc, fr, fq); S.done(cur); }
        if (!has_next) break;
#pragma unroll
        for (int a = 0; a < 2; ++a)
#pragma unroll
            for (int b = 0; b < 2; ++b)
#pragma unroll
                for (int m = 0; m < 4; ++m)
#pragma unroll
                    for (int n = 0; n < 2; ++n) acc[a][b][m][n] = (f32x4){0.f, 0.f, 0.f, 0.f};
        cur = nxt; cA = nA; cB = nB; ++ui;
        do0 = wr * 64 < S.vrows(cur); do1 = wr * 64 + HALF < S.vrows(cur);
        if constexpr (ALIGN_EPI) { if (wr == 1) PG8_BAR; }
    }
    PG8_WAIT_V(0);
    if constexpr (!ALIGN_EPI) { if (wr == 0) PG8_BAR; }
    PG8_BAR;
    if constexpr (Epi::AFTER_DRAIN) { E.fused(acc, cur, wr, wc, fr, fq, lds, wid, lane); S.done(cur); }
#undef PG8_SA
#undef PG8_SB
#undef PG8_STAGE
#undef PG8_LDA
#undef PG8_LDB
#undef PG8_MMA
#undef PG8_WAIT_V
#undef PG8_WAIT_L
#undef PG8_BAR
#undef PG8_SCHED
}
template <class Epi, class Sched, bool ALIGN_EPI = false, bool SP2 = false>
__device__ __forceinline__ void gemm_phase_g8(PG8_LAS unsigned char* lds, const Gemm g, const Sched& S, const Epi& E, const int* gidx, const int sa, const int sb) {
    int tid_ = g.wv * 64 + lane_id(); asm volatile("" : "+v"(tid_));
    const int tid = tid_, wid = __builtin_amdgcn_readfirstlane(tid >> 6), lane = tid & 63, wr = wid >> 2, wc = wid & 3, fr = lane & 15, fq = lane >> 4;
    const int K = g.K, nt = K / BK;
    unsigned voffA[2], voffB[2];
#pragma unroll
    for (int i = 0; i < 2; ++i) { int R, C; stage_rc(tid * 16 + i * 8192, R, C); const int Rb = Epi::PERM ? ((R & ~31) + perm32(R & 31)) : R;
        voffA[i] = (unsigned)(R * g.lda + C) * 2u; voffB[i] = (unsigned)(Rb * g.ldb + C) * 2u; }
    int RA[2]; unsigned cAo[2];
#pragma unroll
    for (int i = 0; i < 2; ++i) { int R, C; stage_rc(tid * 16 + i * 8192, R, C); RA[i] = R; cAo[i] = (unsigned)C * 2u; }
    unsigned vcur[2][2], vnxt[2][2], vsel[2][2];
#define PG8_GOFF(pm_, dst) do { _Pragma("unroll") for (int h_ = 0; h_ < 2; ++h_) _Pragma("unroll") for (int i_ = 0; i_ < 2; ++i_) dst[h_][i_] = (unsigned)gidx[(pm_) * BM + h_ * HALF + RA[i_]] * (unsigned)(g.lda * 2) + cAo[i_]; } while (0)
    const size_t kstep = (size_t)(BK * 2);
    const size_t hstepA = (size_t)HALF * g.lda * 2, hstepB = (size_t)HALF * g.ldb * 2;
    const size_t tstepA = 2 * hstepA, tstepB = 2 * hstepB;
    const unsigned ldsw = (unsigned)wid * 1024u;
    const int aoff8[2] = {lds_byte(wr * 64 + fr, 16 * fq), lds_byte(wr * 64 + fr, 16 * fq + 8)}, boff8[2] = {lds_byte(wc * 32 + fr, 16 * fq), lds_byte(wc * 32 + fr, 16 * fq + 8)};
#define PG8_SA(b, h) (((b) * 2 + (h)) * HTB)
#define PG8_SB(b, h) ((4 + (b) * 2 + (h)) * HTB)
#define PG8_STAGE(bufoff, gbase, voff) do { _Pragma("unroll") for (int _i = 0; _i < 2; ++_i) \
        __builtin_amdgcn_global_load_lds((const unsigned*)((const char*)(gbase) + (voff)[_i]), (PG8_LAS unsigned*)(lds + (bufoff) + ldsw + _i * 8192), 16, 0, 0); } while (0)
#define PG8_LDA(dst, b, h) do { _Pragma("unroll") for (int m = 0; m < 4; ++m) { const v4i_t lo_ = *(const PG8_LAS v4i_t*)(lds + PG8_SA(b, h) + aoff8[0] + m * 2048), hi_ = *(const PG8_LAS v4i_t*)(lds + PG8_SA(b, h) + aoff8[1] + m * 2048); dst[m] = __builtin_shufflevector(lo_, hi_, 0, 1, 2, 3, 4, 5, 6, 7); } } while (0)
#define PG8_LDB(dst, b, h) do { _Pragma("unroll") for (int n = 0; n < 2; ++n) { const v4i_t lo_ = *(const PG8_LAS v4i_t*)(lds + PG8_SB(b, h) + boff8[0] + n * 2048), hi_ = *(const PG8_LAS v4i_t*)(lds + PG8_SB(b, h) + boff8[1] + n * 2048); dst[n] = __builtin_shufflevector(lo_, hi_, 0, 1, 2, 3, 4, 5, 6, 7); } } while (0)
#define PG8_MMA(ai, bj, At, Bt) do { if ((ai) ? do1 : do0) { __builtin_amdgcn_s_setprio(1); _Pragma("unroll") for (int m = 0; m < 4; ++m) _Pragma("unroll") for (int n = 0; n < 2; ++n) \
        asm volatile("v_mfma_scale_f32_16x16x128_f8f6f4 %0, %1, %2, %0, %3, %4 op_sel_hi:[0,0,0]" : "+v"(acc[ai][bj][m][n]) : "v"(Bt[n]), "v"(At[m]), "v"(sa), "v"(sb)); __builtin_amdgcn_s_setprio(0); } } while (0)
#define PG8_WAIT_V(n) asm volatile("s_waitcnt vmcnt(" #n ")" ::: "memory")
#define PG8_WAIT_L(n) asm volatile("s_waitcnt lgkmcnt(" #n ")" ::: "memory")
#define PG8_BAR __builtin_amdgcn_s_barrier()
#define PG8_SCHED __builtin_amdgcn_sched_barrier(0)
    Unit cur, nxt; int ui = 0;
    if (!S.next(0, cur)) return;
    bool do0 = wr * 64 < S.vrows(cur), do1 = wr * 64 + HALF < S.vrows(cur);
    f32x4 acc[2][2][4][2];
#pragma unroll
    for (int a = 0; a < 2; ++a)
#pragma unroll
        for (int b = 0; b < 2; ++b)
#pragma unroll
            for (int m = 0; m < 4; ++m)
#pragma unroll
                for (int n = 0; n < 2; ++n) acc[a][b][m][n] = (f32x4){0.f, 0.f, 0.f, 0.f};
    v8i_t At[4], B0[2], B1[2];
    const char* cA = (const char*)g.A; PG8_GOFF(cur.pm, vcur); const char* cB = (const char*)g.Bt + (size_t)cur.pn * tstepB;
    S.a_ready(cur);
    if constexpr (SP2) {
        PG8_STAGE(PG8_SB(0, 0), cB, voffB); PG8_STAGE(PG8_SB(0, 1), cB + hstepB, voffB); PG8_STAGE(PG8_SA(0, 0), cA, vcur[0]); PG8_STAGE(PG8_SA(0, 1), cA, vcur[1]);
        if (wr == 1) PG8_BAR;
        PG8_WAIT_V(2); PG8_BAR;
        PG8_STAGE(PG8_SB(1, 0), cB + kstep, voffB); PG8_STAGE(PG8_SA(1, 0), cA + kstep, vcur[0]); PG8_STAGE(PG8_SB(1, 1), cB + hstepB + kstep, voffB);
        PG8_WAIT_V(6); PG8_BAR;
    } else {
        PG8_STAGE(PG8_SB(0, 0), cB, voffB); PG8_STAGE(PG8_SA(0, 0), cA, vcur[0]); PG8_STAGE(PG8_SB(0, 1), cB + hstepB, voffB); PG8_STAGE(PG8_SA(0, 1), cA, vcur[1]);
        if (wr == 1) PG8_BAR;
        PG8_WAIT_V(4); PG8_BAR;
        PG8_STAGE(PG8_SB(1, 0), cB + kstep, voffB); PG8_STAGE(PG8_SA(1, 0), cA + kstep, vcur[0]); PG8_STAGE(PG8_SB(1, 1), cB + hstepB + kstep, voffB);
        PG8_WAIT_V(6); PG8_BAR;
    }
    for (;;) {
        const bool has_next = S.next(ui + 1, nxt);
        const char* nA = cA; if (has_next) PG8_GOFF(nxt.pm, vnxt); else { _Pragma("unroll") for (int h_ = 0; h_ < 2; ++h_) _Pragma("unroll") for (int i_ = 0; i_ < 2; ++i_) vnxt[h_][i_] = vcur[h_][i_]; } const char* nB = has_next ? (const char*)g.Bt + (size_t)nxt.pn * tstepB : cB;
        for (int t = 0; t < nt; t += 2) {
            const bool last = (t == nt - 2);
            _Pragma("unroll") for (int h_ = 0; h_ < 2; ++h_) _Pragma("unroll") for (int i_ = 0; i_ < 2; ++i_) vsel[h_][i_] = last ? vnxt[h_][i_] : vcur[h_][i_];
            const char* a1 = cA + (size_t)(t + 1) * kstep;
            const char* a2 = last ? nA : cA + (size_t)(t + 2) * kstep; const char* b2 = last ? nB : cB + (size_t)(t + 2) * kstep;
            const char* a3 = a2 + kstep; const char* b3 = b2 + kstep;
            if (last && has_next) S.a_ready(nxt);
            if constexpr (SP2) {
            PG8_LDB(B0, 0, 0); PG8_LDB(B1, 0, 1); PG8_SCHED; PG8_LDA(At, 0, 0); PG8_STAGE(PG8_SA(1, 1), a1, vcur[1]);
            PG8_WAIT_V(8); PG8_WAIT_L(0); PG8_BAR; PG8_MMA(0, 0, At, B0); PG8_MMA(0, 1, At, B1); PG8_BAR; PG8_SCHED;
            PG8_LDA(At, 0, 1); PG8_STAGE(PG8_SB(0, 0), b2, voffB); PG8_STAGE(PG8_SB(0, 1), b2 + hstepB, voffB); PG8_STAGE(PG8_SA(0, 0), a2, vsel[0]);
            PG8_WAIT_V(8); PG8_WAIT_L(0); PG8_BAR; PG8_MMA(1, 0, At, B0); PG8_MMA(1, 1, At, B1); PG8_BAR; PG8_SCHED;
            PG8_LDB(B0, 1, 0); PG8_LDB(B1, 1, 1); PG8_SCHED; PG8_LDA(At, 1, 0); PG8_STAGE(PG8_SA(0, 1), a2, vsel[1]);
            PG8_WAIT_V(8); PG8_WAIT_L(0); PG8_BAR; PG8_MMA(0, 0, At, B0); PG8_MMA(0, 1, At, B1); PG8_BAR; PG8_SCHED;
            PG8_LDA(At, 1, 1); PG8_STAGE(PG8_SB(1, 0), b3, voffB); PG8_STAGE(PG8_SB(1, 1), b3 + hstepB, voffB); PG8_STAGE(PG8_SA(1, 0), a3, vsel[0]);
            PG8_WAIT_V(8); PG8_WAIT_L(0); PG8_BAR; PG8_MMA(1, 0, At, B0); PG8_MMA(1, 1, At, B1); PG8_BAR; PG8_SCHED;
            } else {
            PG8_LDB(B0, 0, 0); PG8_SCHED; PG8_LDA(At, 0, 0); PG8_STAGE(PG8_SA(1, 1), a1, vcur[1]);
            PG8_WAIT_L(8); PG8_BAR; PG8_WAIT_L(0); PG8_MMA(0, 0, At, B0); PG8_BAR; PG8_SCHED;
            PG8_LDB(B1, 0, 1); PG8_STAGE(PG8_SB(0, 0), b2, voffB);
            PG8_BAR; PG8_WAIT_L(0); PG8_MMA(0, 1, At, B1); PG8_BAR;
            PG8_LDA(At, 0, 1); PG8_STAGE(PG8_SA(0, 0), a2, vsel[0]);
            PG8_BAR; PG8_WAIT_L(0); PG8_MMA(1, 0, At, B0); PG8_BAR; PG8_SCHED;
            PG8_STAGE(PG8_SB(0, 1), b2 + hstepB, voffB);
            PG8_WAIT_V(6); PG8_BAR; PG8_MMA(1, 1, At, B1); PG8_BAR;
            PG8_LDB(B0, 1, 0); PG8_SCHED; PG8_LDA(At, 1, 0); PG8_STAGE(PG8_SA(0, 1), a2, vsel[1]);
            PG8_WAIT_L(8); PG8_BAR; PG8_WAIT_L(0); PG8_MMA(0, 0, At, B0); PG8_BAR; PG8_SCHED;
            PG8_LDB(B1, 1, 1); PG8_STAGE(PG8_SB(1, 0), b3, voffB);
            PG8_BAR; PG8_WAIT_L(0); PG8_MMA(0, 1, At, B1); PG8_BAR;
            PG8_LDA(At, 1, 1); PG8_STAGE(PG8_SA(1, 0), a3, vsel[0]);
            PG8_BAR; PG8_WAIT_L(0); PG8_MMA(1, 0, At, B0); PG8_BAR; PG8_SCHED;
            PG8_STAGE(PG8_SB(1, 1), b3 + hstepB, voffB);
            PG8_WAIT_V(6); PG8_BAR; PG8_MMA(1, 1, At, B1); PG8_BAR;
            }
        }
        if constexpr (ALIGN_EPI) { if (wr == 0) PG8_BAR; }
        asm volatile("s_nop 15\n\ts_nop 15" ::: "memory"); __builtin_amdgcn_sched_barrier(0);
        if constexpr (!Epi::AFTER_DRAIN) { E(acc, cur, wr, wc, fr, fq); S.done(cur); }
        if (!has_next) break;
#pragma unroll
        for (int a = 0; a < 2; ++a)
#pragma unroll
            for (int b = 0; b < 2; ++b)
#pragma unroll
                for (int m = 0; m < 4; ++m)
#pragma unroll
                    for (int n = 0; n < 2; ++n) acc[a][b][m][n] = (f32x4){0.f, 0.f, 0.f, 0.f};
        cur = nxt; cA = nA; cB = nB; ++ui; _Pragma("unroll") for (int h_ = 0; h_ < 2; ++h_) _Pragma("unroll") for (int i_ = 0; i_ < 2; ++i_) vcur[h_][i_] = vnxt[h_][i_];
        do0 = wr * 64 < S.vrows(cur); do1 = wr * 64 + HALF < S.vrows(cur);
        if constexpr (ALIGN_EPI) { if (wr == 1) PG8_BAR; }
    }
    PG8_WAIT_V(0);
    if constexpr (!ALIGN_EPI) { if (wr == 0) PG8_BAR; }
    PG8_BAR;
    if constexpr (Epi::AFTER_DRAIN) { E.fused(acc, cur, wr, wc, fr, fq, lds, wid, lane); S.done(cur); }
#undef PG8_GOFF
#undef PG8_SA
#undef PG8_SB
#undef PG8_STAGE
#undef PG8_LDA
#undef PG8_LDB
#undef PG8_MMA
#undef PG8_WAIT_V
#undef PG8_WAIT_L
#undef PG8_BAR
#undef PG8_SCHED
}
#undef PG8_CAT
}
#ifndef PG8_SP2
#define PG8_SP2 true
#endif
#ifndef PG8_ALIGN
#define PG8_ALIGN true
#endif
constexpr int NB = 2, SEQ = 8192, DM = 1024, LCTX = 256, DEPTH = 2;
constexpr int NX = NB * SEQ, NC = NB * LCTX, NR = NX + NC;
constexpr int INW = 1536, NE = 16, FF = 2048, CAPX = 1024, CAPC = 32;
constexpr int SLOTS_E = 2304, NSLOT = NE * SLOTS_E;
constexpr float LN_EPS = 1e-5f, ALPHA = 1.41421356237309515f;
constexpr int NWAVES = 8, NTHREADS = 512;
constexpr int RING_BYTES = 131072, LDS_BYTES = 147456;

constexpr size_t MiB = 1u << 20, KiB = 1u << 10;
constexpr size_t WS_MOD = 1 * MiB;
constexpr size_t WS_ROPE = 1 * MiB + 160 * KiB;
constexpr size_t WS_LBAR = 1 * MiB + 192 * KiB;
constexpr size_t WS_BBAR = 1 * MiB + 256 * KiB;
constexpr size_t WS_BINP = 1 * MiB + 768 * KiB;
constexpr size_t WS_AFF = 2 * MiB;
constexpr size_t WS_AFFC = 3 * MiB;
constexpr size_t WS_IDX = 3 * MiB + 64 * KiB;
constexpr size_t WS_GATE = 3 * MiB + 256 * KiB;
constexpr size_t WS_TOKSLOT = 4 * MiB;
constexpr size_t WS_WIN = 6 * MiB;
constexpr size_t WS_WOUT = 12 * MiB;
constexpr size_t WS_WGU = 16 * MiB;
constexpr size_t WS_WD = 272 * MiB;
constexpr size_t WS_HX = 400 * MiB;
constexpr size_t WS_Q = 433 * MiB;
constexpr size_t WS_K = 450 * MiB;
constexpr size_t WS_V = 455 * MiB;
constexpr size_t WS_U = 460 * MiB;
constexpr size_t WS_HG = 477 * MiB;
constexpr size_t WS_YF = 494 * MiB;
constexpr size_t WS_YB = 511 * MiB;
constexpr size_t WS_CAT = 528 * MiB;
constexpr size_t WS_YMIX = 561 * MiB;
constexpr size_t WS_XS = 528 * MiB;
constexpr size_t WS_XMID = 627 * MiB;
constexpr size_t WS_XCUR = 693 * MiB;
constexpr size_t WS_HID = 759 * MiB;
constexpr size_t WS_PX = 759 * MiB;
constexpr size_t WS_YEXP = 903 * MiB;
constexpr size_t WS_END = 975 * MiB;

#define LAS __attribute__((address_space(3)))
typedef unsigned short bf16;
typedef unsigned v4u __attribute__((ext_vector_type(4)));
typedef unsigned v2u __attribute__((ext_vector_type(2)));
typedef float f32x4 __attribute__((ext_vector_type(4)));
#define LDS_WAIT() asm volatile("s_waitcnt lgkmcnt(0)" ::: "memory")
__device__ __forceinline__ unsigned f2bf(float f) { unsigned u = __builtin_bit_cast(unsigned, f); return (u + 0x7fffu + ((u >> 16) & 1u)) >> 16; }
__device__ __forceinline__ unsigned pk2(float lo, float hi) { return f2bf(lo) | (f2bf(hi) << 16); }
__device__ __forceinline__ float bflo(unsigned w) { return __builtin_bit_cast(float, w << 16); }
__device__ __forceinline__ float bfhi(unsigned w) { return __builtin_bit_cast(float, w & 0xffff0000u); }
__device__ __forceinline__ float bf2f(bf16 b) { return __builtin_bit_cast(float, ((unsigned)b) << 16); }
template <int CTRL> __device__ __forceinline__ float dppf(float x) { return __builtin_bit_cast(float, __builtin_amdgcn_update_dpp(0, __builtin_bit_cast(int, x), CTRL, 0xf, 0xf, true)); }
template <int CTRL> __device__ __forceinline__ int dppi(int x) { return __builtin_amdgcn_update_dpp(0, x, CTRL, 0xf, 0xf, true); }
constexpr int DPP_X1 = 0xB1, DPP_X2 = 0x4E, DPP_HM = 0x141, DPP_RM = 0x140;
__device__ __forceinline__ void swap16(float& a, float& b) { asm("s_nop 1\n\tv_permlane16_swap_b32 %0, %1" : "+v"(a), "+v"(b)); }
__device__ __forceinline__ void swap32(float& a, float& b) { asm("s_nop 1\n\tv_permlane32_swap_b32 %0, %1" : "+v"(a), "+v"(b)); }
__device__ __forceinline__ float xrow_sum(float v) { { float a = v, b = v; swap16(a, b); v = a + b; } { float a = v, b = v; swap32(a, b); v = a + b; } return v; }
__device__ __forceinline__ float row_sum16(float v) { v += dppf<DPP_X1>(v); v += dppf<DPP_X2>(v); v += dppf<DPP_HM>(v); v += dppf<DPP_RM>(v); return v; }
__device__ __forceinline__ float row_max16(float v) { v = fmaxf(v, dppf<DPP_X1>(v)); v = fmaxf(v, dppf<DPP_X2>(v)); v = fmaxf(v, dppf<DPP_HM>(v)); v = fmaxf(v, dppf<DPP_RM>(v)); return v; }
__device__ __forceinline__ float wave_sum(float v) { return xrow_sum(row_sum16(v)); }
__device__ __forceinline__ float wave_max(float v) { v = row_max16(v); { float a = v, b = v; swap16(a, b); v = fmaxf(a, b); } { float a = v, b = v; swap32(a, b); v = fmaxf(a, b); } return v; }
__device__ __forceinline__ int wave_sum_i(int v) {
    v += dppi<DPP_X1>(v); v += dppi<DPP_X2>(v); v += dppi<DPP_HM>(v); v += dppi<DPP_RM>(v);
    float f = __builtin_bit_cast(float, v);
    { float a = f, b = f; swap16(a, b); v = __builtin_bit_cast(int, a) + __builtin_bit_cast(int, b); f = __builtin_bit_cast(float, v); }
    { float a = f, b = f; swap32(a, b); v = __builtin_bit_cast(int, a) + __builtin_bit_cast(int, b); }
    return v;
}
__device__ __forceinline__ float sigmoid_f(float x) { return 1.f / (1.f + __expf(-x)); }
__device__ __forceinline__ float silu_f(float x) { return x / (1.f + __expf(-x)); }
__device__ __forceinline__ float gelu_tanh_f(float x) { const float u = 0.7978845608028654f * (x + 0.044715f * x * x * x); return 0.5f * x * (1.f + tanhf(u)); }

struct Args { const float* in[35]; float* out; unsigned char* ws; int ph_lo, ph_hi, G, pad; };
typedef const __attribute__((address_space(4))) Args* KArgs;
__device__ __forceinline__ KArgs kargs() { unsigned long long p = (unsigned long long)__builtin_amdgcn_kernarg_segment_ptr(); asm volatile("" : "+s"(p)); return (KArgs)p; }

__device__ __forceinline__ unsigned char* launder_ws(unsigned char* p) { unsigned long long v = (unsigned long long)p; asm volatile("" : "+s"(v)); return (unsigned char*)v; }
template <class T> __device__ __forceinline__ T* opq(T* p) { unsigned long long v = (unsigned long long)p; asm volatile("" : "+s"(v)); return (T*)v; }
struct Frame {
    LAS unsigned char* lds;
    int tid, lane, wave, bid, G, gw, NGW;
    unsigned char* ws;
};

__device__ __forceinline__ void s5_build_ops(Frame& F, unsigned char* ws_, KArgs ka, int l, int g);
constexpr size_t WS_WPT_FWD = 5 * MiB + 512 * KiB;
constexpr size_t WS_CTR = 16 * KiB;
__device__ __forceinline__ int maprow(int type, int n0) {
    if (type == 1) return 256 * (n0 >> 7) + (n0 & 127);
    if (type == 2) return 256 * (n0 >> 7) + 128 + (n0 & 127);
    if (type == 3) { if (n0 < 1024) return n0; if (n0 < 1280) { const int ch = n0 - 1024; return 1024 + 256 * (ch >> 7) + (ch & 127); } const int ch = n0 - 1280; return 1024 + 256 * (ch >> 7) + 128 + (ch & 127); }
    return n0;
}
struct TItem { const float* src; unsigned char* dst; int N, rowbytes, f8; float scale; };
__device__ __forceinline__ float sat_e4m3(float x) { return __builtin_amdgcn_fmed3f(x, -448.f, 448.f); }
__device__ __forceinline__ unsigned pack4_fp8(float a, float b, float c, float d) { int w = __builtin_amdgcn_cvt_pk_fp8_f32(sat_e4m3(a), sat_e4m3(b), 0, false); w = __builtin_amdgcn_cvt_pk_fp8_f32(sat_e4m3(c), sat_e4m3(d), w, true); return (unsigned)w; }
__device__ __forceinline__ TItem titem(const float* W, int K, int N, void* WT, int type, int item, int lane, int f8 = 0, float scale = 1.f) {
    const int nblk = N / 32, kb = item / nblk, nb = item % nblk, k0 = 64 * kb, n0 = 32 * nb;
    TItem t; t.src = W + (size_t)(k0 + (lane >> 5)) * N + n0 + (lane & 31); t.N = N; t.f8 = f8; t.scale = scale;
    t.rowbytes = f8 ? K : 2 * K; t.dst = (unsigned char*)WT + (size_t)maprow(type, n0) * t.rowbytes + (f8 ? k0 : 2 * k0); return t;
}
__device__ __forceinline__ void titem_load(const TItem& t, float (&tmp)[32]) {
#pragma unroll
    for (int i = 0; i < 32; ++i) tmp[i] = __builtin_nontemporal_load(t.src + (size_t)(2 * i) * t.N);
}
__device__ __forceinline__ void titem_finish(const TItem& t, const float (&tmp)[32], LAS float* scr, int lane) {
#pragma unroll
    for (int i = 0; i < 32; ++i) scr[(2 * i + (lane >> 5)) * 33 + (lane & 31)] = tmp[i];
    LDS_WAIT(); asm volatile("" ::: "memory");
    const int c = lane & 7;
#pragma unroll
    for (int j = 0; j < 4; ++j) { const int n = (lane >> 3) + 8 * j; const LAS float* s = scr + (8 * c) * 33 + n;
        if (t.f8) { const float sc = t.scale; v2u o; o.x = pack4_fp8(s[0 * 33] * sc, s[1 * 33] * sc, s[2 * 33] * sc, s[3 * 33] * sc); o.y = pack4_fp8(s[4 * 33] * sc, s[5 * 33] * sc, s[6 * 33] * sc, s[7 * 33] * sc);
            *(v2u*)(t.dst + (size_t)n * t.rowbytes + 8 * c) = o; }
        else { v4u o; o.x = pk2(s[0 * 33], s[1 * 33]); o.y = pk2(s[2 * 33], s[3 * 33]); o.z = pk2(s[4 * 33], s[5 * 33]); o.w = pk2(s[6 * 33], s[7 * 33]);
            *(v4u*)(t.dst + (size_t)n * t.rowbytes + 16 * c) = o; } }
    LDS_WAIT(); asm volatile("" ::: "memory");
}
__device__ __forceinline__ void ph_prologue(Frame& F) {
    unsigned char* const ws_ = launder_ws(F.ws);
    KArgs ka = kargs();
    const float* c_in = ka->in[1]; const float* cctx = ka->in[3]; const float* w_mod = ka->in[4]; const float* b_mod = ka->in[5];
    for (int u = F.bid; u < 2 * 96; u += F.G) {
        const int l = u / 96, cc = u % 96;
        LAS float* sv = (LAS float*)F.lds;
        LAS float* part = sv + 3072;
        for (int i = F.tid; i < 3072; i += NTHREADS) { const int v = i >> 10, k = i & 1023; const float x = (v < 2) ? c_in[v * 1024 + k] : cctx[k]; sv[i] = silu_f(x); }
        __syncthreads();
        float a0 = 0.f, a1 = 0.f, a2 = 0.f;
        const float* wp = w_mod + (size_t)l * 1024 * 6144 + cc * 64 + F.lane;
#pragma nounroll
        for (int k0 = 0; k0 < 128; k0 += 32) { float wv[32];
#pragma unroll
            for (int q = 0; q < 32; ++q) wv[q] = __builtin_nontemporal_load(wp + (size_t)(F.wave * 128 + k0 + q) * 6144);
#pragma unroll
            for (int q = 0; q < 32; ++q) { const int k = F.wave * 128 + k0 + q; a0 += sv[k] * wv[q]; a1 += sv[1024 + k] * wv[q]; a2 += sv[2048 + k] * wv[q]; } }
        part[(F.wave * 3 + 0) * 64 + F.lane] = a0; part[(F.wave * 3 + 1) * 64 + F.lane] = a1; part[(F.wave * 3 + 2) * 64 + F.lane] = a2;
        __syncthreads();
        if (F.tid < 192) { const int v = F.tid >> 6, j = F.tid & 63; float s = b_mod[l * 6144 + cc * 64 + j];
#pragma unroll
            for (int w = 0; w < 8; ++w) s += part[(w * 3 + v) * 64 + j];
            ((float*)(ws_ + WS_MOD))[(l * 3 + v) * 6144 + cc * 64 + j] = s; }
        __syncthreads();
    }
    if (F.bid >= 192 && F.bid < 224) { const int u = F.bid - 192; s5_build_ops(F, ws_, ka, u >> 4, u & 15); }
    const int gid = F.bid * NTHREADS + F.tid;
    if (gid < 2048) { const int pos = gid >> 4, i = gid & 15; const double ang = (double)pos * pow(10000.0, -(double)i / 16.0);
        float* rp = (float*)(ws_ + WS_ROPE) + gid * 2; rp[0] = (float)cos(ang); rp[1] = (float)sin(ang); }
    if (gid >= 4096 && gid < 4096 + 3072) { const int i = gid - 4096, l = i / 1536, n = i % 1536; ((float*)(ws_ + WS_BINP))[l * 1536 + maprow(3, n & ~31) + (n & 31)] = ka->in[7][l * 1536 + n]; }
    {
        LAS float* scr = (LAS float*)(F.lds + F.wave * 16384);
        constexpr int S_IN = 16 * 48, S_OUT = 16 * 32, S_PW = 2 * 32, PER_S = S_IN + S_OUT + S_PW;
        for (int it = F.gw; it < 2 * PER_S; it += F.NGW) { const int l_ = it / PER_S; int r_ = it % PER_S; TItem T;
            if (r_ < S_IN) T = titem(ka->in[6] + (size_t)l_ * 1024 * 1536, 1024, 1536, (bf16*)(ws_ + WS_WIN) + (size_t)l_ * 1536 * 1024, 3, r_, F.lane);
            else if ((r_ -= S_IN) < S_OUT) T = titem(ka->in[25] + (size_t)l_ * 1024 * 1024, 1024, 1024, (bf16*)(ws_ + WS_WOUT) + (size_t)l_ * 1024 * 1024, 0, r_, F.lane);
            else { r_ -= S_OUT; const int w_ = r_ >> 5; T = titem(ka->in[w_ ? 23 : 17] + (size_t)l_ * 65536, 256, 256, (bf16*)(ws_ + WS_WPT_FWD) + (size_t)(l_ * 2 + w_) * 65536, 0, r_ & 31, F.lane); }
            float tc[32]; titem_load(T, tc); titem_finish(T, tc, scr, F.lane); }
    }
    __syncthreads();
    {
        LAS float* T = (LAS float*)F.lds;
        LAS unsigned* bc = (LAS unsigned*)(F.lds + 128 * 260 * 4);
        unsigned* ctr = (unsigned*)(ws_ + WS_CTR);
        constexpr int TPM = 64, TPE = 3 * TPM, NT_ALL = 2 * NE * TPE;
        const int lk = F.tid >> 6, ln4 = F.tid & 63;
        const int sn = F.tid >> 1, sq = F.tid & 1;
        struct Tl { const float* src; unsigned char* dst; int N, K; float sc; };
#define TILE_DECODE(t, X) do { const int le_ = (t) / TPE, r_ = (t) % TPE, which_ = r_ / TPM, ti_ = r_ % TPM; \
            if (which_ < 2) { const int kb_ = ti_ >> 3, nb_ = ti_ & 7; X.N = 2048; X.K = 1024; X.sc = 32.f; \
                X.src = ka->in[30 + which_] + (size_t)le_ * 1024 * 2048 + (size_t)(128 * kb_) * 2048 + 256 * nb_; \
                X.dst = ws_ + WS_WGU + (size_t)le_ * 4096 * 1024 + (size_t)(512 * nb_ + 128 * which_) * 1024 + 128 * kb_; } \
            else { const int kb_ = ti_ >> 2, nb_ = ti_ & 3; X.N = 1024; X.K = 2048; X.sc = 64.f; \
                X.src = ka->in[32] + (size_t)le_ * 2048 * 1024 + (size_t)(128 * kb_) * 1024 + 256 * nb_; \
                X.dst = ws_ + WS_WD + (size_t)le_ * 1024 * 2048 + (size_t)(256 * nb_) * 2048 + 128 * kb_; } } while (0)
#define TILE_LOAD(X, R) do { _Pragma("unroll") for (int i = 0; i < 16; ++i) R[i] = __builtin_nontemporal_load((const f32x4*)(X.src + (size_t)(lk + 8 * i) * X.N + 4 * ln4)); } while (0)
#define TILE_DRAW(t) do { __syncthreads(); if (F.tid == 0) bc[0] = __hip_atomic_fetch_add(ctr, 1u, __ATOMIC_RELAXED, __HIP_MEMORY_SCOPE_AGENT); __syncthreads(); t = (int)bc[0]; } while (0)
        int tcur, tnxt; Tl cur, nxt; f32x4 rc[16], rn[16];
        TILE_DRAW(tcur);
        if (tcur < NT_ALL) { TILE_DECODE(tcur, cur); TILE_LOAD(cur, rc);
            for (;;) {
                TILE_DRAW(tnxt);
                const bool has = tnxt < NT_ALL;
                if (has) { TILE_DECODE(tnxt, nxt); TILE_LOAD(nxt, rn); }
#pragma unroll
                for (int i = 0; i < 16; ++i) *(LAS f32x4*)(T + (lk + 8 * i) * 260 + 4 * ln4) = rc[i];
                __syncthreads();
                { const float sc = cur.sc; const LAS float* s = T + (64 * sq) * 260 + sn;
                    const int rowoff = (cur.K == 1024) ? (256 * (sn >> 7) + (sn & 127)) : sn;
                    unsigned char* o = cur.dst + (size_t)rowoff * cur.K + 64 * sq;
#pragma unroll
                    for (int q = 0; q < 4; ++q) { unsigned w[4];
#pragma unroll
                        for (int j = 0; j < 4; ++j) { const int k_ = 16 * q + 4 * j; w[j] = pack4_fp8(s[k_ * 260] * sc, s[(k_ + 1) * 260] * sc, s[(k_ + 2) * 260] * sc, s[(k_ + 3) * 260] * sc); }
                        *(v4u*)(o + 16 * q) = (v4u){w[0], w[1], w[2], w[3]}; } }
                if (!has) break;
                cur = nxt;
#pragma unroll
                for (int i = 0; i < 16; ++i) rc[i] = rn[i];
            } }
#undef TILE_DRAW
#undef TILE_LOAD
#undef TILE_DECODE
    }
}

__device__ __forceinline__ void row_load(const float* p, int lane, f32x4 (&v)[4]) {
#pragma unroll
    for (int j = 0; j < 4; ++j) v[j] = ((const f32x4*)p)[lane + 64 * j];
}
__device__ __forceinline__ void row_ln(f32x4 (&v)[4]) {
    float s = 0.f;
#pragma unroll
    for (int j = 0; j < 4; ++j) s += (v[j].x + v[j].y) + (v[j].z + v[j].w);
    const float mean = wave_sum(s) * (1.f / 1024.f); float s2 = 0.f;
#pragma unroll
    for (int j = 0; j < 4; ++j) { v[j] = v[j] - mean; s2 += (v[j].x * v[j].x + v[j].y * v[j].y) + (v[j].z * v[j].z + v[j].w * v[j].w); }
    const float rstd = 1.f / sqrtf(wave_sum(s2) * (1.f / 1024.f) + LN_EPS);
#pragma unroll
    for (int j = 0; j < 4; ++j) v[j] = v[j] * rstd;
}
__device__ __forceinline__ void row_store_bf16(bf16* p, int lane, const f32x4 (&v)[4]) {
#pragma unroll
    for (int j = 0; j < 4; ++j) { v2u o; o.x = pk2(v[j].x, v[j].y); o.y = pk2(v[j].z, v[j].w); ((v2u*)p)[lane + 64 * j] = o; }
}
__device__ __forceinline__ int row_mod_index(int r) { return r < NX ? (r >> 13) : 2; }
__device__ __forceinline__ void modulate_store(f32x4 (&v)[4], const float* shift, const float* scale, bf16* dst, int lane) {
    f32x4 o[4];
#pragma unroll
    for (int j = 0; j < 4; ++j) { const f32x4 sh = ((const f32x4*)shift)[lane + 64 * j], sc = ((const f32x4*)scale)[lane + 64 * j]; o[j] = v[j] * (sc + 1.f) + sh; }
    row_store_bf16(dst, lane, o);
}
__device__ __forceinline__ void ph_rows0(Frame& F) {
    unsigned char* const ws_ = launder_ws(F.ws);
    KArgs ka = kargs();
    const float* MOD = (const float*)(ws_ + WS_MOD); bf16* HX = (bf16*)(ws_ + WS_HX);
    for (int r = F.gw; r < NR; r += F.NGW) {
        const float* src = r < NX ? ka->in[0] + (size_t)r * 1024 : ka->in[2] + (size_t)(r - NX) * 1024;
        f32x4 v[4]; row_load(src, F.lane, v); row_ln(v);
        const float* m = MOD + (0 * 3 + row_mod_index(r)) * 6144;
        modulate_store(v, m, m + 1024, HX + (size_t)r * 1024, F.lane);
    }
}
constexpr int S5T = 32, S5R = 768, S5K = 768;
constexpr size_t WS_HCTX = 1 * MiB + 800 * KiB;
constexpr size_t WS_LB32 = 1 * MiB + 832 * KiB;
constexpr size_t WS_KT = 975 * MiB;
constexpr size_t WS_BE = 999 * MiB;
constexpr size_t WS_UC = 494 * MiB;
constexpr size_t WS_E = 512 * MiB;
constexpr size_t WS_Z = WS_HID + 100 * MiB;
constexpr size_t WS_CN = WS_Z + (size_t)NR * 256 * 2;
constexpr size_t WS_END2 = 1019 * MiB;

__device__ __forceinline__ void s5_build_ops(Frame& F, unsigned char* ws_, KArgs ka, int l, int g) {
    LAS float* PW = (LAS float*)F.lds; LAS float* CM = PW + 8448; LAS float* BB = CM + 4096; LAS float* LAG = BB + 4096;
    __syncthreads();
    if (F.tid < 128) {
        const int d = F.tid >> 6, p = F.tid & 63; const int ldg = (l * 2 + d) * 16 + g;
        const double lr = ka->in[9][ldg * 64 + p], li = ka->in[10][ldg * 64 + p], dt = exp((double)ka->in[11][ldg]);
        const double zr = lr * dt, zi = li * dt, er = exp(zr), lbr = er * cos(zi), lbi = er * sin(zi);
        double pr = 1.0, pi = 0.0;
#pragma nounroll
        for (int tau = 0; tau <= 32; ++tau) { PW[((d * 33 + tau) * 64 + p) * 2] = (float)pr; PW[((d * 33 + tau) * 64 + p) * 2 + 1] = (float)pi; const double t = pr * lbr - pi * lbi; pi = pr * lbi + pi * lbr; pr = t; }
        const double nr = lbr - 1.0, ni = lbi, den = lr * lr + li * li, cr = (nr * lr + ni * li) / den, ci = (ni * lr - nr * li) / den;
        const float* bre = ka->in[12] + ((size_t)ldg * 64 + p) * 16; const float* bim = ka->in[13] + ((size_t)ldg * 64 + p) * 16;
        for (int c = 0; c < 16; ++c) { const double br = bre[c], bi = bim[c]; BB[((d * 64 + p) * 16 + c) * 2] = (float)(cr * br - ci * bi); BB[((d * 64 + p) * 16 + c) * 2 + 1] = (float)(cr * bi + ci * br); } }
    for (int i = F.tid; i < 2 * 16 * 64; i += NTHREADS) { const int d = i >> 10, r = i & 1023; const int ldg = (l * 2 + d) * 16 + g; CM[2 * i] = ka->in[14][(size_t)ldg * 1024 + r]; CM[2 * i + 1] = ka->in[15][(size_t)ldg * 1024 + r]; }
    __syncthreads();
    for (int it = F.tid; it < 2 * 32 * 16; it += NTHREADS) { const int d = it >> 9, tau = (it >> 4) & 31, c = it & 15;
        float acc[16];
#pragma unroll
        for (int q = 0; q < 16; ++q) acc[q] = 0.f;
        for (int p = 0; p < 64; ++p) { const float cr = CM[((d * 16 + c) * 64 + p) * 2], ci = CM[((d * 16 + c) * 64 + p) * 2 + 1], pr = PW[((d * 33 + tau) * 64 + p) * 2], pi = PW[((d * 33 + tau) * 64 + p) * 2 + 1];
            const float wr = cr * pr - ci * pi, wi = cr * pi + ci * pr;
#pragma unroll
            for (int q = 0; q < 16; ++q) acc[q] += wr * BB[((d * 64 + p) * 16 + q) * 2] - wi * BB[((d * 64 + p) * 16 + q) * 2 + 1]; }
#pragma unroll
        for (int q = 0; q < 16; ++q) LAG[((d * 32 + tau) * 16 + c) * 16 + q] = acc[q]; }
    __syncthreads();
    const float* dsk = ka->in[16] + l * 256 + g * 16;
    bf16* KT = (bf16*)(ws_ + WS_KT) + ((size_t)(l * 16 + g) * 512) * S5K;
    for (int pc = F.tid; pc < 512 * 96; pc += NTHREADS) { const int row = pc / 96, q8 = pc % 96, j = row >> 4, c = row & 15; float v[8];
        if (q8 < 64) { const int jp = q8 >> 1, c0 = (q8 & 1) * 8;
#pragma unroll
            for (int e = 0; e < 8; ++e) { float x = 0.f; if (j >= jp) x += LAG[((0 * 32 + (j - jp)) * 16 + c) * 16 + c0 + e]; if (j <= jp) x += LAG[((1 * 32 + (jp - j)) * 16 + c) * 16 + c0 + e]; if (j == jp && c == c0 + e) x += dsk[c]; v[e] = x; } }
        else { const int n0 = (q8 - 64) * 8, d = n0 >> 7, tau = d ? (32 - j) : (j + 1);
#pragma unroll
            for (int e = 0; e < 8; e += 2) { const int p = ((n0 & 127) + e) >> 1; const float cr = CM[((d * 16 + c) * 64 + p) * 2], ci = CM[((d * 16 + c) * 64 + p) * 2 + 1], pr = PW[((d * 33 + tau) * 64 + p) * 2], pi = PW[((d * 33 + tau) * 64 + p) * 2 + 1];
                v[e] = cr * pr - ci * pi; v[e + 1] = -(cr * pi + ci * pr); } }
        v4u o; o.x = pk2(v[0], v[1]); o.y = pk2(v[2], v[3]); o.z = pk2(v[4], v[5]); o.w = pk2(v[6], v[7]);
        *(v4u*)(KT + (size_t)row * S5K + q8 * 8) = o; }
    bf16* BE = (bf16*)(ws_ + WS_BE) + ((size_t)(l * 16 + g) * 256) * 512;
    for (int pc = F.tid; pc < 256 * 64; pc += NTHREADS) { const int n = pc >> 6, q8 = pc & 63, d = n >> 7, p = (n & 127) >> 1, ri = n & 1, jp = q8 >> 1, c0 = (q8 & 1) * 8, tau = d ? jp : (31 - jp);
        const float pr = PW[((d * 33 + tau) * 64 + p) * 2], pi = PW[((d * 33 + tau) * 64 + p) * 2 + 1]; float v[8];
#pragma unroll
        for (int e = 0; e < 8; ++e) { const float br = BB[((d * 64 + p) * 16 + c0 + e) * 2], bi = BB[((d * 64 + p) * 16 + c0 + e) * 2 + 1]; v[e] = ri ? (pr * bi + pi * br) : (pr * br - pi * bi); }
        v4u o; o.x = pk2(v[0], v[1]); o.y = pk2(v[2], v[3]); o.z = pk2(v[4], v[5]); o.w = pk2(v[6], v[7]);
        *(v4u*)(BE + (size_t)n * 512 + q8 * 8) = o; }
    if (F.tid < 128) { const int d = F.tid >> 6, p = F.tid & 63; float* o = (float*)(ws_ + WS_LB32) + (((size_t)(l * 16 + g) * 2 + d) * 64 + p) * 2; o[0] = PW[((d * 33 + 32) * 64 + p) * 2]; o[1] = PW[((d * 33 + 32) * 64 + p) * 2 + 1]; }
    __syncthreads();
}
__device__ __forceinline__ void s5_carry_tile(Frame& F, int l, int g, int mt) {
    unsigned char* const ws_ = launder_ws(F.ws);
    if (mt < 2) {
        const int b = mt, seg = F.tid >> 7, d = (F.tid >> 6) & 1, p = F.tid & 63, dp = F.tid & 127;
        const float* lb = (const float*)(ws_ + WS_LB32) + (((size_t)(l * 16 + g) * 2 + d) * 64 + p) * 2; const float ar = lb[0], ai = lb[1];
        const float* E = (const float*)(ws_ + WS_E) + ((size_t)g * S5R) * 256 + d * 128 + 2 * p;
        bf16* UC = (bf16*)(ws_ + WS_UC) + ((size_t)g * S5R) * S5K + 512 + d * 128 + 2 * p;
        LAS float* Ls = (LAS float*)F.lds;
        float er[64], ei[64], cr[8], ci[8];
#pragma unroll
        for (int q = 0; q < 8; ++q) { const int R = 512 + b * 8 + (d ? 7 - q : q); const float2 e2 = *(const float2*)(E + (size_t)R * 256); cr[q] = e2.x; ci[q] = e2.y; }
        const int R0 = b * 256 + (d ? 255 - 64 * seg : 64 * seg); const long estep = d ? -256 : 256, ustep = d ? -(long)S5K : (long)S5K;
        { const float* ep = E + (size_t)R0 * 256;
#pragma unroll
          for (int q = 0; q < 64; ++q) { const float2 e2 = *(const float2*)ep; er[q] = e2.x; ei[q] = e2.y; ep += estep; } }
        float sr = 0.f, si = 0.f;
#pragma unroll
        for (int q = 0; q < 8; ++q) { const float nr = ar * sr - ai * si + cr[q], ni = ar * si + ai * sr + ci[q]; sr = nr; si = ni; }
        float lr = 0.f, li = 0.f;
#pragma unroll
        for (int q = 0; q < 64; ++q) { const float nr = ar * lr - ai * li + er[q], ni = ar * li + ai * lr + ei[q]; lr = nr; li = ni; }
        float pr = ar, pi = ai;
#pragma unroll
        for (int i = 0; i < 6; ++i) { const float t = pr * pr - pi * pi; pi = 2.f * pr * pi; pr = t; }
        Ls[(seg * 128 + dp) * 2] = lr; Ls[(seg * 128 + dp) * 2 + 1] = li;
        __syncthreads();
        for (int s_ = 0; s_ < seg; ++s_) { const float Lr = Ls[(s_ * 128 + dp) * 2], Li = Ls[(s_ * 128 + dp) * 2 + 1]; const float nr = pr * sr - pi * si + Lr, ni = pr * si + pi * sr + Li; sr = nr; si = ni; }
        { bf16* up = UC + (size_t)R0 * S5K;
#pragma unroll
          for (int q = 0; q < 64; ++q) { *(unsigned*)up = pk2(sr, si); up += ustep;
            const float nr = ar * sr - ai * si + er[q], ni = ar * si + ai * sr + ei[q]; sr = nr; si = ni; } }
    } else if (F.tid < 256) { const int b = F.tid >> 7, d = (F.tid >> 6) & 1, p = F.tid & 63;
        const float* lb = (const float*)(ws_ + WS_LB32) + (((size_t)(l * 16 + g) * 2 + d) * 64 + p) * 2; const float ar = lb[0], ai = lb[1];
        float sr = 0.f, si = 0.f;
        const float* E = (const float*)(ws_ + WS_E) + ((size_t)g * S5R) * 256 + d * 128 + 2 * p;
        bf16* UC = (bf16*)(ws_ + WS_UC) + ((size_t)g * S5R) * S5K + 512 + d * 128 + 2 * p;
        float er[8], ei[8];
#pragma unroll
        for (int q = 0; q < 8; ++q) { const int R = 512 + b * 8 + (d ? 7 - q : q); const float2 e2 = *(const float2*)(E + (size_t)R * 256); er[q] = e2.x; ei[q] = e2.y; }
#pragma unroll
        for (int q = 0; q < 8; ++q) { const int R = 512 + b * 8 + (d ? 7 - q : q); *(unsigned*)(UC + (size_t)R * S5K) = pk2(sr, si);
            const float nr = ar * sr - ai * si + er[q], ni = ar * si + ai * sr + ei[q]; sr = nr; si = ni; }
    }
    asm volatile("s_waitcnt vmcnt(0)" ::: "memory");
    __syncthreads();
}
typedef short bf16x8_t __attribute__((ext_vector_type(8)));
typedef short bf16x4_t __attribute__((ext_vector_type(4)));
typedef float f32x16 __attribute__((ext_vector_type(16)));
typedef unsigned u32x4_t __attribute__((ext_vector_type(4)));
constexpr int AT_KROW = 72, AT_VROW = 388;
constexpr int AT_KBYTES = 640 * AT_KROW * 2, AT_VBYTES = 64 * AT_VROW * 2, AT_SCR = AT_KBYTES + AT_VBYTES;
static_assert(AT_SCR + 8 * 64 * 4 <= LDS_BYTES, "attention LDS");
__device__ __forceinline__ int at_crow(int r, int h) { return (r & 3) + 8 * (r >> 2) + 4 * h; }
__device__ __forceinline__ float mx2(float a, float b, float inf) { return __builtin_amdgcn_fmed3f(a, b, inf); }
__device__ __forceinline__ float max16(const f32x16& s, float inf) { const float a = mx2(mx2(s[0], s[1], inf), mx2(s[2], s[3], inf), inf), b = mx2(mx2(s[4], s[5], inf), mx2(s[6], s[7], inf), inf), c = mx2(mx2(s[8], s[9], inf), mx2(s[10], s[11], inf), inf), d = mx2(mx2(s[12], s[13], inf), mx2(s[14], s[15], inf), inf); return mx2(mx2(a, b, inf), mx2(c, d, inf), inf); }
__device__ __forceinline__ void ph_attn(Frame& F, int l, int ulo, int uhi, int wgi, int nwg) {
    unsigned char* const ws_ = launder_ws(F.ws);
    KArgs ka = kargs();
    const bf16* Q = (const bf16*)(ws_ + WS_Q); const bf16* K = (const bf16*)(ws_ + WS_K); const bf16* V = (const bf16*)(ws_ + WS_V);
    bf16* CAT = (bf16*)(ws_ + WS_CAT); const float* sink = ka->in[8] + l * 8;
    LAS bf16* Ks = (LAS bf16*)F.lds; LAS bf16* Vt = (LAS bf16*)(F.lds + AT_KBYTES); LAS float* scr = (LAS float*)(F.lds + AT_SCR) + F.wave * 64;
    const int lane = F.lane, l31 = lane & 31, h = lane >> 5, hh = F.wave >> 1, qh = F.wave & 1;
    for (int u = ulo + wgi; u < uhi; u += nwg) {
        int b, kvh, n, qrow0; bool win;
        if (u < 256) { b = u >> 7; kvh = (u >> 6) & 1; n = u & 63; win = true; qrow0 = b * SEQ + n * 128; }
        else { const int uc = u - 256; b = uc >> 2; kvh = (uc >> 1) & 1; n = uc & 1; win = false; qrow0 = NX + b * LCTX + n * 128; }
        __syncthreads();
#define AT_VT_WRITE(A_, B_, kp2_, ch_) do { LAS unsigned* vp_ = (LAS unsigned*)(Vt + ((ch_) * 8) * AT_VROW + 2 * (kp2_)); \
            vp_[0] = (A_.x & 0xffffu) | (B_.x << 16); vp_[AT_VROW / 2] = (A_.x >> 16) | (B_.x & 0xffff0000u); vp_[2 * (AT_VROW / 2)] = (A_.y & 0xffffu) | (B_.y << 16); vp_[3 * (AT_VROW / 2)] = (A_.y >> 16) | (B_.y & 0xffff0000u); \
            vp_[4 * (AT_VROW / 2)] = (A_.z & 0xffffu) | (B_.z << 16); vp_[5 * (AT_VROW / 2)] = (A_.z >> 16) | (B_.z & 0xffff0000u); vp_[6 * (AT_VROW / 2)] = (A_.w & 0xffffu) | (B_.w << 16); vp_[7 * (AT_VROW / 2)] = (A_.w >> 16) | (B_.w & 0xffff0000u); } while (0)
        int tid_ = F.tid; asm volatile("" : "+v"(tid_));
        {
            v4u kv[10], va[3], vb[3];
#pragma unroll
            for (int i = 0; i < 10; ++i) { kv[i] = (v4u){0u, 0u, 0u, 0u};
                if (win || i >= 6) { const int pc = tid_ + NTHREADS * i, row = pc >> 3, ch = pc & 7;
                    if (i < 6) { const int kp = 128 * (n - 1) + row; if (kp >= 0 && kp < SEQ) kv[i] = *(const v4u*)(K + ((size_t)(b * SEQ + kp)) * 128 + kvh * 64 + ch * 8); }
                    else kv[i] = *(const v4u*)(K + ((size_t)(NX + b * LCTX + row - 384)) * 128 + kvh * 64 + ch * 8); } }
            if (win) {
#pragma unroll
                for (int it = 0; it < 3; ++it) { const int idx = tid_ + NTHREADS * it, kp2 = idx >> 3, ch = idx & 7, kp = 128 * (n - 1) + 2 * kp2; va[it] = (v4u){0u, 0u, 0u, 0u}; vb[it] = va[it];
                    if (kp >= 0 && kp < SEQ) { const bf16* vsrc = V + ((size_t)(b * SEQ + kp)) * 128 + kvh * 64 + ch * 8; va[it] = *(const v4u*)vsrc; vb[it] = *(const v4u*)(vsrc + 128); } } }
#pragma unroll
            for (int i = 0; i < 10; ++i) if (win || i >= 6) { const int pc = tid_ + NTHREADS * i, row = pc >> 3, ch = pc & 7; *(LAS v4u*)(Ks + row * AT_KROW + ch * 8) = kv[i]; }
            if (win) {
#pragma unroll
                for (int it = 0; it < 3; ++it) { const int idx = tid_ + NTHREADS * it, kp2 = idx >> 3, ch = idx & 7; AT_VT_WRITE(va[it], vb[it], kp2, ch); } }
        }
        const int head = kvh * 4 + hh; const int qbase = qh * 64;
        bf16x8_t qf[2][4];
#pragma unroll
        for (int qb = 0; qb < 2; ++qb)
#pragma unroll
            for (int s = 0; s < 4; ++s) qf[qb][s] = *(const bf16x8_t*)(Q + ((size_t)(qrow0 + qbase + qb * 32 + l31)) * 512 + head * 64 + 16 * s + 8 * h);
        __syncthreads();
        const int qpos0 = n * 128 + qbase + l31;
        const int klo0 = max(qpos0 - 128, 0), klo1 = max(qpos0 + 32 - 128, 0); const unsigned span0 = (unsigned)(min(qpos0 + 128, SEQ - 1) - klo0), span1 = (unsigned)(min(qpos0 + 32 + 128, SEQ - 1) - klo1);
        const int wlo = win ? (qh ? 2 : 0) : 12, whi = win ? (qh ? 12 : 10) : 12;
#define AT_SCORES(st, S0, S1, MASKED, I0, I1) do { \
            const LAS bf16* kp_ = Ks + ((st) * 32 + l31) * AT_KROW + 8 * h; \
            _Pragma("unroll") for (int s = 0; s < 4; ++s) { const bf16x8_t kf = *(const LAS bf16x8_t*)(kp_ + 16 * s); \
                S0 = __builtin_amdgcn_mfma_f32_32x32x16_bf16(kf, qf[0][s], s ? S0 : (I0), 0, 0, 0); S1 = __builtin_amdgcn_mfma_f32_32x32x16_bf16(kf, qf[1][s], s ? S1 : (I1), 0, 0, 0); } \
            if ((MASKED) && (st) < 12 && ((st) < 4 || (st) >= 8)) { const int d0_ = 128 * (n - 1) + (st) * 32 + 4 * h - klo0, d1_ = d0_ + klo0 - klo1;     \
                _Pragma("unroll") for (int r = 0; r < 16; ++r) { const int c_ = (r & 3) + 8 * (r >> 2); \
                    if ((unsigned)(d0_ + c_) > span0) S0[r] = -1e30f; if ((unsigned)(d1_ + c_) > span1) S1[r] = -1e30f; } } \
        } while (0)
        const f32x16 Z16 = (f32x16){0.f,0.f,0.f,0.f,0.f,0.f,0.f,0.f,0.f,0.f,0.f,0.f,0.f,0.f,0.f,0.f};
        float m0 = -1e30f, m1 = -1e30f, INF_ = __builtin_inff(); asm volatile("" : "+v"(INF_));
#define AT_KLOAD(st, KF) do { const LAS bf16* kp_ = Ks + ((st) * 32 + l31) * AT_KROW + 8 * h; _Pragma("unroll") for (int s = 0; s < 4; ++s) KF[s] = *(const LAS bf16x8_t*)(kp_ + 16 * s); } while (0)
#define AT_QK(KF, S0, S1, I0, I1) do { _Pragma("unroll") for (int s = 0; s < 4; ++s) { S0 = __builtin_amdgcn_mfma_f32_32x32x16_bf16(KF[s], qf[0][s], s ? S0 : (I0), 0, 0, 0); S1 = __builtin_amdgcn_mfma_f32_32x32x16_bf16(KF[s], qf[1][s], s ? S1 : (I1), 0, 0, 0); } } while (0)
        const int nw = whi - wlo, nt = nw + 8;
#define AT_STOF(j) ((j) < nw ? wlo + (j) : 12 + (j) - nw)
        { bf16x8_t kA[4], kB[4]; f32x16 Sa0, Sa1, Sb0, Sb1;
        AT_KLOAD(AT_STOF(0), kA);
#pragma nounroll
        for (int j = 0; j < nt; j += 2) {
            AT_KLOAD(AT_STOF(j + 1), kB);
            __builtin_amdgcn_sched_barrier(0);
            AT_QK(kA, Sa0, Sa1, Z16, Z16);
            __builtin_amdgcn_sched_barrier(0);
            if (j + 2 < nt) AT_KLOAD(AT_STOF(j + 2), kA);
            __builtin_amdgcn_sched_barrier(0);
            AT_QK(kB, Sb0, Sb1, Z16, Z16);
            m0 = mx2(m0, max16(Sa0, INF_), INF_); m1 = mx2(m1, max16(Sa1, INF_), INF_);
            __builtin_amdgcn_sched_barrier(0);
            m0 = mx2(m0, max16(Sb0, INF_), INF_); m1 = mx2(m1, max16(Sb1, INF_), INF_);
        } }
        m0 = fmaxf(m0, __shfl_xor(m0, 32)); m1 = fmaxf(m1, __shfl_xor(m1, 32));
        const float sk = sink[head] * 1.4426950408889634f;
        m0 = fmaxf(m0, sk); m1 = fmaxf(m1, sk);
        float l0 = 0.f, l1 = 0.f; f32x16 O[2][2], NM0, NM1;
#pragma unroll
        for (int r = 0; r < 16; ++r) { NM0[r] = -m0; NM1[r] = -m1; }
#pragma unroll
        for (int a_ = 0; a_ < 2; ++a_)
#pragma unroll
            for (int b_ = 0; b_ < 2; ++b_) O[a_][b_] = (f32x16){0.f,0.f,0.f,0.f,0.f,0.f,0.f,0.f,0.f,0.f,0.f,0.f,0.f,0.f,0.f,0.f};
#define AT_PV(st, voff) do { f32x16 S0, S1; AT_SCORES(st, S0, S1, true, NM0, NM1);     \
            _Pragma("unroll") for (int r = 0; r < 16; ++r) { S0[r] = __builtin_amdgcn_exp2f(S0[r]); S1[r] = __builtin_amdgcn_exp2f(S1[r]);     l0 += S0[r]; l1 += S1[r]; } \
            _Pragma("unroll") for (int ks = 0; ks < 2; ++ks) { \
                u32x4_t pa0, pa1; \
                pa0.x = pg8::cvt_pk_bf16(S0[8 * ks + 0], S0[8 * ks + 1]); pa0.y = pg8::cvt_pk_bf16(S0[8 * ks + 2], S0[8 * ks + 3]); pa0.z = pg8::cvt_pk_bf16(S0[8 * ks + 4], S0[8 * ks + 5]); pa0.w = pg8::cvt_pk_bf16(S0[8 * ks + 6], S0[8 * ks + 7]); \
                pa1.x = pg8::cvt_pk_bf16(S1[8 * ks + 0], S1[8 * ks + 1]); pa1.y = pg8::cvt_pk_bf16(S1[8 * ks + 2], S1[8 * ks + 3]); pa1.z = pg8::cvt_pk_bf16(S1[8 * ks + 4], S1[8 * ks + 5]); pa1.w = pg8::cvt_pk_bf16(S1[8 * ks + 6], S1[8 * ks + 7]); \
                _Pragma("unroll") for (int db = 0; db < 2; ++db) { const LAS bf16* vp_ = Vt + (db * 32 + l31) * AT_VROW + (voff) + 16 * ks + 4 * h; \
                    const bf16x4_t lo_ = *(const LAS bf16x4_t*)vp_, hi_ = *(const LAS bf16x4_t*)(vp_ + 8); \
                    const bf16x8_t vf = (bf16x8_t){lo_[0], lo_[1], lo_[2], lo_[3], hi_[0], hi_[1], hi_[2], hi_[3]}; \
                    O[0][db] = __builtin_amdgcn_mfma_f32_32x32x16_bf16(__builtin_bit_cast(bf16x8_t, pa0), vf, O[0][db], 0, 0, 0); \
                    O[1][db] = __builtin_amdgcn_mfma_f32_32x32x16_bf16(__builtin_bit_cast(bf16x8_t, pa1), vf, O[1][db], 0, 0, 0); } } \
        } while (0)
        if (win) {
#pragma nounroll
            for (int st = wlo; st < whi; ++st) AT_PV(st, st * 32); }
        v4u ca[2], cb[2];
#pragma unroll
        for (int it = 0; it < 2; ++it) { const int idx = tid_ + NTHREADS * it, kp2 = idx >> 3, ch = idx & 7; const bf16* vsrc = V + ((size_t)(NX + b * LCTX + 2 * kp2)) * 128 + kvh * 64 + ch * 8; ca[it] = *(const v4u*)vsrc; cb[it] = *(const v4u*)(vsrc + 128); }
        __syncthreads();
#pragma unroll
        for (int it = 0; it < 2; ++it) { const int idx = tid_ + NTHREADS * it, kp2 = idx >> 3, ch = idx & 7; AT_VT_WRITE(ca[it], cb[it], kp2, ch); }
        __syncthreads();
#pragma nounroll
        for (int st = 12; st < 20; ++st) AT_PV(st, (st - 12) * 32);
#undef AT_PV
#undef AT_VT_WRITE
#undef AT_SCORES
#undef AT_KLOAD
#undef AT_QK
#undef AT_STOF
        l0 += __shfl_xor(l0, 32); l1 += __shfl_xor(l1, 32);
        l0 += __builtin_amdgcn_exp2f(sk - m0); l1 += __builtin_amdgcn_exp2f(sk - m1);
        if (h == 0) { scr[l31] = 1.f / l0; scr[32 + l31] = 1.f / l1; }
        LDS_WAIT();
#pragma unroll
        for (int qb = 0; qb < 2; ++qb)
#pragma unroll
            for (int r = 0; r < 16; ++r) { const int qq = at_crow(r, h); const float inv = scr[qb * 32 + qq]; const size_t row = (size_t)(qrow0 + qbase + qb * 32 + qq);
#pragma unroll
                for (int db = 0; db < 2; ++db) CAT[row * 1024 + head * 64 + db * 32 + l31] = (bf16)f2bf(O[qb][db][r] * inv); }
    }
}
constexpr size_t WS_WPT = 5 * MiB + 512 * KiB;
__device__ __forceinline__ void ph_conv(Frame& F, int l, int tlo, int thi, int wgi, int nwg, unsigned* ctr) {
    unsigned char* const ws_ = launder_ws(F.ws);
    KArgs ka = kargs();
    const bf16* HG = (const bf16*)(ws_ + WS_HG); bf16* CN = (bf16*)(ws_ + WS_CN);
    LAS float* Hs = (LAS float*)F.lds; LAS float* Ws = Hs + 94 * 256;
    const int lane = F.lane, c4 = 4 * lane;
    __syncthreads();
    for (int i = F.tid; i < 31 * 256; i += NTHREADS) Ws[i] = ka->in[19][(size_t)l * 31 * 256 + i];
    const f32x4 bd = *(const f32x4*)(ka->in[20] + l * 256 + c4), lg = *(const f32x4*)(ka->in[21] + l * 256 + c4), lb = *(const f32x4*)(ka->in[22] + l * 256 + c4);
    LAS unsigned* bc = (LAS unsigned*)(F.lds + 131072);
#define CONV_DRAW(t) do { __syncthreads(); if (F.tid == 0) bc[0] = __hip_atomic_fetch_add(ctr, 1u, __ATOMIC_RELAXED, __HIP_MEMORY_SCOPE_AGENT); __syncthreads(); t = tlo + (int)bc[0]; } while (0)
    int tile = tlo + wgi; if (ctr) CONV_DRAW(tile);
    for (; tile < thi; ) {
        int t0, base, len;
        if (tile < 256) { t0 = (tile & 127) * 64; base = (tile >> 7) * SEQ; len = SEQ; } else { const int tc = tile - 256; t0 = (tc & 3) * 64; base = NX + (tc >> 2) * LCTX; len = LCTX; }
        __syncthreads();
        { v2u hw[12];
#pragma unroll
          for (int it = 0; it < 12; ++it) { const int idx = F.tid + NTHREADS * it, rr = idx >> 6, cc = (idx & 63) * 4, tt = t0 - 15 + rr; hw[it] = (v2u){0u, 0u};
              if (idx < 94 * 64 && tt >= 0 && tt < len) hw[it] = *(const v2u*)(HG + ((size_t)(base + tt)) * 256 + cc); }
#pragma unroll
          for (int it = 0; it < 12; ++it) { const int idx = F.tid + NTHREADS * it, rr = idx >> 6, cc = (idx & 63) * 4;
              if (idx < 94 * 64) *(LAS f32x4*)(Hs + rr * 256 + cc) = (f32x4){bflo(hw[it].x), bfhi(hw[it].x), bflo(hw[it].y), bfhi(hw[it].y)}; } }
        __syncthreads();
        {
            const int row0 = F.wave * 8; f32x4 acc[8], win[8];
#pragma unroll
            for (int i = 0; i < 8; ++i) acc[i] = bd;
#pragma unroll
            for (int i = 0; i < 7; ++i) win[i] = *(const LAS f32x4*)(Hs + (row0 + i) * 256 + c4);
#pragma unroll
            for (int k = 0; k < 31; ++k) { win[(k + 7) & 7] = *(const LAS f32x4*)(Hs + (row0 + k + 7) * 256 + c4); const f32x4 wv = *(const LAS f32x4*)(Ws + k * 256 + c4);
#pragma unroll
                for (int i = 0; i < 8; ++i) acc[i] += win[(k + i) & 7] * wv; }
#pragma unroll
            for (int i = 0; i < 8; ++i) {
                const float mean = wave_sum((acc[i].x + acc[i].y) + (acc[i].z + acc[i].w)) * (1.f / 256.f); const f32x4 dv = acc[i] - mean;
                const float var = wave_sum((dv.x * dv.x + dv.y * dv.y) + (dv.z * dv.z + dv.w * dv.w)) * (1.f / 256.f); const float rstd = 1.f / sqrtf(var + LN_EPS);
                const f32x4 y = dv * rstd * lg + lb;
                v2u o; o.x = pk2(silu_f(y.x), silu_f(y.y)); o.y = pk2(silu_f(y.z), silu_f(y.w));
                *(v2u*)(CN + ((size_t)(base + t0 + row0 + i)) * 256 + c4) = o; }
        }
        if (ctr) CONV_DRAW(tile); else tile += nwg;
    }
#undef CONV_DRAW
}
__device__ __forceinline__ int block_sum_i(Frame& F, int v, LAS int* red, int slot) {
    const int w = wave_sum_i(v); if (F.lane == 0) red[slot * 8 + F.wave] = w; __syncthreads();
    int s = 0;
#pragma unroll
    for (int i = 0; i < 8; ++i) s += red[slot * 8 + i];
    return s;
}
__device__ __forceinline__ int wave_incl_scan_i(int v) {
    v += __builtin_amdgcn_update_dpp(0, v, 0x111, 0xf, 0xf, true); v += __builtin_amdgcn_update_dpp(0, v, 0x112, 0xf, 0xf, true);
    v += __builtin_amdgcn_update_dpp(0, v, 0x114, 0xf, 0xf, true); v += __builtin_amdgcn_update_dpp(0, v, 0x118, 0xf, 0xf, true);
    v += __builtin_amdgcn_update_dpp(0, v, 0x142, 0xa, 0xf, false);
    v += __builtin_amdgcn_update_dpp(0, v, 0x143, 0xc, 0xf, false);
    return v;
}
__device__ __forceinline__ int block_excl_scan_i(Frame& F, int v, LAS int* red) {
    const int inc = wave_incl_scan_i(v);
    __syncthreads();
    if (F.lane == 63) red[F.wave] = inc;
    __syncthreads();
    int base = 0;
#pragma unroll
    for (int i = 0; i < 8; ++i) if (i < F.wave) base += red[i];
    return base + inc - v;
}
template <int N, int CAP> __device__ __forceinline__ void route_unit(Frame& F, const float* aff, int e, int rowbase, int slotbase) {
    unsigned char* const ws_ = launder_ws(F.ws);
    constexpr int EPT = (N >= NTHREADS) ? N / NTHREADS : 1;
    static_assert(EPT == 16 || EPT == 1, "route_unit");
    LAS unsigned* hist = (LAS unsigned*)F.lds; LAS int* red = (LAS int*)(F.lds + 4096);
    int* IDX = (int*)(ws_ + WS_IDX); float* GATE = (float*)(ws_ + WS_GATE); int* TOK = (int*)(ws_ + WS_TOKSLOT);
    const bool have = (EPT == 16) || F.tid < N; const int i0 = F.tid * EPT;
    unsigned k[EPT];
    if (EPT == 16) {
#pragma unroll
        for (int q = 0; q < 4; ++q) { const v4u w = ((const v4u*)(aff + i0))[q]; k[4 * q % EPT] = w.x; k[(4 * q + 1) % EPT] = w.y; k[(4 * q + 2) % EPT] = w.z; k[(4 * q + 3) % EPT] = w.w; }
    } else k[0] = have ? __builtin_bit_cast(unsigned, aff[i0]) : 0u;
    __syncthreads();
    unsigned prefix = 0u, pmask = 0u; int need = CAP, eqtot = 0;
#pragma nounroll
    for (int pass = 0; pass < 3; ++pass) { const int sh = 20 - 10 * pass;
        hist[F.tid] = 0u; hist[F.tid + NTHREADS] = 0u;
        __syncthreads();
        if (have) {
#pragma unroll
            for (int j = 0; j < EPT; ++j) if ((k[j] & pmask) == prefix) __hip_atomic_fetch_add(hist + ((k[j] >> sh) & 1023u), 1u, __ATOMIC_RELAXED, __HIP_MEMORY_SCOPE_WORKGROUP); }
        __syncthreads();
        if (F.wave == 0) {
            unsigned h[16];
#pragma unroll
            for (int q = 0; q < 4; ++q) { const v4u w = ((const LAS v4u*)(hist + 16 * F.lane))[q]; h[4 * q] = w.x; h[4 * q + 1] = w.y; h[4 * q + 2] = w.z; h[4 * q + 3] = w.w; }
            unsigned own = 0u;
#pragma unroll
            for (int q = 0; q < 16; ++q) own += h[q];
            const unsigned pre = (unsigned)wave_incl_scan_i((int)own), total = (unsigned)__builtin_amdgcn_readlane((int)pre, 63);
            unsigned a = total - pre;
            int dsel = -1; unsigned asel = 0u, esel = 0u;
#pragma unroll
            for (int q = 15; q >= 0; --q) { if (a < (unsigned)need && (unsigned)need <= a + h[q]) { dsel = 16 * F.lane + q; asel = a; esel = h[q]; } a += h[q]; }
            if (dsel >= 0) { red[16] = dsel; red[17] = (int)asel; red[18] = (int)esel; }
        }
        __syncthreads();
        const int dsel = red[16]; need -= red[17]; eqtot = red[18];
        prefix |= ((unsigned)dsel) << sh; pmask |= 1023u << sh;
    }
    const unsigned T = prefix;
    const bool alleq = (eqtot == need);
    int eqb = 0;
    if (!alleq) { int ceq = 0;
#pragma unroll
        for (int j = 0; j < EPT; ++j) ceq += (have && k[j] == T) ? 1 : 0;
        eqb = block_excl_scan_i(F, ceq, red); }
    int csel = 0, e2 = eqb; unsigned selm = 0u;
#pragma unroll
    for (int j = 0; j < EPT; ++j) { const bool iseq = (k[j] == T); const bool sel = have && ((k[j] > T) || (iseq && (alleq || e2 < need))); e2 += iseq ? 1 : 0; csel += sel ? 1 : 0; selm |= sel ? (1u << j) : 0u; }
    int pos = block_excl_scan_i(F, csel, red + 32);
    int tokv[EPT];
#pragma unroll
    for (int j = 0; j < EPT; ++j) { tokv[j] = -1;
        if ((selm >> j) & 1u) { const int slot = slotbase + pos; ++pos; IDX[slot] = rowbase + i0 + j; GATE[slot] = __builtin_bit_cast(float, k[j]); tokv[j] = slot; } }
    int* tp = TOK + (size_t)e * NR + rowbase + i0;
    if (EPT == 16) {
#pragma unroll
        for (int q = 0; q < 4; ++q) ((v4u*)tp)[q] = (v4u){(unsigned)tokv[4 * q % EPT], (unsigned)tokv[(4 * q + 1) % EPT], (unsigned)tokv[(4 * q + 2) % EPT], (unsigned)tokv[(4 * q + 3) % EPT]};
    } else if (have) tp[0] = tokv[0];
}
__device__ __forceinline__ void ph_route(Frame& F, bool last) {
    unsigned char* const ws_ = launder_ws(F.ws);
    const int nunits = last ? 32 : 64;
    for (int u = F.bid; u < nunits; u += F.G) {
        if (u < 32) { const int b = u >> 4, e = u & 15; route_unit<SEQ, CAPX>(F, (const float*)(ws_ + WS_AFF) + (size_t)u * SEQ, e, b * SEQ, e * SLOTS_E + b * CAPX); }
        else { const int uc = u - 32, b = uc >> 4, e = uc & 15; route_unit<LCTX, CAPC>(F, (const float*)(ws_ + WS_AFFC) + (size_t)uc * LCTX, e, NX + b * LCTX, e * SLOTS_E + 2 * CAPX + b * CAPC);
            if (b == 0 && F.tid < 192) { ((int*)(ws_ + WS_IDX))[e * SLOTS_E + 2 * CAPX + 2 * CAPC + F.tid] = 0; ((float*)(ws_ + WS_GATE))[e * SLOTS_E + 2 * CAPX + 2 * CAPC + F.tid] = 0.f; } }
    }
}
__device__ __forceinline__ void ln_pair(f32x4 (&v)[2][4]) {
    float s[2], q[2];
#pragma unroll
    for (int r = 0; r < 2; ++r) { s[r] = 0.f; q[r] = 0.f;
#pragma unroll
        for (int j = 0; j < 4; ++j) { s[r] += (v[r][j].x + v[r][j].y) + (v[r][j].z + v[r][j].w); q[r] += (v[r][j].x * v[r][j].x + v[r][j].y * v[r][j].y) + (v[r][j].z * v[r][j].z + v[r][j].w * v[r][j].w); } }
    s[0] = wave_sum(s[0]); s[1] = wave_sum(s[1]); q[0] = wave_sum(q[0]); q[1] = wave_sum(q[1]);
#pragma unroll
    for (int r = 0; r < 2; ++r) { const float mean = s[r] * (1.f / 1024.f), var = fmaxf(q[r] * (1.f / 1024.f) - mean * mean, 0.f), rstd = 1.f / sqrtf(var + LN_EPS);
#pragma unroll
        for (int j = 0; j < 4; ++j) v[r][j] = (v[r][j] - mean) * rstd; }
}
__device__ __forceinline__ void ph_rows_mid2(Frame& F, int l, bool last) {
    unsigned char* const ws_ = launder_ws(F.ws);
    KArgs ka = kargs();
    const float* MOD = (const float*)(ws_ + WS_MOD); const bf16* YMIX = (const bf16*)(ws_ + WS_YMIX);
    float* XMID = (float*)(ws_ + WS_XMID); bf16* H2 = (bf16*)(ws_ + WS_HX);
    const float* g1_ = ka->in[27] + l * 1024; const float* b1_ = ka->in[28] + l * 1024; const float* wr_ = ka->in[29] + (size_t)l * 1024 * 16;
    float* AFF = (float*)(ws_ + WS_AFF); float* AFFC = (float*)(ws_ + WS_AFFC);
    LAS float* Wp = (LAS float*)F.lds;
    const int lane = F.lane, nrows = last ? NX : NR;
    __syncthreads();
    for (int i = F.tid; i < 16 * 4 * 64; i += NTHREADS) { const int ji = i >> 8, q = (i >> 6) & 3, ln = i & 63, d = 4 * ln + 256 * (ji >> 2) + (ji & 3);
        *(LAS f32x4*)(Wp + (size_t)i * 4) = *(const f32x4*)(wr_ + (size_t)d * 16 + 4 * q); }
    __syncthreads();
    for (int r0 = 2 * F.gw; r0 < nrows; r0 += 2 * F.NGW) {
        const float* g1 = opq(g1_); const float* b1 = opq(b1_);
        const float* m = MOD + (l * 3 + row_mod_index(r0)) * 6144;
        f32x4 v[2][4];
#pragma unroll
        for (int r = 0; r < 2; ++r) { const int rr = r0 + r;
            const float* src = (l == 0) ? (rr < NX ? ka->in[0] + (size_t)rr * 1024 : ka->in[2] + (size_t)(rr - NX) * 1024) : (const float*)(ws_ + WS_XCUR) + (size_t)rr * 1024;
            f32x4 y[4]; row_load(src, lane, v[r]);
#pragma unroll
            for (int j = 0; j < 4; ++j) { const v2u w = ((const v2u*)(YMIX + (size_t)rr * 1024))[lane + 64 * j]; y[j] = (f32x4){bflo(w.x), bfhi(w.x), bflo(w.y), bfhi(w.y)}; }
#pragma unroll
            for (int j = 0; j < 4; ++j) { const f32x4 gt = ((const f32x4*)(m + 2048))[lane + 64 * j]; v[r][j] = v[r][j] * ALPHA + gt * y[j]; } }
        ln_pair(v);
#pragma unroll
        for (int j = 0; j < 4; ++j) { const f32x4 gg = ((const f32x4*)g1)[lane + 64 * j], bb = ((const f32x4*)b1)[lane + 64 * j];
#pragma unroll
            for (int r = 0; r < 2; ++r) v[r][j] = v[r][j] * gg + bb; }
        ln_pair(v);
#pragma unroll
        for (int j = 0; j < 4; ++j) { const f32x4 sh = ((const f32x4*)(m + 3072))[lane + 64 * j], sc = ((const f32x4*)(m + 4096))[lane + 64 * j];
#pragma unroll
            for (int r = 0; r < 2; ++r) v[r][j] = v[r][j] * (sc + 1.f) + sh; }
#pragma unroll
        for (int rr_ = 0; rr_ < 2; ++rr_)
#pragma unroll
            for (int j = 0; j < 4; ++j) ((unsigned*)((unsigned char*)H2 + (size_t)(r0 + rr_) * 1024))[lane + 64 * j] = pack4_fp8(v[rr_][j].x, v[rr_][j].y, v[rr_][j].z, v[rr_][j].w);
        __builtin_amdgcn_sched_barrier(0);
        typedef float f32x2 __attribute__((ext_vector_type(2)));
        f32x2 lg2[2][8];
#pragma unroll
        for (int r = 0; r < 2; ++r)
#pragma unroll
            for (int e = 0; e < 8; ++e) lg2[r][e] = (f32x2){0.f, 0.f};
#pragma unroll
        for (int j = 0; j < 4; ++j)
#pragma unroll
            for (int i = 0; i < 4; ++i) { const LAS float* wp = Wp + ((size_t)((j * 4 + i) * 4) * 64 + lane) * 4; const f32x2 h0 = (f32x2){v[0][j][i], v[0][j][i]}, h1 = (f32x2){v[1][j][i], v[1][j][i]};
#pragma unroll
                for (int q = 0; q < 4; ++q) { const f32x4 w = *(const LAS f32x4*)(wp + q * 256); const f32x2 wa = (f32x2){w.x, w.y}, wb = (f32x2){w.z, w.w};
                    lg2[0][2 * q] = __builtin_elementwise_fma(h0, wa, lg2[0][2 * q]); lg2[0][2 * q + 1] = __builtin_elementwise_fma(h0, wb, lg2[0][2 * q + 1]);
                    lg2[1][2 * q] = __builtin_elementwise_fma(h1, wa, lg2[1][2 * q]); lg2[1][2 * q + 1] = __builtin_elementwise_fma(h1, wb, lg2[1][2 * q + 1]); }
                if (i & 1) __builtin_amdgcn_sched_barrier(0); }
        float lg[2][16];
#pragma unroll
        for (int r = 0; r < 2; ++r)
#pragma unroll
            for (int e = 0; e < 16; ++e) lg[r][e] = lg2[r][e >> 1][e & 1];
        float fin[2];
#pragma unroll
        for (int r = 0; r < 2; ++r) {
            float a8[8], a4[4], a2[2];
            { const bool s = lane & 8;
#pragma unroll
              for (int e = 0; e < 8; ++e) { const float keep = s ? lg[r][e + 8] : lg[r][e], send = s ? lg[r][e] : lg[r][e + 8]; a8[e] = keep + dppf<DPP_RM>(send); } }
            { const bool s = lane & 4;
#pragma unroll
              for (int e = 0; e < 4; ++e) { const float keep = s ? a8[e + 4] : a8[e], send = s ? a8[e] : a8[e + 4]; a4[e] = keep + dppf<DPP_HM>(send); } }
            { const bool s = lane & 2;
#pragma unroll
              for (int e = 0; e < 2; ++e) { const float keep = s ? a4[e + 2] : a4[e], send = s ? a4[e] : a4[e + 2]; a2[e] = keep + dppf<DPP_X2>(send); } }
            { const bool s = lane & 1; const float keep = s ? a2[1] : a2[0], send = s ? a2[0] : a2[1]; fin[r] = xrow_sum(keep + dppf<DPP_X1>(send)); }
        }
        const int e = lane & 15;
#pragma unroll
        for (int r = 0; r < 2; ++r) { const float mx = row_max16(fin[r]);
            const float ex = expf(fin[r] - mx); const float den = row_sum16(ex);
            const int rr = r0 + r;
            if (lane < 16) { if (rr < NX) AFF[((size_t)(rr >> 13) * 16 + e) * SEQ + (rr & (SEQ - 1))] = ex / den; else AFFC[((size_t)((rr - NX) >> 8) * 16 + e) * LCTX + ((rr - NX) & (LCTX - 1))] = ex / den; } }
    }
}
__device__ __forceinline__ void ph_rows_final2(Frame& F, int l, bool last) {
    unsigned char* const ws_ = launder_ws(F.ws);
    KArgs ka = kargs();
    const float* MOD = (const float*)(ws_ + WS_MOD); const bf16* YMIX = (const bf16*)(ws_ + WS_YMIX);
    const int* TOK = (const int*)(ws_ + WS_TOKSLOT); const float* GATE = (const float*)(ws_ + WS_GATE); const bf16* YE = (const bf16*)(ws_ + WS_YEXP);
    const float* g1_ = ka->in[27] + l * 1024; const float* b1_ = ka->in[28] + l * 1024;
    const float* g2_ = ka->in[33] + l * 1024; const float* b2_ = ka->in[34] + l * 1024;
    const int lane = F.lane, nrows = last ? NX : NR;
    for (int r0 = 2 * F.gw; r0 < nrows; r0 += 2 * F.NGW) {
        const float* g1 = opq(g1_); const float* b1 = opq(b1_); const float* g2 = opq(g2_); const float* b2 = opq(b2_);
        const float* m = MOD + (l * 3 + row_mod_index(r0)) * 6144;
        f32x4 v[2][4];
#pragma unroll
        for (int r = 0; r < 2; ++r) { const int rr = r0 + r;
            const float* src = (l == 0) ? (rr < NX ? ka->in[0] + (size_t)rr * 1024 : ka->in[2] + (size_t)(rr - NX) * 1024) : (const float*)(ws_ + WS_XCUR) + (size_t)rr * 1024;
            f32x4 y[4]; row_load(src, lane, v[r]);
#pragma unroll
            for (int j = 0; j < 4; ++j) { const v2u w = ((const v2u*)(YMIX + (size_t)rr * 1024))[lane + 64 * j]; y[j] = (f32x4){bflo(w.x), bfhi(w.x), bflo(w.y), bfhi(w.y)}; }
#pragma unroll
            for (int j = 0; j < 4; ++j) { const f32x4 gt = ((const f32x4*)(m + 2048))[lane + 64 * j]; v[r][j] = v[r][j] * ALPHA + gt * y[j]; } }
        ln_pair(v);
#pragma unroll
        for (int j = 0; j < 4; ++j) { const f32x4 gg = ((const f32x4*)g1)[lane + 64 * j], bb = ((const f32x4*)b1)[lane + 64 * j];
#pragma unroll
            for (int r = 0; r < 2; ++r) v[r][j] = v[r][j] * gg + bb; }
        __builtin_amdgcn_sched_barrier(0);
#pragma unroll
        for (int r = 0; r < 2; ++r) { const int rr = r0 + r;
            int sl = -1; float gv = 0.f; if (lane < 16) { sl = TOK[(size_t)lane * NR + rr]; if (sl >= 0) gv = GATE[sl]; }
            f32x4 mo[4];
#pragma unroll
            for (int j = 0; j < 4; ++j) mo[j] = (f32x4){0.f, 0.f, 0.f, 0.f};
            unsigned long long bal = __ballot(sl >= 0);
            while (bal) { const int e = __builtin_ctzll(bal); bal &= bal - 1; const int s = __shfl(sl, e); const float g = __shfl(gv, e);
                const v2u* yp = (const v2u*)(YE + (size_t)s * 1024);
#pragma unroll
                for (int j = 0; j < 4; ++j) { const v2u w = yp[lane + 64 * j]; mo[j].x += g * bflo(w.x); mo[j].y += g * bfhi(w.x); mo[j].z += g * bflo(w.y); mo[j].w += g * bfhi(w.y); } }
#pragma unroll
            for (int j = 0; j < 4; ++j) { const f32x4 gt = ((const f32x4*)(m + 5120))[lane + 64 * j]; v[r][j] = v[r][j] * ALPHA + gt * mo[j]; } }
        ln_pair(v);
#pragma unroll
        for (int j = 0; j < 4; ++j) { const f32x4 gg = ((const f32x4*)g2)[lane + 64 * j], bb = ((const f32x4*)b2)[lane + 64 * j];
#pragma unroll
            for (int r = 0; r < 2; ++r) { v[r][j] = v[r][j] * gg + bb;
                float* dst = last ? ka->out + (size_t)(r0 + r) * 1024 : (float*)(ws_ + WS_XCUR) + (size_t)(r0 + r) * 1024; ((f32x4*)dst)[lane + 64 * j] = v[r][j]; } }
        if (!last) { ln_pair(v); const float* m1 = MOD + ((l + 1) * 3 + row_mod_index(r0)) * 6144;
            modulate_store(v[0], m1, m1 + 1024, (bf16*)(ws_ + WS_HX) + (size_t)r0 * 1024, lane); modulate_store(v[1], m1, m1 + 1024, (bf16*)(ws_ + WS_HX) + (size_t)(r0 + 1) * 1024, lane); }
    }
}
#define XB_TMO      128
#define XB_XCNT(j)  (256  + 64 * (j))
#define XB_XSUB(j)  (1280 + 64 * (j))
#define XB_XGEN(j)  (2304 + 64 * (j))
#define XB_TOP      3328
#define XB_TOPGEN   3392
#define XCD_BAR_WORDS 3456
#define XB_SPIN_CAP (1u << 18)

__device__ __forceinline__ unsigned xb_ld(unsigned* p)              { return __hip_atomic_load(p, __ATOMIC_RELAXED, __HIP_MEMORY_SCOPE_AGENT); }
__device__ __forceinline__ unsigned xb_add(unsigned* p, unsigned v) { return __hip_atomic_fetch_add(p, v, __ATOMIC_RELAXED, __HIP_MEMORY_SCOPE_AGENT); }
__device__ __forceinline__ unsigned xb_xcc_id() { return (unsigned)__builtin_amdgcn_s_getreg((3 << 11) | 20) & 0xFu; }
#define XB_SPIN(cond, bar) do { unsigned _sp = 0; while (cond) { __builtin_amdgcn_s_sleep(1); \
    if ((++_sp & 255u) == 0u) { if (xb_ld(&(bar)[XB_TMO])) break; if (_sp > XB_SPIN_CAP) { atomicAdd(&(bar)[XB_TMO], 1u); break; } } } } while (0)

struct XcdBarrier {
    unsigned* bar; unsigned x;
    volatile LAS unsigned* st;
    int wv;
};

__device__ __forceinline__ XcdBarrier xcd_barrier_post(unsigned* bar, volatile LAS unsigned* st) {
    XcdBarrier b; b.bar = bar; b.x = xb_xcc_id(); b.st = st;
    if (threadIdx.x == 0) (void)xb_add(&bar[XB_XCNT(b.x)], 1u);
    return b;
}
__device__ __forceinline__ void xcd_barrier_complete(unsigned* bar, unsigned x, unsigned& nloc, unsigned& nx) {
    const unsigned G = gridDim.x * gridDim.y * gridDim.z;
    unsigned sum, cnt, mine, sp = 0u;
    for (;;) {
        sum = 0u; cnt = 0u; mine = 0u;
#pragma unroll
        for (unsigned j = 0; j < 16; ++j) { const unsigned c = xb_ld(&bar[XB_XCNT(j)]); sum += c; cnt += (c > 0u) ? 1u : 0u; mine = (j == x) ? c : mine; }
        if (sum == G) break;
        __builtin_amdgcn_s_sleep(1);
        if ((++sp & 255u) == 0u) { if (xb_ld(&bar[XB_TMO])) break; if (sp > XB_SPIN_CAP) { atomicAdd(&bar[XB_TMO], 1u); break; } }
    }
    nloc = mine > 0u ? mine : 1u; nx = cnt > 0u ? cnt : 1u;
}

__device__ __forceinline__ void xcd_barrier(const XcdBarrier& b) {
    asm volatile("s_waitcnt vmcnt(0)" ::: "memory");
    __syncthreads();
    if (b.wv == 0 && pg8::lane_id() == 0) {
        unsigned* bar = b.bar;
        __builtin_amdgcn_s_waitcnt(0);
        unsigned nloc = b.st[0], nx = b.st[1];
        if (nloc == 0u) { xcd_barrier_complete(bar, b.x, nloc, nx); b.st[0] = nloc; b.st[1] = nx; }
        const unsigned old = xb_add(&bar[XB_XSUB(b.x)], 1u);
        const unsigned gen = old / nloc;
        if (old + 1u == (gen + 1u) * nloc) {
            __builtin_amdgcn_fence(__ATOMIC_RELEASE, "agent");
            asm volatile("s_waitcnt vmcnt(0)" ::: "memory");
            const unsigned og = xb_add(&bar[XB_TOP], 1u);
            const unsigned tg = og / nx;
            if (og + 1u == (tg + 1u) * nx) xb_add(&bar[XB_TOPGEN], 1u);
            else XB_SPIN(xb_ld(&bar[XB_TOPGEN]) == tg, bar);
            __builtin_amdgcn_fence(__ATOMIC_ACQUIRE, "agent");
            xb_add(&bar[XB_XGEN(b.x)], 1u);
            asm volatile("s_waitcnt vmcnt(0)" ::: "memory");
        } else {
            XB_SPIN(xb_ld(&bar[XB_XGEN(b.x)]) == gen, bar);
            __builtin_amdgcn_fence(__ATOMIC_ACQUIRE, "agent");
            asm volatile("s_waitcnt vmcnt(0)" ::: "memory");
        }
    }
    __syncthreads();
}

#ifndef MK_SPLIT
#define MK_SPLIT 0
#endif
#ifndef DUP_MASK
#define DUP_MASK 0u
#endif
#ifndef DUP_CNT
#define DUP_CNT 2
#endif
#define NREP(n) (((DUP_MASK >> (n)) & 1u) ? DUP_CNT : 1)
#define NREPP(n) (((DUP_MASK >> (16 + (n))) & 1u) ? 2 : 1)
constexpr int PPL = 11, NPH = 2 + PPL * DEPTH;
constexpr size_t WS_BAR = 0;
constexpr int MISC_OFF = LDS_BYTES - 64;
__device__ __forceinline__ void grid_seam(int k, int wv) {
    if (k + 1 >= kargs()->ph_hi) return;
    extern __shared__ __attribute__((aligned(16))) unsigned char lds[];
    XcdBarrier b; b.bar = (unsigned*)(kargs()->ws + WS_BAR); b.x = xb_xcc_id(); b.st = (volatile LAS unsigned*)((LAS unsigned char*)lds + MISC_OFF); b.wv = wv;
    xcd_barrier(b);
}
#define SEAM(k) grid_seam(k, wv)
#define IN(k) (kargs()->ph_lo <= (k) && (k) < kargs()->ph_hi)
__device__ __forceinline__ Frame make_frame(int wv) {
    extern __shared__ __attribute__((aligned(16))) unsigned char lds[];
    KArgs ka = kargs(); Frame F;
    F.lds = (LAS unsigned char*)lds; { int t_ = wv * 64 + pg8::lane_id(); asm volatile("" : "+v"(t_)); F.tid = t_; } F.lane = F.tid & 63; F.wave = wv;
    F.bid = blockIdx.x; F.G = ka->G; F.gw = F.bid * NWAVES + F.wave; F.NGW = F.G * NWAVES; F.ws = ka->ws; return F;
}
template <int l> __device__ __forceinline__ void run_layer(const int wv) {
        const bool last = (l == DEPTH - 1); const int k0 = 2 + PPL * l;
        if (IN(k0 + 0)) { for (int rep_ = 0; rep_ < NREP(0); ++rep_) { if (rep_) __syncthreads(); Frame F = make_frame(wv); unsigned char* const ws_ = F.ws;
            pg8::Gemm g{(const pg8::bf16_t*)(ws_ + WS_HX), (const pg8::bf16_t*)(ws_ + WS_WIN) + (size_t)l * INW * DM, NR, INW, DM, DM, DM};
            g.wv = F.wave;
            pg8::InProjOrder S; S.init(0, 256, F.G, F.bid);
            pg8::EpiInProj E{(const float*)(ws_ + WS_BINP) + l * INW, (const float*)(ws_ + WS_ROPE), (pg8::bf16_t*)(ws_ + WS_Q), (pg8::bf16_t*)(ws_ + WS_K), (pg8::bf16_t*)(ws_ + WS_V), (pg8::bf16_t*)(ws_ + WS_UC), (pg8::bf16_t*)(ws_ + WS_HG)};
            pg8::gemm_phase<pg8::EpiInProj, pg8::InProjOrder, PG8_ALIGN, PG8_SP2>(F.lds, g, S, E);
            } SEAM(k0 + 0); }
        if (IN(k0 + 1)) { for (int rep_ = 0; rep_ < NREP(1); ++rep_) { if (rep_) __syncthreads(); Frame F = make_frame(wv); unsigned char* const ws_ = F.ws;
            const int GB = (F.G * 140) / 256, nl = F.G - GB;
            if (F.bid < GB) {
                pg8::Gemm g{(const pg8::bf16_t*)(ws_ + WS_HX), (const pg8::bf16_t*)(ws_ + WS_WIN) + (size_t)l * INW * DM, NR, INW, DM, DM, DM};
                g.wv = F.wave;
                pg8::InProjOrder S; S.init(256, 140, GB, F.bid);
                pg8::EpiInProj E{(const float*)(ws_ + WS_BINP) + l * INW, (const float*)(ws_ + WS_ROPE), (pg8::bf16_t*)(ws_ + WS_Q), (pg8::bf16_t*)(ws_ + WS_K), (pg8::bf16_t*)(ws_ + WS_V), (pg8::bf16_t*)(ws_ + WS_UC), (pg8::bf16_t*)(ws_ + WS_HG)};
                pg8::gemm_phase<pg8::EpiInProj, pg8::InProjOrder, PG8_ALIGN, PG8_SP2>(F.lds, g, S, E);
            } else { const int w = F.bid - GB;
                if (w < 48) {
                    pg8::Gemm g{(const pg8::bf16_t*)(ws_ + WS_UC), (const pg8::bf16_t*)(ws_ + WS_BE) + (size_t)l * 16 * 256 * 512, 16 * S5R, 16 * 256, 512, S5K, 512};
                    g.wv = F.wave;
                    pg8::MoeOrder S; S.init(3, 1, 3, 16, nl < 48 ? nl : 48, w);
                    pg8::EpiF32G E{(float*)(ws_ + WS_E), 256, 1};
                    pg8::gemm_phase<pg8::EpiF32G, pg8::MoeOrder, PG8_ALIGN, PG8_SP2>(F.lds, g, S, E); }
                ph_conv(F, l, 0, last ? 256 : 264, 0, 0, (unsigned*)(ws_ + WS_CTR) + 4 + l);
            }
            } SEAM(k0 + 1); }
        if (IN(k0 + 2)) { for (int rep_ = 0; rep_ < NREP(2); ++rep_) { if (rep_) __syncthreads(); Frame F = make_frame(wv); unsigned char* const ws_ = F.ws;
            { pg8::Gemm g{(const pg8::bf16_t*)(ws_ + WS_UC), (const pg8::bf16_t*)(ws_ + WS_KT) + (size_t)l * 16 * 512 * S5K, 16 * S5R, 16 * 512, S5K, S5K, S5K};
            g.wv = F.wave;
            const bool twin = F.G >= 224 && F.bid >= 128 && F.bid < 224;
            pg8::MoeOrder S; S.init(3, 2, 3, 16, F.G, twin ? F.bid - 128 : F.bid);
            pg8::EpiS5Y E{(pg8::bf16_t*)(ws_ + WS_Z), (F.G >= 224) ? (twin ? 1 : 0) : -1};
            pg8::Unit u0;
            if ((twin || F.bid < 128) && S.next(0, u0)) { s5_carry_tile(F, l, u0.pm / 3, u0.pm % 3);
                pg8::gemm_phase<pg8::EpiS5Y, pg8::MoeOrder, PG8_ALIGN, PG8_SP2>(F.lds, g, S, E); }
            else if (!last && F.bid >= 96 && F.bid < 104) ph_attn(F, l, 256, 264, F.bid - 96, 8); }
            { Frame F2 = make_frame(wv); ph_attn(F2, l, 0, 256, F2.bid, F2.G); }
            } SEAM(k0 + 2); }
        if (IN(k0 + 4)) { for (int rep_ = 0; rep_ < NREP(4); ++rep_) { if (rep_) __syncthreads(); Frame F = make_frame(wv); unsigned char* const ws_ = F.ws;
            pg8::Gemm g{(const pg8::bf16_t*)(ws_ + WS_Z), (const pg8::bf16_t*)(ws_ + WS_WPT) + (size_t)l * 2 * 65536, 2 * NR, 512, 256, 256, 256};
            g.wv = F.wave;
            pg8::MoeOrder S; S.init(last ? 64 : 66, 1, 66, 2, F.G, F.bid);
            pg8::EpiPW E{(pg8::bf16_t*)(ws_ + WS_CAT), (const pg8::bf16_t*)(ws_ + WS_Z), kargs()->in[18] + l * 256, kargs()->in[24] + l * 256, 66};
            pg8::gemm_phase<pg8::EpiPW, pg8::MoeOrder, PG8_ALIGN, PG8_SP2>(F.lds, g, S, E);
            } SEAM(k0 + 4); }
        if (IN(k0 + 5)) { for (int rep_ = 0; rep_ < NREP(5); ++rep_) { if (rep_) __syncthreads(); Frame F = make_frame(wv); unsigned char* const ws_ = F.ws;
            pg8::Gemm g{(const pg8::bf16_t*)(ws_ + WS_CAT), (const pg8::bf16_t*)(ws_ + WS_WOUT) + (size_t)l * DM * DM, NR, DM, DM, DM, DM};
            g.wv = F.wave;
            pg8::StaticOrder S; S.init(last ? NX : NR, DM, F.G, F.bid);
            pg8::EpiBf16B E{(pg8::bf16_t*)(ws_ + WS_YMIX), DM, kargs()->in[26] + l * DM};
            pg8::gemm_phase<pg8::EpiBf16B, pg8::StaticOrder, PG8_ALIGN, PG8_SP2>(F.lds, g, S, E);
            } SEAM(k0 + 5); }
        if (IN(k0 + 6)) { for (int rep_ = 0; rep_ < NREP(6); ++rep_) { if (rep_) __syncthreads(); { Frame F = make_frame(wv); ph_rows_mid2(F, l, last); } } SEAM(k0 + 6); }
        if (IN(k0 + 7)) { for (int rep_ = 0; rep_ < NREP(7); ++rep_) { if (rep_) __syncthreads(); { Frame F = make_frame(wv); ph_route(F, last); } } SEAM(k0 + 7); }
        const int MT = last ? 8 : 9;
        if (IN(k0 + 8)) { for (int rep_ = 0; rep_ < NREP(8); ++rep_) { if (rep_) __syncthreads(); Frame F = make_frame(wv); unsigned char* const ws_ = F.ws;
            pg8::Gemm g{(const pg8::bf16_t*)(ws_ + WS_HX), (const pg8::bf16_t*)(ws_ + WS_WGU + (size_t)l * NE * 4096 * 1024), NSLOT, NE * 4096, 512, 512, 512};
            g.wv = F.wave;
            pg8::MoeOrder S; S.init(MT, 16, 9, NE, F.G, F.bid, last ? -1 : 8);
            pg8::EpiSwiGLU8 E{ws_ + WS_HID, FF, 16, last ? -1 : 8, 9};
            pg8::gemm_phase_g8<pg8::EpiSwiGLU8, pg8::MoeOrder, PG8_ALIGN, PG8_SP2>(F.lds, g, S, E, (const int*)(ws_ + WS_IDX), 0x7a7a7a7a, 0x7f7f7f7f);
            } SEAM(k0 + 8); }
        if (IN(k0 + 9)) { for (int rep_ = 0; rep_ < NREP(9); ++rep_) { if (rep_) __syncthreads(); Frame F = make_frame(wv); unsigned char* const ws_ = F.ws;
            pg8::Gemm g{(const pg8::bf16_t*)(ws_ + WS_HID), (const pg8::bf16_t*)(ws_ + WS_WD + (size_t)l * NE * DM * FF), NSLOT, NE * DM, 1024, 1024, 1024};
            g.wv = F.wave;
            pg8::MoeOrder S; S.init(MT, 4, 9, NE, F.G, F.bid, last ? -1 : 8, !last);
            pg8::EpiBf16P E{(pg8::bf16_t*)(ws_ + WS_YEXP), DM, 4};
            pg8::gemm_phase_8<pg8::EpiBf16P, pg8::MoeOrder, PG8_ALIGN, PG8_SP2>(F.lds, g, S, E, 0x79797979, 0x7d7d7d7d);
            } SEAM(k0 + 9); }
        if (IN(k0 + 10)) { for (int rep_ = 0; rep_ < NREP(10); ++rep_) { if (rep_) __syncthreads(); { Frame F = make_frame(wv); ph_rows_final2(F, l, last); } } SEAM(k0 + 10); }
    }
__global__ void __launch_bounds__(NTHREADS, 2) mk_fwd(Args a) {
    { extern __shared__ __attribute__((aligned(16))) unsigned char lds[];
      if (threadIdx.x < 16) ((LAS unsigned*)((LAS unsigned char*)lds + MISC_OFF))[threadIdx.x] = 0u;
      __syncthreads();
      if (threadIdx.x == 0) (void)xb_add((unsigned*)(kargs()->ws + WS_BAR) + XB_XCNT(xb_xcc_id()), 1u); }
    int wv = __builtin_amdgcn_readfirstlane((int)(threadIdx.x >> 6)); asm volatile("" : "+s"(wv));
    if (kargs()->ph_hi < 0) cg::this_grid().sync();
    if (IN(0)) { for (int rep_ = 0; rep_ < NREPP(0); ++rep_) { if (rep_) __syncthreads(); Frame F = make_frame(wv); ph_prologue(F); } SEAM(0); }
    if (IN(1)) { for (int rep_ = 0; rep_ < NREPP(1); ++rep_) { if (rep_) __syncthreads(); Frame F = make_frame(wv); ph_rows0(F); } SEAM(1); }
    run_layer<0>(wv);
    run_layer<1>(wv);
}
#undef IN
#undef SEAM

extern "C" void kernel_launch(void* const* d_in, const int* in_sizes, int n_in, void* d_out, int out_size, void* d_ws, size_t ws_size, hipStream_t stream) {
    static int grid_blocks = 0;
    if (!grid_blocks) {
        int dev = 0, cus = 0, per_cu = 0;
        (void)hipGetDevice(&dev);
        (void)hipDeviceGetAttribute(&cus, hipDeviceAttributeMultiprocessorCount, dev);
        (void)hipFuncSetAttribute((const void*)mk_fwd, hipFuncAttributeMaxDynamicSharedMemorySize, LDS_BYTES);
        (void)hipOccupancyMaxActiveBlocksPerMultiprocessor(&per_cu, (const void*)mk_fwd, NTHREADS, LDS_BYTES);
        grid_blocks = (per_cu >= 1 && cus > 0) ? cus : -1;
        if (n_in != 35 || ws_size < WS_END) { fprintf(stderr, "kernel_launch: unexpected n_in %d or ws_size %zu (need %zu)\n", n_in, ws_size, (size_t)WS_END); grid_blocks = -1; }
        fprintf(stderr, "kernel_launch: cus %d per_cu %d ws %zu\n", cus, per_cu, ws_size);
    }
    if (grid_blocks < 0) return;
    (void)hipMemsetAsync((char*)d_ws + WS_BAR, 0, 32 * KiB, stream);
    Args a{};
    for (int i = 0; i < 35; ++i) a.in[i] = (const float*)d_in[i];
    a.out = (float*)d_out; a.ws = (unsigned char*)d_ws; a.G = grid_blocks;
#if MK_SPLIT
    for (int p = 0; p < NPH; ++p) { a.ph_lo = p; a.ph_hi = p + 1; void* args[] = {&a};
        hipError_t e = hipLaunchCooperativeKernel((const void*)mk_fwd, dim3(grid_blocks), dim3(NTHREADS), args, LDS_BYTES, stream);
        if (e != hipSuccess) { fprintf(stderr, "launch failed: %s\n", hipGetErrorString(e)); break; } }
#else
    a.ph_lo = 0; a.ph_hi = NPH; void* args[] = {&a};
    hipError_t e = hipLaunchCooperativeKernel((const void*)mk_fwd, dim3(grid_blocks), dim3(NTHREADS), args, LDS_BYTES, stream);
    if (e != hipSuccess) fprintf(stderr, "cooperative launch failed: %s (grid %d)\n", hipGetErrorString(e), grid_blocks);
#endif
}
```

```cpp
#include <hip/hip_runtime.h>
#include <hip/hip_cooperative_groups.h>
#include <cstdio>
#include <cstdint>
namespace cg = cooperative_groups;
namespace pg8 {
#define PG8_LAS __attribute__((address_space(3)))
typedef unsigned short bf16_t;
typedef short bf16x8 __attribute__((ext_vector_type(8)));
typedef float f32x4 __attribute__((ext_vector_type(4)));
typedef unsigned u32x4 __attribute__((ext_vector_type(4)));
constexpr int BM = 256, BK = 64, HALF = 128, HTB = HALF * BK * 2  , STAGE_BYTES = 8 * HTB, NXCD = 8, WGM = 8;

__host__ __device__ __forceinline__ int lds_byte(int r, int c) { const int st = (r >> 4) * 2 + (c >> 5), rr = r & 15, cc = c & 31, ob = rr * 64 + cc * 2; return st * 1024 + (ob ^ (((ob >> 9) & 1) << 5)); }
__host__ __device__ __forceinline__ void stage_rc(int b, int& R, int& C) { const int st = b / 1024, sb = b % 1024, swz = sb ^ (((sb >> 9) & 1) << 5); R = (st >> 1) * 16 + swz / 64; C = (st & 1) * 32 + (swz % 64) / 2; }
__host__ __device__ __forceinline__ int perm32(int rho) { const int n = rho >> 4, i = rho & 15; return 8 * (i >> 2) + 4 * n + (i & 3); }

struct Unit { int pm, pn; };
__device__ __forceinline__ int lane_id() { int r; asm volatile("v_mbcnt_lo_u32_b32 %0, -1, 0\n\tv_mbcnt_hi_u32_b32 %0, -1, %0" : "=v"(r)); return r; }
struct Gemm { const bf16_t* A; const bf16_t* Bt; int M, N, K, lda, ldb; int wv = 0; };

struct StaticOrder {
    int nM, nN, nwg, G, c;
    __host__ __device__ __forceinline__ void init(int M, int N, int G_, int c_) { nM = M / BM; nN = N / BM; nwg = nM * nN; G = G_; c = c_; }
    __host__ __device__ __forceinline__ bool next(int i, Unit& u) const {
        const long L = (long)i * G + c; if (L >= nwg) return false;
        int wgid = (int)L; { const int q = nwg / NXCD, r = nwg % NXCD, xcd = wgid % NXCD, off = wgid / NXCD; wgid = (xcd < r ? xcd * (q + 1) : r * (q + 1) + (xcd - r) * q) + off; }
        const int nig = WGM * nN, gid = wgid / nig, fm = gid * WGM, gsz = (nM - fm) < WGM ? (nM - fm) : WGM;
        u.pm = fm + ((wgid % nig) % gsz); u.pn = (wgid % nig) / gsz; return true;
    }
    __device__ __forceinline__ void a_ready(const Unit&) const {}
    __device__ __forceinline__ void done(const Unit&) const {}
    __device__ __forceinline__ int vrows(const Unit&) const { return BM; }
};

__device__ __forceinline__ unsigned cvt_pk_bf16(float lo, float hi) { unsigned r; asm volatile("v_cvt_pk_bf16_f32 %0, %1, %2" : "=v"(r) : "v"(lo), "v"(hi)); return r; }
typedef float f32x2 __attribute__((ext_vector_type(2)));
__device__ __forceinline__ f32x2 gelu_pk(f32x2 v) {
    const f32x2 av = __builtin_elementwise_abs(v), d = av * 0.2316418882f + 1.0f;
    f32x2 t; t.x = __builtin_amdgcn_rcpf(d.x); t.y = __builtin_amdgcn_rcpf(d.y);
    f32x2 q = t * 0.5307027145f + (-0.7265760135f); q = q * t + 0.7107068705f; q = q * t + (-0.142248368f); q = q * t + 0.127414796f; q = q * t;
    const f32x2 s = (v * v) * (-0.72134752044f);
    f32x2 e; e.x = __builtin_amdgcn_exp2f(s.x); e.y = __builtin_amdgcn_exp2f(s.y);
    const f32x2 m = v * (q * e), r = v - m;
    f32x2 o; o.x = v.x < 0.f ? m.x : r.x; o.y = v.y < 0.f ? m.y : r.y; return o;
}

typedef unsigned u32x2e __attribute__((ext_vector_type(2)));
__device__ __forceinline__ float silu_f(float x) { return x * __builtin_amdgcn_rcpf(1.f + __expf(-x)); }
struct EpiBf16P {
    static constexpr bool PERM = true, AFTER_DRAIN = false;
    bf16_t* O; int ldo; int ntpe;
    __device__ __forceinline__ void operator()(const f32x4 (&acc)[2][2][4][2], const Unit& u, int wr, int wc, int fr, int fq) const {
        const int row0 = u.pm * BM + wr * 64 + fr; const int col0 = (u.pn % ntpe) * BM + wc * 32 + 8 * fq;
#pragma unroll
        for (int ai = 0; ai < 2; ++ai)
#pragma unroll
            for (int m = 0; m < 4; ++m) { bf16_t* rowp = O + (size_t)(row0 + ai * HALF + m * 16) * ldo + col0;
#pragma unroll
                for (int bj = 0; bj < 2; ++bj) { const f32x4 v0 = acc[ai][bj][m][0], v1 = acc[ai][bj][m][1];
                    u32x4 w; w.x = cvt_pk_bf16(v0[0], v0[1]); w.y = cvt_pk_bf16(v0[2], v0[3]); w.z = cvt_pk_bf16(v1[0], v1[1]); w.w = cvt_pk_bf16(v1[2], v1[3]);
                    *(u32x4*)(rowp + bj * HALF) = w; } }
    }
};
struct EpiBf16B {
    static constexpr bool PERM = true, AFTER_DRAIN = false;
    bf16_t* O; int ldo; const float* bias;
    __device__ __forceinline__ void operator()(const f32x4 (&acc)[2][2][4][2], const Unit& u, int wr, int wc, int fr, int fq) const {
        const int row0 = u.pm * BM + wr * 64 + fr; const int col0 = u.pn * BM + wc * 32 + 8 * fq;
        f32x4 bv[2][2];
        { unsigned long long bp_ = (unsigned long long)bias; asm volatile("" : "+s"(bp_)); const float* bq = (const float*)bp_ + col0;
#pragma unroll
          for (int bj = 0; bj < 2; ++bj) { bv[bj][0] = *(const f32x4*)(bq + bj * HALF); bv[bj][1] = *(const f32x4*)(bq + bj * HALF + 4); } }
#pragma unroll
        for (int ai = 0; ai < 2; ++ai)
#pragma unroll
            for (int m = 0; m < 4; ++m) { bf16_t* rowp = O + (size_t)(row0 + ai * HALF + m * 16) * ldo + col0;
#pragma unroll
                for (int bj = 0; bj < 2; ++bj) {
                    const f32x4 v0 = acc[ai][bj][m][0] + bv[bj][0], v1 = acc[ai][bj][m][1] + bv[bj][1];
                    u32x4 w; w.x = cvt_pk_bf16(v0[0], v0[1]); w.y = cvt_pk_bf16(v0[2], v0[3]); w.z = cvt_pk_bf16(v1[0], v1[1]); w.w = cvt_pk_bf16(v1[2], v1[3]);
                    *(u32x4*)(rowp + bj * HALF) = w; } }
    }
};
__device__ __forceinline__ float sat_e4m3(float x) { return __builtin_amdgcn_fmed3f(x, -448.f, 448.f); }
__device__ __forceinline__ unsigned pack4_fp8(float a, float b, float c, float d) { int w = __builtin_amdgcn_cvt_pk_fp8_f32(sat_e4m3(a), sat_e4m3(b), 0, false); w = __builtin_amdgcn_cvt_pk_fp8_f32(sat_e4m3(c), sat_e4m3(d), w, true); return (unsigned)w; }
struct EpiSwiGLU8 {
    static constexpr bool PERM = true, AFTER_DRAIN = false;
    unsigned char* O; int ldo; int ntpe; int ctxpm, mstride;
    __device__ __forceinline__ void operator()(const f32x4 (&acc)[2][2][4][2], const Unit& u, int wr, int wc, int fr, int fq) const {
        const int row0 = u.pm * BM + wr * 64 + fr; const int col0 = (u.pn % ntpe) * HALF + wc * 32 + 8 * fq;
        const int vr = (ctxpm >= 0 && (u.pm % mstride) == ctxpm) ? 64 : BM;
#pragma unroll
        for (int ai = 0; ai < 2; ++ai) { if (wr * 64 + ai * HALF >= vr) continue;
#pragma unroll
            for (int m = 0; m < 4; ++m) { unsigned char* rowp = O + (size_t)(row0 + ai * HALF + m * 16) * ldo + col0;
                const f32x4 g0 = acc[ai][0][m][0], g1 = acc[ai][0][m][1], u0 = acc[ai][1][m][0], u1 = acc[ai][1][m][1];
#define SG2(g_) ((g_) * __builtin_amdgcn_rcpf(1.f + __builtin_amdgcn_exp2f(-(g_))))
                u32x2e w; w.x = pack4_fp8(SG2(g0[0]) * u0[0], SG2(g0[1]) * u0[1], SG2(g0[2]) * u0[2], SG2(g0[3]) * u0[3]);
                w.y = pack4_fp8(SG2(g1[0]) * u1[0], SG2(g1[1]) * u1[1], SG2(g1[2]) * u1[2], SG2(g1[3]) * u1[3]);
#undef SG2
                *(u32x2e*)rowp = w; } }
    }
};
struct InProjOrder {
    int base, cnt, G, c;
    __device__ __forceinline__ void init(int base_, int cnt_, int G_, int c_) { base = base_; cnt = cnt_; G = G_; c = c_; }
    __device__ __forceinline__ bool next(int i, Unit& u) const {
        const long L = (long)i * G + c; if (L >= cnt) return false;
        int id = (int)L; { const int q = cnt / NXCD, r = cnt % NXCD, xcd = id % NXCD, off = id / NXCD; id = (xcd < r ? xcd * (q + 1) : r * (q + 1) + (xcd - r) * q) + off; }
        id += base; const bool hi = id >= 198; const int id2 = hi ? id - 198 : id;
        u.pm = id2 / 3; u.pn = (hi ? 0 : 3) + id2 % 3; return true;
    }
    __device__ __forceinline__ void a_ready(const Unit&) const {}
    __device__ __forceinline__ void done(const Unit&) const {}
    __device__ __forceinline__ int vrows(const Unit&) const { return BM; }
};
struct MoeOrder {
    int MT, NT, mstride, nwg, G, c, ctxpm, nx;
    __device__ __forceinline__ void init(int MT_, int NT_, int mstride_, int NE_, int G_, int c_, int ctxpm_ = -1, bool ctxlast = false) { MT = MT_; NT = NT_; mstride = mstride_; nwg = MT_ * NT_ * NE_; G = G_; c = c_; ctxpm = ctxpm_; nx = ctxlast ? (MT_ - 1) * NT_ * NE_ : 0; }
    __device__ __forceinline__ bool next(int i, Unit& u) const {
        const long L = (long)i * G + c; if (L >= nwg) return false;
        int id = (int)L;
        if (nx > 0) {
            if (id >= nx) { const int j = id - nx, e = j / NT; u.pm = e * mstride + (MT - 1); u.pn = e * NT + j % NT; return true; }
            { const int q = nx / NXCD, xcd = id % NXCD, off = id / NXCD; id = xcd * q + off; }
            const int upe = (MT - 1) * NT, e = id / upe, r2 = id % upe;
            u.pm = e * mstride + (r2 % (MT - 1)); u.pn = e * NT + (r2 / (MT - 1)); return true;
        }
        { const int q = nwg / NXCD, r = nwg % NXCD, xcd = id % NXCD, off = id / NXCD; id = (xcd < r ? xcd * (q + 1) : r * (q + 1) + (xcd - r) * q) + off; }
        const int upe = MT * NT, e = id / upe, r2 = id % upe;
        u.pm = e * mstride + (r2 % MT); u.pn = e * NT + (r2 / MT); return true;
    }
    __device__ __forceinline__ void a_ready(const Unit&) const {}
    __device__ __forceinline__ void done(const Unit&) const {}
    __device__ __forceinline__ int vrows(const Unit& u) const { return (ctxpm >= 0 && (u.pm % mstride) == ctxpm) ? 64 : BM; }
};
struct EpiF32G {
    static constexpr bool PERM = false, AFTER_DRAIN = false;
    float* C; int ldc; int ntpe;
    __device__ __forceinline__ void operator()(const f32x4 (&acc)[2][2][4][2], const Unit& u, int wr, int wc, int fr, int fq) const {
        const int row0 = u.pm * BM + wr * 64 + fr, col0 = (u.pn % ntpe) * BM + wc * 32 + 4 * fq;
#pragma unroll
        for (int ai = 0; ai < 2; ++ai)
#pragma unroll
            for (int m = 0; m < 4; ++m) { float* rowp = C + (size_t)(row0 + ai * HALF + m * 16) * ldc + col0;
#pragma unroll
                for (int bj = 0; bj < 2; ++bj)
#pragma unroll
                    for (int n = 0; n < 2; ++n) *(f32x4*)(rowp + bj * HALF + n * 16) = acc[ai][bj][m][n]; }
    }
};
__device__ __forceinline__ float gelu_tanh_e(float x) { const float u = 1.5957691216057308f * (x + 0.044715f * x * x * x); return x * __builtin_amdgcn_rcpf(1.f + __expf(-u)); }
struct EpiS5Y {
    static constexpr bool PERM = true, AFTER_DRAIN = false;
    bf16_t* Z; int half;
    __device__ __forceinline__ void operator()(const f32x4 (&acc)[2][2][4][2], const Unit& u, int wr, int wc, int fr, int fq) const {
        const int g = u.pm / 3, R0 = (u.pm % 3) * BM + wr * 64 + fr, n0 = (u.pn & 1) * BM + wc * 32 + 8 * fq;
#pragma unroll
        for (int ai = 0; ai < 2; ++ai) { if (half >= 0 && ai != half) continue;
#pragma unroll
            for (int m = 0; m < 4; ++m) { const int R = R0 + ai * HALF + m * 16; if (R >= 528) continue;
                const int tok0 = (R < 512) ? ((R >> 8) * 8192 + 32 * (R & 255)) : (16384 + ((R - 512) >> 3) * 256 + 32 * ((R - 512) & 7));
#pragma unroll
                for (int bj = 0; bj < 2; ++bj) { const int n = n0 + bj * HALF, j = n >> 4, c0 = n & 15; const f32x4 v0 = acc[ai][bj][m][0], v1 = acc[ai][bj][m][1];
                    u32x4 w; w.x = cvt_pk_bf16(gelu_tanh_e(v0[0]), gelu_tanh_e(v0[1])); w.y = cvt_pk_bf16(gelu_tanh_e(v0[2]), gelu_tanh_e(v0[3])); w.z = cvt_pk_bf16(gelu_tanh_e(v1[0]), gelu_tanh_e(v1[1])); w.w = cvt_pk_bf16(gelu_tanh_e(v1[2]), gelu_tanh_e(v1[3]));
                    *(u32x4*)(Z + ((size_t)(tok0 + j)) * 256 + 16 * g + c0) = w; } } }
    }
};
struct EpiPW {
    static constexpr bool PERM = true, AFTER_DRAIN = false;
    bf16_t* CAT; const bf16_t* Z; const float* bglu; const float* bpw; int mtpe;
    __device__ __forceinline__ void operator()(const f32x4 (&acc)[2][2][4][2], const Unit& u, int wr, int wc, int fr, int fq) const {
        const int grp = u.pn, row0 = (u.pm % mtpe) * BM + wr * 64 + fr, col0 = wc * 32 + 8 * fq; const float* bias = grp ? bpw : bglu;
#pragma unroll
        for (int ai = 0; ai < 2; ++ai)
#pragma unroll
            for (int m = 0; m < 4; ++m) { const size_t row = (size_t)(row0 + ai * HALF + m * 16);
#pragma unroll
                for (int bj = 0; bj < 2; ++bj) { const int col = col0 + bj * HALF;
                    unsigned long long bp_ = (unsigned long long)bias; asm volatile("" : "+s"(bp_)); const float* bq = (const float*)bp_ + col;
                    f32x4 v0 = acc[ai][bj][m][0] + *(const f32x4*)bq, v1 = acc[ai][bj][m][1] + *(const f32x4*)(bq + 4);
                    if (grp == 0) { const u32x4 zz = *(const u32x4*)(Z + row * 256 + col);
                        v0[0] = __builtin_bit_cast(float, zz.x << 16) * __builtin_amdgcn_rcpf(1.f + __expf(-v0[0])); v0[1] = __builtin_bit_cast(float, zz.x & 0xffff0000u) * __builtin_amdgcn_rcpf(1.f + __expf(-v0[1]));
                        v0[2] = __builtin_bit_cast(float, zz.y << 16) * __builtin_amdgcn_rcpf(1.f + __expf(-v0[2])); v0[3] = __builtin_bit_cast(float, zz.y & 0xffff0000u) * __builtin_amdgcn_rcpf(1.f + __expf(-v0[3]));
                        v1[0] = __builtin_bit_cast(float, zz.z << 16) * __builtin_amdgcn_rcpf(1.f + __expf(-v1[0])); v1[1] = __builtin_bit_cast(float, zz.z & 0xffff0000u) * __builtin_amdgcn_rcpf(1.f + __expf(-v1[1]));
                        v1[2] = __builtin_bit_cast(float, zz.w << 16) * __builtin_amdgcn_rcpf(1.f + __expf(-v1[2])); v1[3] = __builtin_bit_cast(float, zz.w & 0xffff0000u) * __builtin_amdgcn_rcpf(1.f + __expf(-v1[3])); }
                    u32x4 w; w.x = cvt_pk_bf16(v0[0], v0[1]); w.y = cvt_pk_bf16(v0[2], v0[3]); w.z = cvt_pk_bf16(v1[0], v1[1]); w.w = cvt_pk_bf16(v1[2], v1[3]);
                    *(u32x4*)(CAT + row * 1024 + 512 + grp * 256 + col) = w; }
                asm volatile("" ::: "memory"); }
    }
};
typedef unsigned u32x2 __attribute__((ext_vector_type(2)));
struct EpiInProj {
    static constexpr bool PERM = true, AFTER_DRAIN = false;
    const float* bias; const float* rope; bf16_t* Q; bf16_t* K; bf16_t* V; bf16_t* UC; bf16_t* HG;
    __device__ __forceinline__ void operator()(const f32x4 (&acc)[2][2][4][2], const Unit& u, int wr, int wc, int fr, int fq) const {
        const int pn = u.pn; const bool isx = u.pm < 64;
        f32x4 bv[2][2];
        { unsigned long long bp_ = (unsigned long long)bias; asm volatile("" : "+s"(bp_)); const float* bq = (const float*)bp_ + pn * BM + wc * 32 + 8 * fq;
#pragma unroll
          for (int bj = 0; bj < 2; ++bj) { bv[bj][0] = *(const f32x4*)(bq + bj * HALF); bv[bj][1] = *(const f32x4*)(bq + bj * HALF + 4); } }
        const bool rot = (pn <= 2) && isx; const int hi = fq >> 1, i0 = 8 * (fq & 1);
#pragma unroll
        for (int ai = 0; ai < 2; ++ai)
#pragma unroll
            for (int m = 0; m < 4; ++m) {
                const int r = u.pm * BM + ai * HALF + wr * 64 + m * 16 + fr;
                f32x4 v[2][2];
#pragma unroll
                for (int bj = 0; bj < 2; ++bj)
#pragma unroll
                    for (int n = 0; n < 2; ++n) v[bj][n] = acc[ai][bj][m][n] + bv[bj][n];
                if (pn <= 2) {
                    f32x4 cs[4];
                    if (rot) { const int t = r & 8191, pos = (wc & 1) ? (t & 63) : (t >> 6); const f32x4* rp = (const f32x4*)(rope + ((size_t)pos * 16 + i0) * 2);
#pragma unroll
                        for (int q = 0; q < 4; ++q) cs[q] = rp[q]; }
                    else {
#pragma unroll
                        for (int q = 0; q < 4; ++q) cs[q] = (f32x4){1.f, 0.f, 1.f, 0.f}; }
#pragma unroll
                    for (int bj = 0; bj < 2; ++bj) {
                        u32x4 w;
                        if (pn == 2 && bj == 1) {
                            w.x = cvt_pk_bf16(v[1][0][0], v[1][0][1]); w.y = cvt_pk_bf16(v[1][0][2], v[1][0][3]); w.z = cvt_pk_bf16(v[1][1][0], v[1][1][1]); w.w = cvt_pk_bf16(v[1][1][2], v[1][1][3]);
                            *(u32x4*)(V + (size_t)r * 128 + wc * 32 + 8 * fq) = w;
                        } else {
                            float o[8];
#pragma unroll
                            for (int n = 0; n < 2; ++n)
#pragma unroll
                                for (int e = 0; e < 4; ++e) { const float mine = v[bj][n][e], other = __shfl_xor(mine, 32); const int q = 2 * n + (e >> 1); const float c = cs[q][2 * (e & 1)], s = cs[q][2 * (e & 1) + 1];
                                    o[4 * n + e] = hi ? (mine * c + other * s) : (mine * c - other * s); }
                            const float qs = (pn == 2) ? 1.f : 0.18033688011112042f;
                            w.x = cvt_pk_bf16(o[0] * qs, o[1] * qs); w.y = cvt_pk_bf16(o[2] * qs, o[3] * qs); w.z = cvt_pk_bf16(o[4] * qs, o[5] * qs); w.w = cvt_pk_bf16(o[6] * qs, o[7] * qs);
                            bf16_t* op = (pn == 2) ? K + (size_t)r * 128 + wc * 32 + 8 * fq : Q + (size_t)r * 512 + pn * BM + bj * HALF + wc * 32 + 8 * fq;
                            *(u32x4*)op = w;
                        } }
                } else if (pn == 3) {
                    int R, j; if (isx) { const int t = r & 8191; R = (r >> 13) * 256 + (t >> 5); j = t & 31; } else { const int rc = r - 16384, t = rc & 255; R = 512 + (rc >> 8) * 8 + (t >> 5); j = t & 31; }
#pragma unroll
                    for (int bj = 0; bj < 2; ++bj) { const int g = 8 * bj + 2 * wc + (fq >> 1); u32x4 w;
                        w.x = cvt_pk_bf16(v[bj][0][0], v[bj][0][1]); w.y = cvt_pk_bf16(v[bj][0][2], v[bj][0][3]); w.z = cvt_pk_bf16(v[bj][1][0], v[bj][1][1]); w.w = cvt_pk_bf16(v[bj][1][2], v[bj][1][3]);
                        *(u32x4*)(UC + ((size_t)(g * 768 + R)) * 768 + j * 16 + 8 * (fq & 1)) = w; }
                } else {
                    u32x4 w; float hgv[8];
#pragma unroll
                    for (int n = 0; n < 2; ++n)
#pragma unroll
                        for (int e = 0; e < 4; ++e) hgv[4 * n + e] = v[0][n][e] * __builtin_amdgcn_rcpf(1.f + __expf(-v[1][n][e]));
                    w.x = cvt_pk_bf16(hgv[0], hgv[1]); w.y = cvt_pk_bf16(hgv[2], hgv[3]); w.z = cvt_pk_bf16(hgv[4], hgv[5]); w.w = cvt_pk_bf16(hgv[6], hgv[7]);
                    *(u32x4*)(HG + (size_t)r * 256 + (pn - 4) * HALF + wc * 32 + 8 * fq) = w;
                }
                asm volatile("" ::: "memory");
            }
    }
};
template <class Epi, class Sched, bool ALIGN_EPI = false, bool SP2 = false>
__device__ __forceinline__ void gemm_phase(PG8_LAS unsigned char* lds, const Gemm g, const Sched& S, const Epi& E) {
    int tid_ = g.wv * 64 + lane_id(); asm volatile("" : "+v"(tid_));
    const int tid = tid_, wid = __builtin_amdgcn_readfirstlane(tid >> 6), lane = tid & 63, wr = wid >> 2, wc = wid & 3, fr = lane & 15, fq = lane >> 4;
    const int K = g.K, nt = K / BK;
    unsigned voffA[2], voffB[2];
#pragma unroll
    for (int i = 0; i < 2; ++i) { int R, C; stage_rc(tid * 16 + i * 8192, R, C); const int Rb = Epi::PERM ? ((R & ~31) + perm32(R & 31)) : R;
        voffA[i] = (unsigned)(R * g.lda + C) * 2u; voffB[i] = (unsigned)(Rb * g.ldb + C) * 2u; }
    const size_t kstep = (size_t)(BK * 2);
    const size_t hstepA = (size_t)HALF * g.lda * 2, hstepB = (size_t)HALF * g.ldb * 2;
    const size_t tstepA = 2 * hstepA, tstepB = 2 * hstepB;
    const unsigned ldsw = (unsigned)wid * 1024u;
    const int aoff = lds_byte(wr * 64 + fr, fq * 8), boff = lds_byte(wc * 32 + fr, fq * 8);
#define PG8_SA(b, h) (((b) * 2 + (h)) * HTB)
#define PG8_SB(b, h) ((4 + (b) * 2 + (h)) * HTB)
#define PG8_STAGE(bufoff, gbase, voff) do { _Pragma("unroll") for (int _i = 0; _i < 2; ++_i) \
        __builtin_amdgcn_global_load_lds((const unsigned*)((const char*)(gbase) + (voff)[_i]), (PG8_LAS unsigned*)(lds + (bufoff) + ldsw + _i * 8192), 16, 0, 0); } while (0)
#define PG8_LDA(dst, b, h) do { _Pragma("unroll") for (int m = 0; m < 4; ++m) _Pragma("unroll") for (int k = 0; k < 2; ++k) dst[m][k] = *(const PG8_LAS bf16x8*)(lds + PG8_SA(b, h) + aoff + m * 2048 + k * 1024); } while (0)
#define PG8_LDB(dst, b, h) do { _Pragma("unroll") for (int n = 0; n < 2; ++n) _Pragma("unroll") for (int k = 0; k < 2; ++k) dst[n][k] = *(const PG8_LAS bf16x8*)(lds + PG8_SB(b, h) + boff + n * 2048 + k * 1024); } while (0)
#define PG8_MMA(ai, bj, At, Bt) do { __builtin_amdgcn_s_setprio(1); _Pragma("unroll") for (int m = 0; m < 4; ++m) _Pragma("unroll") for (int n = 0; n < 2; ++n) _Pragma("unroll") for (int k = 0; k < 2; ++k) \
        acc[ai][bj][m][n] = __builtin_amdgcn_mfma_f32_16x16x32_bf16(Bt[n][k], At[m][k], acc[ai][bj][m][n], 0, 0, 0); __builtin_amdgcn_s_setprio(0); } while (0)
#define PG8_WAIT_V(n) asm volatile("s_waitcnt vmcnt(" #n ")" ::: "memory")
#define PG8_WAIT_L(n) asm volatile("s_waitcnt lgkmcnt(" #n ")" ::: "memory")
#define PG8_BAR __builtin_amdgcn_s_barrier()
#define PG8_SCHED __builtin_amdgcn_sched_barrier(0)
    Unit cur, nxt; int ui = 0;
    if (!S.next(0, cur)) return;
    f32x4 acc[2][2][4][2];
#pragma unroll
    for (int a = 0; a < 2; ++a)
#pragma unroll
        for (int b = 0; b < 2; ++b)
#pragma unroll
            for (int m = 0; m < 4; ++m)
#pragma unroll
                for (int n = 0; n < 2; ++n) acc[a][b][m][n] = (f32x4){0.f, 0.f, 0.f, 0.f};
    bf16x8 At[4][2], B0[2][2], B1[2][2];
    const char* cA = (const char*)g.A + (size_t)cur.pm * tstepA; const char* cB = (const char*)g.Bt + (size_t)cur.pn * tstepB;
    S.a_ready(cur);
    if constexpr (SP2) {
        PG8_STAGE(PG8_SB(0, 0), cB, voffB); PG8_STAGE(PG8_SB(0, 1), cB + hstepB, voffB); PG8_STAGE(PG8_SA(0, 0), cA, voffA); PG8_STAGE(PG8_SA(0, 1), cA + hstepA, voffA);
        if (wr == 1) PG8_BAR;
        PG8_WAIT_V(2); PG8_BAR;
        PG8_STAGE(PG8_SB(1, 0), cB + kstep, voffB); PG8_STAGE(PG8_SA(1, 0), cA + kstep, voffA); PG8_STAGE(PG8_SB(1, 1), cB + hstepB + kstep, voffB);
        PG8_WAIT_V(6); PG8_BAR;
    } else {
        PG8_STAGE(PG8_SB(0, 0), cB, voffB); PG8_STAGE(PG8_SA(0, 0), cA, voffA); PG8_STAGE(PG8_SB(0, 1), cB + hstepB, voffB); PG8_STAGE(PG8_SA(0, 1), cA + hstepA, voffA);
        if (wr == 1) PG8_BAR;
        PG8_WAIT_V(4); PG8_BAR;
        PG8_STAGE(PG8_SB(1, 0), cB + kstep, voffB); PG8_STAGE(PG8_SA(1, 0), cA + kstep, voffA); PG8_STAGE(PG8_SB(1, 1), cB + hstepB + kstep, voffB);
        PG8_WAIT_V(6); PG8_BAR;
    }
    for (;;) {
        const bool has_next = S.next(ui + 1, nxt);
        const char* nA = has_next ? (const char*)g.A + (size_t)nxt.pm * tstepA : cA; const char* nB = has_next ? (const char*)g.Bt + (size_t)nxt.pn * tstepB : cB;
        for (int t = 0; t < nt; t += 2) {
            const bool last = (t == nt - 2);
            const char* a1 = cA + (size_t)(t + 1) * kstep;
            const char* a2 = last ? nA : cA + (size_t)(t + 2) * kstep; const char* b2 = last ? nB : cB + (size_t)(t + 2) * kstep;
            const char* a3 = a2 + kstep; const char* b3 = b2 + kstep;
            if (last && has_next) S.a_ready(nxt);
            if constexpr (SP2) {
            PG8_LDB(B0, 0, 0); PG8_LDB(B1, 0, 1); PG8_SCHED; PG8_LDA(At, 0, 0); PG8_STAGE(PG8_SA(1, 1), a1 + hstepA, voffA);
            PG8_WAIT_V(8); PG8_WAIT_L(0); PG8_BAR; PG8_MMA(0, 0, At, B0); PG8_MMA(0, 1, At, B1); PG8_BAR; PG8_SCHED;
            PG8_LDA(At, 0, 1); PG8_STAGE(PG8_SB(0, 0), b2, voffB); PG8_STAGE(PG8_SB(0, 1), b2 + hstepB, voffB); PG8_STAGE(PG8_SA(0, 0), a2, voffA);
            PG8_WAIT_V(8); PG8_WAIT_L(0); PG8_BAR; PG8_MMA(1, 0, At, B0); PG8_MMA(1, 1, At, B1); PG8_BAR; PG8_SCHED;
            PG8_LDB(B0, 1, 0); PG8_LDB(B1, 1, 1); PG8_SCHED; PG8_LDA(At, 1, 0); PG8_STAGE(PG8_SA(0, 1), a2 + hstepA, voffA);
            PG8_WAIT_V(8); PG8_WAIT_L(0); PG8_BAR; PG8_MMA(0, 0, At, B0); PG8_MMA(0, 1, At, B1); PG8_BAR; PG8_SCHED;
            PG8_LDA(At, 1, 1); PG8_STAGE(PG8_SB(1, 0), b3, voffB); PG8_STAGE(PG8_SB(1, 1), b3 + hstepB, voffB); PG8_STAGE(PG8_SA(1, 0), a3, voffA);
            PG8_WAIT_V(8); PG8_WAIT_L(0); PG8_BAR; PG8_MMA(1, 0, At, B0); PG8_MMA(1, 1, At, B1); PG8_BAR; PG8_SCHED;
            } else {
            PG8_LDB(B0, 0, 0); PG8_SCHED; PG8_LDA(At, 0, 0); PG8_STAGE(PG8_SA(1, 1), a1 + hstepA, voffA);
            PG8_WAIT_L(8); PG8_BAR; PG8_WAIT_L(0); PG8_MMA(0, 0, At, B0); PG8_BAR; PG8_SCHED;
            PG8_LDB(B1, 0, 1); PG8_STAGE(PG8_SB(0, 0), b2, voffB);
            PG8_BAR; PG8_WAIT_L(0); PG8_MMA(0, 1, At, B1); PG8_BAR;
            PG8_LDA(At, 0, 1); PG8_STAGE(PG8_SA(0, 0), a2, voffA);
            PG8_BAR; PG8_WAIT_L(0); PG8_MMA(1, 0, At, B0); PG8_BAR; PG8_SCHED;
            PG8_STAGE(PG8_SB(0, 1), b2 + hstepB, voffB);
            PG8_WAIT_V(6); PG8_BAR; PG8_MMA(1, 1, At, B1); PG8_BAR;
            PG8_LDB(B0, 1, 0); PG8_SCHED; PG8_LDA(At, 1, 0); PG8_STAGE(PG8_SA(0, 1), a2 + hstepA, voffA);
            PG8_WAIT_L(8); PG8_BAR; PG8_WAIT_L(0); PG8_MMA(0, 0, At, B0); PG8_BAR; PG8_SCHED;
            PG8_LDB(B1, 1, 1); PG8_STAGE(PG8_SB(1, 0), b3, voffB);
            PG8_BAR; PG8_WAIT_L(0); PG8_MMA(0, 1, At, B1); PG8_BAR;
            PG8_LDA(At, 1, 1); PG8_STAGE(PG8_SA(1, 0), a3, voffA);
            PG8_BAR; PG8_WAIT_L(0); PG8_MMA(1, 0, At, B0); PG8_BAR; PG8_SCHED;
            PG8_STAGE(PG8_SB(1, 1), b3 + hstepB, voffB);
            PG8_WAIT_V(6); PG8_BAR; PG8_MMA(1, 1, At, B1); PG8_BAR;
            }
        }
        if constexpr (ALIGN_EPI) { if (wr == 0) PG8_BAR; }
        if constexpr (!Epi::AFTER_DRAIN) { E(acc, cur, wr, wc, fr, fq); S.done(cur); }
        if (!has_next) break;
#pragma unroll
        for (int a = 0; a < 2; ++a)
#pragma unroll
            for (int b = 0; b < 2; ++b)
#pragma unroll
                for (int m = 0; m < 4; ++m)
#pragma unroll
                    for (int n = 0; n < 2; ++n) acc[a][b][m][n] = (f32x4){0.f, 0.f, 0.f, 0.f};
        cur = nxt; cA = nA; cB = nB; ++ui;
        if constexpr (ALIGN_EPI) { if (wr == 1) PG8_BAR; }
    }
    PG8_WAIT_V(0);
    if constexpr (!ALIGN_EPI) { if (wr == 0) PG8_BAR; }
    PG8_BAR;
    if constexpr (Epi::AFTER_DRAIN) { E.fused(acc, cur, wr, wc, fr, fq, lds, wid, lane); S.done(cur); }
#undef PG8_SA
#undef PG8_SB
#undef PG8_STAGE
#undef PG8_LDA
#undef PG8_LDB
#undef PG8_MMA
#undef PG8_WAIT_V
#undef PG8_WAIT_L
#undef PG8_BAR
#undef PG8_SCHED
}
typedef int v4i_t __attribute__((ext_vector_type(4)));
typedef int v8i_t __attribute__((ext_vector_type(8)));
#define PG8_CAT(x, y) __builtin_shufflevector(__builtin_bit_cast(v4i_t, x), __builtin_bit_cast(v4i_t, y), 0, 1, 2, 3, 4, 5, 6, 7)
template <class Epi, class Sched, bool ALIGN_EPI = false, bool SP2 = false>
__device__ __forceinline__ void gemm_phase_8(PG8_LAS unsigned char* lds, const Gemm g, const Sched& S, const Epi& E, const int sa, const int sb) {
    int tid_ = g.wv * 64 + lane_id(); asm volatile("" : "+v"(tid_));
    const int tid = tid_, wid = __builtin_amdgcn_readfirstlane(tid >> 6), lane = tid & 63, wr = wid >> 2, wc = wid & 3, fr = lane & 15, fq = lane >> 4;
    const int K = g.K, nt = K / BK;
    unsigned voffA[2], voffB[2];
#pragma unroll
    for (int i = 0; i < 2; ++i) { int R, C; stage_rc(tid * 16 + i * 8192, R, C); const int Rb = Epi::PERM ? ((R & ~31) + perm32(R & 31)) : R;
        voffA[i] = (unsigned)(R * g.lda + C) * 2u; voffB[i] = (unsigned)(Rb * g.ldb + C) * 2u; }
    const size_t kstep = (size_t)(BK * 2);
    const size_t hstepA = (size_t)HALF * g.lda * 2, hstepB = (size_t)HALF * g.ldb * 2;
    const size_t tstepA = 2 * hstepA, tstepB = 2 * hstepB;
    const unsigned ldsw = (unsigned)wid * 1024u;
    const int aoff8[2] = {lds_byte(wr * 64 + fr, 16 * fq), lds_byte(wr * 64 + fr, 16 * fq + 8)}, boff8[2] = {lds_byte(wc * 32 + fr, 16 * fq), lds_byte(wc * 32 + fr, 16 * fq + 8)};
#define PG8_SA(b, h) (((b) * 2 + (h)) * HTB)
#define PG8_SB(b, h) ((4 + (b) * 2 + (h)) * HTB)
#define PG8_STAGE(bufoff, gbase, voff) do { _Pragma("unroll") for (int _i = 0; _i < 2; ++_i) \
        __builtin_amdgcn_global_load_lds((const unsigned*)((const char*)(gbase) + (voff)[_i]), (PG8_LAS unsigned*)(lds + (bufoff) + ldsw + _i * 8192), 16, 0, 0); } while (0)
#define PG8_LDA(dst, b, h) do { _Pragma("unroll") for (int m = 0; m < 4; ++m) { const v4i_t lo_ = *(const PG8_LAS v4i_t*)(lds + PG8_SA(b, h) + aoff8[0] + m * 2048), hi_ = *(const PG8_LAS v4i_t*)(lds + PG8_SA(b, h) + aoff8[1] + m * 2048); dst[m] = __builtin_shufflevector(lo_, hi_, 0, 1, 2, 3, 4, 5, 6, 7); } } while (0)
#define PG8_LDB(dst, b, h) do { _Pragma("unroll") for (int n = 0; n < 2; ++n) { const v4i_t lo_ = *(const PG8_LAS v4i_t*)(lds + PG8_SB(b, h) + boff8[0] + n * 2048), hi_ = *(const PG8_LAS v4i_t*)(lds + PG8_SB(b, h) + boff8[1] + n * 2048); dst[n] = __builtin_shufflevector(lo_, hi_, 0, 1, 2, 3, 4, 5, 6, 7); } } while (0)
#define PG8_MMA(ai, bj, At, Bt) do { if ((ai) ? do1 : do0) { __builtin_amdgcn_s_setprio(1); _Pragma("unroll") for (int m = 0; m < 4; ++m) _Pragma("unroll") for (int n = 0; n < 2; ++n) \
        asm volatile("v_mfma_scale_f32_16x16x128_f8f6f4 %0, %1, %2, %0, %3, %4 op_sel_hi:[0,0,0]" : "+v"(acc[ai][bj][m][n]) : "v"(Bt[n]), "v"(At[m]), "v"(sa), "v"(sb)); __builtin_amdgcn_s_setprio(0); } } while (0)
#define PG8_WAIT_V(n) asm volatile("s_waitcnt vmcnt(" #n ")" ::: "memory")
#define PG8_WAIT_L(n) asm volatile("s_waitcnt lgkmcnt(" #n ")" ::: "memory")
#define PG8_BAR __builtin_amdgcn_s_barrier()
#define PG8_SCHED __builtin_amdgcn_sched_barrier(0)
    Unit cur, nxt; int ui = 0;
    if (!S.next(0, cur)) return;
    bool do0 = wr * 64 < S.vrows(cur), do1 = wr * 64 + HALF < S.vrows(cur);
    f32x4 acc[2][2][4][2];
#pragma unroll
    for (int a = 0; a < 2; ++a)
#pragma unroll
        for (int b = 0; b < 2; ++b)
#pragma unroll
            for (int m = 0; m < 4; ++m)
#pragma unroll
                for (int n = 0; n < 2; ++n) acc[a][b][m][n] = (f32x4){0.f, 0.f, 0.f, 0.f};
    v8i_t At[4], B0[2], B1[2];
    const char* cA = (const char*)g.A + (size_t)cur.pm * tstepA; const char* cB = (const char*)g.Bt + (size_t)cur.pn * tstepB;
    S.a_ready(cur);
    if constexpr (SP2) {
        PG8_STAGE(PG8_SB(0, 0), cB, voffB); PG8_STAGE(PG8_SB(0, 1), cB + hstepB, voffB); PG8_STAGE(PG8_SA(0, 0), cA, voffA); PG8_STAGE(PG8_SA(0, 1), cA + hstepA, voffA);
        if (wr == 1) PG8_BAR;
        PG8_WAIT_V(2); PG8_BAR;
        PG8_STAGE(PG8_SB(1, 0), cB + kstep, voffB); PG8_STAGE(PG8_SA(1, 0), cA + kstep, voffA); PG8_STAGE(PG8_SB(1, 1), cB + hstepB + kstep, voffB);
        PG8_WAIT_V(6); PG8_BAR;
    } else {
        PG8_STAGE(PG8_SB(0, 0), cB, voffB); PG8_STAGE(PG8_SA(0, 0), cA, voffA); PG8_STAGE(PG8_SB(0, 1), cB + hstepB, voffB); PG8_STAGE(PG8_SA(0, 1), cA + hstepA, voffA);
        if (wr == 1) PG8_BAR;
        PG8_WAIT_V(4); PG8_BAR;
        PG8_STAGE(PG8_SB(1, 0), cB + kstep, voffB); PG8_STAGE(PG8_SA(1, 0), cA + kstep, voffA); PG8_STAGE(PG8_SB(1, 1), cB + hstepB + kstep, voffB);
        PG8_WAIT_V(6); PG8_BAR;
    }
    for (;;) {
        const bool has_next = S.next(ui + 1, nxt);
        const char* nA = has_next ? (const char*)g.A + (size_t)nxt.pm * tstepA : cA; const char* nB = has_next ? (const char*)g.Bt + (size_t)nxt.pn * tstepB : cB;
        for (int t = 0; t < nt; t += 2) {
            const bool last = (t == nt - 2);
            const char* a1 = cA + (size_t)(t + 1) * kstep;
            const char* a2 = last ? nA : cA + (size_t)(t + 2) * kstep; const char* b2 = last ? nB : cB + (size_t)(t + 2) * kstep;
            const char* a3 = a2 + kstep; const char* b3 = b2 + kstep;
            if (last && has_next) S.a_ready(nxt);
            if constexpr (SP2) {
            PG8_LDB(B0, 0, 0); PG8_LDB(B1, 0, 1); PG8_SCHED; PG8_LDA(At, 0, 0); PG8_STAGE(PG8_SA(1, 1), a1 + hstepA, voffA);
            PG8_WAIT_V(8); PG8_WAIT_L(0); PG8_BAR; PG8_MMA(0, 0, At, B0); PG8_MMA(0, 1, At, B1); PG8_BAR; PG8_SCHED;
            PG8_LDA(At, 0, 1); PG8_STAGE(PG8_SB(0, 0), b2, voffB); PG8_STAGE(PG8_SB(0, 1), b2 + hstepB, voffB); PG8_STAGE(PG8_SA(0, 0), a2, voffA);
            PG8_WAIT_V(8); PG8_WAIT_L(0); PG8_BAR; PG8_MMA(1, 0, At, B0); PG8_MMA(1, 1, At, B1); PG8_BAR; PG8_SCHED;
            PG8_LDB(B0, 1, 0); PG8_LDB(B1, 1, 1); PG8_SCHED; PG8_LDA(At, 1, 0); PG8_STAGE(PG8_SA(0, 1), a2 + hstepA, voffA);
            PG8_WAIT_V(8); PG8_WAIT_L(0); PG8_BAR; PG8_MMA(0, 0, At, B0); PG8_MMA(0, 1, At, B1); PG8_BAR; PG8_SCHED;
            PG8_LDA(At, 1, 1); PG8_STAGE(PG8_SB(1, 0), b3, voffB); PG8_STAGE(PG8_SB(1, 1), b3 + hstepB, voffB); PG8_STAGE(PG8_SA(1, 0), a3, voffA);
            PG8_WAIT_V(8); PG8_WAIT_L(0); PG8_BAR; PG8_MMA(1, 0, At, B0); PG8_MMA(1, 1, At, B1); PG8_BAR; PG8_SCHED;
            } else {
            PG8_LDB(B0, 0, 0); PG8_SCHED; PG8_LDA(At, 0, 0); PG8_STAGE(PG8_SA(1, 1), a1 + hstepA, voffA);
            PG8_WAIT_L(8); PG8_BAR; PG8_WAIT_L(0); PG8_MMA(0, 0, At, B0); PG8_BAR; PG8_SCHED;
            PG8_LDB(B1, 0, 1); PG8_STAGE(PG8_SB(0, 0), b2, voffB);
            PG8_BAR; PG8_WAIT_L(0); PG8_MMA(0, 1, At, B1); PG8_BAR;
            PG8_LDA(At, 0, 1); PG8_STAGE(PG8_SA(0, 0), a2, voffA);
            PG8_BAR; PG8_WAIT_L(0); PG8_MMA(1, 0, At, B0); PG8_BAR; PG8_SCHED;
            PG8_STAGE(PG8_SB(0, 1), b2 + hstepB, voffB);
            PG8_WAIT_V(6); PG8_BAR; PG8_MMA(1, 1, At, B1); PG8_BAR;
            PG8_LDB(B0, 1, 0); PG8_SCHED; PG8_LDA(At, 1, 0); PG8_STAGE(PG8_SA(0, 1), a2 + hstepA, voffA);
            PG8_WAIT_L(8); PG8_BAR; PG8_WAIT_L(0); PG8_MMA(0, 0, At, B0); PG8_BAR; PG8_SCHED;
            PG8_LDB(B1, 1, 1); PG8_STAGE(PG8_SB(1, 0), b3, voffB);
            PG8_BAR; PG8_WAIT_L(0); PG8_MMA(0, 1, At, B1); PG8_BAR;
            PG8_LDA(At, 1, 1); PG8_STAGE(PG8_SA(1, 0), a3, voffA);
            PG8_BAR; PG8_WAIT_L(0); PG8_MMA(1, 0, At, B0); PG8_BAR; PG8_SCHED;
            PG8_STAGE(PG8_SB(1, 1), b3 + hstepB, voffB);
            PG8_WAIT_V(6); PG8_BAR; PG8_MMA(1, 1, At, B1); PG8_BAR;
            }
        }
        if constexpr (ALIGN_EPI) { if (wr == 0) PG8_BAR; }
        asm volatile("s_nop 15\n\ts_nop 15" ::: "memory"); __builtin_amdgcn_sched_barrier(0);
        if constexpr (!Epi::AFTER_DRAIN) { E(acc, cur, wr, wc, fr, fq); S.done(cur); }
        if (!has_next) break;
#pragma unroll
        for (int a = 0; a < 2; ++a)
#pragma unroll
            for (int b = 0; b < 2; ++b)
#pragma unroll
                for (int m = 0; m < 4; ++m)
#pragma unroll
                    for (int n = 0; n < 2; ++n) acc[a][b][m][n] = (f32x4){0.f, 0.f, 0.f, 0.f};
        cur = nxt; cA = nA; cB = nB; ++ui;
        do0 = wr * 64 < S.vrows(cur); do1 = wr * 64 + HALF < S.vrows(cur);
        if constexpr (ALIGN_EPI) { if (wr == 1) PG8_BAR; }
    }
    PG8_WAIT_V(0);
    if constexpr (!ALIGN_EPI) { if (wr == 0) PG8_BAR; }
    PG8_BAR;
    if constexpr (Epi::AFTER_DRAIN) { E.fused(acc, cur, wr, wc, fr, fq, lds, wid, lane); S.done(cur); }
#undef PG8_SA
#undef PG8_SB
#undef PG8_STAGE
#undef PG8_LDA
#undef PG8_LDB
#undef PG8_MMA
#undef PG8_WAIT_V
#undef PG8_WAIT_L
#undef PG8_BAR
#undef PG8_SCHED
}
template <class Epi, class Sched, bool ALIGN_EPI = false, bool SP2 = false>
__device__ __forceinline__ void gemm_phase_g8(PG8_LAS unsigned char* lds, const Gemm g, const Sched& S, const Epi& E, const int* gidx, const int sa, const int sb) {
    int tid_ = g.wv * 64 + lane_id(); asm volatile("" : "+v"(tid_));
    const int tid = tid_, wid = __builtin_amdgcn_readfirstlane(tid >> 6), lane = tid & 63, wr = wid >> 2, wc = wid & 3, fr = lane & 15, fq = lane >> 4;
    const int K = g.K, nt = K / BK;
    unsigned voffA[2], voffB[2];
#pragma unroll
    for (int i = 0; i < 2; ++i) { int R, C; stage_rc(tid * 16 + i * 8192, R, C); const int Rb = Epi::PERM ? ((R & ~31) + perm32(R & 31)) : R;
        voffA[i] = (unsigned)(R * g.lda + C) * 2u; voffB[i] = (unsigned)(Rb * g.ldb + C) * 2u; }
    int RA[2]; unsigned cAo[2];
#pragma unroll
    for (int i = 0; i < 2; ++i) { int R, C; stage_rc(tid * 16 + i * 8192, R, C); RA[i] = R; cAo[i] = (unsigned)C * 2u; }
    unsigned vcur[2][2], vnxt[2][2], vsel[2][2];
#define PG8_GOFF(pm_, dst) do { _Pragma("unroll") for (int h_ = 0; h_ < 2; ++h_) _Pragma("unroll") for (int i_ = 0; i_ < 2; ++i_) dst[h_][i_] = (unsigned)gidx[(pm_) * BM + h_ * HALF + RA[i_]] * (unsigned)(g.lda * 2) + cAo[i_]; } while (0)
    const size_t kstep = (size_t)(BK * 2);
    const size_t hstepA = (size_t)HALF * g.lda * 2, hstepB = (size_t)HALF * g.ldb * 2;
    const size_t tstepA = 2 * hstepA, tstepB = 2 * hstepB;
    const unsigned ldsw = (unsigned)wid * 1024u;
    const int aoff8[2] = {lds_byte(wr * 64 + fr, 16 * fq), lds_byte(wr * 64 + fr, 16 * fq + 8)}, boff8[2] = {lds_byte(wc * 32 + fr, 16 * fq), lds_byte(wc * 32 + fr, 16 * fq + 8)};
#define PG8_SA(b, h) (((b) * 2 + (h)) * HTB)
#define PG8_SB(b, h) ((4 + (b) * 2 + (h)) * HTB)
#define PG8_STAGE(bufoff, gbase, voff) do { _Pragma("unroll") for (int _i = 0; _i < 2; ++_i) \
        __builtin_amdgcn_global_load_lds((const unsigned*)((const char*)(gbase) + (voff)[_i]), (PG8_LAS unsigned*)(lds + (bufoff) + ldsw + _i * 8192), 16, 0, 0); } while (0)
#define PG8_LDA(dst, b, h) do { _Pragma("unroll") for (int m = 0; m < 4; ++m) { const v4i_t lo_ = *(const PG8_LAS v4i_t*)(lds + PG8_SA(b, h) + aoff8[0] + m * 2048), hi_ = *(const PG8_LAS v4i_t*)(lds + PG8_SA(b, h) + aoff8[1] + m * 2048); dst[m] = __builtin_shufflevector(lo_, hi_, 0, 1, 2, 3, 4, 5, 6, 7); } } while (0)
#define PG8_LDB(dst, b, h) do { _Pragma("unroll") for (int n = 0; n < 2; ++n) { const v4i_t lo_ = *(const PG8_LAS v4i_t*)(lds + PG8_SB(b, h) + boff8[0] + n * 2048), hi_ = *(const PG8_LAS v4i_t*)(lds + PG8_SB(b, h) + boff8[1] + n * 2048); dst[n] = __builtin_shufflevector(lo_, hi_, 0, 1, 2, 3, 4, 5, 6, 7); } } while (0)
#define PG8_MMA(ai, bj, At, Bt) do { if ((ai) ? do1 : do0) { __builtin_amdgcn_s_setprio(1); _Pragma("unroll") for (int m = 0; m < 4; ++m) _Pragma("unroll") for (int n = 0; n < 2; ++n) \
        asm volatile("v_mfma_scale_f32_16x16x128_f8f6f4 %0, %1, %2, %0, %3, %4 op_sel_hi:[0,0,0]" : "+v"(acc[ai][bj][m][n]) : "v"(Bt[n]), "v"(At[m]), "v"(sa), "v"(sb)); __builtin_amdgcn_s_setprio(0); } } while (0)
#define PG8_WAIT_V(n) asm volatile("s_waitcnt vmcnt(" #n ")" ::: "memory")
#define PG8_WAIT_L(n) asm volatile("s_waitcnt lgkmcnt(" #n ")" ::: "memory")
#define PG8_BAR __builtin_amdgcn_s_barrier()
#define PG8_SCHED __builtin_amdgcn_sched_barrier(0)
    Unit cur, nxt; int ui = 0;
    if (!S.next(0, cur)) return;
    bool do0 = wr * 64 < S.vrows(cur), do1 = wr * 64 + HALF < S.vrows(cur);
    f32x4 acc[2][2][4][2];
#pragma unroll
    for (int a = 0; a < 2; ++a)
#pragma unroll
        for (int b = 0; b < 2; ++b)
#pragma unroll
            for (int m = 0; m < 4; ++m)
#pragma unroll
                for (int n = 0; n < 2; ++n) acc[a][b][m][n] = (f32x4){0.f, 0.f, 0.f, 0.f};
    v8i_t At[4], B0[2], B1[2];
    const char* cA = (const char*)g.A; PG8_GOFF(cur.pm, vcur); const char* cB = (const char*)g.Bt + (size_t)cur.pn * tstepB;
    S.a_ready(cur);
    if constexpr (SP2) {
        PG8_STAGE(PG8_SB(0, 0), cB, voffB); PG8_STAGE(PG8_SB(0, 1), cB + hstepB, voffB); PG8_STAGE(PG8_SA(0, 0), cA, vcur[0]); PG8_STAGE(PG8_SA(0, 1), cA, vcur[1]);
        if (wr == 1) PG8_BAR;
        PG8_WAIT_V(2); PG8_BAR;
        PG8_STAGE(PG8_SB(1, 0), cB + kstep, voffB); PG8_STAGE(PG8_SA(1, 0), cA + kstep, vcur[0]); PG8_STAGE(PG8_SB(1, 1), cB + hstepB + kstep, voffB);
        PG8_WAIT_V(6); PG8_BAR;
    } else {
        PG8_STAGE(PG8_SB(0, 0), cB, voffB); PG8_STAGE(PG8_SA(0, 0), cA, vcur[0]); PG8_STAGE(PG8_SB(0, 1), cB + hstepB, voffB); PG8_STAGE(PG8_SA(0, 1), cA, vcur[1]);
        if (wr == 1) PG8_BAR;
        PG8_WAIT_V(4); PG8_BAR;
        PG8_STAGE(PG8_SB(1, 0), cB + kstep, voffB); PG8_STAGE(PG8_SA(1, 0), cA + kstep, vcur[0]); PG8_STAGE(PG8_SB(1, 1), cB + hstepB + kstep, voffB);
        PG8_WAIT_V(6); PG8_BAR;
    }
    for (;;) {
        const bool has_next = S.next(ui + 1, nxt);
        const char* nA = cA; if (has_next) PG8_GOFF(nxt.pm, vnxt); else { _Pragma("unroll") for (int h_ = 0; h_ < 2; ++h_) _Pragma("unroll") for (int i_ = 0; i_ < 2; ++i_) vnxt[h_][i_] = vcur[h_][i_]; } const char* nB = has_next ? (const char*)g.Bt + (size_t)nxt.pn * tstepB : cB;
        for (int t = 0; t < nt; t += 2) {
            const bool last = (t == nt - 2);
            _Pragma("unroll") for (int h_ = 0; h_ < 2; ++h_) _Pragma("unroll") for (int i_ = 0; i_ < 2; ++i_) vsel[h_][i_] = last ? vnxt[h_][i_] : vcur[h_][i_];
            const char* a1 = cA + (size_t)(t + 1) * kstep;
            const char* a2 = last ? nA : cA + (size_t)(t + 2) * kstep; const char* b2 = last ? nB : cB + (size_t)(t + 2) * kstep;
            const char* a3 = a2 + kstep; const char* b3 = b2 + kstep;
            if (last && has_next) S.a_ready(nxt);
            if constexpr (SP2) {
            PG8_LDB(B0, 0, 0); PG8_LDB(B1, 0, 1); PG8_SCHED; PG8_LDA(At, 0, 0); PG8_STAGE(PG8_SA(1, 1), a1, vcur[1]);
            PG8_WAIT_V(8); PG8_WAIT_L(0); PG8_BAR; PG8_MMA(0, 0, At, B0); PG8_MMA(0, 1, At, B1); PG8_BAR; PG8_SCHED;
            PG8_LDA(At, 0, 1); PG8_STAGE(PG8_SB(0, 0), b2, voffB); PG8_STAGE(PG8_SB(0, 1), b2 + hstepB, voffB); PG8_STAGE(PG8_SA(0, 0), a2, vsel[0]);
            PG8_WAIT_V(8); PG8_WAIT_L(0); PG8_BAR; PG8_MMA(1, 0, At, B0); PG8_MMA(1, 1, At, B1); PG8_BAR; PG8_SCHED;
            PG8_LDB(B0, 1, 0); PG8_LDB(B1, 1, 1); PG8_SCHED; PG8_LDA(At, 1, 0); PG8_STAGE(PG8_SA(0, 1), a2, vsel[1]);
            PG8_WAIT_V(8); PG8_WAIT_L(0); PG8_BAR; PG8_MMA(0, 0, At, B0); PG8_MMA(0, 1, At, B1); PG8_BAR; PG8_SCHED;
            PG8_LDA(At, 1, 1); PG8_STAGE(PG8_SB(1, 0), b3, voffB); PG8_STAGE(PG8_SB(1, 1), b3 + hstepB, voffB); PG8_STAGE(PG8_SA(1, 0), a3, vsel[0]);
            PG8_WAIT_V(8); PG8_WAIT_L(0); PG8_BAR; PG8_MMA(1, 0, At, B0); PG8_MMA(1, 1, At, B1); PG8_BAR; PG8_SCHED;
            } else {
            PG8_LDB(B0, 0, 0); PG8_SCHED; PG8_LDA(At, 0, 0); PG8_STAGE(PG8_SA(1, 1), a1, vcur[1]);
            PG8_WAIT_L(8); PG8_BAR; PG8_WAIT_L(0); PG8_MMA(0, 0, At, B0); PG8_BAR; PG8_SCHED;
            PG8_LDB(B1, 0, 1); PG8_STAGE(PG8_SB(0, 0), b2, voffB);
            PG8_BAR; PG8_WAIT_L(0); PG8_MMA(0, 1, At, B1); PG8_BAR;
            PG8_LDA(At, 0, 1); PG8_STAGE(PG8_SA(0, 0), a2, vsel[0]);
            PG8_BAR; PG8_WAIT_L(0); PG8_MMA(1, 0, At, B0); PG8_BAR; PG8_SCHED;
            PG8_STAGE(PG8_SB(0, 1), b2 + hstepB, voffB);
            PG8_WAIT_V(6); PG8_BAR; PG8_MMA(1, 1, At, B1); PG8_BAR;
            PG8_LDB(B0, 1, 0); PG8_SCHED; PG8_LDA(At, 1, 0); PG8_STAGE(PG8_SA(0, 1), a2, vsel[1]);
            PG8_WAIT_L(8); PG8_BAR; PG8_WAIT_L(0); PG8_MMA(0, 0, At, B0); PG8_BAR; PG8_SCHED;
            PG8_LDB(B1, 1, 1); PG8_STAGE(PG8_SB(1, 0), b3, voffB);
            PG8_BAR; PG8_WAIT_L(0); PG8_MMA(0, 1, At, B1); PG8_BAR;
            PG8_LDA(At, 1, 1); PG8_STAGE(PG8_SA(1, 0), a3, vsel[0]);
            PG8_BAR; PG8_WAIT_L(0); PG8_MMA(1, 0, At, B0); PG8_BAR; PG8_SCHED;
            PG8_STAGE(PG8_SB(1, 1), b3 + hstepB, voffB);
            PG8_WAIT_V(6); PG8_BAR; PG8_MMA(1, 1, At, B1); PG8_BAR;
            }
        }
        if constexpr (ALIGN_EPI) { if (wr == 0) PG8_BAR; }
        asm volatile("s_nop 15\n\ts_nop 15" ::: "memory"); __builtin_amdgcn_sched_barrier(0);
        if constexpr (!Epi::AFTER_DRAIN) { E(acc, cur, wr, wc, fr, fq); S.done(cur); }
        if (!has_next) break;
#pragma unroll
        for (int a = 0; a < 2; ++a)
#pragma unroll
            for (int b = 0; b < 2; ++b)
#pragma unroll
                for (int m = 0; m < 4; ++m)
#pragma unroll
                    for (int n = 0; n < 2; ++n) acc[a][b][m][n] = (f32x4){0.f, 0.f, 0.f, 0.f};
        cur = nxt; cA = nA; cB = nB; ++ui; _Pragma("unroll") for (int h_ = 0; h_ < 2; ++h_) _Pragma("unroll") for (int i_ = 0; i_ < 2; ++i_) vcur[h_][i_] = vnxt[h_][i_];
        do0 = wr * 64 < S.vrows(cur); do1 = wr * 64 + HALF < S.vrows(cur);
        if constexpr (ALIGN_EPI) { if (wr == 1) PG8_BAR; }
    }
    PG8_WAIT_V(0);
    if constexpr (!ALIGN_EPI) { if (wr == 0) PG8_BAR; }
    PG8_BAR;
    if constexpr (Epi::AFTER_DRAIN) { E.fused(acc, cur, wr, wc, fr, fq, lds, wid, lane); S.done(cur); }
#undef PG8_GOFF
#undef PG8_SA
#undef PG8_SB
#undef PG8_STAGE
#undef PG8_LDA
#undef PG8_LDB
#undef PG8_MMA
#undef PG8_WAIT_V
#undef PG8_WAIT_L
#undef PG8_BAR
#undef PG8_SCHED
}
#undef PG8_CAT
}
#ifndef PG8_SP2
#define PG8_SP2 true
#endif
#ifndef PG8_ALIGN
#define PG8_ALIGN true
#endif
constexpr int NB = 2, SEQ = 8192, DM = 1024, LCTX = 256, DEPTH = 2;
constexpr int NX = NB * SEQ, NC = NB * LCTX, NR = NX + NC;
constexpr int INW = 1536, NE = 16, FF = 2048, CAPX = 1024, CAPC = 32;
constexpr int SLOTS_E = 2304, NSLOT = NE * SLOTS_E;
constexpr float LN_EPS = 1e-5f, ALPHA = 1.41421356237309515f;
constexpr int NWAVES = 8, NTHREADS = 512;
constexpr int RING_BYTES = 131072, LDS_BYTES = 147456;

constexpr size_t MiB = 1u << 20, KiB = 1u << 10;
constexpr size_t WS_MOD = 1 * MiB;
constexpr size_t WS_ROPE = 1 * MiB + 160 * KiB;
constexpr size_t WS_LBAR = 1 * MiB + 192 * KiB;
constexpr size_t WS_BBAR = 1 * MiB + 256 * KiB;
constexpr size_t WS_BINP = 1 * MiB + 768 * KiB;
constexpr size_t WS_AFF = 2 * MiB;
constexpr size_t WS_AFFC = 3 * MiB;
constexpr size_t WS_IDX = 3 * MiB + 64 * KiB;
constexpr size_t WS_GATE = 3 * MiB + 256 * KiB;
constexpr size_t WS_TOKSLOT = 4 * MiB;
constexpr size_t WS_WIN = 6 * MiB;
constexpr size_t WS_WOUT = 12 * MiB;
constexpr size_t WS_WGU = 16 * MiB;
constexpr size_t WS_WD = 272 * MiB;
constexpr size_t WS_HX = 400 * MiB;
constexpr size_t WS_Q = 433 * MiB;
constexpr size_t WS_K = 450 * MiB;
constexpr size_t WS_V = 455 * MiB;
constexpr size_t WS_U = 460 * MiB;
constexpr size_t WS_HG = 477 * MiB;
constexpr size_t WS_YF = 494 * MiB;
constexpr size_t WS_YB = 511 * MiB;
constexpr size_t WS_CAT = 528 * MiB;
constexpr size_t WS_YMIX = 561 * MiB;
constexpr size_t WS_XS = 528 * MiB;
constexpr size_t WS_XMID = 627 * MiB;
constexpr size_t WS_XCUR = 693 * MiB;
constexpr size_t WS_HID = 759 * MiB;
constexpr size_t WS_PX = 759 * MiB;
constexpr size_t WS_YEXP = 903 * MiB;
constexpr size_t WS_END = 975 * MiB;

#define LAS __attribute__((address_space(3)))
typedef unsigned short bf16;
typedef unsigned v4u __attribute__((ext_vector_type(4)));
typedef unsigned v2u __attribute__((ext_vector_type(2)));
typedef float f32x4 __attribute__((ext_vector_type(4)));
#define LDS_WAIT() asm volatile("s_waitcnt lgkmcnt(0)" ::: "memory")
__device__ __forceinline__ unsigned f2bf(float f) { unsigned u = __builtin_bit_cast(unsigned, f); return (u + 0x7fffu + ((u >> 16) & 1u)) >> 16; }
__device__ __forceinline__ unsigned pk2(float lo, float hi) { return f2bf(lo) | (f2bf(hi) << 16); }
__device__ __forceinline__ float bflo(unsigned w) { return __builtin_bit_cast(float, w << 16); }
__device__ __forceinline__ float bfhi(unsigned w) { return __builtin_bit_cast(float, w & 0xffff0000u); }
__device__ __forceinline__ float bf2f(bf16 b) { return __builtin_bit_cast(float, ((unsigned)b) << 16); }
template <int CTRL> __device__ __forceinline__ float dppf(float x) { return __builtin_bit_cast(float, __builtin_amdgcn_update_dpp(0, __builtin_bit_cast(int, x), CTRL, 0xf, 0xf, true)); }
template <int CTRL> __device__ __forceinline__ int dppi(int x) { return __builtin_amdgcn_update_dpp(0, x, CTRL, 0xf, 0xf, true); }
constexpr int DPP_X1 = 0xB1, DPP_X2 = 0x4E, DPP_HM = 0x141, DPP_RM = 0x140;
__device__ __forceinline__ void swap16(float& a, float& b) { asm("s_nop 1\n\tv_permlane16_swap_b32 %0, %1" : "+v"(a), "+v"(b)); }
__device__ __forceinline__ void swap32(float& a, float& b) { asm("s_nop 1\n\tv_permlane32_swap_b32 %0, %1" : "+v"(a), "+v"(b)); }
__device__ __forceinline__ float xrow_sum(float v) { { float a = v, b = v; swap16(a, b); v = a + b; } { float a = v, b = v; swap32(a, b); v = a + b; } return v; }
__device__ __forceinline__ float row_sum16(float v) { v += dppf<DPP_X1>(v); v += dppf<DPP_X2>(v); v += dppf<DPP_HM>(v); v += dppf<DPP_RM>(v); return v; }
__device__ __forceinline__ float row_max16(float v) { v = fmaxf(v, dppf<DPP_X1>(v)); v = fmaxf(v, dppf<DPP_X2>(v)); v = fmaxf(v, dppf<DPP_HM>(v)); v = fmaxf(v, dppf<DPP_RM>(v)); return v; }
__device__ __forceinline__ float wave_sum(float v) { return xrow_sum(row_sum16(v)); }
__device__ __forceinline__ float wave_max(float v) { v = row_max16(v); { float a = v, b = v; swap16(a, b); v = fmaxf(a, b); } { float a = v, b = v; swap32(a, b); v = fmaxf(a, b); } return v; }
__device__ __forceinline__ int wave_sum_i(int v) {
    v += dppi<DPP_X1>(v); v += dppi<DPP_X2>(v); v += dppi<DPP_HM>(v); v += dppi<DPP_RM>(v);
    float f = __builtin_bit_cast(float, v);
    { float a = f, b = f; swap16(a, b); v = __builtin_bit_cast(int, a) + __builtin_bit_cast(int, b); f = __builtin_bit_cast(float, v); }
    { float a = f, b = f; swap32(a, b); v = __builtin_bit_cast(int, a) + __builtin_bit_cast(int, b); }
    return v;
}
__device__ __forceinline__ float sigmoid_f(float x) { return 1.f / (1.f + __expf(-x)); }
__device__ __forceinline__ float silu_f(float x) { return x / (1.f + __expf(-x)); }
__device__ __forceinline__ float gelu_tanh_f(float x) { const float u = 0.7978845608028654f * (x + 0.044715f * x * x * x); return 0.5f * x * (1.f + tanhf(u)); }

struct Args { const float* in[35]; float* out; unsigned char* ws; int ph_lo, ph_hi, G, pad; };
typedef const __attribute__((address_space(4))) Args* KArgs;
__device__ __forceinline__ KArgs kargs() { unsigned long long p = (unsigned long long)__builtin_amdgcn_kernarg_segment_ptr(); asm volatile("" : "+s"(p)); return (KArgs)p; }

__device__ __forceinline__ unsigned char* launder_ws(unsigned char* p) { unsigned long long v = (unsigned long long)p; asm volatile("" : "+s"(v)); return (unsigned char*)v; }
template <class T> __device__ __forceinline__ T* opq(T* p) { unsigned long long v = (unsigned long long)p; asm volatile("" : "+s"(v)); return (T*)v; }
struct Frame {
    LAS unsigned char* lds;
    int tid, lane, wave, bid, G, gw, NGW;
    unsigned char* ws;
};

__device__ __forceinline__ void s5_build_ops(Frame& F, unsigned char* ws_, KArgs ka, int l, int g);
constexpr size_t WS_WPT_FWD = 5 * MiB + 512 * KiB;
constexpr size_t WS_CTR = 16 * KiB;
__device__ __forceinline__ int maprow(int type, int n0) {
    if (type == 1) return 256 * (n0 >> 7) + (n0 & 127);
    if (type == 2) return 256 * (n0 >> 7) + 128 + (n0 & 127);
    if (type == 3) { if (n0 < 1024) return n0; if (n0 < 1280) { const int ch = n0 - 1024; return 1024 + 256 * (ch >> 7) + (ch & 127); } const int ch = n0 - 1280; return 1024 + 256 * (ch >> 7) + 128 + (ch & 127); }
    return n0;
}
struct TItem { const float* src; unsigned char* dst; int N, rowbytes, f8; float scale; };
__device__ __forceinline__ float sat_e4m3(float x) { return __builtin_amdgcn_fmed3f(x, -448.f, 448.f); }
__device__ __forceinline__ unsigned pack4_fp8(float a, float b, float c, float d) { int w = __builtin_amdgcn_cvt_pk_fp8_f32(sat_e4m3(a), sat_e4m3(b), 0, false); w = __builtin_amdgcn_cvt_pk_fp8_f32(sat_e4m3(c), sat_e4m3(d), w, true); return (unsigned)w; }
__device__ __forceinline__ TItem titem(const float* W, int K, int N, void* WT, int type, int item, int lane, int f8 = 0, float scale = 1.f) {
    const int nblk = N / 32, kb = item / nblk, nb = item % nblk, k0 = 64 * kb, n0 = 32 * nb;
    TItem t; t.src = W + (size_t)(k0 + (lane >> 5)) * N + n0 + (lane & 31); t.N = N; t.f8 = f8; t.scale = scale;
    t.rowbytes = f8 ? K : 2 * K; t.dst = (unsigned char*)WT + (size_t)maprow(type, n0) * t.rowbytes + (f8 ? k0 : 2 * k0); return t;
}
__device__ __forceinline__ void titem_load(const TItem& t, float (&tmp)[32]) {
#pragma unroll
    for (int i = 0; i < 32; ++i) tmp[i] = __builtin_nontemporal_load(t.src + (size_t)(2 * i) * t.N);
}
__device__ __forceinline__ void titem_finish(const TItem& t, const float (&tmp)[32], LAS float* scr, int lane) {
#pragma unroll
    for (int i = 0; i < 32; ++i) scr[(2 * i + (lane >> 5)) * 33 + (lane & 31)] = tmp[i];
    LDS_WAIT(); asm volatile("" ::: "memory");
    const int c = lane & 7;
#pragma unroll
    for (int j = 0; j < 4; ++j) { const int n = (lane >> 3) + 8 * j; const LAS float* s = scr + (8 * c) * 33 + n;
        if (t.f8) { const float sc = t.scale; v2u o; o.x = pack4_fp8(s[0 * 33] * sc, s[1 * 33] * sc, s[2 * 33] * sc, s[3 * 33] * sc); o.y = pack4_fp8(s[4 * 33] * sc, s[5 * 33] * sc, s[6 * 33] * sc, s[7 * 33] * sc);
            *(v2u*)(t.dst + (size_t)n * t.rowbytes + 8 * c) = o; }
        else { v4u o; o.x = pk2(s[0 * 33], s[1 * 33]); o.y = pk2(s[2 * 33], s[3 * 33]); o.z = pk2(s[4 * 33], s[5 * 33]); o.w = pk2(s[6 * 33], s[7 * 33]);
            *(v4u*)(t.dst + (size_t)n * t.rowbytes + 16 * c) = o; } }
    LDS_WAIT(); asm volatile("" ::: "memory");
}
__device__ __forceinline__ void ph_prologue(Frame& F) {
    unsigned char* const ws_ = launder_ws(F.ws);
    KArgs ka = kargs();
    const float* c_in = ka->in[1]; const float* cctx = ka->in[3]; const float* w_mod = ka->in[4]; const float* b_mod = ka->in[5];
    for (int u = F.bid; u < 2 * 96; u += F.G) {
        const int l = u / 96, cc = u % 96;
        LAS float* sv = (LAS float*)F.lds;
        LAS float* part = sv + 3072;
        for (int i = F.tid; i < 3072; i += NTHREADS) { const int v = i >> 10, k = i & 1023; const float x = (v < 2) ? c_in[v * 1024 + k] : cctx[k]; sv[i] = silu_f(x); }
        __syncthreads();
        float a0 = 0.f, a1 = 0.f, a2 = 0.f;
        const float* wp = w_mod + (size_t)l * 1024 * 6144 + cc * 64 + F.lane;
#pragma nounroll
        for (int k0 = 0; k0 < 128; k0 += 32) { float wv[32];
#pragma unroll
            for (int q = 0; q < 32; ++q) wv[q] = __builtin_nontemporal_load(wp + (size_t)(F.wave * 128 + k0 + q) * 6144);
#pragma unroll
            for (int q = 0; q < 32; ++q) { const int k = F.wave * 128 + k0 + q; a0 += sv[k] * wv[q]; a1 += sv[1024 + k] * wv[q]; a2 += sv[2048 + k] * wv[q]; } }
        part[(F.wave * 3 + 0) * 64 + F.lane] = a0; part[(F.wave * 3 + 1) * 64 + F.lane] = a1; part[(F.wave * 3 + 2) * 64 + F.lane] = a2;
        __syncthreads();
        if (F.tid < 192) { const int v = F.tid >> 6, j = F.tid & 63; float s = b_mod[l * 6144 + cc * 64 + j];
#pragma unroll
            for (int w = 0; w < 8; ++w) s += part[(w * 3 + v) * 64 + j];
            ((float*)(ws_ + WS_MOD))[(l * 3 + v) * 6144 + cc * 64 + j] = s; }
        __syncthreads();
    }
    if (F.bid >= 192 && F.bid < 224) { const int u = F.bid - 192; s5_build_ops(F, ws_, ka, u >> 4, u & 15); }
    const int gid = F.bid * NTHREADS + F.tid;
    if (gid < 2048) { const int pos = gid >> 4, i = gid & 15; const double ang = (double)pos * pow(10000.0, -(double)i / 16.0);
        float* rp = (float*)(ws_ + WS_ROPE) + gid * 2; rp[0] = (float)cos(ang); rp[1] = (float)sin(ang); }
    if (gid >= 4096 && gid < 4096 + 3072) { const int i = gid - 4096, l = i / 1536, n = i % 1536; ((float*)(ws_ + WS_BINP))[l * 1536 + maprow(3, n & ~31) + (n & 31)] = ka->in[7][l * 1536 + n]; }
    {
        LAS float* scr = (LAS float*)(F.lds + F.wave * 16384);
        constexpr int S_IN = 16 * 48, S_OUT = 16 * 32, S_PW = 2 * 32, PER_S = S_IN + S_OUT + S_PW;
        for (int it = F.gw; it < 2 * PER_S; it += F.NGW) { const int l_ = it / PER_S; int r_ = it % PER_S; TItem T;
            if (r_ < S_IN) T = titem(ka->in[6] + (size_t)l_ * 1024 * 1536, 1024, 1536, (bf16*)(ws_ + WS_WIN) + (size_t)l_ * 1536 * 1024, 3, r_, F.lane);
            else if ((r_ -= S_IN) < S_OUT) T = titem(ka->in[25] + (size_t)l_ * 1024 * 1024, 1024, 1024, (bf16*)(ws_ + WS_WOUT) + (size_t)l_ * 1024 * 1024, 0, r_, F.lane);
            else { r_ -= S_OUT; const int w_ = r_ >> 5; T = titem(ka->in[w_ ? 23 : 17] + (size_t)l_ * 65536, 256, 256, (bf16*)(ws_ + WS_WPT_FWD) + (size_t)(l_ * 2 + w_) * 65536, 0, r_ & 31, F.lane); }
            float tc[32]; titem_load(T, tc); titem_finish(T, tc, scr, F.lane); }
    }
    __syncthreads();
    {
        LAS float* T = (LAS float*)F.lds;
        LAS unsigned* bc = (LAS unsigned*)(F.lds + 128 * 260 * 4);
        unsigned* ctr = (unsigned*)(ws_ + WS_CTR);
        constexpr int TPM = 64, TPE = 3 * TPM, NT_ALL = 2 * NE * TPE;
        const int lk = F.tid >> 6, ln4 = F.tid & 63;
        const int sn = F.tid >> 1, sq = F.tid & 1;
        struct Tl { const float* src; unsigned char* dst; int N, K; float sc; };
#define TILE_DECODE(t, X) do { const int le_ = (t) / TPE, r_ = (t) % TPE, which_ = r_ / TPM, ti_ = r_ % TPM; \
            if (which_ < 2) { const int kb_ = ti_ >> 3, nb_ = ti_ & 7; X.N = 2048; X.K = 1024; X.sc = which_ ? 32.f * 4.f * 0.6931471805599453f : 32.f * 1.4426950408889634f;     \
                X.src = ka->in[30 + which_] + (size_t)le_ * 1024 * 2048 + (size_t)(128 * kb_) * 2048 + 256 * nb_; \
                X.dst = ws_ + WS_WGU + (size_t)le_ * 4096 * 1024 + (size_t)(512 * nb_ + 128 * which_) * 1024 + 128 * kb_; } \
            else { const int kb_ = ti_ >> 2, nb_ = ti_ & 3; X.N = 1024; X.K = 2048; X.sc = 64.f; \
                X.src = ka->in[32] + (size_t)le_ * 2048 * 1024 + (size_t)(128 * kb_) * 1024 + 256 * nb_; \
                X.dst = ws_ + WS_WD + (size_t)le_ * 1024 * 2048 + (size_t)(256 * nb_) * 2048 + 128 * kb_; } } while (0)
#define TILE_LOAD(X, R) do { _Pragma("unroll") for (int i = 0; i < 16; ++i) R[i] = __builtin_nontemporal_load((const f32x4*)(X.src + (size_t)(lk + 8 * i) * X.N + 4 * ln4)); } while (0)
#define TILE_DRAW(t) do { __syncthreads(); if (F.tid == 0) bc[0] = __hip_atomic_fetch_add(ctr, 1u, __ATOMIC_RELAXED, __HIP_MEMORY_SCOPE_AGENT); __syncthreads(); t = (int)bc[0]; } while (0)
        int tcur, tnxt; Tl cur, nxt; f32x4 rc[16], rn[16];
        TILE_DRAW(tcur);
        if (tcur < NT_ALL) { TILE_DECODE(tcur, cur); TILE_LOAD(cur, rc);
            for (;;) {
                TILE_DRAW(tnxt);
                const bool has = tnxt < NT_ALL;
                if (has) { TILE_DECODE(tnxt, nxt); TILE_LOAD(nxt, rn); }
#pragma unroll
                for (int i = 0; i < 16; ++i) *(LAS f32x4*)(T + (lk + 8 * i) * 260 + 4 * ln4) = rc[i];
                __syncthreads();
                { const float sc = cur.sc; const LAS float* s = T + (64 * sq) * 260 + sn;
                    const int rowoff = (cur.K == 1024) ? (256 * (sn >> 7) + (sn & 127)) : sn;
                    unsigned char* o = cur.dst + (size_t)rowoff * cur.K + 64 * sq;
#pragma unroll
                    for (int q = 0; q < 4; ++q) { unsigned w[4];
#pragma unroll
                        for (int j = 0; j < 4; ++j) { const int k_ = 16 * q + 4 * j; w[j] = pack4_fp8(s[k_ * 260] * sc, s[(k_ + 1) * 260] * sc, s[(k_ + 2) * 260] * sc, s[(k_ + 3) * 260] * sc); }
                        *(v4u*)(o + 16 * q) = (v4u){w[0], w[1], w[2], w[3]}; } }
                if (!has) break;
                cur = nxt;
#pragma unroll
                for (int i = 0; i < 16; ++i) rc[i] = rn[i];
            } }
#undef TILE_DRAW
#undef TILE_LOAD
#undef TILE_DECODE
    }
}

__device__ __forceinline__ void row_load(const float* p, int lane, f32x4 (&v)[4]) {
#pragma unroll
    for (int j = 0; j < 4; ++j) v[j] = ((const f32x4*)p)[lane + 64 * j];
}
__device__ __forceinline__ void row_ln(f32x4 (&v)[4]) {
    float s = 0.f;
#pragma unroll
    for (int j = 0; j < 4; ++j) s += (v[j].x + v[j].y) + (v[j].z + v[j].w);
    const float mean = wave_sum(s) * (1.f / 1024.f); float s2 = 0.f;
#pragma unroll
    for (int j = 0; j < 4; ++j) { v[j] = v[j] - mean; s2 += (v[j].x * v[j].x + v[j].y * v[j].y) + (v[j].z * v[j].z + v[j].w * v[j].w); }
    const float rstd = 1.f / sqrtf(wave_sum(s2) * (1.f / 1024.f) + LN_EPS);
#pragma unroll
    for (int j = 0; j < 4; ++j) v[j] = v[j] * rstd;
}
__device__ __forceinline__ void row_store_bf16(bf16* p, int lane, const f32x4 (&v)[4]) {
#pragma unroll
    for (int j = 0; j < 4; ++j) { v2u o; o.x = pk2(v[j].x, v[j].y); o.y = pk2(v[j].z, v[j].w); ((v2u*)p)[lane + 64 * j] = o; }
}
__device__ __forceinline__ int row_mod_index(int r) { return r < NX ? (r >> 13) : 2; }
__device__ __forceinline__ void modulate_store(f32x4 (&v)[4], const float* shift, const float* scale, bf16* dst, int lane) {
    f32x4 o[4];
#pragma unroll
    for (int j = 0; j < 4; ++j) { const f32x4 sh = ((const f32x4*)shift)[lane + 64 * j], sc = ((const f32x4*)scale)[lane + 64 * j]; o[j] = v[j] * (sc + 1.f) + sh; }
    row_store_bf16(dst, lane, o);
}
__device__ __forceinline__ void ph_rows0(Frame& F) {
    unsigned char* const ws_ = launder_ws(F.ws);
    KArgs ka = kargs();
    const float* MOD = (const float*)(ws_ + WS_MOD); bf16* HX = (bf16*)(ws_ + WS_HX);
    for (int r = F.gw; r < NR; r += F.NGW) {
        const float* src = r < NX ? ka->in[0] + (size_t)r * 1024 : ka->in[2] + (size_t)(r - NX) * 1024;
        f32x4 v[4]; row_load(src, F.lane, v); row_ln(v);
        const float* m = MOD + (0 * 3 + row_mod_index(r)) * 6144;
        modulate_store(v, m, m + 1024, HX + (size_t)r * 1024, F.lane);
    }
}
constexpr int S5T = 32, S5R = 768, S5K = 768;
constexpr size_t WS_HCTX = 1 * MiB + 800 * KiB;
constexpr size_t WS_LB32 = 1 * MiB + 832 * KiB;
constexpr size_t WS_KT = 975 * MiB;
constexpr size_t WS_BE = 999 * MiB;
constexpr size_t WS_UC = 494 * MiB;
constexpr size_t WS_E = 512 * MiB;
constexpr size_t WS_Z = WS_HID + 100 * MiB;
constexpr size_t WS_CN = WS_Z + (size_t)NR * 256 * 2;
constexpr size_t WS_END2 = 1019 * MiB;

__device__ __forceinline__ void s5_build_ops(Frame& F, unsigned char* ws_, KArgs ka, int l, int g) {
    LAS float* PW = (LAS float*)F.lds; LAS float* CM = PW + 8448; LAS float* BB = CM + 4096; LAS float* LAG = BB + 4096;
    __syncthreads();
    if (F.tid < 128) {
        const int d = F.tid >> 6, p = F.tid & 63; const int ldg = (l * 2 + d) * 16 + g;
        const double lr = ka->in[9][ldg * 64 + p], li = ka->in[10][ldg * 64 + p], dt = exp((double)ka->in[11][ldg]);
        const double zr = lr * dt, zi = li * dt, er = exp(zr), lbr = er * cos(zi), lbi = er * sin(zi);
        double pr = 1.0, pi = 0.0;
#pragma nounroll
        for (int tau = 0; tau <= 32; ++tau) { PW[((d * 33 + tau) * 64 + p) * 2] = (float)pr; PW[((d * 33 + tau) * 64 + p) * 2 + 1] = (float)pi; const double t = pr * lbr - pi * lbi; pi = pr * lbi + pi * lbr; pr = t; }
        const double nr = lbr - 1.0, ni = lbi, den = lr * lr + li * li, cr = (nr * lr + ni * li) / den, ci = (ni * lr - nr * li) / den;
        const float* bre = ka->in[12] + ((size_t)ldg * 64 + p) * 16; const float* bim = ka->in[13] + ((size_t)ldg * 64 + p) * 16;
        for (int c = 0; c < 16; ++c) { const double br = bre[c], bi = bim[c]; BB[((d * 64 + p) * 16 + c) * 2] = (float)(cr * br - ci * bi); BB[((d * 64 + p) * 16 + c) * 2 + 1] = (float)(cr * bi + ci * br); } }
    for (int i = F.tid; i < 2 * 16 * 64; i += NTHREADS) { const int d = i >> 10, r = i & 1023; const int ldg = (l * 2 + d) * 16 + g; CM[2 * i] = ka->in[14][(size_t)ldg * 1024 + r]; CM[2 * i + 1] = ka->in[15][(size_t)ldg * 1024 + r]; }
    __syncthreads();
    for (int it = F.tid; it < 2 * 32 * 16; it += NTHREADS) { const int d = it >> 9, tau = (it >> 4) & 31, c = it & 15;
        float acc[16];
#pragma unroll
        for (int q = 0; q < 16; ++q) acc[q] = 0.f;
        for (int p = 0; p < 64; ++p) { const float cr = CM[((d * 16 + c) * 64 + p) * 2], ci = CM[((d * 16 + c) * 64 + p) * 2 + 1], pr = PW[((d * 33 + tau) * 64 + p) * 2], pi = PW[((d * 33 + tau) * 64 + p) * 2 + 1];
            const float wr = cr * pr - ci * pi, wi = cr * pi + ci * pr;
#pragma unroll
            for (int q = 0; q < 16; ++q) acc[q] += wr * BB[((d * 64 + p) * 16 + q) * 2] - wi * BB[((d * 64 + p) * 16 + q) * 2 + 1]; }
#pragma unroll
        for (int q = 0; q < 16; ++q) LAG[((d * 32 + tau) * 16 + c) * 16 + q] = acc[q]; }
    __syncthreads();
    const float* dsk = ka->in[16] + l * 256 + g * 16;
    bf16* KT = (bf16*)(ws_ + WS_KT) + ((size_t)(l * 16 + g) * 512) * S5K;
    for (int pc = F.tid; pc < 512 * 96; pc += NTHREADS) { const int row = pc / 96, q8 = pc % 96, j = row >> 4, c = row & 15; float v[8];
        if (q8 < 64) { const int jp = q8 >> 1, c0 = (q8 & 1) * 8;
#pragma unroll
            for (int e = 0; e < 8; ++e) { float x = 0.f; if (j >= jp) x += LAG[((0 * 32 + (j - jp)) * 16 + c) * 16 + c0 + e]; if (j <= jp) x += LAG[((1 * 32 + (jp - j)) * 16 + c) * 16 + c0 + e]; if (j == jp && c == c0 + e) x += dsk[c]; v[e] = x; } }
        else { const int n0 = (q8 - 64) * 8, d = n0 >> 7, tau = d ? (32 - j) : (j + 1);
#pragma unroll
            for (int e = 0; e < 8; e += 2) { const int p = ((n0 & 127) + e) >> 1; const float cr = CM[((d * 16 + c) * 64 + p) * 2], ci = CM[((d * 16 + c) * 64 + p) * 2 + 1], pr = PW[((d * 33 + tau) * 64 + p) * 2], pi = PW[((d * 33 + tau) * 64 + p) * 2 + 1];
                v[e] = cr * pr - ci * pi; v[e + 1] = -(cr * pi + ci * pr); } }
        v4u o; o.x = pk2(v[0], v[1]); o.y = pk2(v[2], v[3]); o.z = pk2(v[4], v[5]); o.w = pk2(v[6], v[7]);
        *(v4u*)(KT + (size_t)row * S5K + q8 * 8) = o; }
    bf16* BE = (bf16*)(ws_ + WS_BE) + ((size_t)(l * 16 + g) * 256) * 512;
    for (int pc = F.tid; pc < 256 * 64; pc += NTHREADS) { const int n = pc >> 6, q8 = pc & 63, d = n >> 7, p = (n & 127) >> 1, ri = n & 1, jp = q8 >> 1, c0 = (q8 & 1) * 8, tau = d ? jp : (31 - jp);
        const float pr = PW[((d * 33 + tau) * 64 + p) * 2], pi = PW[((d * 33 + tau) * 64 + p) * 2 + 1]; float v[8];
#pragma unroll
        for (int e = 0; e < 8; ++e) { const float br = BB[((d * 64 + p) * 16 + c0 + e) * 2], bi = BB[((d * 64 + p) * 16 + c0 + e) * 2 + 1]; v[e] = ri ? (pr * bi + pi * br) : (pr * br - pi * bi); }
        v4u o; o.x = pk2(v[0], v[1]); o.y = pk2(v[2], v[3]); o.z = pk2(v[4], v[5]); o.w = pk2(v[6], v[7]);
        *(v4u*)(BE + (size_t)n * 512 + q8 * 8) = o; }
    if (F.tid < 128) { const int d = F.tid >> 6, p = F.tid & 63; float* o = (float*)(ws_ + WS_LB32) + (((size_t)(l * 16 + g) * 2 + d) * 64 + p) * 2; o[0] = PW[((d * 33 + 32) * 64 + p) * 2]; o[1] = PW[((d * 33 + 32) * 64 + p) * 2 + 1]; }
    __syncthreads();
}
__device__ __forceinline__ void s5_carry_tile(Frame& F, int l, int g, int mt) {
    unsigned char* const ws_ = launder_ws(F.ws);
    if (mt < 2) {
        const int b = mt, seg = F.tid >> 7, d = (F.tid >> 6) & 1, p = F.tid & 63, dp = F.tid & 127;
        const float* lb = (const float*)(ws_ + WS_LB32) + (((size_t)(l * 16 + g) * 2 + d) * 64 + p) * 2; const float ar = lb[0], ai = lb[1];
        const float* E = (const float*)(ws_ + WS_E) + ((size_t)g * S5R) * 256 + d * 128 + 2 * p;
        bf16* UC = (bf16*)(ws_ + WS_UC) + ((size_t)g * S5R) * S5K + 512 + d * 128 + 2 * p;
        LAS float* Ls = (LAS float*)F.lds;
        float er[64], ei[64], cr[8], ci[8];
#pragma unroll
        for (int q = 0; q < 8; ++q) { const int R = 512 + b * 8 + (d ? 7 - q : q); const float2 e2 = *(const float2*)(E + (size_t)R * 256); cr[q] = e2.x; ci[q] = e2.y; }
        const int R0 = b * 256 + (d ? 255 - 64 * seg : 64 * seg); const long estep = d ? -256 : 256, ustep = d ? -(long)S5K : (long)S5K;
        { const float* ep = E + (size_t)R0 * 256;
#pragma unroll
          for (int q = 0; q < 64; ++q) { const float2 e2 = *(const float2*)ep; er[q] = e2.x; ei[q] = e2.y; ep += estep; } }
        float sr = 0.f, si = 0.f;
#pragma unroll
        for (int q = 0; q < 8; ++q) { const float nr = ar * sr - ai * si + cr[q], ni = ar * si + ai * sr + ci[q]; sr = nr; si = ni; }
        float lr = 0.f, li = 0.f;
#pragma unroll
        for (int q = 0; q < 64; ++q) { const float nr = ar * lr - ai * li + er[q], ni = ar * li + ai * lr + ei[q]; lr = nr; li = ni; }
        float pr = ar, pi = ai;
#pragma unroll
        for (int i = 0; i < 6; ++i) { const float t = pr * pr - pi * pi; pi = 2.f * pr * pi; pr = t; }
        Ls[(seg * 128 + dp) * 2] = lr; Ls[(seg * 128 + dp) * 2 + 1] = li;
        __syncthreads();
        for (int s_ = 0; s_ < seg; ++s_) { const float Lr = Ls[(s_ * 128 + dp) * 2], Li = Ls[(s_ * 128 + dp) * 2 + 1]; const float nr = pr * sr - pi * si + Lr, ni = pr * si + pi * sr + Li; sr = nr; si = ni; }
        { bf16* up = UC + (size_t)R0 * S5K;
#pragma unroll
          for (int q = 0; q < 64; ++q) { *(unsigned*)up = pk2(sr, si); up += ustep;
            const float nr = ar * sr - ai * si + er[q], ni = ar * si + ai * sr + ei[q]; sr = nr; si = ni; } }
    } else if (F.tid < 256) { const int b = F.tid >> 7, d = (F.tid >> 6) & 1, p = F.tid & 63;
        const float* lb = (const float*)(ws_ + WS_LB32) + (((size_t)(l * 16 + g) * 2 + d) * 64 + p) * 2; const float ar = lb[0], ai = lb[1];
        float sr = 0.f, si = 0.f;
        const float* E = (const float*)(ws_ + WS_E) + ((size_t)g * S5R) * 256 + d * 128 + 2 * p;
        bf16* UC = (bf16*)(ws_ + WS_UC) + ((size_t)g * S5R) * S5K + 512 + d * 128 + 2 * p;
        float er[8], ei[8];
#pragma unroll
        for (int q = 0; q < 8; ++q) { const int R = 512 + b * 8 + (d ? 7 - q : q); const float2 e2 = *(const float2*)(E + (size_t)R * 256); er[q] = e2.x; ei[q] = e2.y; }
#pragma unroll
        for (int q = 0; q < 8; ++q) { const int R = 512 + b * 8 + (d ? 7 - q : q); *(unsigned*)(UC + (size_t)R * S5K) = pk2(sr, si);
            const float nr = ar * sr - ai * si + er[q], ni = ar * si + ai * sr + ei[q]; sr = nr; si = ni; }
    }
    asm volatile("s_waitcnt vmcnt(0)" ::: "memory");
    __syncthreads();
}
typedef short bf16x8_t __attribute__((ext_vector_type(8)));
typedef short bf16x4_t __attribute__((ext_vector_type(4)));
typedef float f32x16 __attribute__((ext_vector_type(16)));
typedef unsigned u32x4_t __attribute__((ext_vector_type(4)));
constexpr int AT_KROW = 72, AT_VROW = 388;
constexpr int AT_KBYTES = 640 * AT_KROW * 2, AT_VBYTES = 64 * AT_VROW * 2, AT_SCR = AT_KBYTES + AT_VBYTES;
static_assert(AT_SCR + 8 * 64 * 4 <= LDS_BYTES, "attention LDS");
__device__ __forceinline__ int at_crow(int r, int h) { return (r & 3) + 8 * (r >> 2) + 4 * h; }
__device__ __forceinline__ float mx2(float a, float b, float inf) { return __builtin_amdgcn_fmed3f(a, b, inf); }
__device__ __forceinline__ float max16(const f32x16& s, float inf) { const float a = mx2(mx2(s[0], s[1], inf), mx2(s[2], s[3], inf), inf), b = mx2(mx2(s[4], s[5], inf), mx2(s[6], s[7], inf), inf), c = mx2(mx2(s[8], s[9], inf), mx2(s[10], s[11], inf), inf), d = mx2(mx2(s[12], s[13], inf), mx2(s[14], s[15], inf), inf); return mx2(mx2(a, b, inf), mx2(c, d, inf), inf); }
__device__ __forceinline__ void ph_attn(Frame& F, int l, int ulo, int uhi, int wgi, int nwg) {
    unsigned char* const ws_ = launder_ws(F.ws);
    KArgs ka = kargs();
    const bf16* Q = (const bf16*)(ws_ + WS_Q); const bf16* K = (const bf16*)(ws_ + WS_K); const bf16* V = (const bf16*)(ws_ + WS_V);
    bf16* CAT = (bf16*)(ws_ + WS_CAT); const float* sink = ka->in[8] + l * 8;
    LAS bf16* Ks = (LAS bf16*)F.lds; LAS bf16* Vt = (LAS bf16*)(F.lds + AT_KBYTES); LAS float* scr = (LAS float*)(F.lds + AT_SCR) + F.wave * 64;
    const int lane = F.lane, l31 = lane & 31, h = lane >> 5, hh = F.wave >> 1, qh = F.wave & 1;
    for (int u = ulo + wgi; u < uhi; u += nwg) {
        int b, kvh, n, qrow0; bool win;
        if (u < 256) { b = u >> 7; kvh = (u >> 6) & 1; n = u & 63; win = true; qrow0 = b * SEQ + n * 128; }
        else { const int uc = u - 256; b = uc >> 2; kvh = (uc >> 1) & 1; n = uc & 1; win = false; qrow0 = NX + b * LCTX + n * 128; }
        __syncthreads();
#define AT_VT_WRITE(A_, B_, kp2_, ch_) do { LAS unsigned* vp_ = (LAS unsigned*)(Vt + ((ch_) * 8) * AT_VROW + 2 * (kp2_)); \
            vp_[0] = (A_.x & 0xffffu) | (B_.x << 16); vp_[AT_VROW / 2] = (A_.x >> 16) | (B_.x & 0xffff0000u); vp_[2 * (AT_VROW / 2)] = (A_.y & 0xffffu) | (B_.y << 16); vp_[3 * (AT_VROW / 2)] = (A_.y >> 16) | (B_.y & 0xffff0000u); \
            vp_[4 * (AT_VROW / 2)] = (A_.z & 0xffffu) | (B_.z << 16); vp_[5 * (AT_VROW / 2)] = (A_.z >> 16) | (B_.z & 0xffff0000u); vp_[6 * (AT_VROW / 2)] = (A_.w & 0xffffu) | (B_.w << 16); vp_[7 * (AT_VROW / 2)] = (A_.w >> 16) | (B_.w & 0xffff0000u); } while (0)
        int tid_ = F.tid; asm volatile("" : "+v"(tid_));
        {
            v4u kv[10], va[3], vb[3];
#pragma unroll
            for (int i = 0; i < 10; ++i) { kv[i] = (v4u){0u, 0u, 0u, 0u};
                if (win || i >= 6) { const int pc = tid_ + NTHREADS * i, row = pc >> 3, ch = pc & 7;
                    if (i < 6) { const int kp = 128 * (n - 1) + row; if (kp >= 0 && kp < SEQ) kv[i] = *(const v4u*)(K + ((size_t)(b * SEQ + kp)) * 128 + kvh * 64 + ch * 8); }
                    else kv[i] = *(const v4u*)(K + ((size_t)(NX + b * LCTX + row - 384)) * 128 + kvh * 64 + ch * 8); } }
            if (win) {
#pragma unroll
                for (int it = 0; it < 3; ++it) { const int idx = tid_ + NTHREADS * it, kp2 = idx >> 3, ch = idx & 7, kp = 128 * (n - 1) + 2 * kp2; va[it] = (v4u){0u, 0u, 0u, 0u}; vb[it] = va[it];
                    if (kp >= 0 && kp < SEQ) { const bf16* vsrc = V + ((size_t)(b * SEQ + kp)) * 128 + kvh * 64 + ch * 8; va[it] = *(const v4u*)vsrc; vb[it] = *(const v4u*)(vsrc + 128); } } }
#pragma unroll
            for (int i = 0; i < 10; ++i) if (win || i >= 6) { const int pc = tid_ + NTHREADS * i, row = pc >> 3, ch = pc & 7; *(LAS v4u*)(Ks + row * AT_KROW + ch * 8) = kv[i]; }
            if (win) {
#pragma unroll
                for (int it = 0; it < 3; ++it) { const int idx = tid_ + NTHREADS * it, kp2 = idx >> 3, ch = idx & 7; AT_VT_WRITE(va[it], vb[it], kp2, ch); } }
        }
        const int head = kvh * 4 + hh; const int qbase = qh * 64;
        bf16x8_t qf[2][4];
#pragma unroll
        for (int qb = 0; qb < 2; ++qb)
#pragma unroll
            for (int s = 0; s < 4; ++s) qf[qb][s] = *(const bf16x8_t*)(Q + ((size_t)(qrow0 + qbase + qb * 32 + l31)) * 512 + head * 64 + 16 * s + 8 * h);
        __syncthreads();
        const int qpos0 = n * 128 + qbase + l31;
        const int klo0 = max(qpos0 - 128, 0), klo1 = max(qpos0 + 32 - 128, 0); const unsigned span0 = (unsigned)(min(qpos0 + 128, SEQ - 1) - klo0), span1 = (unsigned)(min(qpos0 + 32 + 128, SEQ - 1) - klo1);
        const int wlo = win ? (qh ? 2 : 0) : 12, whi = win ? (qh ? 12 : 10) : 12;
#define AT_SCORES(st, S0, S1, MASKED, I0, I1) do { \
            const LAS bf16* kp_ = Ks + ((st) * 32 + l31) * AT_KROW + 8 * h; \
            _Pragma("unroll") for (int s = 0; s < 4; ++s) { const bf16x8_t kf = *(const LAS bf16x8_t*)(kp_ + 16 * s); \
                S0 = __builtin_amdgcn_mfma_f32_32x32x16_bf16(kf, qf[0][s], s ? S0 : (I0), 0, 0, 0); S1 = __builtin_amdgcn_mfma_f32_32x32x16_bf16(kf, qf[1][s], s ? S1 : (I1), 0, 0, 0); } \
            if ((MASKED) && (st) < 12 && ((st) < 4 || (st) >= 8)) { const int d0_ = 128 * (n - 1) + (st) * 32 + 4 * h - klo0, d1_ = d0_ + klo0 - klo1;     \
                _Pragma("unroll") for (int r = 0; r < 16; ++r) { const int c_ = (r & 3) + 8 * (r >> 2); \
                    if ((unsigned)(d0_ + c_) > span0) S0[r] = -1e30f; if ((unsigned)(d1_ + c_) > span1) S1[r] = -1e30f; } } \
        } while (0)
        const f32x16 Z16 = (f32x16){0.f,0.f,0.f,0.f,0.f,0.f,0.f,0.f,0.f,0.f,0.f,0.f,0.f,0.f,0.f,0.f};
        float m0 = -1e30f, m1 = -1e30f, INF_ = __builtin_inff(); asm volatile("" : "+v"(INF_));
#define AT_KLOAD(st, KF) do { const LAS bf16* kp_ = Ks + ((st) * 32 + l31) * AT_KROW + 8 * h; _Pragma("unroll") for (int s = 0; s < 4; ++s) KF[s] = *(const LAS bf16x8_t*)(kp_ + 16 * s); } while (0)
#define AT_QK(KF, S0, S1, I0, I1) do { _Pragma("unroll") for (int s = 0; s < 4; ++s) { S0 = __builtin_amdgcn_mfma_f32_32x32x16_bf16(KF[s], qf[0][s], s ? S0 : (I0), 0, 0, 0); S1 = __builtin_amdgcn_mfma_f32_32x32x16_bf16(KF[s], qf[1][s], s ? S1 : (I1), 0, 0, 0); } } while (0)
        const int nw = whi - wlo, nt = nw + 8;
#define AT_STOF(j) ((j) < nw ? wlo + (j) : 12 + (j) - nw)
        { bf16x8_t kA[4], kB[4]; f32x16 Sa0, Sa1, Sb0, Sb1;
        AT_KLOAD(AT_STOF(0), kA);
#pragma nounroll
        for (int j = 0; j < nt; j += 2) {
            AT_KLOAD(AT_STOF(j + 1), kB);
            __builtin_amdgcn_sched_barrier(0);
            AT_QK(kA, Sa0, Sa1, Z16, Z16);
            __builtin_amdgcn_sched_barrier(0);
            if (j + 2 < nt) AT_KLOAD(AT_STOF(j + 2), kA);
            __builtin_amdgcn_sched_barrier(0);
            AT_QK(kB, Sb0, Sb1, Z16, Z16);
            m0 = mx2(m0, max16(Sa0, INF_), INF_); m1 = mx2(m1, max16(Sa1, INF_), INF_);
            __builtin_amdgcn_sched_barrier(0);
            m0 = mx2(m0, max16(Sb0, INF_), INF_); m1 = mx2(m1, max16(Sb1, INF_), INF_);
        } }
        m0 = fmaxf(m0, __shfl_xor(m0, 32)); m1 = fmaxf(m1, __shfl_xor(m1, 32));
        const float sk = sink[head] * 1.4426950408889634f;
        m0 = fmaxf(m0, sk); m1 = fmaxf(m1, sk);
        float l0 = 0.f, l1 = 0.f; f32x16 O[2][2], NM0, NM1;
#pragma unroll
        for (int r = 0; r < 16; ++r) { NM0[r] = -m0; NM1[r] = -m1; }
#pragma unroll
        for (int a_ = 0; a_ < 2; ++a_)
#pragma unroll
            for (int b_ = 0; b_ < 2; ++b_) O[a_][b_] = (f32x16){0.f,0.f,0.f,0.f,0.f,0.f,0.f,0.f,0.f,0.f,0.f,0.f,0.f,0.f,0.f,0.f};
#define AT_PV(st, voff) do { f32x16 S0, S1; AT_SCORES(st, S0, S1, true, NM0, NM1);     \
            _Pragma("unroll") for (int r = 0; r < 16; ++r) { S0[r] = __builtin_amdgcn_exp2f(S0[r]); S1[r] = __builtin_amdgcn_exp2f(S1[r]);     l0 += S0[r]; l1 += S1[r]; } \
            _Pragma("unroll") for (int ks = 0; ks < 2; ++ks) { \
                u32x4_t pa0, pa1; \
                pa0.x = pg8::cvt_pk_bf16(S0[8 * ks + 0], S0[8 * ks + 1]); pa0.y = pg8::cvt_pk_bf16(S0[8 * ks + 2], S0[8 * ks + 3]); pa0.z = pg8::cvt_pk_bf16(S0[8 * ks + 4], S0[8 * ks + 5]); pa0.w = pg8::cvt_pk_bf16(S0[8 * ks + 6], S0[8 * ks + 7]); \
                pa1.x = pg8::cvt_pk_bf16(S1[8 * ks + 0], S1[8 * ks + 1]); pa1.y = pg8::cvt_pk_bf16(S1[8 * ks + 2], S1[8 * ks + 3]); pa1.z = pg8::cvt_pk_bf16(S1[8 * ks + 4], S1[8 * ks + 5]); pa1.w = pg8::cvt_pk_bf16(S1[8 * ks + 6], S1[8 * ks + 7]); \
                _Pragma("unroll") for (int db = 0; db < 2; ++db) { const LAS bf16* vp_ = Vt + (db * 32 + l31) * AT_VROW + (voff) + 16 * ks + 4 * h; \
                    const bf16x4_t lo_ = *(const LAS bf16x4_t*)vp_, hi_ = *(const LAS bf16x4_t*)(vp_ + 8); \
                    const bf16x8_t vf = (bf16x8_t){lo_[0], lo_[1], lo_[2], lo_[3], hi_[0], hi_[1], hi_[2], hi_[3]}; \
                    O[0][db] = __builtin_amdgcn_mfma_f32_32x32x16_bf16(__builtin_bit_cast(bf16x8_t, pa0), vf, O[0][db], 0, 0, 0); \
                    O[1][db] = __builtin_amdgcn_mfma_f32_32x32x16_bf16(__builtin_bit_cast(bf16x8_t, pa1), vf, O[1][db], 0, 0, 0); } } \
        } while (0)
        if (win) {
#pragma nounroll
            for (int st = wlo; st < whi; ++st) AT_PV(st, st * 32); }
        v4u ca[2], cb[2];
#pragma unroll
        for (int it = 0; it < 2; ++it) { const int idx = tid_ + NTHREADS * it, kp2 = idx >> 3, ch = idx & 7; const bf16* vsrc = V + ((size_t)(NX + b * LCTX + 2 * kp2)) * 128 + kvh * 64 + ch * 8; ca[it] = *(const v4u*)vsrc; cb[it] = *(const v4u*)(vsrc + 128); }
        __syncthreads();
#pragma unroll
        for (int it = 0; it < 2; ++it) { const int idx = tid_ + NTHREADS * it, kp2 = idx >> 3, ch = idx & 7; AT_VT_WRITE(ca[it], cb[it], kp2, ch); }
        __syncthreads();
#pragma nounroll
        for (int st = 12; st < 20; ++st) AT_PV(st, (st - 12) * 32);
#undef AT_PV
#undef AT_VT_WRITE
#undef AT_SCORES
#undef AT_KLOAD
#undef AT_QK
#undef AT_STOF
        l0 += __shfl_xor(l0, 32); l1 += __shfl_xor(l1, 32);
        l0 += __builtin_amdgcn_exp2f(sk - m0); l1 += __builtin_amdgcn_exp2f(sk - m1);
        if (h == 0) { scr[l31] = 1.f / l0; scr[32 + l31] = 1.f / l1; }
        LDS_WAIT();
#pragma unroll
        for (int qb = 0; qb < 2; ++qb)
#pragma unroll
            for (int r = 0; r < 16; ++r) { const int qq = at_crow(r, h); const float inv = scr[qb * 32 + qq]; const size_t row = (size_t)(qrow0 + qbase + qb * 32 + qq);
#pragma unroll
                for (int db = 0; db < 2; ++db) CAT[row * 1024 + head * 64 + db * 32 + l31] = (bf16)f2bf(O[qb][db][r] * inv); }
    }
}
constexpr size_t WS_WPT = 5 * MiB + 512 * KiB;
__device__ __forceinline__ void ph_conv(Frame& F, int l, int tlo, int thi, int wgi, int nwg, unsigned* ctr) {
    unsigned char* const ws_ = launder_ws(F.ws);
    KArgs ka = kargs();
    const bf16* HG = (const bf16*)(ws_ + WS_HG); bf16* CN = (bf16*)(ws_ + WS_CN);
    LAS float* Hs = (LAS float*)F.lds; LAS float* Ws = Hs + 94 * 256;
    const int lane = F.lane, c4 = 4 * lane;
    __syncthreads();
    for (int i = F.tid; i < 31 * 256; i += NTHREADS) Ws[i] = ka->in[19][(size_t)l * 31 * 256 + i];
    const f32x4 bd = *(const f32x4*)(ka->in[20] + l * 256 + c4), lg = *(const f32x4*)(ka->in[21] + l * 256 + c4), lb = *(const f32x4*)(ka->in[22] + l * 256 + c4);
    LAS unsigned* bc = (LAS unsigned*)(F.lds + 131072);
#define CONV_DRAW(t) do { __syncthreads(); if (F.tid == 0) bc[0] = __hip_atomic_fetch_add(ctr, 1u, __ATOMIC_RELAXED, __HIP_MEMORY_SCOPE_AGENT); __syncthreads(); t = tlo + (int)bc[0]; } while (0)
    int tile = tlo + wgi; if (ctr) CONV_DRAW(tile);
    for (; tile < thi; ) {
        int t0, base, len;
        if (tile < 256) { t0 = (tile & 127) * 64; base = (tile >> 7) * SEQ; len = SEQ; } else { const int tc = tile - 256; t0 = (tc & 3) * 64; base = NX + (tc >> 2) * LCTX; len = LCTX; }
        __syncthreads();
        { v2u hw[12];
#pragma unroll
          for (int it = 0; it < 12; ++it) { const int idx = F.tid + NTHREADS * it, rr = idx >> 6, cc = (idx & 63) * 4, tt = t0 - 15 + rr; hw[it] = (v2u){0u, 0u};
              if (idx < 94 * 64 && tt >= 0 && tt < len) hw[it] = *(const v2u*)(HG + ((size_t)(base + tt)) * 256 + cc); }
#pragma unroll
          for (int it = 0; it < 12; ++it) { const int idx = F.tid + NTHREADS * it, rr = idx >> 6, cc = (idx & 63) * 4;
              if (idx < 94 * 64) *(LAS f32x4*)(Hs + rr * 256 + cc) = (f32x4){bflo(hw[it].x), bfhi(hw[it].x), bflo(hw[it].y), bfhi(hw[it].y)}; } }
        __syncthreads();
        {
            const int row0 = F.wave * 8; f32x4 acc[8], win[8];
#pragma unroll
            for (int i = 0; i < 8; ++i) acc[i] = bd;
#pragma unroll
            for (int i = 0; i < 7; ++i) win[i] = *(const LAS f32x4*)(Hs + (row0 + i) * 256 + c4);
#pragma unroll
            for (int k = 0; k < 31; ++k) { win[(k + 7) & 7] = *(const LAS f32x4*)(Hs + (row0 + k + 7) * 256 + c4); const f32x4 wv = *(const LAS f32x4*)(Ws + k * 256 + c4);
#pragma unroll
                for (int i = 0; i < 8; ++i) acc[i] += win[(k + i) & 7] * wv; }
#pragma unroll
            for (int i = 0; i < 8; ++i) {
                const float mean = wave_sum((acc[i].x + acc[i].y) + (acc[i].z + acc[i].w)) * (1.f / 256.f); const f32x4 dv = acc[i] - mean;
                const float var = wave_sum((dv.x * dv.x + dv.y * dv.y) + (dv.z * dv.z + dv.w * dv.w)) * (1.f / 256.f); const float rstd = 1.f / sqrtf(var + LN_EPS);
                const f32x4 y = dv * rstd * lg + lb;
                v2u o; o.x = pk2(silu_f(y.x), silu_f(y.y)); o.y = pk2(silu_f(y.z), silu_f(y.w));
                *(v2u*)(CN + ((size_t)(base + t0 + row0 + i)) * 256 + c4) = o; }
        }
        if (ctr) CONV_DRAW(tile); else tile += nwg;
    }
#undef CONV_DRAW
}
__device__ __forceinline__ int block_sum_i(Frame& F, int v, LAS int* red, int slot) {
    const int w = wave_sum_i(v); if (F.lane == 0) red[slot * 8 + F.wave] = w; __syncthreads();
    int s = 0;
#pragma unroll
    for (int i = 0; i < 8; ++i) s += red[slot * 8 + i];
    return s;
}
__device__ __forceinline__ int wave_incl_scan_i(int v) {
    v += __builtin_amdgcn_update_dpp(0, v, 0x111, 0xf, 0xf, true); v += __builtin_amdgcn_update_dpp(0, v, 0x112, 0xf, 0xf, true);
    v += __builtin_amdgcn_update_dpp(0, v, 0x114, 0xf, 0xf, true); v += __builtin_amdgcn_update_dpp(0, v, 0x118, 0xf, 0xf, true);
    v += __builtin_amdgcn_update_dpp(0, v, 0x142, 0xa, 0xf, false);
    v += __builtin_amdgcn_update_dpp(0, v, 0x143, 0xc, 0xf, false);
    return v;
}
__device__ __forceinline__ int block_excl_scan_i(Frame& F, int v, LAS int* red) {
    const int inc = wave_incl_scan_i(v);
    __syncthreads();
    if (F.lane == 63) red[F.wave] = inc;
    __syncthreads();
    int base = 0;
#pragma unroll
    for (int i = 0; i < 8; ++i) if (i < F.wave) base += red[i];
    return base + inc - v;
}
template <int N, int CAP> __device__ __forceinline__ void route_unit(Frame& F, const float* aff, int e, int rowbase, int slotbase) {
    unsigned char* const ws_ = launder_ws(F.ws);
    constexpr int EPT = (N >= NTHREADS) ? N / NTHREADS : 1;
    static_assert(EPT == 16 || EPT == 1, "route_unit");
    LAS unsigned* hist = (LAS unsigned*)F.lds; LAS int* red = (LAS int*)(F.lds + 4096);
    int* IDX = (int*)(ws_ + WS_IDX); float* GATE = (float*)(ws_ + WS_GATE); int* TOK = (int*)(ws_ + WS_TOKSLOT);
    const bool have = (EPT == 16) || F.tid < N; const int i0 = F.tid * EPT;
    unsigned k[EPT];
    if (EPT == 16) {
#pragma unroll
        for (int q = 0; q < 4; ++q) { const v4u w = ((const v4u*)(aff + i0))[q]; k[4 * q % EPT] = w.x; k[(4 * q + 1) % EPT] = w.y; k[(4 * q + 2) % EPT] = w.z; k[(4 * q + 3) % EPT] = w.w; }
    } else k[0] = have ? __builtin_bit_cast(unsigned, aff[i0]) : 0u;
    __syncthreads();
    unsigned prefix = 0u, pmask = 0u; int need = CAP, eqtot = 0;
#pragma nounroll
    for (int pass = 0; pass < 3; ++pass) { const int sh = 20 - 10 * pass;
        hist[F.tid] = 0u; hist[F.tid + NTHREADS] = 0u;
        __syncthreads();
        if (have) {
#pragma unroll
            for (int j = 0; j < EPT; ++j) if ((k[j] & pmask) == prefix) __hip_atomic_fetch_add(hist + ((k[j] >> sh) & 1023u), 1u, __ATOMIC_RELAXED, __HIP_MEMORY_SCOPE_WORKGROUP); }
        __syncthreads();
        if (F.wave == 0) {
            unsigned h[16];
#pragma unroll
            for (int q = 0; q < 4; ++q) { const v4u w = ((const LAS v4u*)(hist + 16 * F.lane))[q]; h[4 * q] = w.x; h[4 * q + 1] = w.y; h[4 * q + 2] = w.z; h[4 * q + 3] = w.w; }
            unsigned own = 0u;
#pragma unroll
            for (int q = 0; q < 16; ++q) own += h[q];
            const unsigned pre = (unsigned)wave_incl_scan_i((int)own), total = (unsigned)__builtin_amdgcn_readlane((int)pre, 63);
            unsigned a = total - pre;
            int dsel = -1; unsigned asel = 0u, esel = 0u;
#pragma unroll
            for (int q = 15; q >= 0; --q) { if (a < (unsigned)need && (unsigned)need <= a + h[q]) { dsel = 16 * F.lane + q; asel = a; esel = h[q]; } a += h[q]; }
            if (dsel >= 0) { red[16] = dsel; red[17] = (int)asel; red[18] = (int)esel; }
        }
        __syncthreads();
        const int dsel = red[16]; need -= red[17]; eqtot = red[18];
        prefix |= ((unsigned)dsel) << sh; pmask |= 1023u << sh;
    }
    const unsigned T = prefix;
    const bool alleq = (eqtot == need);
    int eqb = 0;
    if (!alleq) { int ceq = 0;
#pragma unroll
        for (int j = 0; j < EPT; ++j) ceq += (have && k[j] == T) ? 1 : 0;
        eqb = block_excl_scan_i(F, ceq, red); }
    int csel = 0, e2 = eqb; unsigned selm = 0u;
#pragma unroll
    for (int j = 0; j < EPT; ++j) { const bool iseq = (k[j] == T); const bool sel = have && ((k[j] > T) || (iseq && (alleq || e2 < need))); e2 += iseq ? 1 : 0; csel += sel ? 1 : 0; selm |= sel ? (1u << j) : 0u; }
    int pos = block_excl_scan_i(F, csel, red + 32);
    int tokv[EPT];
#pragma unroll
    for (int j = 0; j < EPT; ++j) { tokv[j] = -1;
        if ((selm >> j) & 1u) { const int slot = slotbase + pos; ++pos; IDX[slot] = rowbase + i0 + j; GATE[slot] = __builtin_bit_cast(float, k[j]); tokv[j] = slot; } }
    int* tp = TOK + (size_t)e * NR + rowbase + i0;
    if (EPT == 16) {
#pragma unroll
        for (int q = 0; q < 4; ++q) ((v4u*)tp)[q] = (v4u){(unsigned)tokv[4 * q % EPT], (unsigned)tokv[(4 * q + 1) % EPT], (unsigned)tokv[(4 * q + 2) % EPT], (unsigned)tokv[(4 * q + 3) % EPT]};
    } else if (have) tp[0] = tokv[0];
}
__device__ __forceinline__ void ph_route(Frame& F, bool last) {
    unsigned char* const ws_ = launder_ws(F.ws);
    const int nunits = last ? 32 : 64;
    for (int u = F.bid; u < nunits; u += F.G) {
        if (u < 32) { const int b = u >> 4, e = u & 15; route_unit<SEQ, CAPX>(F, (const float*)(ws_ + WS_AFF) + (size_t)u * SEQ, e, b * SEQ, e * SLOTS_E + b * CAPX); }
        else { const int uc = u - 32, b = uc >> 4, e = uc & 15; route_unit<LCTX, CAPC>(F, (const float*)(ws_ + WS_AFFC) + (size_t)uc * LCTX, e, NX + b * LCTX, e * SLOTS_E + 2 * CAPX + b * CAPC);
            if (b == 0 && F.tid < 192) { ((int*)(ws_ + WS_IDX))[e * SLOTS_E + 2 * CAPX + 2 * CAPC + F.tid] = 0; ((float*)(ws_ + WS_GATE))[e * SLOTS_E + 2 * CAPX + 2 * CAPC + F.tid] = 0.f; } }
    }
}
__device__ __forceinline__ void ln_pair(f32x4 (&v)[2][4]) {
    float s[2], q[2];
#pragma unroll
    for (int r = 0; r < 2; ++r) { s[r] = 0.f; q[r] = 0.f;
#pragma unroll
        for (int j = 0; j < 4; ++j) { s[r] += (v[r][j].x + v[r][j].y) + (v[r][j].z + v[r][j].w); q[r] += (v[r][j].x * v[r][j].x + v[r][j].y * v[r][j].y) + (v[r][j].z * v[r][j].z + v[r][j].w * v[r][j].w); } }
    s[0] = wave_sum(s[0]); s[1] = wave_sum(s[1]); q[0] = wave_sum(q[0]); q[1] = wave_sum(q[1]);
#pragma unroll
    for (int r = 0; r < 2; ++r) { const float mean = s[r] * (1.f / 1024.f), var = fmaxf(q[r] * (1.f / 1024.f) - mean * mean, 0.f), rstd = 1.f / sqrtf(var + LN_EPS);
        const float nmr = -mean * rstd;
#pragma unroll
        for (int j = 0; j < 4; ++j) v[r][j] = v[r][j] * rstd + nmr; }
}
__device__ __forceinline__ void ph_rows_mid2(Frame& F, int l, bool last) {
    unsigned char* const ws_ = launder_ws(F.ws);
    KArgs ka = kargs();
    const float* MOD = (const float*)(ws_ + WS_MOD); const bf16* YMIX = (const bf16*)(ws_ + WS_YMIX);
    float* XMID = (float*)(ws_ + WS_XMID); bf16* H2 = (bf16*)(ws_ + WS_HX);
    const float* g1_ = ka->in[27] + l * 1024; const float* b1_ = ka->in[28] + l * 1024; const float* wr_ = ka->in[29] + (size_t)l * 1024 * 16;
    float* AFF = (float*)(ws_ + WS_AFF); float* AFFC = (float*)(ws_ + WS_AFFC);
    LAS float* Wp = (LAS float*)F.lds;
    const int lane = F.lane, nrows = last ? NX : NR;
    __syncthreads();
    for (int i = F.tid; i < 16 * 4 * 64; i += NTHREADS) { const int ji = i >> 8, q = (i >> 6) & 3, ln = i & 63, d = 4 * ln + 256 * (ji >> 2) + (ji & 3);
        *(LAS f32x4*)(Wp + (size_t)i * 4) = *(const f32x4*)(wr_ + (size_t)d * 16 + 4 * q); }
    __syncthreads();
    for (int r0 = 2 * F.gw; r0 < nrows; r0 += 2 * F.NGW) {
        const float* g1 = opq(g1_); const float* b1 = opq(b1_);
        const float* m = MOD + (l * 3 + row_mod_index(r0)) * 6144;
        f32x4 v[2][4];
#pragma unroll
        for (int r = 0; r < 2; ++r) { const int rr = r0 + r;
            const float* src = (l == 0) ? (rr < NX ? ka->in[0] + (size_t)rr * 1024 : ka->in[2] + (size_t)(rr - NX) * 1024) : (const float*)(ws_ + WS_XCUR) + (size_t)rr * 1024;
            f32x4 y[4]; row_load(src, lane, v[r]);
#pragma unroll
            for (int j = 0; j < 4; ++j) { const v2u w = ((const v2u*)(YMIX + (size_t)rr * 1024))[lane + 64 * j]; y[j] = (f32x4){bflo(w.x), bfhi(w.x), bflo(w.y), bfhi(w.y)}; }
#pragma unroll
            for (int j = 0; j < 4; ++j) { const f32x4 gt = ((const f32x4*)(m + 2048))[lane + 64 * j]; v[r][j] = v[r][j] * ALPHA + gt * y[j]; } }
        ln_pair(v);
#pragma unroll
        for (int j = 0; j < 4; ++j) { const f32x4 gg = ((const f32x4*)g1)[lane + 64 * j], bb = ((const f32x4*)b1)[lane + 64 * j];
#pragma unroll
            for (int r = 0; r < 2; ++r) v[r][j] = v[r][j] * gg + bb; }
        ln_pair(v);
#pragma unroll
        for (int j = 0; j < 4; ++j) { const f32x4 sh = ((const f32x4*)(m + 3072))[lane + 64 * j], sc = ((const f32x4*)(m + 4096))[lane + 64 * j];
#pragma unroll
            for (int r = 0; r < 2; ++r) v[r][j] = v[r][j] * (sc + 1.f) + sh; }
#pragma unroll
        for (int rr_ = 0; rr_ < 2; ++rr_)
#pragma unroll
            for (int j = 0; j < 4; ++j) ((unsigned*)((unsigned char*)H2 + (size_t)(r0 + rr_) * 1024))[lane + 64 * j] = pack4_fp8(v[rr_][j].x, v[rr_][j].y, v[rr_][j].z, v[rr_][j].w);
        __builtin_amdgcn_sched_barrier(0);
        typedef float f32x2 __attribute__((ext_vector_type(2)));
        f32x2 lg2[2][8];
#pragma unroll
        for (int r = 0; r < 2; ++r)
#pragma unroll
            for (int e = 0; e < 8; ++e) lg2[r][e] = (f32x2){0.f, 0.f};
#pragma unroll
        for (int j = 0; j < 4; ++j)
#pragma unroll
            for (int i = 0; i < 4; ++i) { const LAS float* wp = Wp + ((size_t)((j * 4 + i) * 4) * 64 + lane) * 4; const f32x2 h0 = (f32x2){v[0][j][i], v[0][j][i]}, h1 = (f32x2){v[1][j][i], v[1][j][i]};
#pragma unroll
                for (int q = 0; q < 4; ++q) { const f32x4 w = *(const LAS f32x4*)(wp + q * 256); const f32x2 wa = (f32x2){w.x, w.y}, wb = (f32x2){w.z, w.w};
                    lg2[0][2 * q] = __builtin_elementwise_fma(h0, wa, lg2[0][2 * q]); lg2[0][2 * q + 1] = __builtin_elementwise_fma(h0, wb, lg2[0][2 * q + 1]);
                    lg2[1][2 * q] = __builtin_elementwise_fma(h1, wa, lg2[1][2 * q]); lg2[1][2 * q + 1] = __builtin_elementwise_fma(h1, wb, lg2[1][2 * q + 1]); }
                if (i & 1) __builtin_amdgcn_sched_barrier(0); }
        float lg[2][16];
#pragma unroll
        for (int r = 0; r < 2; ++r)
#pragma unroll
            for (int e = 0; e < 16; ++e) lg[r][e] = lg2[r][e >> 1][e & 1];
        float fin[2];
#pragma unroll
        for (int r = 0; r < 2; ++r) {
            float a8[8], a4[4], a2[2];
            { const bool s = lane & 8;
#pragma unroll
              for (int e = 0; e < 8; ++e) { const float keep = s ? lg[r][e + 8] : lg[r][e], send = s ? lg[r][e] : lg[r][e + 8]; a8[e] = keep + dppf<DPP_RM>(send); } }
            { const bool s = lane & 4;
#pragma unroll
              for (int e = 0; e < 4; ++e) { const float keep = s ? a8[e + 4] : a8[e], send = s ? a8[e] : a8[e + 4]; a4[e] = keep + dppf<DPP_HM>(send); } }
            { const bool s = lane & 2;
#pragma unroll
              for (int e = 0; e < 2; ++e) { const float keep = s ? a4[e + 2] : a4[e], send = s ? a4[e] : a4[e + 2]; a2[e] = keep + dppf<DPP_X2>(send); } }
            { const bool s = lane & 1; const float keep = s ? a2[1] : a2[0], send = s ? a2[0] : a2[1]; fin[r] = xrow_sum(keep + dppf<DPP_X1>(send)); }
        }
        const int e = lane & 15;
#pragma unroll
        for (int r = 0; r < 2; ++r) { const float mx = row_max16(fin[r]);
            const float ex = expf(fin[r] - mx); const float den = row_sum16(ex);
            const int rr = r0 + r;
            if (lane < 16) { if (rr < NX) AFF[((size_t)(rr >> 13) * 16 + e) * SEQ + (rr & (SEQ - 1))] = ex / den; else AFFC[((size_t)((rr - NX) >> 8) * 16 + e) * LCTX + ((rr - NX) & (LCTX - 1))] = ex / den; } }
    }
}
__device__ __forceinline__ void ph_rows_final2(Frame& F, int l, bool last) {
    unsigned char* const ws_ = launder_ws(F.ws);
    KArgs ka = kargs();
    const float* MOD = (const float*)(ws_ + WS_MOD); const bf16* YMIX = (const bf16*)(ws_ + WS_YMIX);
    const int* TOK = (const int*)(ws_ + WS_TOKSLOT); const float* GATE = (const float*)(ws_ + WS_GATE); const bf16* YE = (const bf16*)(ws_ + WS_YEXP);
    const float* g1_ = ka->in[27] + l * 1024; const float* b1_ = ka->in[28] + l * 1024;
    const float* g2_ = ka->in[33] + l * 1024; const float* b2_ = ka->in[34] + l * 1024;
    const int lane = F.lane, nrows = last ? NX : NR;
    for (int r0 = 2 * F.gw; r0 < nrows; r0 += 2 * F.NGW) {
        const float* g1 = opq(g1_); const float* b1 = opq(b1_); const float* g2 = opq(g2_); const float* b2 = opq(b2_);
        const float* m = MOD + (l * 3 + row_mod_index(r0)) * 6144;
        f32x4 v[2][4];
#pragma unroll
        for (int r = 0; r < 2; ++r) { const int rr = r0 + r;
            const float* src = (l == 0) ? (rr < NX ? ka->in[0] + (size_t)rr * 1024 : ka->in[2] + (size_t)(rr - NX) * 1024) : (const float*)(ws_ + WS_XCUR) + (size_t)rr * 1024;
            f32x4 y[4]; row_load(src, lane, v[r]);
#pragma unroll
            for (int j = 0; j < 4; ++j) { const v2u w = ((const v2u*)(YMIX + (size_t)rr * 1024))[lane + 64 * j]; y[j] = (f32x4){bflo(w.x), bfhi(w.x), bflo(w.y), bfhi(w.y)}; }
#pragma unroll
            for (int j = 0; j < 4; ++j) { const f32x4 gt = ((const f32x4*)(m + 2048))[lane + 64 * j]; v[r][j] = v[r][j] * ALPHA + gt * y[j]; } }
        ln_pair(v);
#pragma unroll
        for (int j = 0; j < 4; ++j) { const f32x4 gg = ((const f32x4*)g1)[lane + 64 * j], bb = ((const f32x4*)b1)[lane + 64 * j];
#pragma unroll
            for (int r = 0; r < 2; ++r) v[r][j] = v[r][j] * gg + bb; }
        __builtin_amdgcn_sched_barrier(0);
#pragma unroll
        for (int r = 0; r < 2; ++r) { const int rr = r0 + r;
            int sl = -1; float gv = 0.f; if (lane < 16) { sl = TOK[(size_t)lane * NR + rr]; if (sl >= 0) gv = GATE[sl]; }
            f32x4 mo[4];
#pragma unroll
            for (int j = 0; j < 4; ++j) mo[j] = (f32x4){0.f, 0.f, 0.f, 0.f};
            unsigned long long bal = __ballot(sl >= 0);
            while (bal) { const int e = __builtin_ctzll(bal); bal &= bal - 1; const int s = __shfl(sl, e); const float g = __shfl(gv, e);
                const v2u* yp = (const v2u*)(YE + (size_t)s * 1024);
#pragma unroll
                for (int j = 0; j < 4; ++j) { const v2u w = yp[lane + 64 * j]; mo[j].x += g * bflo(w.x); mo[j].y += g * bfhi(w.x); mo[j].z += g * bflo(w.y); mo[j].w += g * bfhi(w.y); } }
#pragma unroll
            for (int j = 0; j < 4; ++j) { const f32x4 gt = ((const f32x4*)(m + 5120))[lane + 64 * j]; v[r][j] = v[r][j] * ALPHA + gt * mo[j]; } }
        ln_pair(v);
#pragma unroll
        for (int j = 0; j < 4; ++j) { const f32x4 gg = ((const f32x4*)g2)[lane + 64 * j], bb = ((const f32x4*)b2)[lane + 64 * j];
#pragma unroll
            for (int r = 0; r < 2; ++r) { v[r][j] = v[r][j] * gg + bb;
                float* dst = last ? ka->out + (size_t)(r0 + r) * 1024 : (float*)(ws_ + WS_XCUR) + (size_t)(r0 + r) * 1024; ((f32x4*)dst)[lane + 64 * j] = v[r][j]; } }
        if (!last) { ln_pair(v); const float* m1 = MOD + ((l + 1) * 3 + row_mod_index(r0)) * 6144;
            modulate_store(v[0], m1, m1 + 1024, (bf16*)(ws_ + WS_HX) + (size_t)r0 * 1024, lane); modulate_store(v[1], m1, m1 + 1024, (bf16*)(ws_ + WS_HX) + (size_t)(r0 + 1) * 1024, lane); }
    }
}
#define XB_TMO      128
#define XB_XCNT(j)  (256  + 64 * (j))
#define XB_XSUB(j)  (1280 + 64 * (j))
#define XB_XGEN(j)  (2304 + 64 * (j))
#define XB_TOP      3328
#define XB_TOPGEN   3392
#define XCD_BAR_WORDS 3456
#define XB_SPIN_CAP (1u << 18)

__device__ __forceinline__ unsigned xb_ld(unsigned* p)              { return __hip_atomic_load(p, __ATOMIC_RELAXED, __HIP_MEMORY_SCOPE_AGENT); }
__device__ __forceinline__ unsigned xb_add(unsigned* p, unsigned v) { return __hip_atomic_fetch_add(p, v, __ATOMIC_RELAXED, __HIP_MEMORY_SCOPE_AGENT); }
__device__ __forceinline__ unsigned xb_xcc_id() { return (unsigned)__builtin_amdgcn_s_getreg((3 << 11) | 20) & 0xFu; }
#define XB_SPIN(cond, bar) do { unsigned _sp = 0; while (cond) { __builtin_amdgcn_s_sleep(1); \
    if ((++_sp & 255u) == 0u) { if (xb_ld(&(bar)[XB_TMO])) break; if (_sp > XB_SPIN_CAP) { atomicAdd(&(bar)[XB_TMO], 1u); break; } } } } while (0)

struct XcdBarrier {
    unsigned* bar; unsigned x;
    volatile LAS unsigned* st;
    int wv;
};

__device__ __forceinline__ XcdBarrier xcd_barrier_post(unsigned* bar, volatile LAS unsigned* st) {
    XcdBarrier b; b.bar = bar; b.x = xb_xcc_id(); b.st = st;
    if (threadIdx.x == 0) (void)xb_add(&bar[XB_XCNT(b.x)], 1u);
    return b;
}
__device__ __forceinline__ void xcd_barrier_complete(unsigned* bar, unsigned x, unsigned& nloc, unsigned& nx) {
    const unsigned G = gridDim.x * gridDim.y * gridDim.z;
    unsigned sum, cnt, mine, sp = 0u;
    for (;;) {
        sum = 0u; cnt = 0u; mine = 0u;
#pragma unroll
        for (unsigned j = 0; j < 16; ++j) { const unsigned c = xb_ld(&bar[XB_XCNT(j)]); sum += c; cnt += (c > 0u) ? 1u : 0u; mine = (j == x) ? c : mine; }
        if (sum == G) break;
        __builtin_amdgcn_s_sleep(1);
        if ((++sp & 255u) == 0u) { if (xb_ld(&bar[XB_TMO])) break; if (sp > XB_SPIN_CAP) { atomicAdd(&bar[XB_TMO], 1u); break; } }
    }
    nloc = mine > 0u ? mine : 1u; nx = cnt > 0u ? cnt : 1u;
}

__device__ __forceinline__ void xcd_barrier(const XcdBarrier& b) {
    asm volatile("s_waitcnt vmcnt(0)" ::: "memory");
    __syncthreads();
    if (b.wv == 0 && pg8::lane_id() == 0) {
        unsigned* bar = b.bar;
        __builtin_amdgcn_s_waitcnt(0);
        unsigned nloc = b.st[0], nx = b.st[1];
        if (nloc == 0u) { xcd_barrier_complete(bar, b.x, nloc, nx); b.st[0] = nloc; b.st[1] = nx; }
        const unsigned old = xb_add(&bar[XB_XSUB(b.x)], 1u);
        const unsigned gen = old / nloc;
        if (old + 1u == (gen + 1u) * nloc) {
            __builtin_amdgcn_fence(__ATOMIC_RELEASE, "agent");
            asm volatile("s_waitcnt vmcnt(0)" ::: "memory");
            const unsigned og = xb_add(&bar[XB_TOP], 1u);
            const unsigned tg = og / nx;
            if (og + 1u == (tg + 1u) * nx) xb_add(&bar[XB_TOPGEN], 1u);
            else XB_SPIN(xb_ld(&bar[XB_TOPGEN]) == tg, bar);
            __builtin_amdgcn_fence(__ATOMIC_ACQUIRE, "agent");
            xb_add(&bar[XB_XGEN(b.x)], 1u);
            asm volatile("s_waitcnt vmcnt(0)" ::: "memory");
        } else {
            XB_SPIN(xb_ld(&bar[XB_XGEN(b.x)]) == gen, bar);
            __builtin_amdgcn_fence(__ATOMIC_ACQUIRE, "agent");
            asm volatile("s_waitcnt vmcnt(0)" ::: "memory");
        }
    }
    __syncthreads();
}

#ifndef MK_SPLIT
#define MK_SPLIT 0
#endif
#ifndef DUP_MASK
#define DUP_MASK 0u
#endif
#ifndef DUP_CNT
#define DUP_CNT 2
#endif
#define NREP(n) (((DUP_MASK >> (n)) & 1u) ? DUP_CNT : 1)
#define NREPP(n) (((DUP_MASK >> (16 + (n))) & 1u) ? 2 : 1)
constexpr int PPL = 11, NPH = 2 + PPL * DEPTH;
constexpr size_t WS_BAR = 0;
constexpr int MISC_OFF = LDS_BYTES - 64;
__device__ __forceinline__ void grid_seam(int k, int wv) {
    if (k + 1 >= kargs()->ph_hi) return;
    extern __shared__ __attribute__((aligned(16))) unsigned char lds[];
    XcdBarrier b; b.bar = (unsigned*)(kargs()->ws + WS_BAR); b.x = xb_xcc_id(); b.st = (volatile LAS unsigned*)((LAS unsigned char*)lds + MISC_OFF); b.wv = wv;
    xcd_barrier(b);
}
#define SEAM(k) grid_seam(k, wv)
#define IN(k) (kargs()->ph_lo <= (k) && (k) < kargs()->ph_hi)
__device__ __forceinline__ Frame make_frame(int wv) {
    extern __shared__ __attribute__((aligned(16))) unsigned char lds[];
    KArgs ka = kargs(); Frame F;
    F.lds = (LAS unsigned char*)lds; { int t_ = wv * 64 + pg8::lane_id(); asm volatile("" : "+v"(t_)); F.tid = t_; } F.lane = F.tid & 63; F.wave = wv;
    F.bid = blockIdx.x; F.G = ka->G; F.gw = F.bid * NWAVES + F.wave; F.NGW = F.G * NWAVES; F.ws = ka->ws; return F;
}
template <int l> __device__ __forceinline__ void run_layer(const int wv) {
        const bool last = (l == DEPTH - 1); const int k0 = 2 + PPL * l;
        if (IN(k0 + 0)) { for (int rep_ = 0; rep_ < NREP(0); ++rep_) { if (rep_) __syncthreads(); Frame F = make_frame(wv); unsigned char* const ws_ = F.ws;
            pg8::Gemm g{(const pg8::bf16_t*)(ws_ + WS_HX), (const pg8::bf16_t*)(ws_ + WS_WIN) + (size_t)l * INW * DM, NR, INW, DM, DM, DM};
            g.wv = F.wave;
            pg8::InProjOrder S; S.init(0, 256, F.G, F.bid);
            pg8::EpiInProj E{(const float*)(ws_ + WS_BINP) + l * INW, (const float*)(ws_ + WS_ROPE), (pg8::bf16_t*)(ws_ + WS_Q), (pg8::bf16_t*)(ws_ + WS_K), (pg8::bf16_t*)(ws_ + WS_V), (pg8::bf16_t*)(ws_ + WS_UC), (pg8::bf16_t*)(ws_ + WS_HG)};
            pg8::gemm_phase<pg8::EpiInProj, pg8::InProjOrder, PG8_ALIGN, PG8_SP2>(F.lds, g, S, E);
            } SEAM(k0 + 0); }
        if (IN(k0 + 1)) { for (int rep_ = 0; rep_ < NREP(1); ++rep_) { if (rep_) __syncthreads(); Frame F = make_frame(wv); unsigned char* const ws_ = F.ws;
            const int GB = (F.G * 140) / 256, nl = F.G - GB;
            if (F.bid < GB) {
                pg8::Gemm g{(const pg8::bf16_t*)(ws_ + WS_HX), (const pg8::bf16_t*)(ws_ + WS_WIN) + (size_t)l * INW * DM, NR, INW, DM, DM, DM};
                g.wv = F.wave;
                pg8::InProjOrder S; S.init(256, 140, GB, F.bid);
                pg8::EpiInProj E{(const float*)(ws_ + WS_BINP) + l * INW, (const float*)(ws_ + WS_ROPE), (pg8::bf16_t*)(ws_ + WS_Q), (pg8::bf16_t*)(ws_ + WS_K), (pg8::bf16_t*)(ws_ + WS_V), (pg8::bf16_t*)(ws_ + WS_UC), (pg8::bf16_t*)(ws_ + WS_HG)};
                pg8::gemm_phase<pg8::EpiInProj, pg8::InProjOrder, PG8_ALIGN, PG8_SP2>(F.lds, g, S, E);
            } else { const int w = F.bid - GB;
                if (w < 48) {
                    pg8::Gemm g{(const pg8::bf16_t*)(ws_ + WS_UC), (const pg8::bf16_t*)(ws_ + WS_BE) + (size_t)l * 16 * 256 * 512, 16 * S5R, 16 * 256, 512, S5K, 512};
                    g.wv = F.wave;
                    pg8::MoeOrder S; S.init(3, 1, 3, 16, nl < 48 ? nl : 48, w);
                    pg8::EpiF32G E{(float*)(ws_ + WS_E), 256, 1};
                    pg8::gemm_phase<pg8::EpiF32G, pg8::MoeOrder, PG8_ALIGN, PG8_SP2>(F.lds, g, S, E); }
                ph_conv(F, l, 0, last ? 256 : 264, 0, 0, (unsigned*)(ws_ + WS_CTR) + 4 + l);
            }
            } SEAM(k0 + 1); }
        if (IN(k0 + 2)) { for (int rep_ = 0; rep_ < NREP(2); ++rep_) { if (rep_) __syncthreads(); Frame F = make_frame(wv); unsigned char* const ws_ = F.ws;
            { pg8::Gemm g{(const pg8::bf16_t*)(ws_ + WS_UC), (const pg8::bf16_t*)(ws_ + WS_KT) + (size_t)l * 16 * 512 * S5K, 16 * S5R, 16 * 512, S5K, S5K, S5K};
            g.wv = F.wave;
            const bool twin = F.G >= 224 && F.bid >= 128 && F.bid < 224;
            pg8::MoeOrder S; S.init(3, 2, 3, 16, F.G, twin ? F.bid - 128 : F.bid);
            pg8::EpiS5Y E{(pg8::bf16_t*)(ws_ + WS_Z), (F.G >= 224) ? (twin ? 1 : 0) : -1};
            pg8::Unit u0;
            if ((twin || F.bid < 128) && S.next(0, u0)) { s5_carry_tile(F, l, u0.pm / 3, u0.pm % 3);
                pg8::gemm_phase<pg8::EpiS5Y, pg8::MoeOrder, PG8_ALIGN, PG8_SP2>(F.lds, g, S, E); }
            else if (!last && F.bid >= 96 && F.bid < 104) ph_attn(F, l, 256, 264, F.bid - 96, 8); }
            { Frame F2 = make_frame(wv); ph_attn(F2, l, 0, 256, F2.bid, F2.G); }
            } SEAM(k0 + 2); }
        if (IN(k0 + 4)) { for (int rep_ = 0; rep_ < NREP(4); ++rep_) { if (rep_) __syncthreads(); Frame F = make_frame(wv); unsigned char* const ws_ = F.ws;
            pg8::Gemm g{(const pg8::bf16_t*)(ws_ + WS_Z), (const pg8::bf16_t*)(ws_ + WS_WPT) + (size_t)l * 2 * 65536, 2 * NR, 512, 256, 256, 256};
            g.wv = F.wave;
            pg8::MoeOrder S; S.init(last ? 64 : 66, 1, 66, 2, F.G, F.bid);
            pg8::EpiPW E{(pg8::bf16_t*)(ws_ + WS_CAT), (const pg8::bf16_t*)(ws_ + WS_Z), kargs()->in[18] + l * 256, kargs()->in[24] + l * 256, 66};
            pg8::gemm_phase<pg8::EpiPW, pg8::MoeOrder, PG8_ALIGN, PG8_SP2>(F.lds, g, S, E);
            } SEAM(k0 + 4); }
        if (IN(k0 + 5)) { for (int rep_ = 0; rep_ < NREP(5); ++rep_) { if (rep_) __syncthreads(); Frame F = make_frame(wv); unsigned char* const ws_ = F.ws;
            pg8::Gemm g{(const pg8::bf16_t*)(ws_ + WS_CAT), (const pg8::bf16_t*)(ws_ + WS_WOUT) + (size_t)l * DM * DM, NR, DM, DM, DM, DM};
            g.wv = F.wave;
            pg8::StaticOrder S; S.init(last ? NX : NR, DM, F.G, F.bid);
            pg8::EpiBf16B E{(pg8::bf16_t*)(ws_ + WS_YMIX), DM, kargs()->in[26] + l * DM};
            pg8::gemm_phase<pg8::EpiBf16B, pg8::StaticOrder, PG8_ALIGN, PG8_SP2>(F.lds, g, S, E);
            } SEAM(k0 + 5); }
        if (IN(k0 + 6)) { for (int rep_ = 0; rep_ < NREP(6); ++rep_) { if (rep_) __syncthreads(); { Frame F = make_frame(wv); ph_rows_mid2(F, l, last); } } SEAM(k0 + 6); }
        if (IN(k0 + 7)) { for (int rep_ = 0; rep_ < NREP(7); ++rep_) { if (rep_) __syncthreads(); { Frame F = make_frame(wv); ph_route(F, last); } } SEAM(k0 + 7); }
        const int MT = last ? 8 : 9;
        if (IN(k0 + 8)) { for (int rep_ = 0; rep_ < NREP(8); ++rep_) { if (rep_) __syncthreads(); Frame F = make_frame(wv); unsigned char* const ws_ = F.ws;
            pg8::Gemm g{(const pg8::bf16_t*)(ws_ + WS_HX), (const pg8::bf16_t*)(ws_ + WS_WGU + (size_t)l * NE * 4096 * 1024), NSLOT, NE * 4096, 512, 512, 512};
            g.wv = F.wave;
            pg8::MoeOrder S; S.init(MT, 16, 9, NE, F.G, F.bid, last ? -1 : 8);
            pg8::EpiSwiGLU8 E{ws_ + WS_HID, FF, 16, last ? -1 : 8, 9};
            pg8::gemm_phase_g8<pg8::EpiSwiGLU8, pg8::MoeOrder, PG8_ALIGN, PG8_SP2>(F.lds, g, S, E, (const int*)(ws_ + WS_IDX), 0x7a7a7a7a, 0x7f7f7f7f);
            } SEAM(k0 + 8); }
        if (IN(k0 + 9)) { for (int rep_ = 0; rep_ < NREP(9); ++rep_) { if (rep_) __syncthreads(); Frame F = make_frame(wv); unsigned char* const ws_ = F.ws;
            pg8::Gemm g{(const pg8::bf16_t*)(ws_ + WS_HID), (const pg8::bf16_t*)(ws_ + WS_WD + (size_t)l * NE * DM * FF), NSLOT, NE * DM, 1024, 1024, 1024};
            g.wv = F.wave;
            pg8::MoeOrder S; S.init(MT, 4, 9, NE, F.G, F.bid, last ? -1 : 8, !last);
            pg8::EpiBf16P E{(pg8::bf16_t*)(ws_ + WS_YEXP), DM, 4};
            pg8::gemm_phase_8<pg8::EpiBf16P, pg8::MoeOrder, PG8_ALIGN, PG8_SP2>(F.lds, g, S, E, 0x79797979, 0x7d7d7d7d);
            } SEAM(k0 + 9); }
        if (IN(k0 + 10)) { for (int rep_ = 0; rep_ < NREP(10); ++rep_) { if (rep_) __syncthreads(); { Frame F = make_frame(wv); ph_rows_final2(F, l, last); } } SEAM(k0 + 10); }
    }
__global__ void __launch_bounds__(NTHREADS, 2) mk_fwd(Args a) {
    { extern __shared__ __attribute__((aligned(16))) unsigned char lds[];
      if (threadIdx.x < 16) ((LAS unsigned*)((LAS unsigned char*)lds + MISC_OFF))[threadIdx.x] = 0u;
      __syncthreads();
      if (threadIdx.x == 0) (void)xb_add((unsigned*)(kargs()->ws + WS_BAR) + XB_XCNT(xb_xcc_id()), 1u); }
    int wv = __builtin_amdgcn_readfirstlane((int)(threadIdx.x >> 6)); asm volatile("" : "+s"(wv));
    if (kargs()->ph_hi < 0) cg::this_grid().sync();
    if (IN(0)) { for (int rep_ = 0; rep_ < NREPP(0); ++rep_) { if (rep_) __syncthreads(); Frame F = make_frame(wv); ph_prologue(F); } SEAM(0); }
    if (IN(1)) { for (int rep_ = 0; rep_ < NREPP(1); ++rep_) { if (rep_) __syncthreads(); Frame F = make_frame(wv); ph_rows0(F); } SEAM(1); }
    run_layer<0>(wv);
    run_layer<1>(wv);
}
#undef IN
#undef SEAM

extern "C" void kernel_launch(void* const* d_in, const int* in_sizes, int n_in, void* d_out, int out_size, void* d_ws, size_t ws_size, hipStream_t stream) {
    static int grid_blocks = 0;
    if (!grid_blocks) {
        int dev = 0, cus = 0, per_cu = 0;
        (void)hipGetDevice(&dev);
        (void)hipDeviceGetAttribute(&cus, hipDeviceAttributeMultiprocessorCount, dev);
        (void)hipFuncSetAttribute((const void*)mk_fwd, hipFuncAttributeMaxDynamicSharedMemorySize, LDS_BYTES);
        (void)hipOccupancyMaxActiveBlocksPerMultiprocessor(&per_cu, (const void*)mk_fwd, NTHREADS, LDS_BYTES);
        grid_blocks = (per_cu >= 1 && cus > 0) ? cus : -1;
        if (n_in != 35 || ws_size < WS_END) { fprintf(stderr, "kernel_launch: unexpected n_in %d or ws_size %zu (need %zu)\n", n_in, ws_size, (size_t)WS_END); grid_blocks = -1; }
        fprintf(stderr, "kernel_launch: cus %d per_cu %d ws %zu\n", cus, per_cu, ws_size);
    }
    if (grid_blocks < 0) return;
    (void)hipMemsetAsync((char*)d_ws + WS_BAR, 0, 32 * KiB, stream);
    Args a{};
    for (int i = 0; i < 35; ++i) a.in[i] = (const float*)d_in[i];
    a.out = (float*)d_out; a.ws = (unsigned char*)d_ws; a.G = grid_blocks;
#if MK_SPLIT
    for (int p = 0; p < NPH; ++p) { a.ph_lo = p; a.ph_hi = p + 1; void* args[] = {&a};
        hipError_t e = hipLaunchCooperativeKernel((const void*)mk_fwd, dim3(grid_blocks), dim3(NTHREADS), args, LDS_BYTES, stream);
        if (e != hipSuccess) { fprintf(stderr, "launch failed: %s\n", hipGetErrorString(e)); break; } }
#else
    a.ph_lo = 0; a.ph_hi = NPH; void* args[] = {&a};
    hipError_t e = hipLaunchCooperativeKernel((const void*)mk_fwd, dim3(grid_blocks), dim3(NTHREADS), args, LDS_BYTES, stream);
    if (e != hipSuccess) fprintf(stderr, "cooperative launch failed: %s (grid %d)\n", hipGetErrorString(e), grid_blocks);
#endif
}
```
